# Optimizing an MI355X kernel written in HIP

```python
import math
import jax, jax.numpy as jnp
from jax import lax
import numpy as np

D_MODEL = 1024
BATCH = 4
SEQ = 8192
DEPTH = 2

HG_HEADS = 4
HG_DK = 128
HG_DV = 128
HG_KWIDTH = HG_HEADS * HG_DK
HG_WIDTH = HG_HEADS * HG_DV
HG_CHUNK = 64
NSA_HEADS = 8
NSA_GROUPS = 2
NSA_HPG = NSA_HEADS // NSA_GROUPS
NSA_DH = 64
NSA_WIDTH = NSA_HEADS * NSA_DH
KV_WIDTH = NSA_GROUPS * NSA_DH
CMP_LEN = 32
CMP_STRIDE = 16
CMP_HIDDEN = 2 * NSA_DH
SEL_BLOCK = 64
N_SEL = 16
WINDOW = 512
Q_BLOCK = 128
FORCE_SCORE = 1e9
NEG_BIG = -1e30
REL_BUCKETS = 32
REL_MAX_DIST = 2048
D_FF = 2752
N_EXPERTS = 8
TOP_K = 2
D_FF_EXPERT = 3584
MOE_ROW_BLOCK = 512
N_DENSE = (DEPTH + 1) // 2
N_MOE = DEPTH // 2
DN_ALPHA = (2 * DEPTH) ** 0.25
DN_BETA = (8 * DEPTH) ** -0.25
LN_EPS = 1e-5
IN_SIZES = (HG_KWIDTH, HG_KWIDTH, HG_WIDTH, HG_WIDTH, NSA_WIDTH,
            KV_WIDTH, KV_WIDTH, KV_WIDTH, KV_WIDTH, KV_WIDTH, KV_WIDTH,
            3 * NSA_HEADS, D_MODEL, D_MODEL)
IN_WIDTH = sum(IN_SIZES)
VALUE_SLOTS = (2, 6, 8, 10)

kernel_name = "hgrn2_nsa_gated_hybrid_deepnorm_moe"


def layer_norm(x, g, b):
    xf = x.astype(jnp.float32)
    mu = jnp.mean(xf, -1, keepdims=True)
    var = jnp.mean(jnp.square(xf - mu), -1, keepdims=True)
    return ((xf - mu) * lax.rsqrt(var + LN_EPS) * g + b).astype(x.dtype)


def rel_bucket(dist):
    n = jnp.maximum(dist, 0)
    exact = REL_BUCKETS // 2
    large = exact + (jnp.log(jnp.maximum(n, exact).astype(jnp.float32) / exact)
                     / math.log(REL_MAX_DIST / exact) * (REL_BUCKETS - exact)).astype(jnp.int32)
    return jnp.where(n < exact, n, jnp.minimum(large, REL_BUCKETS - 1))


def masked_softmax(logits, mask):
    logits = jnp.where(mask, logits, NEG_BIG)
    m = jnp.max(logits, -1, keepdims=True)
    p = jnp.where(mask, jnp.exp(logits - m), 0.0)
    return p / jnp.maximum(jnp.sum(p, -1, keepdims=True), 1e-30)


def hgrn2_mix(q, f_logit, i, g, lb, norm_w):
    B, S, _ = q.shape
    f32 = jnp.float32
    nc = S // HG_CHUNK
    lb = lb.astype(f32)
    k = (1.0 - lb) * jax.nn.sigmoid(-f_logit.astype(f32))
    log_f = jnp.log1p(-k)

    def to_chunks(t, d):
        return t.astype(f32).reshape(B, nc, HG_CHUNK, HG_HEADS, d).transpose(1, 0, 3, 2, 4)

    qc, kc, vc = to_chunks(q, HG_DK), to_chunks(k, HG_DK), to_chunks(i, HG_DV)
    bc = jnp.cumsum(to_chunks(log_f, HG_DK), axis=3)
    causal = jnp.tril(jnp.ones((HG_CHUNK, HG_CHUNK), bool))[:, :, None]

    def step(state, inp):
        qt, kt, vt, bt = inp
        o_inter = jnp.einsum('bhtd,bhdv->bhtv', qt * jnp.exp(bt), state)
        diff = jnp.where(causal, bt[:, :, :, None, :] - bt[:, :, None, :, :], NEG_BIG)
        att = jnp.einsum('bhtsd,bhsd->bhts', qt[:, :, :, None, :] * jnp.exp(diff), kt)
        o_intra = jnp.einsum('bhts,bhsv->bhtv', att, vt)
        b_last = bt[:, :, -1:, :]
        state = (jnp.exp(b_last[:, :, 0, :, None]) * state
                 + jnp.einsum('bhsd,bhsv->bhdv', kt * jnp.exp(b_last - bt), vt))
        return state, o_inter + o_intra

    s0 = jnp.zeros((B, HG_HEADS, HG_DK, HG_DV), f32)
    _, o = lax.scan(step, s0, (qc, kc, vc, bc))
    o = o.transpose(1, 0, 3, 2, 4).reshape(B, S, HG_HEADS, HG_DV)
    o = o * lax.rsqrt(jnp.mean(o * o, -1, keepdims=True) + 1e-6)
    o = o.reshape(B, S, HG_WIDTH) * norm_w * jax.nn.silu(g.astype(f32))
    return o.astype(q.dtype)


def compress_blocks(kv, pos, w1, w2):
    B, S = kv.shape[:2]
    nc = (S - CMP_LEN) // CMP_STRIDE + 1
    idx = np.arange(nc)[:, None] * CMP_STRIDE + np.arange(CMP_LEN)[None, :]
    blk = kv[:, idx] + pos[:, None, :]
    blk = blk.transpose(0, 3, 1, 2, 4).reshape(B, NSA_GROUPS, nc, CMP_LEN * NSA_DH)
    return jax.nn.gelu(blk @ w1) @ w2


def nsa_mix(q, kc_raw, vc_raw, ks, vs, kw, vw, gate_logit, cmp_pos, cmp_w1, cmp_w2, rel_bias):
    B, S, _ = q.shape
    f32 = jnp.float32
    G, P, dh = NSA_GROUPS, NSA_HPG, NSA_DH
    nc = (S - CMP_LEN) // CMP_STRIDE + 1
    ns = S // SEL_BLOCK
    n_sel = min(N_SEL, ns)
    scale = NSA_DH ** -0.5

    def kv_heads(t):
        return t.reshape(B, S, G, dh).transpose(0, 2, 1, 3)

    qh = q.reshape(B, S, G, P, dh).transpose(0, 2, 3, 1, 4)
    k_cmp = compress_blocks(kc_raw.reshape(B, S, G, dh), cmp_pos[0], cmp_w1[0], cmp_w2[0])
    v_cmp = compress_blocks(vc_raw.reshape(B, S, G, dh), cmp_pos[1], cmp_w1[1], cmp_w2[1]).astype(f32)
    ks_blk = kv_heads(ks).reshape(B, G, ns, SEL_BLOCK, dh)
    vs_blk = kv_heads(vs).reshape(B, G, ns, SEL_BLOCK, dh)
    pad = ((0, 0), (0, 0), (WINDOW, 0), (0, 0))
    kw_pad = jnp.pad(kv_heads(kw), pad)
    vw_pad = jnp.pad(kv_heads(vw), pad)
    gates = jax.nn.sigmoid(gate_logit.astype(f32)).reshape(B, S, G, P, 3).transpose(0, 2, 3, 1, 4)
    table = rel_bias.astype(f32).reshape(REL_BUCKETS, G, P).transpose(1, 0, 2)
    cmp_end = jnp.arange(nc) * CMP_STRIDE + CMP_LEN - 1
    cs = np.arange(nc)[:, None] * CMP_STRIDE
    ss = np.arange(ns)[None, :] * SEL_BLOCK
    overlap = np.clip(np.minimum(cs + CMP_LEN, ss + SEL_BLOCK) - np.maximum(cs, ss), 0, None) / CMP_LEN
    cmp_to_sel = jnp.asarray(overlap, f32)
    b_idx = jnp.arange(B)[:, None, None, None]
    g_idx = jnp.arange(G)[None, :, None, None]

    def bias_2d(dist):
        return table[:, rel_bucket(dist), :].transpose(0, 3, 1, 2)

    def block(qb):
        t0 = qb * Q_BLOCK
        tpos = t0 + jnp.arange(Q_BLOCK)
        qq = lax.dynamic_slice_in_dim(qh, t0, Q_BLOCK, axis=3)
        gg = lax.dynamic_slice_in_dim(gates, t0, Q_BLOCK, axis=3)
        dist_c = tpos[:, None] - cmp_end[None, :]
        lc = jnp.einsum('bgpqd,bgnd->bgpqn', qq, k_cmp, preferred_element_type=f32) * scale + bias_2d(dist_c)
        pc = masked_softmax(lc, dist_c >= 0)
        o_cmp = jnp.einsum('bgpqn,bgnd->bgpqd', pc, v_cmp)
        imp = jnp.einsum('bgpqn,ns->bgqs', pc, cmp_to_sel)
        sblk = jnp.arange(ns)[None, :]
        cur = (tpos // SEL_BLOCK)[:, None]
        forced = (sblk == 0) | (sblk == cur) | (sblk == cur - 1)
        score = jnp.where(forced, FORCE_SCORE, jnp.where(sblk <= cur, imp, NEG_BIG))
        _, sel = lax.top_k(score, n_sel)
        k_sel = ks_blk[b_idx, g_idx, sel].reshape(B, G, Q_BLOCK, n_sel * SEL_BLOCK, dh)
        v_sel = vs_blk[b_idx, g_idx, sel].reshape(B, G, Q_BLOCK, n_sel * SEL_BLOCK, dh).astype(f32)
        kpos = (sel[..., None] * SEL_BLOCK + jnp.arange(SEL_BLOCK)).reshape(B, G, Q_BLOCK, n_sel * SEL_BLOCK)
        dist_s = tpos[None, None, :, None] - kpos
        bias_s = table[g_idx, rel_bucket(dist_s)].transpose(0, 1, 4, 2, 3)
        ls = jnp.einsum('bgpqd,bgqkd->bgpqk', qq, k_sel, preferred_element_type=f32) * scale + bias_s
        ps = masked_softmax(ls, (dist_s >= 0)[:, :, None])
        o_sel = jnp.einsum('bgpqk,bgqkd->bgpqd', ps, v_sel)
        k_win = lax.dynamic_slice_in_dim(kw_pad, t0, WINDOW + Q_BLOCK, axis=2)
        v_win = lax.dynamic_slice_in_dim(vw_pad, t0, WINDOW + Q_BLOCK, axis=2).astype(f32)
        kpos_w = t0 - WINDOW + jnp.arange(WINDOW + Q_BLOCK)
        dist_w = tpos[:, None] - kpos_w[None, :]
        valid_w = (dist_w >= 0) & (dist_w < WINDOW) & (kpos_w[None, :] >= 0)
        lw = jnp.einsum('bgpqd,bgkd->bgpqk', qq, k_win, preferred_element_type=f32) * scale + bias_2d(dist_w)
        pw = masked_softmax(lw, valid_w)
        o_win = jnp.einsum('bgpqk,bgkd->bgpqd', pw, v_win)
        return gg[..., 0:1] * o_cmp + gg[..., 1:2] * o_sel + gg[..., 2:3] * o_win

    o = lax.map(block, jnp.arange(S // Q_BLOCK))
    o = o.transpose(1, 0, 4, 2, 3, 5).reshape(B, S, NSA_WIDTH)
    return o.astype(q.dtype)


def token_mixer(h, w_in, lb, hg_norm_w, cmp_pos, cmp_w1, cmp_w2, rel_bias, w_branch_a, w_branch_b, w_out):
    split_points = [int(c) for c in np.cumsum(IN_SIZES)[:-1]]
    proj = h @ w_in
    (hq, hf, hi, hg, nq, kcr, vcr, ksl, vsl, kwn, vwn, ngate, gate_a, gate_b) = jnp.split(proj, split_points, axis=-1)
    o_a = hgrn2_mix(hq, hf, hi, hg, lb, hg_norm_w)
    o_b = nsa_mix(nq, kcr, vcr, ksl, vsl, kwn, vwn, ngate, cmp_pos, cmp_w1, cmp_w2, rel_bias)
    y = jax.nn.sigmoid(gate_a) * (o_a @ w_branch_a) + jax.nn.sigmoid(gate_b) * (o_b @ w_branch_b)
    return y @ w_out


def swiglu(x, wg, wu, wd):
    return (jax.nn.silu(x @ wg) * (x @ wu)) @ wd


def moe_swiglu(x, w_router, wg, wu, wd):
    T, D = x.shape
    TK = T * TOP_K
    logits = jnp.matmul(x, w_router, preferred_element_type=jnp.float32)
    top_v, top_e = lax.top_k(logits, TOP_K)
    gate = jax.nn.softmax(top_v, -1).astype(x.dtype)
    flat_e = top_e.reshape(-1)
    flat_tok = jnp.arange(TK) // TOP_K
    order = jnp.argsort(flat_e)
    e_sorted = flat_e[order]
    tok_sorted = flat_tok[order]
    gate_sorted = gate.reshape(-1)[order]
    counts = jnp.bincount(flat_e, length=N_EXPERTS)
    padded = (counts + MOE_ROW_BLOCK - 1) // MOE_ROW_BLOCK * MOE_ROW_BLOCK
    start = jnp.cumsum(counts) - counts
    pstart = jnp.cumsum(padded) - padded
    dest = pstart[e_sorted] + jnp.arange(TK) - start[e_sorted]
    n_blocks = -(-(TK + N_EXPERTS * (MOE_ROW_BLOCK - 1)) // MOE_ROW_BLOCK)
    n_rows = n_blocks * MOE_ROW_BLOCK
    row_tok = jnp.zeros((n_rows,), jnp.int32).at[dest].set(tok_sorted)
    blk_e = jnp.minimum(jnp.searchsorted(jnp.cumsum(padded), jnp.arange(n_blocks) * MOE_ROW_BLOCK, side='right'),
                        N_EXPERTS - 1)
    xs = x[row_tok].reshape(n_blocks, MOE_ROW_BLOCK, D)
    ys = lax.map(lambda a: swiglu(a[0], wg[a[1]], wu[a[1]], wd[a[1]]), (xs, blk_e))
    ys = ys.reshape(n_rows, D)[dest] * gate_sorted[:, None]
    return jnp.zeros_like(x).at[tok_sorted].add(ys)


def setup_inputs(seed: int = 0) -> dict:
    key = jax.random.key(seed)
    k = jax.random.split(key, 22)
    f32 = jnp.float32

    def nrm(kk, shape, s):
        return jax.random.normal(kk, shape, f32) * s

    col_scale = jnp.asarray(np.concatenate(
        [np.full((n,), DN_BETA if j in VALUE_SLOTS else 1.0, np.float32) for j, n in enumerate(IN_SIZES)]))
    return {
        "x": nrm(k[0], (BATCH, SEQ, D_MODEL), 1.0),
        "w_in": nrm(k[1], (DEPTH, D_MODEL, IN_WIDTH), D_MODEL ** -0.5) * col_scale,
        "hg_lb_logits": nrm(k[2], (DEPTH, HG_KWIDTH), 0.5),
        "hg_norm_w": 1.0 + nrm(k[3], (DEPTH, HG_WIDTH), 0.02),
        "cmp_pos": nrm(k[4], (DEPTH, 2, CMP_LEN, NSA_DH), 0.1),
        "cmp_w1": nrm(k[5], (DEPTH, 2, CMP_LEN * NSA_DH, CMP_HIDDEN), (CMP_LEN * NSA_DH) ** -0.5),
        "cmp_w2": nrm(k[6], (DEPTH, 2, CMP_HIDDEN, NSA_DH), CMP_HIDDEN ** -0.5),
        "rel_bias": nrm(k[7], (REL_BUCKETS, NSA_HEADS), 0.3),
        "w_branch_a": nrm(k[8], (DEPTH, HG_WIDTH, D_MODEL), HG_WIDTH ** -0.5 * DN_BETA),
        "w_branch_b": nrm(k[9], (DEPTH, NSA_WIDTH, D_MODEL), NSA_WIDTH ** -0.5 * DN_BETA),
        "w_out": nrm(k[10], (DEPTH, D_MODEL, D_MODEL), D_MODEL ** -0.5 * DN_BETA),
        "ln1_g": 1.0 + nrm(k[11], (DEPTH, D_MODEL), 0.02),
        "ln1_b": nrm(k[12], (DEPTH, D_MODEL), 0.02),
        "ln2_g": 1.0 + nrm(k[13], (DEPTH, D_MODEL), 0.02),
        "ln2_b": nrm(k[14], (DEPTH, D_MODEL), 0.02),
        "ffn_w_gate": nrm(k[15], (N_DENSE, D_MODEL, D_FF), D_MODEL ** -0.5),
        "ffn_w_up": nrm(k[16], (N_DENSE, D_MODEL, D_FF), D_MODEL ** -0.5 * DN_BETA),
        "ffn_w_down": nrm(k[17], (N_DENSE, D_FF, D_MODEL), D_FF ** -0.5 * DN_BETA),
        "moe_router": nrm(k[18], (N_MOE, D_MODEL, N_EXPERTS), D_MODEL ** -0.5),
        "moe_w_gate": nrm(k[19], (N_MOE, N_EXPERTS, D_MODEL, D_FF_EXPERT), D_MODEL ** -0.5),
        "moe_w_up": nrm(k[20], (N_MOE, N_EXPERTS, D_MODEL, D_FF_EXPERT), D_MODEL ** -0.5 * DN_BETA),
        "moe_w_down": nrm(k[21], (N_MOE, N_EXPERTS, D_FF_EXPERT, D_MODEL), D_FF_EXPERT ** -0.5 * DN_BETA),
    }


def reference(x, w_in, hg_lb_logits, hg_norm_w, cmp_pos, cmp_w1, cmp_w2, rel_bias, w_branch_a, w_branch_b,
              w_out, ln1_g, ln1_b, ln2_g, ln2_b, ffn_w_gate, ffn_w_up, ffn_w_down, moe_router, moe_w_gate,
              moe_w_up, moe_w_down):
    B, S, D = x.shape
    p_lb = jax.nn.softmax(hg_lb_logits.astype(jnp.float32), axis=0)
    lbs = jnp.cumsum(p_lb, axis=0) - p_lb[0]
    for l in range(DEPTH):
        mix = token_mixer(x, w_in[l], lbs[l], hg_norm_w[l], cmp_pos[l], cmp_w1[l], cmp_w2[l], rel_bias,
                          w_branch_a[l], w_branch_b[l], w_out[l])
        x = layer_norm(DN_ALPHA * x + mix, ln1_g[l], ln1_b[l])
        h = x.reshape(B * S, D)
        if l % 2 == 0:
            f = swiglu(h, ffn_w_gate[l // 2], ffn_w_up[l // 2], ffn_w_down[l // 2])
        else:
            f = moe_swiglu(h, moe_router[l // 2], moe_w_gate[l // 2], moe_w_up[l // 2], moe_w_down[l // 2])
        x = layer_norm(DN_ALPHA * x + f.reshape(B, S, D), ln2_g[l], ln2_b[l])
    return x
```

```cpp
#include <hip/hip_runtime.h>
#include <cstdio>
#include <cstdint>

#ifndef ONE_LAUNCH
#define ONE_LAUNCH 0
#endif

#define LAS __attribute__((address_space(3)))
typedef unsigned short bf16;
typedef short bf16x8 __attribute__((ext_vector_type(8)));
typedef float f32x4 __attribute__((ext_vector_type(4)));
typedef float f32x2 __attribute__((ext_vector_type(2)));
typedef unsigned u32x4 __attribute__((ext_vector_type(4)));
typedef unsigned u32x2 __attribute__((ext_vector_type(2)));

__device__ __forceinline__ unsigned cvt_pk_bf16(float lo, float hi) { unsigned r; asm volatile("v_cvt_pk_bf16_f32 %0, %1, %2" : "=v"(r) : "v"(lo), "v"(hi)); return r; }
__device__ __forceinline__ bf16 f2bf(float f) { unsigned u = __float_as_uint(f); u += 0x7FFFu + ((u >> 16) & 1u); return (bf16)(u >> 16); }
__device__ __forceinline__ float bf2f(bf16 b) { return __uint_as_float(((unsigned)b) << 16); }
__device__ __forceinline__ float bflo(unsigned u) { return __uint_as_float(u << 16); }
__device__ __forceinline__ float bfhi(unsigned u) { return __uint_as_float(u & 0xFFFF0000u); }
__device__ __forceinline__ float sigmoidf_(float x) { return 1.0f / (1.0f + __expf(-x)); }
__device__ __forceinline__ float siluf_(float x) { return x / (1.0f + __expf(-x)); }
__device__ __forceinline__ float wave_sum(float v) {
#pragma unroll
    for (int o = 1; o < 64; o <<= 1) v += __shfl_xor(v, o);
    return v;
}
__device__ __forceinline__ float wave_max(float v) {
#pragma unroll
    for (int o = 1; o < 64; o <<= 1) v = fmaxf(v, __shfl_xor(v, o));
    return v;
}
#define WAVE_SYNC() do { asm volatile("s_waitcnt lgkmcnt(0)" ::: "memory"); __builtin_amdgcn_wave_barrier(); } while (0)

#define PHASE_IDS() int tid_ph = threadIdx.x; asm volatile("" : "+v"(tid_ph)); const int tid = tid_ph, lane = tid & 63, wave = __builtin_amdgcn_readfirstlane(tid >> 6), gwave = bid * NWAVES + wave; (void)tid; (void)lane; (void)wave; (void)gwave
namespace pg8 {
constexpr int BM = 256, BK = 64, HALF = 128, HTB = HALF * BK * 2, STAGE_BYTES = 8 * HTB, NXCD = 8, WGM = 8;
__host__ __device__ __forceinline__ int lds_byte(int r, int c) { const int st = (r >> 4) * 2 + (c >> 5), rr = r & 15, cc = c & 31, ob = rr * 64 + cc * 2; return st * 1024 + (ob ^ (((ob >> 9) & 1) << 5)); }
__host__ __device__ __forceinline__ void stage_rc(int b, int& R, int& C) { const int st = b / 1024, sb = b % 1024, swz = sb ^ (((sb >> 9) & 1) << 5); R = (st >> 1) * 16 + swz / 64; C = (st & 1) * 32 + (swz % 64) / 2; }
__host__ __device__ __forceinline__ int perm32(int rho) { const int n = rho >> 4, i = rho & 15; return 8 * (i >> 2) + 4 * n + (i & 3); }

struct Unit { int pm, pn, e; };
struct Gemm { const bf16* A; const bf16* Bt; int M, N, K; size_t bt_estride; };

struct StaticOrder {
    int nM, nN, nwg, G, c; const int* pe;
    __device__ void init(int M, int N, int G_, int c_, const int* pe_ = nullptr) { nM = M / BM; nN = N / BM; nwg = nM * nN; G = G_; c = c_; pe = pe_; }
    __device__ bool next(int i, Unit& u) const {
        const long L = (long)i * G + c; if (L >= nwg) return false;
        int wgid = (int)L; { const int q = nwg / NXCD, r = nwg % NXCD, xcd = wgid % NXCD, off = wgid / NXCD; wgid = (xcd < r ? xcd * (q + 1) : r * (q + 1) + (xcd - r) * q) + off; }
        const int nig = WGM * nN, gid = wgid / nig, fm = gid * WGM, gsz = (nM - fm) < WGM ? (nM - fm) : WGM;
        u.pm = fm + ((wgid % nig) % gsz); u.pn = (wgid % nig) / gsz; u.e = pe ? pe[u.pm] : 0; return true;
    }
    __device__ __forceinline__ void a_ready(const Unit&) const {}
    __device__ __forceinline__ void done(const Unit&) const {}
};

template <class Epi, class Sched, bool ALIGN_EPI = true, bool SP2 = true>
__device__ __forceinline__ void gemm_phase(LAS unsigned char* lds, const Gemm g, const Sched& S, const Epi& E) {
    int tid_l = threadIdx.x; asm volatile("" : "+v"(tid_l));
    const int tid = tid_l, wid = __builtin_amdgcn_readfirstlane(tid >> 6), lane = tid & 63, wr = wid >> 2, wc = wid & 3, fr = lane & 15, fq = lane >> 4;
    const int K = g.K, nt = K / BK;
    unsigned voffA[2], voffB[2];
#pragma unroll
    for (int i = 0; i < 2; ++i) { int R, C; stage_rc(tid * 16 + i * 8192, R, C); const int Rb = Epi::PERM ? ((R & ~31) + perm32(R & 31)) : R;
        voffA[i] = (unsigned)(R * K + C) * 2u; voffB[i] = (unsigned)(Rb * K + C) * 2u; }
    const size_t kstep = (size_t)(BK * 2);
    const size_t hstep = (size_t)HALF * K * 2;
    const size_t tstep = 2 * hstep;
    const unsigned ldsw = (unsigned)wid * 1024u;
    const int aoff = lds_byte(wr * 64 + fr, fq * 8), boff = lds_byte(wc * 32 + fr, fq * 8);
#define PG8_SA(b, h) (((b) * 2 + (h)) * HTB)
#define PG8_SB(b, h) ((4 + (b) * 2 + (h)) * HTB)
#define PG8_STAGE(bufoff, gbase, voff) do { _Pragma("unroll") for (int _i = 0; _i < 2; ++_i) \
        __builtin_amdgcn_global_load_lds((const unsigned*)((const char*)(gbase) + (voff)[_i]), (LAS unsigned*)(lds + (bufoff) + ldsw + _i * 8192), 16, 0, 0); } while (0)
#define PG8_LDA(dst, b, h) do { _Pragma("unroll") for (int m = 0; m < 4; ++m) _Pragma("unroll") for (int k = 0; k < 2; ++k) dst[m][k] = *(const LAS bf16x8*)(lds + PG8_SA(b, h) + aoff + m * 2048 + k * 1024); } while (0)
#define PG8_LDB(dst, b, h) do { _Pragma("unroll") for (int n = 0; n < 2; ++n) _Pragma("unroll") for (int k = 0; k < 2; ++k) dst[n][k] = *(const LAS bf16x8*)(lds + PG8_SB(b, h) + boff + n * 2048 + k * 1024); } while (0)
#define PG8_MMA(ai, bj, At, Bt) do { __builtin_amdgcn_s_setprio(1); _Pragma("unroll") for (int m = 0; m < 4; ++m) _Pragma("unroll") for (int n = 0; n < 2; ++n) _Pragma("unroll") for (int k = 0; k < 2; ++k) \
        acc[ai][bj][m][n] = __builtin_amdgcn_mfma_f32_16x16x32_bf16(Bt[n][k], At[m][k], acc[ai][bj][m][n], 0, 0, 0); __builtin_amdgcn_s_setprio(0); } while (0)
#define PG8_WAIT_V(n) asm volatile("s_waitcnt vmcnt(" #n ")" ::: "memory")
#define PG8_WAIT_L(n) asm volatile("s_waitcnt lgkmcnt(" #n ")" ::: "memory")
#define PG8_BAR __builtin_amdgcn_s_barrier()
#define PG8_SCHED __builtin_amdgcn_sched_barrier(0)
    Unit cur, nxt; int ui = 0;
    if (!S.next(0, cur)) return;
    f32x4 acc[2][2][4][2];
#pragma unroll
    for (int a = 0; a < 2; ++a)
#pragma unroll
        for (int b = 0; b < 2; ++b)
#pragma unroll
            for (int m = 0; m < 4; ++m)
#pragma unroll
                for (int n = 0; n < 2; ++n) acc[a][b][m][n] = (f32x4){0.f, 0.f, 0.f, 0.f};
    bf16x8 At[4][2], B0[2][2], B1[2][2];
    const char* cA = (const char*)g.A + (size_t)cur.pm * tstep; const char* cB = (const char*)(g.Bt + (size_t)cur.e * g.bt_estride) + (size_t)cur.pn * tstep;
    S.a_ready(cur);
    if constexpr (SP2) {
        PG8_STAGE(PG8_SB(0, 0), cB, voffB); PG8_STAGE(PG8_SB(0, 1), cB + hstep, voffB); PG8_STAGE(PG8_SA(0, 0), cA, voffA); PG8_STAGE(PG8_SA(0, 1), cA + hstep, voffA);
        if (wr == 1) PG8_BAR;
        PG8_WAIT_V(2); PG8_BAR;
        PG8_STAGE(PG8_SB(1, 0), cB + kstep, voffB); PG8_STAGE(PG8_SA(1, 0), cA + kstep, voffA); PG8_STAGE(PG8_SB(1, 1), cB + hstep + kstep, voffB);
        PG8_WAIT_V(6); PG8_BAR;
    } else {
        PG8_STAGE(PG8_SB(0, 0), cB, voffB); PG8_STAGE(PG8_SA(0, 0), cA, voffA); PG8_STAGE(PG8_SB(0, 1), cB + hstep, voffB); PG8_STAGE(PG8_SA(0, 1), cA + hstep, voffA);
        if (wr == 1) PG8_BAR;
        PG8_WAIT_V(4); PG8_BAR;
        PG8_STAGE(PG8_SB(1, 0), cB + kstep, voffB); PG8_STAGE(PG8_SA(1, 0), cA + kstep, voffA); PG8_STAGE(PG8_SB(1, 1), cB + hstep + kstep, voffB);
        PG8_WAIT_V(6); PG8_BAR;
    }
    for (;;) {
        const bool has_next = S.next(ui + 1, nxt);
        const char* nA = has_next ? (const char*)g.A + (size_t)nxt.pm * tstep : cA;
        const char* nB = has_next ? (const char*)(g.Bt + (size_t)nxt.e * g.bt_estride) + (size_t)nxt.pn * tstep : cB;
        for (int t = 0; t < nt; t += 2) {
            const bool last = (t == nt - 2);
            const char* a1 = cA + (size_t)(t + 1) * kstep;
            const char* a2 = last ? nA : cA + (size_t)(t + 2) * kstep; const char* b2 = last ? nB : cB + (size_t)(t + 2) * kstep;
            const char* a3 = a2 + kstep; const char* b3 = b2 + kstep;
            if (last && has_next) S.a_ready(nxt);
            if constexpr (SP2) {
            PG8_LDB(B0, 0, 0); PG8_LDB(B1, 0, 1); PG8_SCHED; PG8_LDA(At, 0, 0); PG8_STAGE(PG8_SA(1, 1), a1 + hstep, voffA);
            PG8_WAIT_V(8); PG8_WAIT_L(0); PG8_BAR; PG8_MMA(0, 0, At, B0); PG8_MMA(0, 1, At, B1); PG8_BAR; PG8_SCHED;
            PG8_LDA(At, 0, 1); PG8_STAGE(PG8_SB(0, 0), b2, voffB); PG8_STAGE(PG8_SB(0, 1), b2 + hstep, voffB); PG8_STAGE(PG8_SA(0, 0), a2, voffA);
            PG8_WAIT_V(8); PG8_WAIT_L(0); PG8_BAR; PG8_MMA(1, 0, At, B0); PG8_MMA(1, 1, At, B1); PG8_BAR; PG8_SCHED;
            PG8_LDB(B0, 1, 0); PG8_LDB(B1, 1, 1); PG8_SCHED; PG8_LDA(At, 1, 0); PG8_STAGE(PG8_SA(0, 1), a2 + hstep, voffA);
            PG8_WAIT_V(8); PG8_WAIT_L(0); PG8_BAR; PG8_MMA(0, 0, At, B0); PG8_MMA(0, 1, At, B1); PG8_BAR; PG8_SCHED;
            PG8_LDA(At, 1, 1); PG8_STAGE(PG8_SB(1, 0), b3, voffB); PG8_STAGE(PG8_SB(1, 1), b3 + hstep, voffB); PG8_STAGE(PG8_SA(1, 0), a3, voffA);
            PG8_WAIT_V(8); PG8_WAIT_L(0); PG8_BAR; PG8_MMA(1, 0, At, B0); PG8_MMA(1, 1, At, B1); PG8_BAR; PG8_SCHED;
            } else {
            PG8_LDB(B0, 0, 0); PG8_SCHED; PG8_LDA(At, 0, 0); PG8_STAGE(PG8_SA(1, 1), a1 + hstep, voffA);
            PG8_WAIT_L(8); PG8_BAR; PG8_WAIT_L(0); PG8_MMA(0, 0, At, B0); PG8_BAR; PG8_SCHED;
            PG8_LDB(B1, 0, 1); PG8_STAGE(PG8_SB(0, 0), b2, voffB);
            PG8_BAR; PG8_WAIT_L(0); PG8_MMA(0, 1, At, B1); PG8_BAR;
            PG8_LDA(At, 0, 1); PG8_STAGE(PG8_SA(0, 0), a2, voffA);
            PG8_BAR; PG8_WAIT_L(0); PG8_MMA(1, 0, At, B0); PG8_BAR; PG8_SCHED;
            PG8_STAGE(PG8_SB(0, 1), b2 + hstep, voffB);
            PG8_WAIT_V(6); PG8_BAR; PG8_MMA(1, 1, At, B1); PG8_BAR;
            PG8_LDB(B0, 1, 0); PG8_SCHED; PG8_LDA(At, 1, 0); PG8_STAGE(PG8_SA(0, 1), a2 + hstep, voffA);
            PG8_WAIT_L(8); PG8_BAR; PG8_WAIT_L(0); PG8_MMA(0, 0, At, B0); PG8_BAR; PG8_SCHED;
            PG8_LDB(B1, 1, 1); PG8_STAGE(PG8_SB(1, 0), b3, voffB);
            PG8_BAR; PG8_WAIT_L(0); PG8_MMA(0, 1, At, B1); PG8_BAR;
            PG8_LDA(At, 1, 1); PG8_STAGE(PG8_SA(1, 0), a3, voffA);
            PG8_BAR; PG8_WAIT_L(0); PG8_MMA(1, 0, At, B0); PG8_BAR; PG8_SCHED;
            PG8_STAGE(PG8_SB(1, 1), b3 + hstep, voffB);
            PG8_WAIT_V(6); PG8_BAR; PG8_MMA(1, 1, At, B1); PG8_BAR;
            }
        }
        if constexpr (ALIGN_EPI) { if (wr == 0) PG8_BAR; }
        E(acc, cur, wr, wc, fr, fq); S.done(cur);
        if (!has_next) break;
#pragma unroll
        for (int a = 0; a < 2; ++a)
#pragma unroll
            for (int b = 0; b < 2; ++b)
#pragma unroll
                for (int m = 0; m < 4; ++m)
#pragma unroll
                    for (int n = 0; n < 2; ++n) acc[a][b][m][n] = (f32x4){0.f, 0.f, 0.f, 0.f};
        cur = nxt; cA = nA; cB = nB; ++ui;
        if constexpr (ALIGN_EPI) { if (wr == 1) PG8_BAR; }
    }
    PG8_WAIT_V(0);
    if constexpr (!ALIGN_EPI) { if (wr == 0) PG8_BAR; }
    PG8_BAR;
#undef PG8_SA
#undef PG8_SB
#undef PG8_STAGE
#undef PG8_LDA
#undef PG8_LDB
#undef PG8_MMA
#undef PG8_WAIT_V
#undef PG8_WAIT_L
#undef PG8_BAR
#undef PG8_SCHED
}
}

#define XB_TMO      128
#define XB_XCNT(j)  (256  + 64 * (j))
#define XB_XSUB(j)  (1280 + 64 * (j))
#define XB_XGEN(j)  (2304 + 64 * (j))
#define XB_TOP      3328
#define XB_TOPGEN   3392
#define XCD_BAR_WORDS 3456
#define XB_SPIN_CAP (1u << 18)
__device__ __forceinline__ unsigned xb_ld(unsigned* p)              { return __hip_atomic_load(p, __ATOMIC_RELAXED, __HIP_MEMORY_SCOPE_AGENT); }
__device__ __forceinline__ unsigned xb_add(unsigned* p, unsigned v) { return __hip_atomic_fetch_add(p, v, __ATOMIC_RELAXED, __HIP_MEMORY_SCOPE_AGENT); }
__device__ __forceinline__ unsigned xb_xcc_id() { return (unsigned)__builtin_amdgcn_s_getreg((3 << 11) | 20) & 0xFu; }
#define XB_SPIN(cond, bar) do { unsigned _sp = 0; while (cond) { __builtin_amdgcn_s_sleep(1); \
    if ((++_sp & 255u) == 0u) { if (xb_ld(&(bar)[XB_TMO])) break; if (_sp > XB_SPIN_CAP) { atomicAdd(&(bar)[XB_TMO], 1u); break; } } } } while (0)
struct XcdBarrier { unsigned* bar; unsigned x; volatile LAS unsigned* st; };
__device__ __forceinline__ XcdBarrier xcd_barrier_post(unsigned* bar, volatile LAS unsigned* st) {
    XcdBarrier b; b.bar = bar; b.x = xb_xcc_id(); b.st = st;
    if (threadIdx.x == 0) (void)xb_add(&bar[XB_XCNT(b.x)], 1u);
    return b;
}
__device__ __forceinline__ void xcd_barrier_complete(unsigned* bar, unsigned x, unsigned& nloc, unsigned& nx) {
    const unsigned G = gridDim.x * gridDim.y * gridDim.z;
    unsigned sum, cnt, mine, sp = 0u;
    for (;;) {
        sum = 0u; cnt = 0u; mine = 0u;
#pragma unroll
        for (unsigned j = 0; j < 16; ++j) { const unsigned c = xb_ld(&bar[XB_XCNT(j)]); sum += c; cnt += (c > 0u) ? 1u : 0u; mine = (j == x) ? c : mine; }
        if (sum == G) break;
        __builtin_amdgcn_s_sleep(1);
        if ((++sp & 255u) == 0u) { if (xb_ld(&bar[XB_TMO])) break; if (sp > XB_SPIN_CAP) { atomicAdd(&bar[XB_TMO], 1u); break; } }
    }
    nloc = mine > 0u ? mine : 1u; nx = cnt > 0u ? cnt : 1u;
}
__device__ __forceinline__ void xcd_barrier(const XcdBarrier& b) {
    asm volatile("s_waitcnt vmcnt(0)" ::: "memory");
    __syncthreads();
    if (threadIdx.x == 0) {
        unsigned* bar = b.bar;
        __builtin_amdgcn_s_waitcnt(0);
        unsigned nloc = b.st[0], nx = b.st[1];
        if (nloc == 0u) { xcd_barrier_complete(bar, b.x, nloc, nx); b.st[0] = nloc; b.st[1] = nx; }
        const unsigned old = xb_add(&bar[XB_XSUB(b.x)], 1u);
        const unsigned gen = old / nloc;
        if (old + 1u == (gen + 1u) * nloc) {
            __builtin_amdgcn_fence(__ATOMIC_RELEASE, "agent");
            asm volatile("s_waitcnt vmcnt(0)" ::: "memory");
            const unsigned og = xb_add(&bar[XB_TOP], 1u);
            const unsigned tg = og / nx;
            if (og + 1u == (tg + 1u) * nx) xb_add(&bar[XB_TOPGEN], 1u);
            else XB_SPIN(xb_ld(&bar[XB_TOPGEN]) == tg, bar);
            __builtin_amdgcn_fence(__ATOMIC_ACQUIRE, "agent");
            xb_add(&bar[XB_XGEN(b.x)], 1u);
            asm volatile("s_waitcnt vmcnt(0)" ::: "memory");
        } else {
            XB_SPIN(xb_ld(&bar[XB_XGEN(b.x)]) == gen, bar);
            __builtin_amdgcn_fence(__ATOMIC_ACQUIRE, "agent");
            asm volatile("s_waitcnt vmcnt(0)" ::: "memory");
        }
    }
    __syncthreads();
}

constexpr int NB = 4, SEQ = 8192, DM = 1024, NT = NB * SEQ;
constexpr int NINP = 5632;
constexpr int FF0 = 2752, FF0P = 2816, FFE = 3584, NEXP = 8;
constexpr int NWAVES = 8, NTHR = 512;
constexpr int LDS_BYTES = 155648;
constexpr int MISC_OFF = LDS_BYTES - 64;
constexpr float DN_ALPHA = 1.41421356237309515f;
constexpr int MAXPANELS = 272;
constexpr int MAXCHUNK = 5;

constexpr size_t al256(size_t x) { return (x + 255) & ~(size_t)255; }
constexpr size_t WS_CTL = 0;
constexpr size_t CTL_BYTES = 65536;
constexpr size_t CW_BAR = 0;
constexpr size_t CW_BLKCNT = 16384;
constexpr size_t CW_META = 16384 + 8192;
constexpr size_t CW_PANELE = 16384 + 8192 + 256;
constexpr size_t WS_LBS = WS_CTL + CTL_BYTES;
constexpr size_t WS_KC = WS_LBS + 4096;
constexpr size_t WS_VC = WS_KC + 1048576;
constexpr size_t WS_DEC = WS_VC + 1048576;
constexpr size_t WS_TOPI = WS_DEC + 1048576;
constexpr size_t WS_TOPG = WS_TOPI + (size_t)NT * 4;
constexpr size_t WS_ROWINFO = WS_TOPG + (size_t)NT * 8;
constexpr size_t WS_BIG = al256(WS_ROWINFO + (size_t)MAXPANELS * 256 * 4);
constexpr size_t SZ_WIN = (size_t)NINP * DM * 2, SZ_WBR = (size_t)DM * 512 * 2, SZ_WOUT = (size_t)DM * DM * 2;
constexpr size_t WS_WIN0 = WS_BIG, WS_WIN1 = WS_WIN0 + SZ_WIN;
constexpr size_t WS_WBA0 = WS_WIN1 + SZ_WIN, WS_WBA1 = WS_WBA0 + SZ_WBR, WS_WBB0 = WS_WBA1 + SZ_WBR, WS_WBB1 = WS_WBB0 + SZ_WBR;
constexpr size_t WS_WOUT0 = WS_WBB1 + SZ_WBR, WS_WOUT1 = WS_WOUT0 + SZ_WOUT;
constexpr size_t WS_WGU0 = WS_WOUT1 + SZ_WOUT;
constexpr size_t WS_WDN0 = WS_WGU0 + (size_t)NINP * DM * 2;
constexpr size_t WS_XB = WS_WDN0 + (size_t)DM * FF0P * 2;
constexpr size_t WS_US = WS_XB;
constexpr size_t WS_PROJ = WS_XB + (size_t)NT * DM * 2;
constexpr size_t WS_QHG = WS_PROJ;
constexpr size_t WS_HF = WS_QHG + (size_t)NT * 512 * 2;
constexpr size_t WS_HI = WS_HF + (size_t)NT * 512 * 4;
constexpr size_t WS_HG = WS_HI + (size_t)NT * 512 * 2;
constexpr size_t WS_NQ = WS_HG + (size_t)NT * 512 * 2;
constexpr size_t WS_KV6 = WS_NQ + (size_t)NT * 512 * 2;
constexpr size_t WS_GA = WS_KV6 + (size_t)NT * 768 * 2;
constexpr size_t WS_GB = WS_GA + (size_t)NT * DM * 2;
constexpr size_t WS_NG = WS_GB + (size_t)NT * DM * 2;
constexpr size_t WS_MIX_END = WS_NG + (size_t)NT * 32 * 4;
constexpr size_t WS_H0 = WS_PROJ;
constexpr size_t WS_MGU = WS_BIG;
constexpr size_t WS_MDN = WS_MGU + (size_t)NEXP * 2 * FFE * DM * 2;
constexpr size_t WS_XS = WS_MDN + (size_t)NEXP * DM * FFE * 2;
constexpr size_t WS_HM = WS_XS + (size_t)MAXPANELS * 256 * DM * 2;
constexpr size_t WS_YM = WS_HM + (size_t)64 * 256 * FFE * 2;
constexpr size_t WS_MOE_END = WS_YM + (size_t)NT * 2 * DM * 2;
constexpr size_t WS_END = WS_MOE_END > WS_MIX_END ? WS_MOE_END : WS_MIX_END;

struct Args {
    const float* in[22]; float* out; unsigned char* ws; int ph_lo, ph_hi;
};

struct EpiInProj {
    static constexpr bool PERM = false;
    unsigned char* ws;
    __device__ __forceinline__ void operator()(const f32x4 (&acc)[2][2][4][2], const pg8::Unit& u, int wr, int wc, int fr, int fq) const {
        const int row0 = u.pm * 256 + wr * 64 + fr;
#pragma unroll
        for (int bj = 0; bj < 2; ++bj)
#pragma unroll
            for (int n = 0; n < 2; ++n) {
                const int cb = u.pn * 256 + bj * 128 + wc * 32 + n * 16;
                const int c = cb + 4 * fq;
                int kind = 0, ld = 512, co = 0; size_t base = 0; float sc = 1.f;
                if (cb < 512) { base = WS_QHG; co = c; }
                else if (cb < 1024) { kind = 1; base = WS_HF; co = c - 512; }
                else if (cb < 1536) { base = WS_HI; co = c - 1024; }
                else if (cb < 2048) { base = WS_HG; co = c - 1536; }
                else if (cb < 2560) { base = WS_NQ; co = c - 2048; sc = 0.125f; }
                else if (cb < 3328) { base = WS_KV6; co = c - 2560; ld = 768; }
                else if (cb < 4352) { base = WS_GA; co = c - 3328; ld = 1024; }
                else if (cb < 5376) { base = WS_GB; co = c - 4352; ld = 1024; }
                else if (cb < 5408) { kind = 1; base = WS_NG; co = c - 5376; ld = 32; }
                else kind = 2;
                if (kind == 2) continue;
#pragma unroll
                for (int ai = 0; ai < 2; ++ai)
#pragma unroll
                    for (int m = 0; m < 4; ++m) {
                        const int row = row0 + ai * 128 + m * 16;
                        const f32x4 v = acc[ai][bj][m][n];
                        if (kind == 0) { u32x2 w; w.x = cvt_pk_bf16(v[0] * sc, v[1] * sc); w.y = cvt_pk_bf16(v[2] * sc, v[3] * sc); *(u32x2*)((bf16*)(ws + base) + (size_t)row * ld + co) = w; }
                        else *(f32x4*)((float*)(ws + base) + (size_t)row * ld + co) = v;
                    }
            }
    }
};
template <bool FIRST> struct EpiGate {
    static constexpr bool PERM = false;
    bf16* Y; const bf16* G;
    __device__ __forceinline__ void operator()(const f32x4 (&acc)[2][2][4][2], const pg8::Unit& u, int wr, int wc, int fr, int fq) const {
        const int row0 = u.pm * 256 + wr * 64 + fr, col0 = u.pn * 256 + wc * 32 + 4 * fq;
#pragma unroll
        for (int ai = 0; ai < 2; ++ai)
#pragma unroll
            for (int m = 0; m < 4; ++m)
#pragma unroll
                for (int bj = 0; bj < 2; ++bj)
#pragma unroll
                    for (int n = 0; n < 2; ++n) {
                        const size_t off = (size_t)(row0 + ai * 128 + m * 16) * DM + col0 + bj * 128 + n * 16;
                        const u32x2 gq = *(const u32x2*)(G + off);
                        const f32x4 v = acc[ai][bj][m][n];
                        float o0 = sigmoidf_(bflo(gq.x)) * v[0], o1 = sigmoidf_(bfhi(gq.x)) * v[1], o2 = sigmoidf_(bflo(gq.y)) * v[2], o3 = sigmoidf_(bfhi(gq.y)) * v[3];
                        if (!FIRST) { const u32x2 yq = *(const u32x2*)(Y + off); o0 += bflo(yq.x); o1 += bfhi(yq.x); o2 += bflo(yq.y); o3 += bfhi(yq.y); }
                        u32x2 w; w.x = cvt_pk_bf16(o0, o1); w.y = cvt_pk_bf16(o2, o3); *(u32x2*)(Y + off) = w;
                    }
    }
};
struct EpiResid {
    static constexpr bool PERM = false;
    const float* XI; float* XO;
    __device__ __forceinline__ void operator()(const f32x4 (&acc)[2][2][4][2], const pg8::Unit& u, int wr, int wc, int fr, int fq) const {
        const int row0 = u.pm * 256 + wr * 64 + fr, col0 = u.pn * 256 + wc * 32 + 4 * fq;
#pragma unroll
        for (int ai = 0; ai < 2; ++ai)
#pragma unroll
            for (int m = 0; m < 4; ++m)
#pragma unroll
                for (int bj = 0; bj < 2; ++bj)
#pragma unroll
                    for (int n = 0; n < 2; ++n) {
                        const size_t off = (size_t)(row0 + ai * 128 + m * 16) * DM + col0 + bj * 128 + n * 16;
                        const f32x4 xi = *(const f32x4*)(XI + off);
                        *(f32x4*)(XO + off) = xi * DN_ALPHA + acc[ai][bj][m][n];
                    }
    }
};
struct EpiSwiglu {
    static constexpr bool PERM = false;
    bf16* H; int ldh;
    __device__ __forceinline__ void operator()(const f32x4 (&acc)[2][2][4][2], const pg8::Unit& u, int wr, int wc, int fr, int fq) const {
        const int row0 = u.pm * 256 + wr * 64 + fr, col0 = u.pn * 128 + wc * 32 + 4 * fq;
#pragma unroll
        for (int ai = 0; ai < 2; ++ai)
#pragma unroll
            for (int m = 0; m < 4; ++m)
#pragma unroll
                for (int n = 0; n < 2; ++n) {
                    const f32x4 gq = acc[ai][0][m][n], uq = acc[ai][1][m][n];
                    u32x2 w; w.x = cvt_pk_bf16(siluf_(gq[0]) * uq[0], siluf_(gq[1]) * uq[1]); w.y = cvt_pk_bf16(siluf_(gq[2]) * uq[2], siluf_(gq[3]) * uq[3]);
                    *(u32x2*)(H + (size_t)(row0 + ai * 128 + m * 16) * ldh + col0 + n * 16) = w;
                }
    }
};
struct EpiScatter {
    static constexpr bool PERM = false;
    bf16* Y; const int* rowinfo;
    __device__ __forceinline__ void operator()(const f32x4 (&acc)[2][2][4][2], const pg8::Unit& u, int wr, int wc, int fr, int fq) const {
        const int row0 = u.pm * 256 + wr * 64 + fr, col0 = u.pn * 256 + wc * 32 + 4 * fq;
#pragma unroll
        for (int ai = 0; ai < 2; ++ai)
#pragma unroll
            for (int m = 0; m < 4; ++m) {
                const int info = rowinfo[row0 + ai * 128 + m * 16];
                if (info < 0) continue;
#pragma unroll
                for (int bj = 0; bj < 2; ++bj)
#pragma unroll
                    for (int n = 0; n < 2; ++n) {
                        const f32x4 v = acc[ai][bj][m][n];
                        u32x2 w; w.x = cvt_pk_bf16(v[0], v[1]); w.y = cvt_pk_bf16(v[2], v[3]);
                        *(u32x2*)(Y + (size_t)info * DM + col0 + bj * 128 + n * 16) = w;
                    }
            }
    }
};

__device__ __forceinline__ int rel_bucket(int n) {
    if (n < 16) return n;
    return 16 + (n >= 22) + (n >= 30) + (n >= 40) + (n >= 54) + (n >= 73) + (n >= 99) + (n >= 134) + (n >= 182) + (n >= 246) + (n >= 332) + (n >= 450) + (n >= 609) + (n >= 825) + (n >= 1117) + (n >= 1513);
}
template <class F>
__device__ __forceinline__ void tr_item(F colptr, int ld, int Kvalid, bf16* dst, int dstld, int n0, int k0, LAS float* scr, int lane) {
    const float* cp = colptr(n0 + (lane & 31));
#pragma unroll 8
    for (int i = 0; i < 32; ++i) { const int kk = 2 * i + (lane >> 5), k = k0 + kk; float v = 0.f; if (cp && k < Kvalid) v = cp[(size_t)k * ld]; scr[kk * 33 + (lane & 31)] = v; }
    WAVE_SYNC();
    const int c = lane & 7;
#pragma unroll
    for (int j = 0; j < 4; ++j) { const int n = (lane >> 3) + 8 * j; const LAS float* s = scr + (8 * c) * 33 + n;
        u32x4 o; o.x = cvt_pk_bf16(s[0 * 33], s[1 * 33]); o.y = cvt_pk_bf16(s[2 * 33], s[3 * 33]); o.z = cvt_pk_bf16(s[4 * 33], s[5 * 33]); o.w = cvt_pk_bf16(s[6 * 33], s[7 * 33]);
        *(u32x4*)(dst + (size_t)(n0 + n) * dstld + k0 + 8 * c) = o; }
    WAVE_SYNC();
}

__global__ void __launch_bounds__(NTHR, 2) mega_fwd(Args args) {
    extern __shared__ __attribute__((aligned(16))) unsigned char lds_raw[];
    LAS unsigned char* lds = (LAS unsigned char*)lds_raw;
    const int G = gridDim.x, bid = blockIdx.x;
    const int nwaves = G * NWAVES;
    unsigned char* ws = args.ws;
    const int lo = args.ph_lo, hi = args.ph_hi;

    volatile LAS unsigned* misc = (volatile LAS unsigned*)(lds + MISC_OFF);
    if (threadIdx.x < 16) misc[threadIdx.x] = 0u;
    __syncthreads();
    XcdBarrier bar; bar.bar = (unsigned*)(ws + WS_CTL + CW_BAR); bar.x = 0; bar.st = misc;
    const bool multi = (hi - lo) > 1;
    if (multi) bar = xcd_barrier_post((unsigned*)(ws + WS_CTL + CW_BAR), misc);
#ifndef EN_MASK
#define EN_MASK 0xFFFFFFFFu
#endif
#define EN(b) (((EN_MASK) >> (b)) & 1u)
#define IN(k) (lo <= (k) && (k) < hi)
#define SEAM(k) do { if (IN(k) && IN((k) + 1)) xcd_barrier(bar); } while (0)

    const float* x_in = args.in[0];
    float* X = args.out;
    bf16* XB = (bf16*)(ws + WS_XB);
    float* LBS = (float*)(ws + WS_LBS);

    if (EN(0) && IN(0)) { PHASE_IDS();
        LAS float* scr = (LAS float*)(lds + wave * 16384);
        constexpr int I_WIN = 16 * (NINP / 32), I_BR = 8 * 32, I_OUT = 16 * 32, I_GU = 16 * (NINP / 32), I_DN = (FF0P / 64) * 32;
        constexpr int NITEMS = 2 * (I_WIN + 2 * I_BR + I_OUT) + I_GU + I_DN;
        for (int it = gwave; it < NITEMS; it += nwaves) {
            int r = it;
            if (r < 2 * I_WIN) { const int l = r / I_WIN; r %= I_WIN; const int nb = r % (NINP / 32), kb = r / (NINP / 32);
                const float* W = args.in[1] + (size_t)l * DM * 5400;
                auto cp = [=](int n) -> const float* { int c; if (n < 3328) c = n; else if (n < 5376) c = n + 24; else if (n < 5400) c = n - 5376 + 3328; else return nullptr; return W + c; };
                tr_item(cp, 5400, DM, (bf16*)(ws + (l ? WS_WIN1 : WS_WIN0)), DM, nb * 32, kb * 64, scr, lane); continue; }
            r -= 2 * I_WIN;
            if (r < 4 * I_BR) { const int which = r / I_BR; r %= I_BR; const int l = which & 1, ab = which >> 1; const int nb = r % 32, kb = r / 32;
                const float* W = args.in[ab ? 9 : 8] + (size_t)l * 512 * DM;
                auto cp = [=](int n) -> const float* { return W + n; };
                const size_t dsto = ab ? (l ? WS_WBB1 : WS_WBB0) : (l ? WS_WBA1 : WS_WBA0);
                tr_item(cp, DM, 512, (bf16*)(ws + dsto), 512, nb * 32, kb * 64, scr, lane); continue; }
            r -= 4 * I_BR;
            if (r < 2 * I_OUT) { const int l = r / I_OUT; r %= I_OUT; const int nb = r % 32, kb = r / 32;
                const float* W = args.in[10] + (size_t)l * DM * DM;
                auto cp = [=](int n) -> const float* { return W + n; };
                tr_item(cp, DM, DM, (bf16*)(ws + (l ? WS_WOUT1 : WS_WOUT0)), DM, nb * 32, kb * 64, scr, lane); continue; }
            r -= 2 * I_OUT;
            if (r < I_GU) { const int nb = r % (NINP / 32), kb = r / (NINP / 32);
                const float* Wg = args.in[15]; const float* Wu = args.in[16];
                auto cp = [=](int n) -> const float* { const int pn = n >> 8, hf = (n >> 7) & 1, c = pn * 128 + (n & 127); if (c >= FF0) return nullptr; return (hf ? Wu : Wg) + c; };
                tr_item(cp, FF0, DM, (bf16*)(ws + WS_WGU0), DM, nb * 32, kb * 64, scr, lane); continue; }
            r -= I_GU;
            { const int nb = r % 32, kb = r / 32;
                const float* W = args.in[17];
                auto cp = [=](int n) -> const float* { return W + n; };
                tr_item(cp, DM, FF0, (bf16*)(ws + WS_WDN0), FF0P, nb * 32, kb * 64, scr, lane); }
        }
        for (int row = gwave; row < NT; row += nwaves) {
            const f32x4* xr = (const f32x4*)(x_in + (size_t)row * DM);
            u32x2* o = (u32x2*)(XB + (size_t)row * DM);
#pragma unroll
            for (int j = 0; j < 4; ++j) { const f32x4 v = xr[64 * j + lane]; u32x2 w; w.x = cvt_pk_bf16(v[0], v[1]); w.y = cvt_pk_bf16(v[2], v[3]); o[64 * j + lane] = w; }
        }
        if (bid == 0) {
            const float* lg = args.in[2];
            const float a = lg[tid], b = lg[512 + tid], m = fmaxf(a, b), ea = expf(a - m), eb = expf(b - m), s = ea + eb, p0 = ea / s, p1 = eb / s;
            LBS[tid] = p0 - p0; LBS[512 + tid] = (p0 + p1) - p0;
        }
    }
    SEAM(0);

    for (int l = 0; l < 2; ++l) {
        const int pb = 1 + l * 10;
        const float* XI = l ? (const float*)X : x_in;

        if (EN(1) && IN(pb + 0)) { PHASE_IDS();
            pg8::Gemm g{XB, (const bf16*)(ws + (l ? WS_WIN1 : WS_WIN0)), NT, NINP, DM, 0};
            pg8::StaticOrder S; S.init(NT, NINP, G, bid);
            EpiInProj E{ws};
            pg8::gemm_phase<EpiInProj, pg8::StaticOrder>(lds, g, S, E);
        }
        SEAM(pb + 0);

        if (EN(2) && IN(pb + 1)) { PHASE_IDS();
            {
                LAS float* bs = (LAS float*)lds;
                LAS float* ks = bs + 64 * 128;
                LAS float* vs = ks + 64 * 128;
                const bf16* HI = (const bf16*)(ws + WS_HI); const float* HF = (const float*)(ws + WS_HF);
                bf16* US = (bf16*)(ws + WS_US); float* DEC = (float*)(ws + WS_DEC);
                for (int item = bid; item < NB * 128 * 4; item += G) {
                    const int h = item & 3, ci = (item >> 2) & 127, b = item >> 9, bh = b * 4 + h;
                    const size_t tok0 = (size_t)b * SEQ + ci * 64;
                    for (int idx = tid; idx < 64 * 128; idx += NTHR) { const int t = idx >> 7, d = idx & 127;
                        const float z = HF[(tok0 + t) * 512 + h * 128 + d], lb = LBS[l * 512 + h * 128 + d];
                        const float kk = (1.f - lb) / (1.f + __expf(z));
                        ks[idx] = kk; bs[idx] = log1pf(-kk); vs[idx] = bf2f(HI[(tok0 + t) * 512 + h * 128 + d]); }
                    __syncthreads();
                    if (tid < 128) { float run = 0.f; for (int t = 0; t < 64; ++t) { run += bs[t * 128 + tid]; bs[t * 128 + tid] = run; }
                        DEC[((size_t)bh * 128 + ci) * 128 + tid] = __expf(run); }
                    __syncthreads();
                    for (int idx = tid; idx < 64 * 128; idx += NTHR) { const int d = idx & 127; ks[idx] *= __expf(bs[63 * 128 + d] - bs[idx]); }
                    __syncthreads();
                    { const int v = tid & 127, dg = tid >> 7; float acc[32];
#pragma unroll
                        for (int j = 0; j < 32; ++j) acc[j] = 0.f;
                        for (int s = 0; s < 64; ++s) { const float vv = vs[s * 128 + v];
#pragma unroll
                            for (int j = 0; j < 32; ++j) acc[j] += ks[s * 128 + dg * 32 + j] * vv; }
                        bf16* u = US + ((size_t)bh * 128 + ci) * 16384;
#pragma unroll
                        for (int j = 0; j < 32; ++j) u[(dg * 32 + j) * 128 + v] = f2bf(acc[j]); }
                    __syncthreads();
                }
            }
            {
                LAS float* win = (LAS float*)lds;
                LAS float* pos = win + 144 * 64;
                LAS float* hid = pos + 32 * 64;
                const bf16* KV6 = (const bf16*)(ws + WS_KV6);
                for (int item = bid; item < 2 * NB * 2 * 64; item += G) {
                    const int nt8 = item & 63, g = (item >> 6) & 1, b = (item >> 7) & 3, kind = item >> 9;
                    const int n0 = nt8 * 8;
                    const float* W1 = args.in[5] + ((size_t)l * 2 + kind) * 2048 * 128;
                    const float* W2 = args.in[6] + ((size_t)l * 2 + kind) * 128 * 64;
                    const float* PS = args.in[4] + ((size_t)l * 2 + kind) * 32 * 64;
                    for (int idx = tid; idx < 144 * 64; idx += NTHR) { const int r = idx >> 6, d = idx & 63, tok = 16 * n0 + r;
                        win[idx] = tok < SEQ ? bf2f(KV6[((size_t)b * SEQ + tok) * 768 + kind * 128 + g * 64 + d]) : 0.f; }
                    for (int idx = tid; idx < 32 * 64; idx += NTHR) pos[idx] = PS[idx];
                    __syncthreads();
                    { const int w = wave, n = n0 + w; float a0 = 0.f, a1 = 0.f;
                        for (int ld = 0; ld < 2048; ++ld) { const int lp = ld >> 6, d = ld & 63;
                            const float a = win[(16 * w + lp) * 64 + d] + pos[ld]; const float* wr_ = W1 + (size_t)ld * 128;
                            a0 += a * wr_[lane]; a1 += a * wr_[64 + lane]; }
                        auto gelu = [](float x) { return 0.5f * x * (1.f + tanhf(0.7978845608028654f * (x + 0.044715f * x * x * x))); };
                        hid[w * 128 + lane] = gelu(a0); hid[w * 128 + 64 + lane] = gelu(a1);
                        WAVE_SYNC();
                        float o = 0.f;
                        for (int j = 0; j < 128; ++j) o += hid[w * 128 + j] * W2[j * 64 + lane];
                        if (n <= 510) ((float*)(ws + (kind ? WS_VC : WS_KC)))[(((size_t)b * 2 + g) * 512 + n) * 64 + lane] = o; }
                    __syncthreads();
                }
            }
        }
        SEAM(pb + 1);

        if (EN(3) && IN(pb + 2)) { PHASE_IDS();
            {
                unsigned* US32 = (unsigned*)(ws + WS_US); const float* DEC = (const float*)(ws + WS_DEC);
                for (int e2 = bid * NTHR + tid; e2 < 16 * 8192; e2 += G * NTHR) {
                    const int bh = e2 >> 13, dv2 = e2 & 8191, d = dv2 >> 6;
                    float s0 = 0.f, s1 = 0.f;
                    for (int c = 0; c < 128; ++c) {
                        const size_t o = ((size_t)bh * 128 + c) * 8192 + dv2;
                        const unsigned u = US32[o]; const float dec = DEC[((size_t)bh * 128 + c) * 128 + d];
                        US32[o] = cvt_pk_bf16(s0, s1);
                        s0 = dec * s0 + bflo(u); s1 = dec * s1 + bfhi(u);
                    }
                }
            }
            {
                LAS float* qs = (LAS float*)(lds + wave * 18432);
                LAS float* P = qs + 256;
                LAS int* selL = (LAS int*)(P + 4096);
                const bf16* NQ = (const bf16*)(ws + WS_NQ); const bf16* KV6 = (const bf16*)(ws + WS_KV6);
                const float* NG = (const float*)(ws + WS_NG);
                const float* KC = (const float*)(ws + WS_KC); const float* VC = (const float*)(ws + WS_VC);
                const float* RB = args.in[7];
                bf16* OB = (bf16*)(ws + WS_NQ);
                const int per = (NB * 2 * SEQ + nwaves - 1) / nwaves;
                auto dot4 = [&](const bf16* krow, float (&a)[4]) {
                    const u32x4* kr = (const u32x4*)krow;
#pragma unroll
                    for (int p = 0; p < 4; ++p) a[p] = 0.f;
#pragma unroll 2
                    for (int dq = 0; dq < 8; ++dq) { const u32x4 kv = kr[dq];
                        const float k0 = bflo(kv.x), k1 = bfhi(kv.x), k2 = bflo(kv.y), k3 = bfhi(kv.y), k4 = bflo(kv.z), k5 = bfhi(kv.z), k6 = bflo(kv.w), k7 = bfhi(kv.w);
#pragma unroll
                        for (int p = 0; p < 4; ++p) { const f32x4 q0 = *(const LAS f32x4*)(qs + p * 64 + dq * 8), q1 = *(const LAS f32x4*)(qs + p * 64 + dq * 8 + 4);
                            a[p] += q0[0] * k0 + q0[1] * k1 + q0[2] * k2 + q0[3] * k3 + q1[0] * k4 + q1[1] * k5 + q1[2] * k6 + q1[3] * k7; } }
                };
#pragma unroll 1
                for (int ii = 0; ii < per; ++ii) {
                    const int item = gwave * per + ii; if (item >= NB * 2 * SEQ) break;
                    const int t = item & (SEQ - 1), g = (item >> 13) & 1, b = item >> 14;
                    const size_t tok = (size_t)b * SEQ + t; const int bg = b * 2 + g;
                    WAVE_SYNC();
#pragma unroll
                    for (int p = 0; p < 4; ++p) qs[p * 64 + lane] = bf2f(NQ[tok * 512 + (g * 4 + p) * 64 + lane]);
                    WAVE_SYNC();
                    float ocmp[4] = {0.f, 0.f, 0.f, 0.f}, osel[4] = {0.f, 0.f, 0.f, 0.f}, owin[4] = {0.f, 0.f, 0.f, 0.f};
                    float mx[4], sm[4];
                    const int ncv = t >= 31 ? (t - 31) / 16 + 1 : 0;
#pragma unroll
                    for (int p = 0; p < 4; ++p) mx[p] = -3e38f;
#pragma unroll 1
                    for (int i = 0; i < 8; ++i) { const int n = lane + 64 * i; float a[4] = {-3e38f, -3e38f, -3e38f, -3e38f};
                        if (n < ncv) { const f32x4* kr = (const f32x4*)(KC + ((size_t)bg * 512 + n) * 64);
#pragma unroll
                            for (int p = 0; p < 4; ++p) a[p] = 0.f;
#pragma unroll 4
                            for (int dq = 0; dq < 16; ++dq) { const f32x4 kv = kr[dq];
#pragma unroll
                                for (int p = 0; p < 4; ++p) { const f32x4 qv = *(const LAS f32x4*)(qs + p * 64 + dq * 4); a[p] += qv[0] * kv[0] + qv[1] * kv[1] + qv[2] * kv[2] + qv[3] * kv[3]; } }
                            const int bk = rel_bucket(t - (16 * n + 31));
#pragma unroll
                            for (int p = 0; p < 4; ++p) { a[p] += RB[bk * 8 + g * 4 + p]; mx[p] = fmaxf(mx[p], a[p]); } }
#pragma unroll
                        for (int p = 0; p < 4; ++p) P[p * 1024 + n] = a[p]; }
#pragma unroll
                    for (int p = 0; p < 4; ++p) { mx[p] = wave_max(mx[p]); sm[p] = 0.f; }
#pragma unroll 1
                    for (int i = 0; i < 8; ++i) { const int n = lane + 64 * i;
#pragma unroll
                        for (int p = 0; p < 4; ++p) { const float e = (n < ncv) ? __expf(P[p * 1024 + n] - mx[p]) : 0.f; sm[p] += e; P[p * 1024 + n] = e; } }
#pragma unroll
                    for (int p = 0; p < 4; ++p) sm[p] = 1.f / fmaxf(wave_sum(sm[p]), 1e-30f);
#pragma unroll 1
                    for (int i = 0; i < 8; ++i) { const int n = lane + 64 * i;
#pragma unroll
                        for (int p = 0; p < 4; ++p) P[p * 1024 + n] *= sm[p]; }
                    WAVE_SYNC();
#pragma unroll 4
                    for (int n = 0; n < ncv; ++n) { const float v = VC[((size_t)bg * 512 + n) * 64 + lane];
#pragma unroll
                        for (int p = 0; p < 4; ++p) ocmp[p] += P[p * 1024 + n] * v; }
                    const int cur = t >> 6;
                    {
                        unsigned long long key0, key1;
                        { float sc[2];
#pragma unroll
                          for (int q = 0; q < 2; ++q) { const int s = lane + 64 * q; float im = 0.f;
#pragma unroll
                            for (int p = 0; p < 4; ++p) { const LAS float* pp = P + p * 1024 + 4 * s;
                                im += pp[0] + pp[1] + pp[2] + 0.5f * pp[3]; if (s > 0) im += 0.5f * pp[-1]; }
                            const bool forced = (s == 0) || (s == cur) || (s == cur - 1);
                            sc[q] = forced ? 1e9f : (s <= cur ? im : -1e30f); }
                          unsigned u0 = __float_as_uint(sc[0]); u0 ^= (u0 >> 31) ? 0xFFFFFFFFu : 0x80000000u;
                          unsigned u1 = __float_as_uint(sc[1]); u1 ^= (u1 >> 31) ? 0xFFFFFFFFu : 0x80000000u;
                          key0 = ((unsigned long long)u0 << 32) | (unsigned)(0xFFFFFFFFu - (unsigned)lane);
                          key1 = ((unsigned long long)u1 << 32) | (unsigned)(0xFFFFFFFFu - (unsigned)(lane + 64)); }
                        WAVE_SYNC();
#pragma unroll 1
                        for (int k = 0; k < 16; ++k) {
                            unsigned long long best = key0 > key1 ? key0 : key1;
#pragma unroll
                            for (int o = 1; o < 64; o <<= 1) { const unsigned long long ot = __shfl_xor(best, o); best = ot > best ? ot : best; }
                            const int idx = (int)(0xFFFFFFFFu - (unsigned)(best & 0xFFFFFFFFull));
                            if (lane == 0) selL[k] = idx;
                            if (idx == lane) key0 = 0ull; if (idx == lane + 64) key1 = 0ull;
                        }
                    }
                    WAVE_SYNC();
#pragma unroll
                    for (int p = 0; p < 4; ++p) mx[p] = -3e38f;
#pragma unroll 1
                    for (int k = 0; k < 16; ++k) { const int blk = selL[k]; const int kpos = blk * 64 + lane; const bool ok = (blk <= cur) && (kpos <= t);
                        float a[4] = {-3e38f, -3e38f, -3e38f, -3e38f};
                        if (ok) { dot4(KV6 + ((size_t)b * SEQ + kpos) * 768 + 256 + g * 64, a); const int bk = rel_bucket(t - kpos);
#pragma unroll
                            for (int p = 0; p < 4; ++p) { a[p] += RB[bk * 8 + g * 4 + p]; mx[p] = fmaxf(mx[p], a[p]); } }
#pragma unroll
                        for (int p = 0; p < 4; ++p) P[p * 1024 + k * 64 + lane] = a[p]; }
#pragma unroll
                    for (int p = 0; p < 4; ++p) { mx[p] = wave_max(mx[p]); sm[p] = 0.f; }
#pragma unroll 1
                    for (int k = 0; k < 16; ++k) {
#pragma unroll
                        for (int p = 0; p < 4; ++p) { const float lgv = P[p * 1024 + k * 64 + lane]; const float e = (lgv > -1e38f) ? __expf(lgv - mx[p]) : 0.f; sm[p] += e; P[p * 1024 + k * 64 + lane] = e; } }
#pragma unroll
                    for (int p = 0; p < 4; ++p) sm[p] = 1.f / fmaxf(wave_sum(sm[p]), 1e-30f);
                    WAVE_SYNC();
#pragma unroll 1
                    for (int k = 0; k < 16; ++k) { const int blk = selL[k]; if (blk > cur) continue;
                        const bf16* vr = KV6 + ((size_t)b * SEQ + blk * 64) * 768 + 384 + g * 64 + lane;
#pragma unroll 4
                        for (int i = 0; i < 64; ++i) { const float v = bf2f(vr[(size_t)i * 768]);
#pragma unroll
                            for (int p = 0; p < 4; ++p) osel[p] += P[p * 1024 + k * 64 + i] * v; } }
#pragma unroll
                    for (int p = 0; p < 4; ++p) osel[p] *= sm[p];
                    WAVE_SYNC();
#pragma unroll
                    for (int p = 0; p < 4; ++p) mx[p] = -3e38f;
#pragma unroll 1
                    for (int k = 0; k < 8; ++k) { const int kpos = t - 511 + 64 * k + lane; const bool ok = kpos >= 0;
                        float a[4] = {-3e38f, -3e38f, -3e38f, -3e38f};
                        if (ok) { dot4(KV6 + ((size_t)b * SEQ + kpos) * 768 + 512 + g * 64, a); const int bk = rel_bucket(t - kpos);
#pragma unroll
                            for (int p = 0; p < 4; ++p) { a[p] += RB[bk * 8 + g * 4 + p]; mx[p] = fmaxf(mx[p], a[p]); } }
#pragma unroll
                        for (int p = 0; p < 4; ++p) P[p * 1024 + k * 64 + lane] = a[p]; }
#pragma unroll
                    for (int p = 0; p < 4; ++p) { mx[p] = wave_max(mx[p]); sm[p] = 0.f; }
#pragma unroll 1
                    for (int k = 0; k < 8; ++k) {
#pragma unroll
                        for (int p = 0; p < 4; ++p) { const float lgv = P[p * 1024 + k * 64 + lane]; const float e = (lgv > -1e38f) ? __expf(lgv - mx[p]) : 0.f; sm[p] += e; P[p * 1024 + k * 64 + lane] = e; } }
#pragma unroll
                    for (int p = 0; p < 4; ++p) sm[p] = 1.f / fmaxf(wave_sum(sm[p]), 1e-30f);
                    WAVE_SYNC();
                    {
                        const int kfirst = t - 511 < 0 ? 0 : t - 511;
                        const bf16* vr = KV6 + ((size_t)b * SEQ) * 768 + 640 + g * 64 + lane;
#pragma unroll 4
                        for (int kp = kfirst; kp <= t; ++kp) { const float v = bf2f(vr[(size_t)kp * 768]); const int slot = kp - (t - 511);
#pragma unroll
                            for (int p = 0; p < 4; ++p) owin[p] += P[p * 1024 + slot] * v; }
#pragma unroll
                        for (int p = 0; p < 4; ++p) owin[p] *= sm[p];
                    }
#pragma unroll
                    for (int p = 0; p < 4; ++p) { const float* gl = NG + tok * 32 + (g * 4 + p) * 3;
                        const float o = sigmoidf_(gl[0]) * ocmp[p] + sigmoidf_(gl[1]) * osel[p] + sigmoidf_(gl[2]) * owin[p];
                        OB[tok * 512 + (g * 4 + p) * 64 + lane] = f2bf(o); }
                }
            }
        }
        SEAM(pb + 2);

        if (EN(4) && IN(pb + 3)) { PHASE_IDS();
            LAS float* qs = (LAS float*)lds;
            LAS float* ks = qs + 64 * 129;
            LAS float* bs = ks + 64 * 129;
            LAS float* As = bs + 64 * 129;
            LAS bf16* vs = (LAS bf16*)(As + 64 * 65);
            bf16* QHG = (bf16*)(ws + WS_QHG); const bf16* HI = (const bf16*)(ws + WS_HI); const bf16* HG = (const bf16*)(ws + WS_HG); const float* HF = (const float*)(ws + WS_HF);
            const bf16* US = (const bf16*)(ws + WS_US);
            const float* NW = args.in[3] + l * 512;
            for (int item = bid; item < NB * 128 * 4; item += G) {
                const int h = item & 3, ci = (item >> 2) & 127, b = item >> 9, bh = b * 4 + h;
                const size_t tok0 = (size_t)b * SEQ + ci * 64;
                for (int idx = tid; idx < 64 * 128; idx += NTHR) { const int t = idx >> 7, d = idx & 127;
                    const size_t go = (tok0 + t) * 512 + h * 128 + d;
                    const float z = HF[go], lb = LBS[l * 512 + h * 128 + d];
                    const float kk = (1.f - lb) / (1.f + __expf(z));
                    qs[t * 129 + d] = bf2f(QHG[go]); ks[t * 129 + d] = kk; bs[t * 129 + d] = log1pf(-kk); vs[idx] = HI[go]; }
                __syncthreads();
                if (tid < 128) { float run = 0.f; for (int t = 0; t < 64; ++t) { run += bs[t * 129 + tid]; bs[t * 129 + tid] = run; } }
                __syncthreads();
                for (int i = 0; i < 8; ++i) { const int p = tid + NTHR * i, t = p >> 6, s = p & 63; float a = 0.f;
                    if (s <= t) { for (int d = 0; d < 128; ++d) a += qs[t * 129 + d] * ks[s * 129 + d] * __expf(bs[t * 129 + d] - bs[s * 129 + d]); }
                    As[t * 65 + s] = a; }
                __syncthreads();
                for (int idx = tid; idx < 64 * 128; idx += NTHR) { const int t = idx >> 7, d = idx & 127; qs[t * 129 + d] *= __expf(bs[t * 129 + d]); }
                __syncthreads();
                {
                    float acc[8][2];
#pragma unroll
                    for (int j = 0; j < 8; ++j) { acc[j][0] = 0.f; acc[j][1] = 0.f; }
                    const bf16* Sg = US + ((size_t)bh * 128 + ci) * 16384;
                    for (int d = 0; d < 128; ++d) { const float s0 = bf2f(Sg[d * 128 + lane]), s1 = bf2f(Sg[d * 128 + 64 + lane]);
#pragma unroll
                        for (int j = 0; j < 8; ++j) { const float qv = qs[(wave * 8 + j) * 129 + d]; acc[j][0] += qv * s0; acc[j][1] += qv * s1; } }
                    for (int s = 0; s < 64; ++s) { const float v0 = bf2f(vs[s * 128 + lane]), v1 = bf2f(vs[s * 128 + 64 + lane]);
#pragma unroll
                        for (int j = 0; j < 8; ++j) { const float a = As[(wave * 8 + j) * 65 + s]; acc[j][0] += a * v0; acc[j][1] += a * v1; } }
#pragma unroll
                    for (int j = 0; j < 8; ++j) { const int t = wave * 8 + j;
                        const float ss = wave_sum(acc[j][0] * acc[j][0] + acc[j][1] * acc[j][1]);
                        const float r = rsqrtf(ss * (1.f / 128.f) + 1e-6f);
                        const size_t go = (tok0 + t) * 512 + h * 128;
                        const float g0 = bf2f(HG[go + lane]), g1 = bf2f(HG[go + 64 + lane]);
                        QHG[go + lane] = f2bf(acc[j][0] * r * NW[h * 128 + lane] * siluf_(g0));
                        QHG[go + 64 + lane] = f2bf(acc[j][1] * r * NW[h * 128 + 64 + lane] * siluf_(g1)); }
                }
                __syncthreads();
            }
        }
        SEAM(pb + 3);

        if (EN(5) && IN(pb + 4)) { PHASE_IDS();
            bf16* Y = (bf16*)(ws + WS_GA);
            { pg8::Gemm g{(const bf16*)(ws + WS_QHG), (const bf16*)(ws + (l ? WS_WBA1 : WS_WBA0)), NT, DM, 512, 0};
              pg8::StaticOrder S; S.init(NT, DM, G, bid); EpiGate<true> E{Y, (const bf16*)(ws + WS_GA)};
              pg8::gemm_phase<EpiGate<true>, pg8::StaticOrder>(lds, g, S, E); }
            { pg8::Gemm g{(const bf16*)(ws + WS_NQ), (const bf16*)(ws + (l ? WS_WBB1 : WS_WBB0)), NT, DM, 512, 0};
              pg8::StaticOrder S; S.init(NT, DM, G, bid); EpiGate<false> E{Y, (const bf16*)(ws + WS_GB)};
              pg8::gemm_phase<EpiGate<false>, pg8::StaticOrder>(lds, g, S, E); }
        }
        SEAM(pb + 4);

        if (EN(6) && IN(pb + 5)) { PHASE_IDS();
            pg8::Gemm g{(const bf16*)(ws + WS_GA), (const bf16*)(ws + (l ? WS_WOUT1 : WS_WOUT0)), NT, DM, DM, 0};
            pg8::StaticOrder S; S.init(NT, DM, G, bid); EpiResid E{XI, X};
            pg8::gemm_phase<EpiResid, pg8::StaticOrder>(lds, g, S, E);
        }
        SEAM(pb + 5);

        if (EN(7) && IN(pb + 6)) { PHASE_IDS();
            const float* gam = args.in[11] + l * DM; const float* bet = args.in[12] + l * DM;
            LAS int* hist = (LAS int*)(lds + 8 * 16384);
            if (l == 1) { if (tid < 8) hist[tid] = 0; __syncthreads(); }
            const int rpb = (NT + G - 1) / G;
            for (int i = wave; i < rpb; i += NWAVES) {
                const int row = bid * rpb + i; if (row >= NT) break;
                f32x4* xr = (f32x4*)(X + (size_t)row * DM);
                f32x4 v[4]; float s = 0.f;
#pragma unroll
                for (int j = 0; j < 4; ++j) { v[j] = xr[64 * j + lane]; s += (v[j][0] + v[j][1]) + (v[j][2] + v[j][3]); }
                const float mean = wave_sum(s) * (1.f / DM); float s2 = 0.f;
#pragma unroll
                for (int j = 0; j < 4; ++j) { v[j] = v[j] - mean; s2 += (v[j][0] * v[j][0] + v[j][1] * v[j][1]) + (v[j][2] * v[j][2] + v[j][3] * v[j][3]); }
                const float rstd = rsqrtf(wave_sum(s2) * (1.f / DM) + 1e-5f);
#pragma unroll
                for (int j = 0; j < 4; ++j) { const f32x4 gq = ((const f32x4*)gam)[64 * j + lane], bq = ((const f32x4*)bet)[64 * j + lane]; v[j] = v[j] * rstd * gq + bq; xr[64 * j + lane] = v[j]; }
                if (l == 0) { u32x2* o = (u32x2*)(XB + (size_t)row * DM);
#pragma unroll
                    for (int j = 0; j < 4; ++j) { u32x2 w; w.x = cvt_pk_bf16(v[j][0], v[j][1]); w.y = cvt_pk_bf16(v[j][2], v[j][3]); o[64 * j + lane] = w; }
                } else {
                    const float* WR = args.in[18];
                    float lg[8];
#pragma unroll
                    for (int e = 0; e < 8; ++e) lg[e] = 0.f;
#pragma unroll
                    for (int j = 0; j < 4; ++j)
#pragma unroll
                        for (int q = 0; q < 4; ++q) { const int c = 4 * (64 * j + lane) + q; const f32x4 w0 = *(const f32x4*)(WR + c * 8), w1 = *(const f32x4*)(WR + c * 8 + 4); const float xv = v[j][q];
                            lg[0] += xv * w0[0]; lg[1] += xv * w0[1]; lg[2] += xv * w0[2]; lg[3] += xv * w0[3]; lg[4] += xv * w1[0]; lg[5] += xv * w1[1]; lg[6] += xv * w1[2]; lg[7] += xv * w1[3]; }
#pragma unroll
                    for (int e = 0; e < 8; ++e) lg[e] = wave_sum(lg[e]);
                    int e1 = 0; float v1 = lg[0];
#pragma unroll
                    for (int e = 1; e < 8; ++e) if (lg[e] > v1) { v1 = lg[e]; e1 = e; }
                    int e2 = -1; float v2 = -3e38f;
#pragma unroll
                    for (int e = 0; e < 8; ++e) if (e != e1 && lg[e] > v2) { v2 = lg[e]; e2 = e; }
                    if (lane == 0) { const float g2 = 1.f / (1.f + expf(v1 - v2)), g1 = 1.f - g2;
                        ((int*)(ws + WS_TOPI))[row] = e1 | (e2 << 8); ((float*)(ws + WS_TOPG))[row * 2] = g1; ((float*)(ws + WS_TOPG))[row * 2 + 1] = g2;
                        atomicAdd((int*)&hist[e1], 1); atomicAdd((int*)&hist[e2], 1); }
                }
            }
            if (l == 1) {
                __syncthreads();
                if (tid < 8) ((int*)(ws + WS_CTL + CW_BLKCNT))[bid * 8 + tid] = hist[tid];
                LAS float* scr = (LAS float*)(lds + wave * 16384);
                constexpr int I_GU = 16 * (2 * FFE / 32), I_DN = (FFE / 64) * 32;
                for (int it = gwave; it < NEXP * (I_GU + I_DN); it += nwaves) {
                    const int e = it / (I_GU + I_DN); int r = it % (I_GU + I_DN);
                    if (r < I_GU) { const int nb = r % (2 * FFE / 32), kb = r / (2 * FFE / 32);
                        const float* Wg = args.in[19] + (size_t)e * DM * FFE; const float* Wu = args.in[20] + (size_t)e * DM * FFE;
                        auto cp = [=](int n) -> const float* { const int pn = n >> 8, hf = (n >> 7) & 1, c = pn * 128 + (n & 127); return (hf ? Wu : Wg) + c; };
                        tr_item(cp, FFE, DM, (bf16*)(ws + WS_MGU) + (size_t)e * 2 * FFE * DM, DM, nb * 32, kb * 64, scr, lane); }
                    else { r -= I_GU; const int nb = r % 32, kb = r / 32;
                        const float* W = args.in[21] + (size_t)e * FFE * DM;
                        auto cp = [=](int n) -> const float* { return W + n; };
                        tr_item(cp, DM, FFE, (bf16*)(ws + WS_MDN) + (size_t)e * DM * FFE, FFE, nb * 32, kb * 64, scr, lane); }
                }
            }
        }
        SEAM(pb + 6);

        if (l == 0) {
            if (EN(8) && IN(pb + 7)) { PHASE_IDS();
                pg8::Gemm g{XB, (const bf16*)(ws + WS_WGU0), NT, NINP, DM, 0};
                pg8::StaticOrder S; S.init(NT, NINP, G, bid); EpiSwiglu E{(bf16*)(ws + WS_H0), FF0P};
                pg8::gemm_phase<EpiSwiglu, pg8::StaticOrder>(lds, g, S, E);
            }
            SEAM(pb + 7);
            if (EN(9) && IN(pb + 8)) { PHASE_IDS();
                pg8::Gemm g{(const bf16*)(ws + WS_H0), (const bf16*)(ws + WS_WDN0), NT, DM, FF0P, 0};
                pg8::StaticOrder S; S.init(NT, DM, G, bid); EpiResid E{X, X};
                pg8::gemm_phase<EpiResid, pg8::StaticOrder>(lds, g, S, E);
            }
            SEAM(pb + 8);
            if (EN(10) && IN(pb + 9)) { PHASE_IDS();
                const float* gam = args.in[13]; const float* bet = args.in[14];
                for (int row = gwave; row < NT; row += nwaves) {
                    f32x4* xr = (f32x4*)(X + (size_t)row * DM);
                    f32x4 v[4]; float s = 0.f;
#pragma unroll
                    for (int j = 0; j < 4; ++j) { v[j] = xr[64 * j + lane]; s += (v[j][0] + v[j][1]) + (v[j][2] + v[j][3]); }
                    const float mean = wave_sum(s) * (1.f / DM); float s2 = 0.f;
#pragma unroll
                    for (int j = 0; j < 4; ++j) { v[j] = v[j] - mean; s2 += (v[j][0] * v[j][0] + v[j][1] * v[j][1]) + (v[j][2] * v[j][2] + v[j][3] * v[j][3]); }
                    const float rstd = rsqrtf(wave_sum(s2) * (1.f / DM) + 1e-5f);
                    u32x2* o = (u32x2*)(XB + (size_t)row * DM);
#pragma unroll
                    for (int j = 0; j < 4; ++j) { const f32x4 gq = ((const f32x4*)gam)[64 * j + lane], bq = ((const f32x4*)bet)[64 * j + lane]; v[j] = v[j] * rstd * gq + bq; xr[64 * j + lane] = v[j];
                        u32x2 w; w.x = cvt_pk_bf16(v[j][0], v[j][1]); w.y = cvt_pk_bf16(v[j][2], v[j][3]); o[64 * j + lane] = w; }
                }
            }
            SEAM(pb + 9);
        } else {
            int* META = (int*)(ws + WS_CTL + CW_META); int* PANELE = (int*)(ws + WS_CTL + CW_PANELE);
            int* ROWINFO = (int*)(ws + WS_ROWINFO);
            bf16* XS = (bf16*)(ws + WS_XS);
            if (EN(11) && IN(pb + 7)) { PHASE_IDS();
                LAS int* sh = (LAS int*)lds;
                const int* BC = (const int*)(ws + WS_CTL + CW_BLKCNT);
                if (tid < 8) { int tot = 0, pre = 0; for (int bb = 0; bb < G; ++bb) { const int c = BC[bb * 8 + tid]; if (bb < bid) pre += c; tot += c; } sh[tid] = tot; sh[8 + tid] = pre; sh[24 + tid] = 0; }
                __syncthreads();
                if (tid == 0) { int base = 0; for (int e = 0; e < 8; ++e) { sh[16 + e] = base; base += (sh[e] + 255) & ~255; }
                    if (bid == 0) { META[0] = base / 256; META[1] = (base / 256 + 63) / 64; int p = 0; for (int e = 0; e < 8; ++e) { META[8 + e] = sh[16 + e]; META[16 + e] = sh[e]; for (int q = 0; q < ((sh[e] + 255) >> 8); ++q) PANELE[p++] = e; } } }
                __syncthreads();
                if (bid < 8) { const int e = bid, r0 = sh[16 + e] + sh[e], r1 = sh[16 + e] + ((sh[e] + 255) & ~255);
                    for (int r = r0 + wave; r < r1; r += NWAVES) { if (lane == 0) ROWINFO[r] = -1;
#pragma unroll
                        for (int j = 0; j < 4; ++j) ((u32x2*)(XS + (size_t)r * DM))[64 * j + lane] = (u32x2){0u, 0u}; } }
                const int rpb = (NT + G - 1) / G;
                for (int i = wave; i < rpb; i += NWAVES) {
                    const int row = bid * rpb + i; if (row >= NT) break;
                    const int ti = ((const int*)(ws + WS_TOPI))[row]; const int e1 = ti & 255, e2 = ti >> 8;
                    int s1 = 0, s2 = 0;
                    if (lane == 0) { s1 = sh[16 + e1] + sh[8 + e1] + atomicAdd((int*)&sh[24 + e1], 1); s2 = sh[16 + e2] + sh[8 + e2] + atomicAdd((int*)&sh[24 + e2], 1); ROWINFO[s1] = row * 2; ROWINFO[s2] = row * 2 + 1; }
                    s1 = __builtin_amdgcn_readfirstlane(s1); s2 = __builtin_amdgcn_readfirstlane(s2);
                    const f32x4* xr = (const f32x4*)(X + (size_t)row * DM);
#pragma unroll
                    for (int j = 0; j < 4; ++j) { const f32x4 v = xr[64 * j + lane]; u32x2 w; w.x = cvt_pk_bf16(v[0], v[1]); w.y = cvt_pk_bf16(v[2], v[3]);
                        ((u32x2*)(XS + (size_t)s1 * DM))[64 * j + lane] = w; ((u32x2*)(XS + (size_t)s2 * DM))[64 * j + lane] = w; }
                }
            }
            SEAM(pb + 7);
            for (int c = 0; c < MAXCHUNK; ++c) {
                if (EN(12) && IN(pb + 8 + 2 * c)) { PHASE_IDS();
                    const int P = META[0], nch = META[1];
                    if (c < nch) { const int p0 = (int)((long)c * P / nch), p1 = (int)((long)(c + 1) * P / nch);
                        pg8::Gemm g{XS + (size_t)p0 * 256 * DM, (const bf16*)(ws + WS_MGU), (p1 - p0) * 256, 2 * FFE, DM, (size_t)2 * FFE * DM};
                        pg8::StaticOrder S; S.init((p1 - p0) * 256, 2 * FFE, G, bid, PANELE + p0); EpiSwiglu E{(bf16*)(ws + WS_HM), FFE};
                        pg8::gemm_phase<EpiSwiglu, pg8::StaticOrder>(lds, g, S, E); }
                }
                SEAM(pb + 8 + 2 * c);
                if (EN(13) && IN(pb + 9 + 2 * c)) { PHASE_IDS();
                    const int P = META[0], nch = META[1];
                    if (c < nch) { const int p0 = (int)((long)c * P / nch), p1 = (int)((long)(c + 1) * P / nch);
                        pg8::Gemm g{(const bf16*)(ws + WS_HM), (const bf16*)(ws + WS_MDN), (p1 - p0) * 256, DM, FFE, (size_t)DM * FFE};
                        pg8::StaticOrder S; S.init((p1 - p0) * 256, DM, G, bid, PANELE + p0); EpiScatter E{(bf16*)(ws + WS_YM), ROWINFO + p0 * 256};
                        pg8::gemm_phase<EpiScatter, pg8::StaticOrder>(lds, g, S, E); }
                }
                SEAM(pb + 9 + 2 * c);
            }
            if (EN(14) && IN(pb + 8 + 2 * MAXCHUNK)) { PHASE_IDS();
                const float* gam = args.in[13] + DM; const float* bet = args.in[14] + DM;
                const bf16* YM = (const bf16*)(ws + WS_YM); const float* TG = (const float*)(ws + WS_TOPG);
                for (int row = gwave; row < NT; row += nwaves) {
                    f32x4* xr = (f32x4*)(X + (size_t)row * DM);
                    const float g1 = TG[row * 2], g2 = TG[row * 2 + 1];
                    const u32x2* y1 = (const u32x2*)(YM + (size_t)(row * 2) * DM); const u32x2* y2 = (const u32x2*)(YM + (size_t)(row * 2 + 1) * DM);
                    f32x4 v[4]; float s = 0.f;
#pragma unroll
                    for (int j = 0; j < 4; ++j) { const f32x4 xv = xr[64 * j + lane]; const u32x2 a = y1[64 * j + lane], bq = y2[64 * j + lane];
                        v[j][0] = xv[0] * DN_ALPHA + g1 * bflo(a.x) + g2 * bflo(bq.x); v[j][1] = xv[1] * DN_ALPHA + g1 * bfhi(a.x) + g2 * bfhi(bq.x);
                        v[j][2] = xv[2] * DN_ALPHA + g1 * bflo(a.y) + g2 * bflo(bq.y); v[j][3] = xv[3] * DN_ALPHA + g1 * bfhi(a.y) + g2 * bfhi(bq.y);
                        s += (v[j][0] + v[j][1]) + (v[j][2] + v[j][3]); }
                    const float mean = wave_sum(s) * (1.f / DM); float s2 = 0.f;
#pragma unroll
                    for (int j = 0; j < 4; ++j) { v[j] = v[j] - mean; s2 += (v[j][0] * v[j][0] + v[j][1] * v[j][1]) + (v[j][2] * v[j][2] + v[j][3] * v[j][3]); }
                    const float rstd = rsqrtf(wave_sum(s2) * (1.f / DM) + 1e-5f);
#pragma unroll
                    for (int j = 0; j < 4; ++j) { const f32x4 gq = ((const f32x4*)gam)[64 * j + lane], bq = ((const f32x4*)bet)[64 * j + lane]; xr[64 * j + lane] = v[j] * rstd * gq + bq; }
                }
            }
        }
    }
#undef IN
#undef SEAM
}

constexpr int NPHASES = 1 + 10 + 8 + 2 * MAXCHUNK + 1;

extern "C" void kernel_launch(void* const* d_in, const int* in_sizes, int n_in, void* d_out, int out_size, void* d_ws, size_t ws_size, hipStream_t stream) {
    static int grid = 0;
    if (grid == 0) {
        if (n_in != 22 || out_size != NT * DM || ws_size < WS_END) { fprintf(stderr, "kernel_launch: need 22 inputs, %d outputs, >= %zu bytes of workspace; got %d, %d, %zu\n", NT * DM, (size_t)WS_END, n_in, out_size, ws_size); grid = -1; return; }
        int dev = 0, cus = 0, per_cu = 0;
        if (hipGetDevice(&dev) != hipSuccess || hipDeviceGetAttribute(&cus, hipDeviceAttributeMultiprocessorCount, dev) != hipSuccess) { grid = -1; return; }
        if (hipFuncSetAttribute((const void*)mega_fwd, hipFuncAttributeMaxDynamicSharedMemorySize, LDS_BYTES) != hipSuccess) { fprintf(stderr, "kernel_launch: hipFuncSetAttribute failed\n"); grid = -1; return; }
        if (hipOccupancyMaxActiveBlocksPerMultiprocessor(&per_cu, (const void*)mega_fwd, NTHR, LDS_BYTES) != hipSuccess || per_cu < 1) fprintf(stderr, "kernel_launch: occupancy query reports %d\n", per_cu);
        (void)hipGetLastError();
        grid = cus > 256 ? 256 : cus;
    }
    if (grid < 0) return;
    (void)hipMemsetAsync((char*)d_ws + WS_CTL, 0, CTL_BYTES, stream);
    Args a{};
    for (int i = 0; i < 22; ++i) a.in[i] = (const float*)d_in[i];
    a.out = (float*)d_out; a.ws = (unsigned char*)d_ws;
#if ONE_LAUNCH
    a.ph_lo = 0; a.ph_hi = NPHASES;
    hipLaunchKernelGGL(mega_fwd, dim3(grid), dim3(NTHR), LDS_BYTES, stream, a);
#else
    for (int p = 0; p < NPHASES; ++p) { a.ph_lo = p; a.ph_hi = p + 1; hipLaunchKernelGGL(mega_fwd, dim3(grid), dim3(NTHR), LDS_BYTES, stream, a); }
#endif
}
```

```cpp
#include <hip/hip_runtime.h>
#include <cstdio>
#include <cstdint>

#ifndef ONE_LAUNCH
#define ONE_LAUNCH 1
#endif

#define LAS __attribute__((address_space(3)))
typedef unsigned short bf16;
typedef short bf16x8 __attribute__((ext_vector_type(8)));
typedef float f32x4 __attribute__((ext_vector_type(4)));
typedef float f32x2 __attribute__((ext_vector_type(2)));
typedef unsigned u32x4 __attribute__((ext_vector_type(4)));
typedef unsigned u32x2 __attribute__((ext_vector_type(2)));

__device__ __forceinline__ unsigned cvt_pk_bf16(float lo, float hi) { unsigned r; asm volatile("v_cvt_pk_bf16_f32 %0, %1, %2" : "=v"(r) : "v"(lo), "v"(hi)); return r; }
__device__ __forceinline__ bf16 f2bf(float f) { unsigned u = __float_as_uint(f); u += 0x7FFFu + ((u >> 16) & 1u); return (bf16)(u >> 16); }
__device__ __forceinline__ float bf2f(bf16 b) { return __uint_as_float(((unsigned)b) << 16); }
__device__ __forceinline__ float bflo(unsigned u) { return __uint_as_float(u << 16); }
__device__ __forceinline__ float bfhi(unsigned u) { return __uint_as_float(u & 0xFFFF0000u); }
__device__ __forceinline__ float sigmoidf_(float x) { return 1.0f / (1.0f + __expf(-x)); }
__device__ __forceinline__ float siluf_(float x) { return x / (1.0f + __expf(-x)); }
__device__ __forceinline__ float wave_sum(float v) {
#pragma unroll
    for (int o = 1; o < 64; o <<= 1) v += __shfl_xor(v, o);
    return v;
}
__device__ __forceinline__ float wave_max(float v) {
#pragma unroll
    for (int o = 1; o < 64; o <<= 1) v = fmaxf(v, __shfl_xor(v, o));
    return v;
}
#define WAVE_SYNC() do { asm volatile("s_waitcnt lgkmcnt(0)" ::: "memory"); __builtin_amdgcn_wave_barrier(); } while (0)

#define PHASE_IDS() int tid_ph = threadIdx.x; asm volatile("" : "+v"(tid_ph)); const int tid = tid_ph, lane = tid & 63, wave = __builtin_amdgcn_readfirstlane(tid >> 6), gwave = bid * NWAVES + wave; (void)tid; (void)lane; (void)wave; (void)gwave
namespace pg8 {
constexpr int BM = 256, BK = 64, HALF = 128, HTB = HALF * BK * 2, STAGE_BYTES = 8 * HTB, NXCD = 8, WGM = 8;
__host__ __device__ __forceinline__ int lds_byte(int r, int c) { const int st = (r >> 4) * 2 + (c >> 5), rr = r & 15, cc = c & 31, ob = rr * 64 + cc * 2; return st * 1024 + (ob ^ (((ob >> 9) & 1) << 5)); }
__host__ __device__ __forceinline__ void stage_rc(int b, int& R, int& C) { const int st = b / 1024, sb = b % 1024, swz = sb ^ (((sb >> 9) & 1) << 5); R = (st >> 1) * 16 + swz / 64; C = (st & 1) * 32 + (swz % 64) / 2; }
__host__ __device__ __forceinline__ int perm32(int rho) { const int n = rho >> 4, i = rho & 15; return 8 * (i >> 2) + 4 * n + (i & 3); }

struct Unit { int pm, pn, e; };
struct Gemm { const bf16* A; const bf16* Bt; int M, N, K; size_t bt_estride; };

struct StaticOrder {
    int nM, nN, nwg, G, c; const int* pe;
    __device__ void init(int M, int N, int G_, int c_, const int* pe_ = nullptr) { nM = M / BM; nN = N / BM; nwg = nM * nN; G = G_; c = c_; pe = pe_; }
    __device__ bool next(int i, Unit& u) const {
        const long L = (long)i * G + c; if (L >= nwg) return false;
        int wgid = (int)L; { const int q = nwg / NXCD, r = nwg % NXCD, xcd = wgid % NXCD, off = wgid / NXCD; wgid = (xcd < r ? xcd * (q + 1) : r * (q + 1) + (xcd - r) * q) + off; }
        const int nig = WGM * nN, gid = wgid / nig, fm = gid * WGM, gsz = (nM - fm) < WGM ? (nM - fm) : WGM;
        u.pm = fm + ((wgid % nig) % gsz); u.pn = (wgid % nig) / gsz; u.e = pe ? pe[u.pm] : 0; return true;
    }
    __device__ __forceinline__ void a_ready(const Unit&) const {}
    __device__ __forceinline__ void done(const Unit&) const {}
};

template <class Epi, class Sched, bool ALIGN_EPI = true, bool SP2 = true>
__device__ __forceinline__ void gemm_phase(LAS unsigned char* lds, const Gemm g, const Sched& S, const Epi& E) {
    int tid_l = threadIdx.x; asm volatile("" : "+v"(tid_l));
    const int tid = tid_l, wid = __builtin_amdgcn_readfirstlane(tid >> 6), lane = tid & 63, wr = wid >> 2, wc = wid & 3, fr = lane & 15, fq = lane >> 4;
    const int K = g.K, nt = K / BK;
    unsigned voffA[2], voffB[2];
#pragma unroll
    for (int i = 0; i < 2; ++i) { int R, C; stage_rc(tid * 16 + i * 8192, R, C); const int Rb = Epi::PERM ? ((R & ~31) + perm32(R & 31)) : R;
        voffA[i] = (unsigned)(R * K + C) * 2u; voffB[i] = (unsigned)(Rb * K + C) * 2u; }
    const size_t kstep = (size_t)(BK * 2);
    const size_t hstep = (size_t)HALF * K * 2;
    const size_t tstep = 2 * hstep;
    const unsigned ldsw = (unsigned)wid * 1024u;
    const int aoff = lds_byte(wr * 64 + fr, fq * 8), boff = lds_byte(wc * 32 + fr, fq * 8);
#define PG8_SA(b, h) (((b) * 2 + (h)) * HTB)
#define PG8_SB(b, h) ((4 + (b) * 2 + (h)) * HTB)
#define PG8_STAGE(bufoff, gbase, voff) do { _Pragma("unroll") for (int _i = 0; _i < 2; ++_i) \
        __builtin_amdgcn_global_load_lds((const unsigned*)((const char*)(gbase) + (voff)[_i]), (LAS unsigned*)(lds + (bufoff) + ldsw + _i * 8192), 16, 0, 0); } while (0)
#define PG8_LDA(dst, b, h) do { _Pragma("unroll") for (int m = 0; m < 4; ++m) _Pragma("unroll") for (int k = 0; k < 2; ++k) dst[m][k] = *(const LAS bf16x8*)(lds + PG8_SA(b, h) + aoff + m * 2048 + k * 1024); } while (0)
#define PG8_LDB(dst, b, h) do { _Pragma("unroll") for (int n = 0; n < 2; ++n) _Pragma("unroll") for (int k = 0; k < 2; ++k) dst[n][k] = *(const LAS bf16x8*)(lds + PG8_SB(b, h) + boff + n * 2048 + k * 1024); } while (0)
#define PG8_MMA(ai, bj, At, Bt) do { __builtin_amdgcn_s_setprio(1); _Pragma("unroll") for (int m = 0; m < 4; ++m) _Pragma("unroll") for (int n = 0; n < 2; ++n) _Pragma("unroll") for (int k = 0; k < 2; ++k) \
        acc[ai][bj][m][n] = __builtin_amdgcn_mfma_f32_16x16x32_bf16(Bt[n][k], At[m][k], acc[ai][bj][m][n], 0, 0, 0); __builtin_amdgcn_s_setprio(0); } while (0)
#define PG8_WAIT_V(n) asm volatile("s_waitcnt vmcnt(" #n ")" ::: "memory")
#define PG8_WAIT_L(n) asm volatile("s_waitcnt lgkmcnt(" #n ")" ::: "memory")
#define PG8_BAR __builtin_amdgcn_s_barrier()
#define PG8_SCHED __builtin_amdgcn_sched_barrier(0)
    Unit cur, nxt; int ui = 0;
    if (!S.next(0, cur)) return;
    f32x4 acc[2][2][4][2];
#pragma unroll
    for (int a = 0; a < 2; ++a)
#pragma unroll
        for (int b = 0; b < 2; ++b)
#pragma unroll
            for (int m = 0; m < 4; ++m)
#pragma unroll
                for (int n = 0; n < 2; ++n) acc[a][b][m][n] = (f32x4){0.f, 0.f, 0.f, 0.f};
    bf16x8 At[4][2], B0[2][2], B1[2][2];
    const char* cA = (const char*)g.A + (size_t)cur.pm * tstep; const char* cB = (const char*)(g.Bt + (size_t)cur.e * g.bt_estride) + (size_t)cur.pn * tstep;
    S.a_ready(cur);
    if constexpr (SP2) {
        PG8_STAGE(PG8_SB(0, 0), cB, voffB); PG8_STAGE(PG8_SB(0, 1), cB + hstep, voffB); PG8_STAGE(PG8_SA(0, 0), cA, voffA); PG8_STAGE(PG8_SA(0, 1), cA + hstep, voffA);
        if (wr == 1) PG8_BAR;
        PG8_WAIT_V(2); PG8_BAR;
        PG8_STAGE(PG8_SB(1, 0), cB + kstep, voffB); PG8_STAGE(PG8_SA(1, 0), cA + kstep, voffA); PG8_STAGE(PG8_SB(1, 1), cB + hstep + kstep, voffB);
        PG8_WAIT_V(6); PG8_BAR;
    } else {
        PG8_STAGE(PG8_SB(0, 0), cB, voffB); PG8_STAGE(PG8_SA(0, 0), cA, voffA); PG8_STAGE(PG8_SB(0, 1), cB + hstep, voffB); PG8_STAGE(PG8_SA(0, 1), cA + hstep, voffA);
        if (wr == 1) PG8_BAR;
        PG8_WAIT_V(4); PG8_BAR;
        PG8_STAGE(PG8_SB(1, 0), cB + kstep, voffB); PG8_STAGE(PG8_SA(1, 0), cA + kstep, voffA); PG8_STAGE(PG8_SB(1, 1), cB + hstep + kstep, voffB);
        PG8_WAIT_V(6); PG8_BAR;
    }
    for (;;) {
        const bool has_next = S.next(ui + 1, nxt);
        const char* nA = has_next ? (const char*)g.A + (size_t)nxt.pm * tstep : cA;
        const char* nB = has_next ? (const char*)(g.Bt + (size_t)nxt.e * g.bt_estride) + (size_t)nxt.pn * tstep : cB;
        for (int t = 0; t < nt; t += 2) {
            const bool last = (t == nt - 2);
            const char* a1 = cA + (size_t)(t + 1) * kstep;
            const char* a2 = last ? nA : cA + (size_t)(t + 2) * kstep; const char* b2 = last ? nB : cB + (size_t)(t + 2) * kstep;
            const char* a3 = a2 + kstep; const char* b3 = b2 + kstep;
            if (last && has_next) S.a_ready(nxt);
            if constexpr (SP2) {
            PG8_LDB(B0, 0, 0); PG8_LDB(B1, 0, 1); PG8_SCHED; PG8_LDA(At, 0, 0); PG8_STAGE(PG8_SA(1, 1), a1 + hstep, voffA);
            PG8_WAIT_V(8); PG8_WAIT_L(0); PG8_BAR; PG8_MMA(0, 0, At, B0); PG8_MMA(0, 1, At, B1); PG8_BAR; PG8_SCHED;
            PG8_LDA(At, 0, 1); PG8_STAGE(PG8_SB(0, 0), b2, voffB); PG8_STAGE(PG8_SB(0, 1), b2 + hstep, voffB); PG8_STAGE(PG8_SA(0, 0), a2, voffA);
            PG8_WAIT_V(8); PG8_WAIT_L(0); PG8_BAR; PG8_MMA(1, 0, At, B0); PG8_MMA(1, 1, At, B1); PG8_BAR; PG8_SCHED;
            PG8_LDB(B0, 1, 0); PG8_LDB(B1, 1, 1); PG8_SCHED; PG8_LDA(At, 1, 0); PG8_STAGE(PG8_SA(0, 1), a2 + hstep, voffA);
            PG8_WAIT_V(8); PG8_WAIT_L(0); PG8_BAR; PG8_MMA(0, 0, At, B0); PG8_MMA(0, 1, At, B1); PG8_BAR; PG8_SCHED;
            PG8_LDA(At, 1, 1); PG8_STAGE(PG8_SB(1, 0), b3, voffB); PG8_STAGE(PG8_SB(1, 1), b3 + hstep, voffB); PG8_STAGE(PG8_SA(1, 0), a3, voffA);
            PG8_WAIT_V(8); PG8_WAIT_L(0); PG8_BAR; PG8_MMA(1, 0, At, B0); PG8_MMA(1, 1, At, B1); PG8_BAR; PG8_SCHED;
            } else {
            PG8_LDB(B0, 0, 0); PG8_SCHED; PG8_LDA(At, 0, 0); PG8_STAGE(PG8_SA(1, 1), a1 + hstep, voffA);
            PG8_WAIT_L(8); PG8_BAR; PG8_WAIT_L(0); PG8_MMA(0, 0, At, B0); PG8_BAR; PG8_SCHED;
            PG8_LDB(B1, 0, 1); PG8_STAGE(PG8_SB(0, 0), b2, voffB);
            PG8_BAR; PG8_WAIT_L(0); PG8_MMA(0, 1, At, B1); PG8_BAR;
            PG8_LDA(At, 0, 1); PG8_STAGE(PG8_SA(0, 0), a2, voffA);
            PG8_BAR; PG8_WAIT_L(0); PG8_MMA(1, 0, At, B0); PG8_BAR; PG8_SCHED;
            PG8_STAGE(PG8_SB(0, 1), b2 + hstep, voffB);
            PG8_WAIT_V(6); PG8_BAR; PG8_MMA(1, 1, At, B1); PG8_BAR;
            PG8_LDB(B0, 1, 0); PG8_SCHED; PG8_LDA(At, 1, 0); PG8_STAGE(PG8_SA(0, 1), a2 + hstep, voffA);
            PG8_WAIT_L(8); PG8_BAR; PG8_WAIT_L(0); PG8_MMA(0, 0, At, B0); PG8_BAR; PG8_SCHED;
            PG8_LDB(B1, 1, 1); PG8_STAGE(PG8_SB(1, 0), b3, voffB);
            PG8_BAR; PG8_WAIT_L(0); PG8_MMA(0, 1, At, B1); PG8_BAR;
            PG8_LDA(At, 1, 1); PG8_STAGE(PG8_SA(1, 0), a3, voffA);
            PG8_BAR; PG8_WAIT_L(0); PG8_MMA(1, 0, At, B0); PG8_BAR; PG8_SCHED;
            PG8_STAGE(PG8_SB(1, 1), b3 + hstep, voffB);
            PG8_WAIT_V(6); PG8_BAR; PG8_MMA(1, 1, At, B1); PG8_BAR;
            }
        }
        if constexpr (ALIGN_EPI) { if (wr == 0) PG8_BAR; }
        E(acc, cur, wr, wc, fr, fq); S.done(cur);
        if (!has_next) break;
#pragma unroll
        for (int a = 0; a < 2; ++a)
#pragma unroll
            for (int b = 0; b < 2; ++b)
#pragma unroll
                for (int m = 0; m < 4; ++m)
#pragma unroll
                    for (int n = 0; n < 2; ++n) acc[a][b][m][n] = (f32x4){0.f, 0.f, 0.f, 0.f};
        cur = nxt; cA = nA; cB = nB; ++ui;
        if constexpr (ALIGN_EPI) { if (wr == 1) PG8_BAR; }
    }
    PG8_WAIT_V(0);
    if constexpr (!ALIGN_EPI) { if (wr == 0) PG8_BAR; }
    PG8_BAR;
#undef PG8_SA
#undef PG8_SB
#undef PG8_STAGE
#undef PG8_LDA
#undef PG8_LDB
#undef PG8_MMA
#undef PG8_WAIT_V
#undef PG8_WAIT_L
#undef PG8_BAR
#undef PG8_SCHED
}
}

#define XB_TMO      128
#define XB_XCNT(j)  (256  + 64 * (j))
#define XB_XSUB(j)  (1280 + 64 * (j))
#define XB_XGEN(j)  (2304 + 64 * (j))
#define XB_TOP      3328
#define XB_TOPGEN   3392
#define XCD_BAR_WORDS 3456
#define XB_SPIN_CAP (1u << 18)
__device__ __forceinline__ unsigned xb_ld(unsigned* p)              { return __hip_atomic_load(p, __ATOMIC_RELAXED, __HIP_MEMORY_SCOPE_AGENT); }
__device__ __forceinline__ unsigned xb_add(unsigned* p, unsigned v) { return __hip_atomic_fetch_add(p, v, __ATOMIC_RELAXED, __HIP_MEMORY_SCOPE_AGENT); }
__device__ __forceinline__ unsigned xb_xcc_id() { return (unsigned)__builtin_amdgcn_s_getreg((3 << 11) | 20) & 0xFu; }
#define XB_SPIN(cond, bar) do { unsigned _sp = 0; while (cond) { __builtin_amdgcn_s_sleep(1); \
    if ((++_sp & 255u) == 0u) { if (xb_ld(&(bar)[XB_TMO])) break; if (_sp > XB_SPIN_CAP) { atomicAdd(&(bar)[XB_TMO], 1u); break; } } } } while (0)
struct XcdBarrier { unsigned* bar; unsigned x; volatile LAS unsigned* st; };
__device__ __forceinline__ XcdBarrier xcd_barrier_post(unsigned* bar, volatile LAS unsigned* st) {
    XcdBarrier b; b.bar = bar; b.x = xb_xcc_id(); b.st = st;
    if (threadIdx.x == 0) (void)xb_add(&bar[XB_XCNT(b.x)], 1u);
    return b;
}
__device__ __forceinline__ void xcd_barrier_complete(unsigned* bar, unsigned x, unsigned& nloc, unsigned& nx) {
    const unsigned G = gridDim.x * gridDim.y * gridDim.z;
    unsigned sum, cnt, mine, sp = 0u;
    for (;;) {
        sum = 0u; cnt = 0u; mine = 0u;
#pragma unroll
        for (unsigned j = 0; j < 16; ++j) { const unsigned c = xb_ld(&bar[XB_XCNT(j)]); sum += c; cnt += (c > 0u) ? 1u : 0u; mine = (j == x) ? c : mine; }
        if (sum == G) break;
        __builtin_amdgcn_s_sleep(1);
        if ((++sp & 255u) == 0u) { if (xb_ld(&bar[XB_TMO])) break; if (sp > XB_SPIN_CAP) { atomicAdd(&bar[XB_TMO], 1u); break; } }
    }
    nloc = mine > 0u ? mine : 1u; nx = cnt > 0u ? cnt : 1u;
}
__device__ __forceinline__ void xcd_barrier(const XcdBarrier& b) {
    asm volatile("s_waitcnt vmcnt(0)" ::: "memory");
    __syncthreads();
    if (threadIdx.x == 0) {
        unsigned* bar = b.bar;
        __builtin_amdgcn_s_waitcnt(0);
        unsigned nloc = b.st[0], nx = b.st[1];
        if (nloc == 0u) { xcd_barrier_complete(bar, b.x, nloc, nx); b.st[0] = nloc; b.st[1] = nx; }
        const unsigned old = xb_add(&bar[XB_XSUB(b.x)], 1u);
        const unsigned gen = old / nloc;
        if (old + 1u == (gen + 1u) * nloc) {
            __builtin_amdgcn_fence(__ATOMIC_RELEASE, "agent");
            asm volatile("s_waitcnt vmcnt(0)" ::: "memory");
            const unsigned og = xb_add(&bar[XB_TOP], 1u);
            const unsigned tg = og / nx;
            if (og + 1u == (tg + 1u) * nx) xb_add(&bar[XB_TOPGEN], 1u);
            else XB_SPIN(xb_ld(&bar[XB_TOPGEN]) == tg, bar);
            __builtin_amdgcn_fence(__ATOMIC_ACQUIRE, "agent");
            xb_add(&bar[XB_XGEN(b.x)], 1u);
            asm volatile("s_waitcnt vmcnt(0)" ::: "memory");
        } else {
            XB_SPIN(xb_ld(&bar[XB_XGEN(b.x)]) == gen, bar);
            __builtin_amdgcn_fence(__ATOMIC_ACQUIRE, "agent");
            asm volatile("s_waitcnt vmcnt(0)" ::: "memory");
        }
    }
    __syncthreads();
}

constexpr int NB = 4, SEQ = 8192, DM = 1024, NT = NB * SEQ;
constexpr int NINP = 5632;
constexpr int FF0 = 2752, FF0P = 2816, FFE = 3584, NEXP = 8;
constexpr int NWAVES = 8, NTHR = 512;
constexpr int LDS_BYTES = 155648;
constexpr int MISC_OFF = LDS_BYTES - 64;
constexpr float DN_ALPHA = 1.41421356237309515f;
constexpr int MAXPANELS = 272;
constexpr int MAXCHUNK = 5;

constexpr size_t al256(size_t x) { return (x + 255) & ~(size_t)255; }
constexpr size_t WS_CTL = 0;
constexpr size_t CTL_BYTES = 65536;
constexpr size_t CW_BAR = 0;
constexpr size_t CW_BLKCNT = 16384;
constexpr size_t CW_META = 16384 + 8192;
constexpr size_t CW_PANELE = 16384 + 8192 + 256;
constexpr size_t WS_LBS = WS_CTL + CTL_BYTES;
constexpr size_t WS_KC = WS_LBS + 4096;
constexpr size_t WS_VC = WS_KC + 1048576;
constexpr size_t WS_DEC = WS_VC + 1048576;
constexpr size_t WS_TOPI = WS_DEC + 1048576;
constexpr size_t WS_TOPG = WS_TOPI + (size_t)NT * 4;
constexpr size_t WS_ROWINFO = WS_TOPG + (size_t)NT * 8;
constexpr size_t WS_BIG = al256(WS_ROWINFO + (size_t)MAXPANELS * 256 * 4);
constexpr size_t SZ_WIN = (size_t)NINP * DM * 2, SZ_WBR = (size_t)DM * 512 * 2, SZ_WOUT = (size_t)DM * DM * 2;
constexpr size_t WS_WIN0 = WS_BIG, WS_WIN1 = WS_WIN0 + SZ_WIN;
constexpr size_t WS_WBA0 = WS_WIN1 + SZ_WIN, WS_WBA1 = WS_WBA0 + SZ_WBR, WS_WBB0 = WS_WBA1 + SZ_WBR, WS_WBB1 = WS_WBB0 + SZ_WBR;
constexpr size_t WS_WOUT0 = WS_WBB1 + SZ_WBR, WS_WOUT1 = WS_WOUT0 + SZ_WOUT;
constexpr size_t WS_WGU0 = WS_WOUT1 + SZ_WOUT;
constexpr size_t WS_WDN0 = WS_WGU0 + (size_t)NINP * DM * 2;
constexpr size_t WS_XB = WS_WDN0 + (size_t)DM * FF0P * 2;
constexpr size_t WS_US = WS_XB;
constexpr size_t WS_PROJ = WS_XB + (size_t)NT * DM * 2;
constexpr size_t WS_QHG = WS_PROJ;
constexpr size_t WS_HF = WS_QHG + (size_t)NT * 512 * 2;
constexpr size_t WS_HI = WS_HF + (size_t)NT * 512 * 4;
constexpr size_t WS_HG = WS_HI + (size_t)NT * 512 * 2;
constexpr size_t WS_NQ = WS_HG + (size_t)NT * 512 * 2;
constexpr size_t WS_KV6 = WS_NQ + (size_t)NT * 512 * 2;
constexpr size_t WS_GA = WS_KV6 + (size_t)NT * 768 * 2;
constexpr size_t WS_GB = WS_GA + (size_t)NT * DM * 2;
constexpr size_t WS_NG = WS_GB + (size_t)NT * DM * 2;
constexpr size_t WS_MIX_END = WS_NG + (size_t)NT * 32 * 4;
constexpr size_t WS_H0 = WS_PROJ;
constexpr size_t WS_MGU = WS_BIG;
constexpr size_t WS_MDN = WS_MGU + (size_t)NEXP * 2 * FFE * DM * 2;
constexpr size_t WS_XS = WS_MDN + (size_t)NEXP * DM * FFE * 2;
constexpr size_t WS_HM = WS_XS + (size_t)MAXPANELS * 256 * DM * 2;
constexpr size_t WS_YM = WS_HM + (size_t)64 * 256 * FFE * 2;
constexpr size_t WS_MOE_END = WS_YM + (size_t)NT * 2 * DM * 2;
constexpr size_t WS_END = WS_MOE_END > WS_MIX_END ? WS_MOE_END : WS_MIX_END;

struct Args {
    const float* in[22]; float* out; unsigned char* ws; int ph_lo, ph_hi;
};

struct EpiInProj {
    static constexpr bool PERM = false;
    unsigned char* ws;
    __device__ __forceinline__ void operator()(const f32x4 (&acc)[2][2][4][2], const pg8::Unit& u, int wr, int wc, int fr, int fq) const {
        const int row0 = u.pm * 256 + wr * 64 + fr;
#pragma unroll
        for (int bj = 0; bj < 2; ++bj)
#pragma unroll
            for (int n = 0; n < 2; ++n) {
                const int cb = u.pn * 256 + bj * 128 + wc * 32 + n * 16;
                const int c = cb + 4 * fq;
                int kind = 0, ld = 512, co = 0; size_t base = 0; float sc = 1.f;
                if (cb < 512) { base = WS_QHG; co = c; }
                else if (cb < 1024) { kind = 1; base = WS_HF; co = c - 512; }
                else if (cb < 1536) { base = WS_HI; co = c - 1024; }
                else if (cb < 2048) { base = WS_HG; co = c - 1536; }
                else if (cb < 2560) { base = WS_NQ; co = c - 2048; sc = 0.125f; }
                else if (cb < 3328) { base = WS_KV6; co = c - 2560; ld = 768; }
                else if (cb < 4352) { base = WS_GA; co = c - 3328; ld = 1024; }
                else if (cb < 5376) { base = WS_GB; co = c - 4352; ld = 1024; }
                else if (cb < 5408) { kind = 1; base = WS_NG; co = c - 5376; ld = 32; }
                else kind = 2;
                if (kind == 2) continue;
#pragma unroll
                for (int ai = 0; ai < 2; ++ai)
#pragma unroll
                    for (int m = 0; m < 4; ++m) {
                        const int row = row0 + ai * 128 + m * 16;
                        const f32x4 v = acc[ai][bj][m][n];
                        if (kind == 0) { u32x2 w; w.x = cvt_pk_bf16(v[0] * sc, v[1] * sc); w.y = cvt_pk_bf16(v[2] * sc, v[3] * sc); *(u32x2*)((bf16*)(ws + base) + (size_t)row * ld + co) = w; }
                        else *(f32x4*)((float*)(ws + base) + (size_t)row * ld + co) = v;
                    }
            }
    }
};
template <bool FIRST> struct EpiGate {
    static constexpr bool PERM = false;
    bf16* Y; const bf16* G;
    __device__ __forceinline__ void operator()(const f32x4 (&acc)[2][2][4][2], const pg8::Unit& u, int wr, int wc, int fr, int fq) const {
        const int row0 = u.pm * 256 + wr * 64 + fr, col0 = u.pn * 256 + wc * 32 + 4 * fq;
#pragma unroll
        for (int ai = 0; ai < 2; ++ai)
#pragma unroll
            for (int m = 0; m < 4; ++m)
#pragma unroll
                for (int bj = 0; bj < 2; ++bj)
#pragma unroll
                    for (int n = 0; n < 2; ++n) {
                        const size_t off = (size_t)(row0 + ai * 128 + m * 16) * DM + col0 + bj * 128 + n * 16;
                        const u32x2 gq = *(const u32x2*)(G + off);
                        const f32x4 v = acc[ai][bj][m][n];
                        float o0 = sigmoidf_(bflo(gq.x)) * v[0], o1 = sigmoidf_(bfhi(gq.x)) * v[1], o2 = sigmoidf_(bflo(gq.y)) * v[2], o3 = sigmoidf_(bfhi(gq.y)) * v[3];
                        if (!FIRST) { const u32x2 yq = *(const u32x2*)(Y + off); o0 += bflo(yq.x); o1 += bfhi(yq.x); o2 += bflo(yq.y); o3 += bfhi(yq.y); }
                        u32x2 w; w.x = cvt_pk_bf16(o0, o1); w.y = cvt_pk_bf16(o2, o3); *(u32x2*)(Y + off) = w;
                    }
    }
};
struct EpiResid {
    static constexpr bool PERM = false;
    const float* XI; float* XO;
    __device__ __forceinline__ void operator()(const f32x4 (&acc)[2][2][4][2], const pg8::Unit& u, int wr, int wc, int fr, int fq) const {
        const int row0 = u.pm * 256 + wr * 64 + fr, col0 = u.pn * 256 + wc * 32 + 4 * fq;
#pragma unroll
        for (int ai = 0; ai < 2; ++ai)
#pragma unroll
            for (int m = 0; m < 4; ++m)
#pragma unroll
                for (int bj = 0; bj < 2; ++bj)
#pragma unroll
                    for (int n = 0; n < 2; ++n) {
                        const size_t off = (size_t)(row0 + ai * 128 + m * 16) * DM + col0 + bj * 128 + n * 16;
                        const f32x4 xi = *(const f32x4*)(XI + off);
                        *(f32x4*)(XO + off) = xi * DN_ALPHA + acc[ai][bj][m][n];
                    }
    }
};
struct EpiSwiglu {
    static constexpr bool PERM = false;
    bf16* H; int ldh;
    __device__ __forceinline__ void operator()(const f32x4 (&acc)[2][2][4][2], const pg8::Unit& u, int wr, int wc, int fr, int fq) const {
        const int row0 = u.pm * 256 + wr * 64 + fr, col0 = u.pn * 128 + wc * 32 + 4 * fq;
#pragma unroll
        for (int ai = 0; ai < 2; ++ai)
#pragma unroll
            for (int m = 0; m < 4; ++m)
#pragma unroll
                for (int n = 0; n < 2; ++n) {
                    const f32x4 gq = acc[ai][0][m][n], uq = acc[ai][1][m][n];
                    u32x2 w; w.x = cvt_pk_bf16(siluf_(gq[0]) * uq[0], siluf_(gq[1]) * uq[1]); w.y = cvt_pk_bf16(siluf_(gq[2]) * uq[2], siluf_(gq[3]) * uq[3]);
                    *(u32x2*)(H + (size_t)(row0 + ai * 128 + m * 16) * ldh + col0 + n * 16) = w;
                }
    }
};
struct EpiScatter {
    static constexpr bool PERM = false;
    bf16* Y; const int* rowinfo;
    __device__ __forceinline__ void operator()(const f32x4 (&acc)[2][2][4][2], const pg8::Unit& u, int wr, int wc, int fr, int fq) const {
        const int row0 = u.pm * 256 + wr * 64 + fr, col0 = u.pn * 256 + wc * 32 + 4 * fq;
#pragma unroll
        for (int ai = 0; ai < 2; ++ai)
#pragma unroll
            for (int m = 0; m < 4; ++m) {
                const int info = rowinfo[row0 + ai * 128 + m * 16];
                if (info < 0) continue;
#pragma unroll
                for (int bj = 0; bj < 2; ++bj)
#pragma unroll
                    for (int n = 0; n < 2; ++n) {
                        const f32x4 v = acc[ai][bj][m][n];
                        u32x2 w; w.x = cvt_pk_bf16(v[0], v[1]); w.y = cvt_pk_bf16(v[2], v[3]);
                        *(u32x2*)(Y + (size_t)info * DM + col0 + bj * 128 + n * 16) = w;
                    }
            }
    }
};

__device__ __forceinline__ int rel_bucket(int n) {
    if (n < 16) return n;
    return 16 + (n >= 22) + (n >= 30) + (n >= 40) + (n >= 54) + (n >= 73) + (n >= 99) + (n >= 134) + (n >= 182) + (n >= 246) + (n >= 332) + (n >= 450) + (n >= 609) + (n >= 825) + (n >= 1117) + (n >= 1513);
}
template <class F>
__device__ __forceinline__ void tr_item(F colptr, int ld, int Kvalid, bf16* dst, int dstld, int n0, int k0, LAS float* scr, int lane) {
    const float* cp = colptr(n0 + (lane & 31));
#pragma unroll 8
    for (int i = 0; i < 32; ++i) { const int kk = 2 * i + (lane >> 5), k = k0 + kk; float v = 0.f; if (cp && k < Kvalid) v = cp[(size_t)k * ld]; scr[kk * 33 + (lane & 31)] = v; }
    WAVE_SYNC();
    const int c = lane & 7;
#pragma unroll
    for (int j = 0; j < 4; ++j) { const int n = (lane >> 3) + 8 * j; const LAS float* s = scr + (8 * c) * 33 + n;
        u32x4 o; o.x = cvt_pk_bf16(s[0 * 33], s[1 * 33]); o.y = cvt_pk_bf16(s[2 * 33], s[3 * 33]); o.z = cvt_pk_bf16(s[4 * 33], s[5 * 33]); o.w = cvt_pk_bf16(s[6 * 33], s[7 * 33]);
        *(u32x4*)(dst + (size_t)(n0 + n) * dstld + k0 + 8 * c) = o; }
    WAVE_SYNC();
}

__global__ void __launch_bounds__(NTHR, 2) mega_fwd(Args args) {
    extern __shared__ __attribute__((aligned(16))) unsigned char lds_raw[];
    LAS unsigned char* lds = (LAS unsigned char*)lds_raw;
    const int G = gridDim.x, bid = blockIdx.x;
    const int nwaves = G * NWAVES;
    unsigned char* ws = args.ws;
    const int lo = args.ph_lo, hi = args.ph_hi;

    volatile LAS unsigned* misc = (volatile LAS unsigned*)(lds + MISC_OFF);
    if (threadIdx.x < 16) misc[threadIdx.x] = 0u;
    __syncthreads();
    XcdBarrier bar; bar.bar = (unsigned*)(ws + WS_CTL + CW_BAR); bar.x = 0; bar.st = misc;
    const bool multi = (hi - lo) > 1;
    if (multi) bar = xcd_barrier_post((unsigned*)(ws + WS_CTL + CW_BAR), misc);
#ifndef EN_MASK
#define EN_MASK 0xFFFFFFFFu
#endif
#define EN(b) (((EN_MASK) >> (b)) & 1u)
#define IN(k) (lo <= (k) && (k) < hi)
#define SEAM(k) do { if (IN(k) && IN((k) + 1)) xcd_barrier(bar); } while (0)

    const float* x_in = args.in[0];
    float* X = args.out;
    bf16* XB = (bf16*)(ws + WS_XB);
    float* LBS = (float*)(ws + WS_LBS);

    if (EN(0) && IN(0)) { PHASE_IDS();
        LAS float* scr = (LAS float*)(lds + wave * 16384);
        constexpr int I_WIN = 16 * (NINP / 32), I_BR = 8 * 32, I_OUT = 16 * 32, I_GU = 16 * (NINP / 32), I_DN = (FF0P / 64) * 32;
        constexpr int NITEMS = 2 * (I_WIN + 2 * I_BR + I_OUT) + I_GU + I_DN;
        for (int it = gwave; it < NITEMS; it += nwaves) {
            int r = it;
            if (r < 2 * I_WIN) { const int l = r / I_WIN; r %= I_WIN; const int nb = r % (NINP / 32), kb = r / (NINP / 32);
                const float* W = args.in[1] + (size_t)l * DM * 5400;
                auto cp = [=](int n) -> const float* { int c; if (n < 3328) c = n; else if (n < 5376) c = n + 24; else if (n < 5400) c = n - 5376 + 3328; else return nullptr; return W + c; };
                tr_item(cp, 5400, DM, (bf16*)(ws + (l ? WS_WIN1 : WS_WIN0)), DM, nb * 32, kb * 64, scr, lane); continue; }
            r -= 2 * I_WIN;
            if (r < 4 * I_BR) { const int which = r / I_BR; r %= I_BR; const int l = which & 1, ab = which >> 1; const int nb = r % 32, kb = r / 32;
                const float* W = args.in[ab ? 9 : 8] + (size_t)l * 512 * DM;
                auto cp = [=](int n) -> const float* { return W + n; };
                const size_t dsto = ab ? (l ? WS_WBB1 : WS_WBB0) : (l ? WS_WBA1 : WS_WBA0);
                tr_item(cp, DM, 512, (bf16*)(ws + dsto), 512, nb * 32, kb * 64, scr, lane); continue; }
            r -= 4 * I_BR;
            if (r < 2 * I_OUT) { const int l = r / I_OUT; r %= I_OUT; const int nb = r % 32, kb = r / 32;
                const float* W = args.in[10] + (size_t)l * DM * DM;
                auto cp = [=](int n) -> const float* { return W + n; };
                tr_item(cp, DM, DM, (bf16*)(ws + (l ? WS_WOUT1 : WS_WOUT0)), DM, nb * 32, kb * 64, scr, lane); continue; }
            r -= 2 * I_OUT;
            if (r < I_GU) { const int nb = r % (NINP / 32), kb = r / (NINP / 32);
                const float* Wg = args.in[15]; const float* Wu = args.in[16];
                auto cp = [=](int n) -> const float* { const int pn = n >> 8, hf = (n >> 7) & 1, c = pn * 128 + (n & 127); if (c >= FF0) return nullptr; return (hf ? Wu : Wg) + c; };
                tr_item(cp, FF0, DM, (bf16*)(ws + WS_WGU0), DM, nb * 32, kb * 64, scr, lane); continue; }
            r -= I_GU;
            { const int nb = r % 32, kb = r / 32;
                const float* W = args.in[17];
                auto cp = [=](int n) -> const float* { return W + n; };
                tr_item(cp, DM, FF0, (bf16*)(ws + WS_WDN0), FF0P, nb * 32, kb * 64, scr, lane); }
        }
        for (int row = gwave; row < NT; row += nwaves) {
            const f32x4* xr = (const f32x4*)(x_in + (size_t)row * DM);
            u32x2* o = (u32x2*)(XB + (size_t)row * DM);
#pragma unroll
            for (int j = 0; j < 4; ++j) { const f32x4 v = xr[64 * j + lane]; u32x2 w; w.x = cvt_pk_bf16(v[0], v[1]); w.y = cvt_pk_bf16(v[2], v[3]); o[64 * j + lane] = w; }
        }
        if (bid == 0) {
            const float* lg = args.in[2];
            const float a = lg[tid], b = lg[512 + tid], m = fmaxf(a, b), ea = expf(a - m), eb = expf(b - m), s = ea + eb, p0 = ea / s, p1 = eb / s;
            LBS[tid] = p0 - p0; LBS[512 + tid] = (p0 + p1) - p0;
        }
    }
    SEAM(0);

    for (int l = 0; l < 2; ++l) {
        const int pb = 1 + l * 10;
        const float* XI = l ? (const float*)X : x_in;

        if (EN(1) && IN(pb + 0)) { PHASE_IDS();
            pg8::Gemm g{XB, (const bf16*)(ws + (l ? WS_WIN1 : WS_WIN0)), NT, NINP, DM, 0};
            pg8::StaticOrder S; S.init(NT, NINP, G, bid);
            EpiInProj E{ws};
            pg8::gemm_phase<EpiInProj, pg8::StaticOrder>(lds, g, S, E);
        }
        SEAM(pb + 0);

        if (EN(2) && IN(pb + 1)) { PHASE_IDS();
            {
                LAS float* bs = (LAS float*)lds;
                LAS float* ks = bs + 64 * 128;
                LAS float* vs = ks + 64 * 128;
                const bf16* HI = (const bf16*)(ws + WS_HI); const float* HF = (const float*)(ws + WS_HF);
                bf16* US = (bf16*)(ws + WS_US); float* DEC = (float*)(ws + WS_DEC);
                for (int item = bid; item < NB * 128 * 4; item += G) {
                    const int h = item & 3, ci = (item >> 2) & 127, b = item >> 9, bh = b * 4 + h;
                    const size_t tok0 = (size_t)b * SEQ + ci * 64;
                    for (int idx = tid; idx < 64 * 128; idx += NTHR) { const int t = idx >> 7, d = idx & 127;
                        const float z = HF[(tok0 + t) * 512 + h * 128 + d], lb = LBS[l * 512 + h * 128 + d];
                        const float kk = (1.f - lb) / (1.f + __expf(z));
                        ks[idx] = kk; bs[idx] = log1pf(-kk); vs[idx] = bf2f(HI[(tok0 + t) * 512 + h * 128 + d]); }
                    __syncthreads();
                    if (tid < 128) { float run = 0.f; for (int t = 0; t < 64; ++t) { run += bs[t * 128 + tid]; bs[t * 128 + tid] = run; }
                        DEC[((size_t)bh * 128 + ci) * 128 + tid] = __expf(run); }
                    __syncthreads();
                    for (int idx = tid; idx < 64 * 128; idx += NTHR) { const int d = idx & 127; ks[idx] *= __expf(bs[63 * 128 + d] - bs[idx]); }
                    __syncthreads();
                    { const int v = tid & 127, dg = tid >> 7; float acc[32];
#pragma unroll
                        for (int j = 0; j < 32; ++j) acc[j] = 0.f;
                        for (int s = 0; s < 64; ++s) { const float vv = vs[s * 128 + v];
#pragma unroll
                            for (int j = 0; j < 32; ++j) acc[j] += ks[s * 128 + dg * 32 + j] * vv; }
                        bf16* u = US + ((size_t)bh * 128 + ci) * 16384;
#pragma unroll
                        for (int j = 0; j < 32; ++j) u[(dg * 32 + j) * 128 + v] = f2bf(acc[j]); }
                    __syncthreads();
                }
            }
            {
                LAS float* win = (LAS float*)lds;
                LAS float* pos = win + 144 * 64;
                LAS float* hid = pos + 32 * 64;
                const bf16* KV6 = (const bf16*)(ws + WS_KV6);
                for (int item = bid; item < 2 * NB * 2 * 64; item += G) {
                    const int nt8 = item & 63, g = (item >> 6) & 1, b = (item >> 7) & 3, kind = item >> 9;
                    const int n0 = nt8 * 8;
                    const float* W1 = args.in[5] + ((size_t)l * 2 + kind) * 2048 * 128;
                    const float* W2 = args.in[6] + ((size_t)l * 2 + kind) * 128 * 64;
                    const float* PS = args.in[4] + ((size_t)l * 2 + kind) * 32 * 64;
                    for (int idx = tid; idx < 144 * 64; idx += NTHR) { const int r = idx >> 6, d = idx & 63, tok = 16 * n0 + r;
                        win[idx] = tok < SEQ ? bf2f(KV6[((size_t)b * SEQ + tok) * 768 + kind * 128 + g * 64 + d]) : 0.f; }
                    for (int idx = tid; idx < 32 * 64; idx += NTHR) pos[idx] = PS[idx];
                    __syncthreads();
                    { const int w = wave, n = n0 + w; float a0 = 0.f, a1 = 0.f;
                        for (int ld = 0; ld < 2048; ++ld) { const int lp = ld >> 6, d = ld & 63;
                            const float a = win[(16 * w + lp) * 64 + d] + pos[ld]; const float* wr_ = W1 + (size_t)ld * 128;
                            a0 += a * wr_[lane]; a1 += a * wr_[64 + lane]; }
                        auto gelu = [](float x) { return 0.5f * x * (1.f + tanhf(0.7978845608028654f * (x + 0.044715f * x * x * x))); };
                        hid[w * 128 + lane] = gelu(a0); hid[w * 128 + 64 + lane] = gelu(a1);
                        WAVE_SYNC();
                        float o = 0.f;
                        for (int j = 0; j < 128; ++j) o += hid[w * 128 + j] * W2[j * 64 + lane];
                        if (n <= 510) ((float*)(ws + (kind ? WS_VC : WS_KC)))[(((size_t)b * 2 + g) * 512 + n) * 64 + lane] = o; }
                    __syncthreads();
                }
            }
        }
        SEAM(pb + 1);

        if (EN(3) && IN(pb + 2)) { PHASE_IDS();
            {
                unsigned* US32 = (unsigned*)(ws + WS_US); const float* DEC = (const float*)(ws + WS_DEC);
                for (int e2 = bid * NTHR + tid; e2 < 16 * 8192; e2 += G * NTHR) {
                    const int bh = e2 >> 13, dv2 = e2 & 8191, d = dv2 >> 6;
                    float s0 = 0.f, s1 = 0.f;
                    for (int c = 0; c < 128; ++c) {
                        const size_t o = ((size_t)bh * 128 + c) * 8192 + dv2;
                        const unsigned u = US32[o]; const float dec = DEC[((size_t)bh * 128 + c) * 128 + d];
                        US32[o] = cvt_pk_bf16(s0, s1);
                        s0 = dec * s0 + bflo(u); s1 = dec * s1 + bfhi(u);
                    }
                }
            }
            {
                LAS float* qs = (LAS float*)(lds + wave * 18432);
                LAS float* P = qs + 256;
                LAS int* selL = (LAS int*)(P + 4096);
                const bf16* NQ = (const bf16*)(ws + WS_NQ); const bf16* KV6 = (const bf16*)(ws + WS_KV6);
                const float* NG = (const float*)(ws + WS_NG);
                const float* KC = (const float*)(ws + WS_KC); const float* VC = (const float*)(ws + WS_VC);
                const float* RB = args.in[7];
                bf16* OB = (bf16*)(ws + WS_NQ);
                const int per = (NB * 2 * SEQ + nwaves - 1) / nwaves;
                auto dot4 = [&](const bf16* krow, float (&a)[4]) {
                    const u32x4* kr = (const u32x4*)krow;
#pragma unroll
                    for (int p = 0; p < 4; ++p) a[p] = 0.f;
#pragma unroll 2
                    for (int dq = 0; dq < 8; ++dq) { const u32x4 kv = kr[dq];
                        const float k0 = bflo(kv.x), k1 = bfhi(kv.x), k2 = bflo(kv.y), k3 = bfhi(kv.y), k4 = bflo(kv.z), k5 = bfhi(kv.z), k6 = bflo(kv.w), k7 = bfhi(kv.w);
#pragma unroll
                        for (int p = 0; p < 4; ++p) { const f32x4 q0 = *(const LAS f32x4*)(qs + p * 64 + dq * 8), q1 = *(const LAS f32x4*)(qs + p * 64 + dq * 8 + 4);
                            a[p] += q0[0] * k0 + q0[1] * k1 + q0[2] * k2 + q0[3] * k3 + q1[0] * k4 + q1[1] * k5 + q1[2] * k6 + q1[3] * k7; } }
                };
#pragma unroll 1
                for (int ii = 0; ii < per; ++ii) {
                    const int item = gwave * per + ii; if (item >= NB * 2 * SEQ) break;
                    const int t = item & (SEQ - 1), g = (item >> 13) & 1, b = item >> 14;
                    const size_t tok = (size_t)b * SEQ + t; const int bg = b * 2 + g;
                    WAVE_SYNC();
#pragma unroll
                    for (int p = 0; p < 4; ++p) qs[p * 64 + lane] = bf2f(NQ[tok * 512 + (g * 4 + p) * 64 + lane]);
                    WAVE_SYNC();
                    float ocmp[4] = {0.f, 0.f, 0.f, 0.f}, osel[4] = {0.f, 0.f, 0.f, 0.f}, owin[4] = {0.f, 0.f, 0.f, 0.f};
                    float mx[4], sm[4];
                    const int ncv = t >= 31 ? (t - 31) / 16 + 1 : 0;
#pragma unroll
                    for (int p = 0; p < 4; ++p) mx[p] = -3e38f;
#pragma unroll 1
                    for (int i = 0; i < 8; ++i) { const int n = lane + 64 * i; float a[4] = {-3e38f, -3e38f, -3e38f, -3e38f};
                        if (n < ncv) { const f32x4* kr = (const f32x4*)(KC + ((size_t)bg * 512 + n) * 64);
#pragma unroll
                            for (int p = 0; p < 4; ++p) a[p] = 0.f;
#pragma unroll 4
                            for (int dq = 0; dq < 16; ++dq) { const f32x4 kv = kr[dq];
#pragma unroll
                                for (int p = 0; p < 4; ++p) { const f32x4 qv = *(const LAS f32x4*)(qs + p * 64 + dq * 4); a[p] += qv[0] * kv[0] + qv[1] * kv[1] + qv[2] * kv[2] + qv[3] * kv[3]; } }
                            const int bk = rel_bucket(t - (16 * n + 31));
#pragma unroll
                            for (int p = 0; p < 4; ++p) { a[p] += RB[bk * 8 + g * 4 + p]; mx[p] = fmaxf(mx[p], a[p]); } }
#pragma unroll
                        for (int p = 0; p < 4; ++p) P[p * 1024 + n] = a[p]; }
#pragma unroll
                    for (int p = 0; p < 4; ++p) { mx[p] = wave_max(mx[p]); sm[p] = 0.f; }
#pragma unroll 1
                    for (int i = 0; i < 8; ++i) { const int n = lane + 64 * i;
#pragma unroll
                        for (int p = 0; p < 4; ++p) { const float e = (n < ncv) ? __expf(P[p * 1024 + n] - mx[p]) : 0.f; sm[p] += e; P[p * 1024 + n] = e; } }
#pragma unroll
                    for (int p = 0; p < 4; ++p) sm[p] = 1.f / fmaxf(wave_sum(sm[p]), 1e-30f);
#pragma unroll 1
                    for (int i = 0; i < 8; ++i) { const int n = lane + 64 * i;
#pragma unroll
                        for (int p = 0; p < 4; ++p) P[p * 1024 + n] *= sm[p]; }
                    WAVE_SYNC();
#pragma unroll 4
                    for (int n = 0; n < ncv; ++n) { const float v = VC[((size_t)bg * 512 + n) * 64 + lane];
#pragma unroll
                        for (int p = 0; p < 4; ++p) ocmp[p] += P[p * 1024 + n] * v; }
                    const int cur = t >> 6;
                    {
                        unsigned long long key0, key1;
                        { float sc[2];
#pragma unroll
                          for (int q = 0; q < 2; ++q) { const int s = lane + 64 * q; float im = 0.f;
#pragma unroll
                            for (int p = 0; p < 4; ++p) { const LAS float* pp = P + p * 1024 + 4 * s;
                                im += pp[0] + pp[1] + pp[2] + 0.5f * pp[3]; if (s > 0) im += 0.5f * pp[-1]; }
                            const bool forced = (s == 0) || (s == cur) || (s == cur - 1);
                            sc[q] = forced ? 1e9f : (s <= cur ? im : -1e30f); }
                          unsigned u0 = __float_as_uint(sc[0]); u0 ^= (u0 >> 31) ? 0xFFFFFFFFu : 0x80000000u;
                          unsigned u1 = __float_as_uint(sc[1]); u1 ^= (u1 >> 31) ? 0xFFFFFFFFu : 0x80000000u;
                          key0 = ((unsigned long long)u0 << 32) | (unsigned)(0xFFFFFFFFu - (unsigned)lane);
                          key1 = ((unsigned long long)u1 << 32) | (unsigned)(0xFFFFFFFFu - (unsigned)(lane + 64)); }
                        WAVE_SYNC();
#pragma unroll 1
                        for (int k = 0; k < 16; ++k) {
                            unsigned long long best = key0 > key1 ? key0 : key1;
#pragma unroll
                            for (int o = 1; o < 64; o <<= 1) { const unsigned long long ot = __shfl_xor(best, o); best = ot > best ? ot : best; }
                            const int idx = (int)(0xFFFFFFFFu - (unsigned)(best & 0xFFFFFFFFull));
                            if (lane == 0) selL[k] = idx;
                            if (idx == lane) key0 = 0ull; if (idx == lane + 64) key1 = 0ull;
                        }
                    }
                    WAVE_SYNC();
#pragma unroll
                    for (int p = 0; p < 4; ++p) mx[p] = -3e38f;
#pragma unroll 1
                    for (int k = 0; k < 16; ++k) { const int blk = selL[k]; const int kpos = blk * 64 + lane; const bool ok = (blk <= cur) && (kpos <= t);
                        float a[4] = {-3e38f, -3e38f, -3e38f, -3e38f};
                        if (ok) { dot4(KV6 + ((size_t)b * SEQ + kpos) * 768 + 256 + g * 64, a); const int bk = rel_bucket(t - kpos);
#pragma unroll
                            for (int p = 0; p < 4; ++p) { a[p] += RB[bk * 8 + g * 4 + p]; mx[p] = fmaxf(mx[p], a[p]); } }
#pragma unroll
                        for (int p = 0; p < 4; ++p) P[p * 1024 + k * 64 + lane] = a[p]; }
#pragma unroll
                    for (int p = 0; p < 4; ++p) { mx[p] = wave_max(mx[p]); sm[p] = 0.f; }
#pragma unroll 1
                    for (int k = 0; k < 16; ++k) {
#pragma unroll
                        for (int p = 0; p < 4; ++p) { const float lgv = P[p * 1024 + k * 64 + lane]; const float e = (lgv > -1e38f) ? __expf(lgv - mx[p]) : 0.f; sm[p] += e; P[p * 1024 + k * 64 + lane] = e; } }
#pragma unroll
                    for (int p = 0; p < 4; ++p) sm[p] = 1.f / fmaxf(wave_sum(sm[p]), 1e-30f);
                    WAVE_SYNC();
#pragma unroll 1
                    for (int k = 0; k < 16; ++k) { const int blk = selL[k]; if (blk > cur) continue;
                        const bf16* vr = KV6 + ((size_t)b * SEQ + blk * 64) * 768 + 384 + g * 64 + lane;
#pragma unroll 4
                        for (int i = 0; i < 64; ++i) { const float v = bf2f(vr[(size_t)i * 768]);
#pragma unroll
                            for (int p = 0; p < 4; ++p) osel[p] += P[p * 1024 + k * 64 + i] * v; } }
#pragma unroll
                    for (int p = 0; p < 4; ++p) osel[p] *= sm[p];
                    WAVE_SYNC();
#pragma unroll
                    for (int p = 0; p < 4; ++p) mx[p] = -3e38f;
#pragma unroll 1
                    for (int k = 0; k < 8; ++k) { const int kpos = t - 511 + 64 * k + lane; const bool ok = kpos >= 0;
                        float a[4] = {-3e38f, -3e38f, -3e38f, -3e38f};
                        if (ok) { dot4(KV6 + ((size_t)b * SEQ + kpos) * 768 + 512 + g * 64, a); const int bk = rel_bucket(t - kpos);
#pragma unroll
                            for (int p = 0; p < 4; ++p) { a[p] += RB[bk * 8 + g * 4 + p]; mx[p] = fmaxf(mx[p], a[p]); } }
#pragma unroll
                        for (int p = 0; p < 4; ++p) P[p * 1024 + k * 64 + lane] = a[p]; }
#pragma unroll
                    for (int p = 0; p < 4; ++p) { mx[p] = wave_max(mx[p]); sm[p] = 0.f; }
#pragma unroll 1
                    for (int k = 0; k < 8; ++k) {
#pragma unroll
                        for (int p = 0; p < 4; ++p) { const float lgv = P[p * 1024 + k * 64 + lane]; const float e = (lgv > -1e38f) ? __expf(lgv - mx[p]) : 0.f; sm[p] += e; P[p * 1024 + k * 64 + lane] = e; } }
#pragma unroll
                    for (int p = 0; p < 4; ++p) sm[p] = 1.f / fmaxf(wave_sum(sm[p]), 1e-30f);
                    WAVE_SYNC();
                    {
                        const int kfirst = t - 511 < 0 ? 0 : t - 511;
                        const bf16* vr = KV6 + ((size_t)b * SEQ) * 768 + 640 + g * 64 + lane;
#pragma unroll 4
                        for (int kp = kfirst; kp <= t; ++kp) { const float v = bf2f(vr[(size_t)kp * 768]); const int slot = kp - (t - 511);
#pragma unroll
                            for (int p = 0; p < 4; ++p) owin[p] += P[p * 1024 + slot] * v; }
#pragma unroll
                        for (int p = 0; p < 4; ++p) owin[p] *= sm[p];
                    }
#pragma unroll
                    for (int p = 0; p < 4; ++p) { const float* gl = NG + tok * 32 + (g * 4 + p) * 3;
                        const float o = sigmoidf_(gl[0]) * ocmp[p] + sigmoidf_(gl[1]) * osel[p] + sigmoidf_(gl[2]) * owin[p];
                        OB[tok * 512 + (g * 4 + p) * 64 + lane] = f2bf(o); }
                }
            }
        }
        SEAM(pb + 2);

        if (EN(4) && IN(pb + 3)) { PHASE_IDS();
            LAS float* qs = (LAS float*)lds;
            LAS float* ks = qs + 64 * 129;
            LAS float* bs = ks + 64 * 129;
            LAS float* As = bs + 64 * 129;
            LAS bf16* vs = (LAS bf16*)(As + 64 * 65);
            bf16* QHG = (bf16*)(ws + WS_QHG); const bf16* HI = (const bf16*)(ws + WS_HI); const bf16* HG = (const bf16*)(ws + WS_HG); const float* HF = (const float*)(ws + WS_HF);
            const bf16* US = (const bf16*)(ws + WS_US);
            const float* NW = args.in[3] + l * 512;
            for (int item = bid; item < NB * 128 * 4; item += G) {
                const int h = item & 3, ci = (item >> 2) & 127, b = item >> 9, bh = b * 4 + h;
                const size_t tok0 = (size_t)b * SEQ + ci * 64;
                for (int idx = tid; idx < 64 * 128; idx += NTHR) { const int t = idx >> 7, d = idx & 127;
                    const size_t go = (tok0 + t) * 512 + h * 128 + d;
                    const float z = HF[go], lb = LBS[l * 512 + h * 128 + d];
                    const float kk = (1.f - lb) / (1.f + __expf(z));
                    qs[t * 129 + d] = bf2f(QHG[go]); ks[t * 129 + d] = kk; bs[t * 129 + d] = log1pf(-kk); vs[idx] = HI[go]; }
                __syncthreads();
                if (tid < 128) { float run = 0.f; for (int t = 0; t < 64; ++t) { run += bs[t * 129 + tid]; bs[t * 129 + tid] = run; } }
                __syncthreads();
                for (int i = 0; i < 8; ++i) { const int p = tid + NTHR * i, t = p >> 6, s = p & 63; float a = 0.f;
                    if (s <= t) { for (int d = 0; d < 128; ++d) a += qs[t * 129 + d] * ks[s * 129 + d] * __expf(bs[t * 129 + d] - bs[s * 129 + d]); }
                    As[t * 65 + s] = a; }
                __syncthreads();
                for (int idx = tid; idx < 64 * 128; idx += NTHR) { const int t = idx >> 7, d = idx & 127; qs[t * 129 + d] *= __expf(bs[t * 129 + d]); }
                __syncthreads();
                {
                    float acc[8][2];
#pragma unroll
                    for (int j = 0; j < 8; ++j) { acc[j][0] = 0.f; acc[j][1] = 0.f; }
                    const bf16* Sg = US + ((size_t)bh * 128 + ci) * 16384;
                    for (int d = 0; d < 128; ++d) { const float s0 = bf2f(Sg[d * 128 + lane]), s1 = bf2f(Sg[d * 128 + 64 + lane]);
#pragma unroll
                        for (int j = 0; j < 8; ++j) { const float qv = qs[(wave * 8 + j) * 129 + d]; acc[j][0] += qv * s0; acc[j][1] += qv * s1; } }
                    for (int s = 0; s < 64; ++s) { const float v0 = bf2f(vs[s * 128 + lane]), v1 = bf2f(vs[s * 128 + 64 + lane]);
#pragma unroll
                        for (int j = 0; j < 8; ++j) { const float a = As[(wave * 8 + j) * 65 + s]; acc[j][0] += a * v0; acc[j][1] += a * v1; } }
#pragma unroll
                    for (int j = 0; j < 8; ++j) { const int t = wave * 8 + j;
                        const float ss = wave_sum(acc[j][0] * acc[j][0] + acc[j][1] * acc[j][1]);
                        const float r = rsqrtf(ss * (1.f / 128.f) + 1e-6f);
                        const size_t go = (tok0 + t) * 512 + h * 128;
                        const float g0 = bf2f(HG[go + lane]), g1 = bf2f(HG[go + 64 + lane]);
                        QHG[go + lane] = f2bf(acc[j][0] * r * NW[h * 128 + lane] * siluf_(g0));
                        QHG[go + 64 + lane] = f2bf(acc[j][1] * r * NW[h * 128 + 64 + lane] * siluf_(g1)); }
                }
                __syncthreads();
            }
        }
        SEAM(pb + 3);

        if (EN(5) && IN(pb + 4)) { PHASE_IDS();
            bf16* Y = (bf16*)(ws + WS_GA);
            { pg8::Gemm g{(const bf16*)(ws + WS_QHG), (const bf16*)(ws + (l ? WS_WBA1 : WS_WBA0)), NT, DM, 512, 0};
              pg8::StaticOrder S; S.init(NT, DM, G, bid); EpiGate<true> E{Y, (const bf16*)(ws + WS_GA)};
              pg8::gemm_phase<EpiGate<true>, pg8::StaticOrder>(lds, g, S, E); }
            { pg8::Gemm g{(const bf16*)(ws + WS_NQ), (const bf16*)(ws + (l ? WS_WBB1 : WS_WBB0)), NT, DM, 512, 0};
              pg8::StaticOrder S; S.init(NT, DM, G, bid); EpiGate<false> E{Y, (const bf16*)(ws + WS_GB)};
              pg8::gemm_phase<EpiGate<false>, pg8::StaticOrder>(lds, g, S, E); }
        }
        SEAM(pb + 4);

        if (EN(6) && IN(pb + 5)) { PHASE_IDS();
            pg8::Gemm g{(const bf16*)(ws + WS_GA), (const bf16*)(ws + (l ? WS_WOUT1 : WS_WOUT0)), NT, DM, DM, 0};
            pg8::StaticOrder S; S.init(NT, DM, G, bid); EpiResid E{XI, X};
            pg8::gemm_phase<EpiResid, pg8::StaticOrder>(lds, g, S, E);
        }
        SEAM(pb + 5);

        if (EN(7) && IN(pb + 6)) { PHASE_IDS();
            const float* gam = args.in[11] + l * DM; const float* bet = args.in[12] + l * DM;
            LAS int* hist = (LAS int*)(lds + 8 * 16384);
            if (l == 1) { if (tid < 8) hist[tid] = 0; __syncthreads(); }
            const int rpb = (NT + G - 1) / G;
            for (int i = wave; i < rpb; i += NWAVES) {
                const int row = bid * rpb + i; if (row >= NT) break;
                f32x4* xr = (f32x4*)(X + (size_t)row * DM);
                f32x4 v[4]; float s = 0.f;
#pragma unroll
                for (int j = 0; j < 4; ++j) { v[j] = xr[64 * j + lane]; s += (v[j][0] + v[j][1]) + (v[j][2] + v[j][3]); }
                const float mean = wave_sum(s) * (1.f / DM); float s2 = 0.f;
#pragma unroll
                for (int j = 0; j < 4; ++j) { v[j] = v[j] - mean; s2 += (v[j][0] * v[j][0] + v[j][1] * v[j][1]) + (v[j][2] * v[j][2] + v[j][3] * v[j][3]); }
                const float rstd = rsqrtf(wave_sum(s2) * (1.f / DM) + 1e-5f);
#pragma unroll
                for (int j = 0; j < 4; ++j) { const f32x4 gq = ((const f32x4*)gam)[64 * j + lane], bq = ((const f32x4*)bet)[64 * j + lane]; v[j] = v[j] * rstd * gq + bq; xr[64 * j + lane] = v[j]; }
                if (l == 0) { u32x2* o = (u32x2*)(XB + (size_t)row * DM);
#pragma unroll
                    for (int j = 0; j < 4; ++j) { u32x2 w; w.x = cvt_pk_bf16(v[j][0], v[j][1]); w.y = cvt_pk_bf16(v[j][2], v[j][3]); o[64 * j + lane] = w; }
                } else {
                    const float* WR = args.in[18];
                    float lg[8];
#pragma unroll
                    for (int e = 0; e < 8; ++e) lg[e] = 0.f;
#pragma unroll
                    for (int j = 0; j < 4; ++j)
#pragma unroll
                        for (int q = 0; q < 4; ++q) { const int c = 4 * (64 * j + lane) + q; const f32x4 w0 = *(const f32x4*)(WR + c * 8), w1 = *(const f32x4*)(WR + c * 8 + 4); const float xv = v[j][q];
                            lg[0] += xv * w0[0]; lg[1] += xv * w0[1]; lg[2] += xv * w0[2]; lg[3] += xv * w0[3]; lg[4] += xv * w1[0]; lg[5] += xv * w1[1]; lg[6] += xv * w1[2]; lg[7] += xv * w1[3]; }
#pragma unroll
                    for (int e = 0; e < 8; ++e) lg[e] = wave_sum(lg[e]);
                    int e1 = 0; float v1 = lg[0];
#pragma unroll
                    for (int e = 1; e < 8; ++e) if (lg[e] > v1) { v1 = lg[e]; e1 = e; }
                    int e2 = -1; float v2 = -3e38f;
#pragma unroll
                    for (int e = 0; e < 8; ++e) if (e != e1 && lg[e] > v2) { v2 = lg[e]; e2 = e; }
                    if (lane == 0) { const float g2 = 1.f / (1.f + expf(v1 - v2)), g1 = 1.f - g2;
                        ((int*)(ws + WS_TOPI))[row] = e1 | (e2 << 8); ((float*)(ws + WS_TOPG))[row * 2] = g1; ((float*)(ws + WS_TOPG))[row * 2 + 1] = g2;
                        atomicAdd((int*)&hist[e1], 1); atomicAdd((int*)&hist[e2], 1); }
                }
            }
            if (l == 1) {
                __syncthreads();
                if (tid < 8) ((int*)(ws + WS_CTL + CW_BLKCNT))[bid * 8 + tid] = hist[tid];
                LAS float* scr = (LAS float*)(lds + wave * 16384);
                constexpr int I_GU = 16 * (2 * FFE / 32), I_DN = (FFE / 64) * 32;
                for (int it = gwave; it < NEXP * (I_GU + I_DN); it += nwaves) {
                    const int e = it / (I_GU + I_DN); int r = it % (I_GU + I_DN);
                    if (r < I_GU) { const int nb = r % (2 * FFE / 32), kb = r / (2 * FFE / 32);
                        const float* Wg = args.in[19] + (size_t)e * DM * FFE; const float* Wu = args.in[20] + (size_t)e * DM * FFE;
                        auto cp = [=](int n) -> const float* { const int pn = n >> 8, hf = (n >> 7) & 1, c = pn * 128 + (n & 127); return (hf ? Wu : Wg) + c; };
                        tr_item(cp, FFE, DM, (bf16*)(ws + WS_MGU) + (size_t)e * 2 * FFE * DM, DM, nb * 32, kb * 64, scr, lane); }
                    else { r -= I_GU; const int nb = r % 32, kb = r / 32;
                        const float* W = args.in[21] + (size_t)e * FFE * DM;
                        auto cp = [=](int n) -> const float* { return W + n; };
                        tr_item(cp, DM, FFE, (bf16*)(ws + WS_MDN) + (size_t)e * DM * FFE, FFE, nb * 32, kb * 64, scr, lane); }
                }
            }
        }
        SEAM(pb + 6);

        if (l == 0) {
            if (EN(8) && IN(pb + 7)) { PHASE_IDS();
                pg8::Gemm g{XB, (const bf16*)(ws + WS_WGU0), NT, NINP, DM, 0};
                pg8::StaticOrder S; S.init(NT, NINP, G, bid); EpiSwiglu E{(bf16*)(ws + WS_H0), FF0P};
                pg8::gemm_phase<EpiSwiglu, pg8::StaticOrder>(lds, g, S, E);
            }
            SEAM(pb + 7);
            if (EN(9) && IN(pb + 8)) { PHASE_IDS();
                pg8::Gemm g{(const bf16*)(ws + WS_H0), (const bf16*)(ws + WS_WDN0), NT, DM, FF0P, 0};
                pg8::StaticOrder S; S.init(NT, DM, G, bid); EpiResid E{X, X};
                pg8::gemm_phase<EpiResid, pg8::StaticOrder>(lds, g, S, E);
            }
            SEAM(pb + 8);
            if (EN(10) && IN(pb + 9)) { PHASE_IDS();
                const float* gam = args.in[13]; const float* bet = args.in[14];
                for (int row = gwave; row < NT; row += nwaves) {
                    f32x4* xr = (f32x4*)(X + (size_t)row * DM);
                    f32x4 v[4]; float s = 0.f;
#pragma unroll
                    for (int j = 0; j < 4; ++j) { v[j] = xr[64 * j + lane]; s += (v[j][0] + v[j][1]) + (v[j][2] + v[j][3]); }
                    const float mean = wave_sum(s) * (1.f / DM); float s2 = 0.f;
#pragma unroll
                    for (int j = 0; j < 4; ++j) { v[j] = v[j] - mean; s2 += (v[j][0] * v[j][0] + v[j][1] * v[j][1]) + (v[j][2] * v[j][2] + v[j][3] * v[j][3]); }
                    const float rstd = rsqrtf(wave_sum(s2) * (1.f / DM) + 1e-5f);
                    u32x2* o = (u32x2*)(XB + (size_t)row * DM);
#pragma unroll
                    for (int j = 0; j < 4; ++j) { const f32x4 gq = ((const f32x4*)gam)[64 * j + lane], bq = ((const f32x4*)bet)[64 * j + lane]; v[j] = v[j] * rstd * gq + bq; xr[64 * j + lane] = v[j];
                        u32x2 w; w.x = cvt_pk_bf16(v[j][0], v[j][1]); w.y = cvt_pk_bf16(v[j][2], v[j][3]); o[64 * j + lane] = w; }
                }
            }
            SEAM(pb + 9);
        } else {
            int* META = (int*)(ws + WS_CTL + CW_META); int* PANELE = (int*)(ws + WS_CTL + CW_PANELE);
            int* ROWINFO = (int*)(ws + WS_ROWINFO);
            bf16* XS = (bf16*)(ws + WS_XS);
            if (EN(11) && IN(pb + 7)) { PHASE_IDS();
                LAS int* sh = (LAS int*)lds;
                const int* BC = (const int*)(ws + WS_CTL + CW_BLKCNT);
                if (tid < 8) { int tot = 0, pre = 0; for (int bb = 0; bb < G; ++bb) { const int c = BC[bb * 8 + tid]; if (bb < bid) pre += c; tot += c; } sh[tid] = tot; sh[8 + tid] = pre; sh[24 + tid] = 0; }
                __syncthreads();
                if (tid == 0) { int base = 0; for (int e = 0; e < 8; ++e) { sh[16 + e] = base; base += (sh[e] + 255) & ~255; }
                    if (bid == 0) { META[0] = base / 256; META[1] = (base / 256 + 63) / 64; int p = 0; for (int e = 0; e < 8; ++e) { META[8 + e] = sh[16 + e]; META[16 + e] = sh[e]; for (int q = 0; q < ((sh[e] + 255) >> 8); ++q) PANELE[p++] = e; } } }
                __syncthreads();
                if (bid < 8) { const int e = bid, r0 = sh[16 + e] + sh[e], r1 = sh[16 + e] + ((sh[e] + 255) & ~255);
                    for (int r = r0 + wave; r < r1; r += NWAVES) { if (lane == 0) ROWINFO[r] = -1;
#pragma unroll
                        for (int j = 0; j < 4; ++j) ((u32x2*)(XS + (size_t)r * DM))[64 * j + lane] = (u32x2){0u, 0u}; } }
                const int rpb = (NT + G - 1) / G;
                for (int i = wave; i < rpb; i += NWAVES) {
                    const int row = bid * rpb + i; if (row >= NT) break;
                    const int ti = ((const int*)(ws + WS_TOPI))[row]; const int e1 = ti & 255, e2 = ti >> 8;
                    int s1 = 0, s2 = 0;
                    if (lane == 0) { s1 = sh[16 + e1] + sh[8 + e1] + atomicAdd((int*)&sh[24 + e1], 1); s2 = sh[16 + e2] + sh[8 + e2] + atomicAdd((int*)&sh[24 + e2], 1); ROWINFO[s1] = row * 2; ROWINFO[s2] = row * 2 + 1; }
                    s1 = __builtin_amdgcn_readfirstlane(s1); s2 = __builtin_amdgcn_readfirstlane(s2);
                    const f32x4* xr = (const f32x4*)(X + (size_t)row * DM);
#pragma unroll
                    for (int j = 0; j < 4; ++j) { const f32x4 v = xr[64 * j + lane]; u32x2 w; w.x = cvt_pk_bf16(v[0], v[1]); w.y = cvt_pk_bf16(v[2], v[3]);
                        ((u32x2*)(XS + (size_t)s1 * DM))[64 * j + lane] = w; ((u32x2*)(XS + (size_t)s2 * DM))[64 * j + lane] = w; }
                }
            }
            SEAM(pb + 7);
            for (int c = 0; c < MAXCHUNK; ++c) {
                if (EN(12) && IN(pb + 8 + 2 * c)) { PHASE_IDS();
                    const int P = META[0], nch = META[1];
                    if (c < nch) { const int p0 = (int)((long)c * P / nch), p1 = (int)((long)(c + 1) * P / nch);
                        pg8::Gemm g{XS + (size_t)p0 * 256 * DM, (const bf16*)(ws + WS_MGU), (p1 - p0) * 256, 2 * FFE, DM, (size_t)2 * FFE * DM};
                        pg8::StaticOrder S; S.init((p1 - p0) * 256, 2 * FFE, G, bid, PANELE + p0); EpiSwiglu E{(bf16*)(ws + WS_HM), FFE};
                        pg8::gemm_phase<EpiSwiglu, pg8::StaticOrder>(lds, g, S, E); }
                }
                SEAM(pb + 8 + 2 * c);
                if (EN(13) && IN(pb + 9 + 2 * c)) { PHASE_IDS();
                    const int P = META[0], nch = META[1];
                    if (c < nch) { const int p0 = (int)((long)c * P / nch), p1 = (int)((long)(c + 1) * P / nch);
                        pg8::Gemm g{(const bf16*)(ws + WS_HM), (const bf16*)(ws + WS_MDN), (p1 - p0) * 256, DM, FFE, (size_t)DM * FFE};
                        pg8::StaticOrder S; S.init((p1 - p0) * 256, DM, G, bid, PANELE + p0); EpiScatter E{(bf16*)(ws + WS_YM), ROWINFO + p0 * 256};
                        pg8::gemm_phase<EpiScatter, pg8::StaticOrder>(lds, g, S, E); }
                }
                SEAM(pb + 9 + 2 * c);
            }
            if (EN(14) && IN(pb + 8 + 2 * MAXCHUNK)) { PHASE_IDS();
                const float* gam = args.in[13] + DM; const float* bet = args.in[14] + DM;
                const bf16* YM = (const bf16*)(ws + WS_YM); const float* TG = (const float*)(ws + WS_TOPG);
                for (int row = gwave; row < NT; row += nwaves) {
                    f32x4* xr = (f32x4*)(X + (size_t)row * DM);
                    const float g1 = TG[row * 2], g2 = TG[row * 2 + 1];
                    const u32x2* y1 = (const u32x2*)(YM + (size_t)(row * 2) * DM); const u32x2* y2 = (const u32x2*)(YM + (size_t)(row * 2 + 1) * DM);
                    f32x4 v[4]; float s = 0.f;
#pragma unroll
                    for (int j = 0; j < 4; ++j) { const f32x4 xv = xr[64 * j + lane]; const u32x2 a = y1[64 * j + lane], bq = y2[64 * j + lane];
                        v[j][0] = xv[0] * DN_ALPHA + g1 * bflo(a.x) + g2 * bflo(bq.x); v[j][1] = xv[1] * DN_ALPHA + g1 * bfhi(a.x) + g2 * bfhi(bq.x);
                        v[j][2] = xv[2] * DN_ALPHA + g1 * bflo(a.y) + g2 * bflo(bq.y); v[j][3] = xv[3] * DN_ALPHA + g1 * bfhi(a.y) + g2 * bfhi(bq.y);
                        s += (v[j][0] + v[j][1]) + (v[j][2] + v[j][3]); }
                    const float mean = wave_sum(s) * (1.f / DM); float s2 = 0.f;
#pragma unroll
                    for (int j = 0; j < 4; ++j) { v[j] = v[j] - mean; s2 += (v[j][0] * v[j][0] + v[j][1] * v[j][1]) + (v[j][2] * v[j][2] + v[j][3] * v[j][3]); }
                    const float rstd = rsqrtf(wave_sum(s2) * (1.f / DM) + 1e-5f);
#pragma unroll
                    for (int j = 0; j < 4; ++j) { const f32x4 gq = ((const f32x4*)gam)[64 * j + lane], bq = ((const f32x4*)bet)[64 * j + lane]; xr[64 * j + lane] = v[j] * rstd * gq + bq; }
                }
            }
        }
    }
#undef IN
#undef SEAM
}

constexpr int NPHASES = 1 + 10 + 8 + 2 * MAXCHUNK + 1;

extern "C" void kernel_launch(void* const* d_in, const int* in_sizes, int n_in, void* d_out, int out_size, void* d_ws, size_t ws_size, hipStream_t stream) {
    static int grid = 0;
    if (grid == 0) {
        if (n_in != 22 || out_size != NT * DM || ws_size < WS_END) { fprintf(stderr, "kernel_launch: need 22 inputs, %d outputs, >= %zu bytes of workspace; got %d, %d, %zu\n", NT * DM, (size_t)WS_END, n_in, out_size, ws_size); grid = -1; return; }
        int dev = 0, cus = 0, per_cu = 0;
        if (hipGetDevice(&dev) != hipSuccess || hipDeviceGetAttribute(&cus, hipDeviceAttributeMultiprocessorCount, dev) != hipSuccess) { grid = -1; return; }
        if (hipFuncSetAttribute((const void*)mega_fwd, hipFuncAttributeMaxDynamicSharedMemorySize, LDS_BYTES) != hipSuccess) { fprintf(stderr, "kernel_launch: hipFuncSetAttribute failed\n"); grid = -1; return; }
        if (hipOccupancyMaxActiveBlocksPerMultiprocessor(&per_cu, (const void*)mega_fwd, NTHR, LDS_BYTES) != hipSuccess || per_cu < 1) fprintf(stderr, "kernel_launch: occupancy query reports %d\n", per_cu);
        (void)hipGetLastError();
        grid = cus > 256 ? 256 : cus;
    }
    if (grid < 0) return;
    (void)hipMemsetAsync((char*)d_ws + WS_CTL, 0, CTL_BYTES, stream);
    Args a{};
    for (int i = 0; i < 22; ++i) a.in[i] = (const float*)d_in[i];
    a.out = (float*)d_out; a.ws = (unsigned char*)d_ws;
#if ONE_LAUNCH
    a.ph_lo = 0; a.ph_hi = NPHASES;
    hipLaunchKernelGGL(mega_fwd, dim3(grid), dim3(NTHR), LDS_BYTES, stream, a);
#else
    for (int p = 0; p < NPHASES; ++p) { a.ph_lo = p; a.ph_hi = p + 1; hipLaunchKernelGGL(mega_fwd, dim3(grid), dim3(NTHR), LDS_BYTES, stream, a); }
#endif
}
```

```cpp
#include <hip/hip_runtime.h>
#include <cstdio>
#include <cstdint>

#ifndef ONE_LAUNCH
#define ONE_LAUNCH 1
#endif

#define LAS __attribute__((address_space(3)))
typedef unsigned short bf16;
typedef short bf16x8 __attribute__((ext_vector_type(8)));
typedef short s16x4 __attribute__((ext_vector_type(4)));
typedef float f32x4 __attribute__((ext_vector_type(4)));
typedef float f32x16 __attribute__((ext_vector_type(16)));
typedef float f32x2 __attribute__((ext_vector_type(2)));
typedef unsigned u32x4 __attribute__((ext_vector_type(4)));
typedef unsigned u32x2 __attribute__((ext_vector_type(2)));

typedef __bf16 bf16x2_t __attribute__((ext_vector_type(2)));
__device__ __forceinline__ unsigned cvt_pk_bf16(float lo, float hi) { bf16x2_t v; v[0] = (__bf16)lo; v[1] = (__bf16)hi; return __builtin_bit_cast(unsigned, v); }
__device__ __forceinline__ bf16 f2bf(float f) { unsigned u = __float_as_uint(f); u += 0x7FFFu + ((u >> 16) & 1u); return (bf16)(u >> 16); }
__device__ __forceinline__ float bf2f(bf16 b) { return __uint_as_float(((unsigned)b) << 16); }
__device__ __forceinline__ float bflo(unsigned u) { return __uint_as_float(u << 16); }
__device__ __forceinline__ float bfhi(unsigned u) { return __uint_as_float(u & 0xFFFF0000u); }
__device__ __forceinline__ float sigmoidf_(float x) { return 1.0f / (1.0f + __expf(-x)); }
__device__ __forceinline__ float siluf_(float x) { return x / (1.0f + __expf(-x)); }
__device__ __forceinline__ float wave_sum(float v) {
#pragma unroll
    for (int o = 1; o < 64; o <<= 1) v += __shfl_xor(v, o);
    return v;
}
__device__ __forceinline__ float wave_max(float v) {
#pragma unroll
    for (int o = 1; o < 64; o <<= 1) v = fmaxf(v, __shfl_xor(v, o));
    return v;
}
__device__ __forceinline__ float max_x32(float x) { auto r = __builtin_amdgcn_permlane32_swap(__float_as_uint(x), __float_as_uint(x), false, false); return fmaxf(__uint_as_float(r[0]), __uint_as_float(r[1])); }
__device__ __forceinline__ float max_x16(float x) { auto r = __builtin_amdgcn_permlane16_swap(__float_as_uint(x), __float_as_uint(x), false, false); return fmaxf(__uint_as_float(r[0]), __uint_as_float(r[1])); }
__device__ __forceinline__ float sum_x32(float x) { auto r = __builtin_amdgcn_permlane32_swap(__float_as_uint(x), __float_as_uint(x), false, false); return __uint_as_float(r[0]) + __uint_as_float(r[1]); }
__device__ __forceinline__ float sum_x16(float x) { auto r = __builtin_amdgcn_permlane16_swap(__float_as_uint(x), __float_as_uint(x), false, false); return __uint_as_float(r[0]) + __uint_as_float(r[1]); }
__device__ __forceinline__ float dpp_x1(float x) { return __uint_as_float(__builtin_amdgcn_mov_dpp(__float_as_uint(x), 0xB1, 0xF, 0xF, true)); }
__device__ __forceinline__ float dpp_x2(float x) { return __uint_as_float(__builtin_amdgcn_mov_dpp(__float_as_uint(x), 0x4E, 0xF, 0xF, true)); }
__device__ __forceinline__ int lane_id() { int l; asm volatile("v_mbcnt_lo_u32_b32 %0, -1, 0\n\tv_mbcnt_hi_u32_b32 %0, -1, %0" : "=v"(l)); return l; }
#define WAVE_SYNC() do { asm volatile("s_waitcnt lgkmcnt(0)" ::: "memory"); __builtin_amdgcn_wave_barrier(); } while (0)

#define PHASE_IDS() int tid_ph = wave_s * 64 + lane_id(); asm volatile("" : "+v"(tid_ph)); const int tid = tid_ph, lane = tid & 63, wave = __builtin_amdgcn_readfirstlane(tid >> 6), gwave = bid * NWAVES + wave; (void)tid; (void)lane; (void)wave; (void)gwave; \
    KArgsP ap = kap; asm volatile("" : "+s"(ap));     \
    unsigned char* ws = ap->ws; float* X = ap->out; const float* x_in = ap->in[0]; bf16* XB = (bf16*)(ws + WS_XB); float* LBS = (float*)(ws + WS_LBS); (void)X; (void)x_in; (void)XB; (void)LBS
namespace pg8 {
constexpr int BM = 256, BK = 64, HALF = 128, HTB = HALF * BK * 2, STAGE_BYTES = 8 * HTB, NXCD = 8, WGM = 8;
__host__ __device__ __forceinline__ int lds_byte(int r, int c) { const int st = (r >> 4) * 2 + (c >> 5), rr = r & 15, cc = c & 31, ob = rr * 64 + cc * 2; return st * 1024 + (ob ^ (((ob >> 9) & 1) << 5)); }
__host__ __device__ __forceinline__ void stage_rc(int b, int& R, int& C) { const int st = b / 1024, sb = b % 1024, swz = sb ^ (((sb >> 9) & 1) << 5); R = (st >> 1) * 16 + swz / 64; C = (st & 1) * 32 + (swz % 64) / 2; }
__host__ __device__ __forceinline__ int perm32(int rho) { const int n = rho >> 4, i = rho & 15; return 8 * (i >> 2) + 4 * n + (i & 3); }

struct Unit { int pm, pn, e; };
struct Gemm { const bf16* A; const bf16* Bt; int M, N, K; size_t bt_estride; int lda; const bf16* A2; int ksw; };

struct StaticOrder {
    int nM, nN, nwg, G, c; const int* pe;
    __device__ void init(int M, int N, int G_, int c_, const int* pe_ = nullptr) { nM = M / BM; nN = N / BM; nwg = nM * nN; G = G_; c = c_; pe = pe_; }
    __device__ bool next(int i, Unit& u) const {
        const long L = (long)i * G + c; if (L >= nwg) return false;
        int wgid = (int)L; { const int q = nwg / NXCD, r = nwg % NXCD, xcd = wgid % NXCD, off = wgid / NXCD; wgid = (xcd < r ? xcd * (q + 1) : r * (q + 1) + (xcd - r) * q) + off; }
        const int nig = WGM * nN, gid = wgid / nig, fm = gid * WGM, gsz = (nM - fm) < WGM ? (nM - fm) : WGM;
        u.pm = fm + ((wgid % nig) % gsz); u.pn = (wgid % nig) / gsz; u.e = pe ? pe[u.pm] : 0; return true;
    }
    __device__ __forceinline__ void a_ready(const Unit&) const {}
    __device__ __forceinline__ void done(const Unit&) const {}
};

template <class Epi, class Sched, bool ALIGN_EPI = true, bool SP2 = true>
__device__ __forceinline__ void gemm_phase(LAS unsigned char* lds, const Gemm g, const Sched& S, const Epi& E, const int wave_s) {
    int tid_l = wave_s * 64 + lane_id(); asm volatile("" : "+v"(tid_l));
    const int tid = tid_l, wid = __builtin_amdgcn_readfirstlane(tid >> 6), lane = tid & 63, wr = wid >> 2, wc = wid & 3, fr = lane & 15, fq = lane >> 4;
    const int K = g.K, nt = K / BK, LDA = g.lda ? g.lda : g.K;
    unsigned voffA[2], voffB[2];
#pragma unroll
    for (int i = 0; i < 2; ++i) { int R, C; stage_rc(tid * 16 + i * 8192, R, C); const int Rb = Epi::PERM ? ((R & ~31) + perm32(R & 31)) : R;
        voffA[i] = (unsigned)(R * LDA + C) * 2u; voffB[i] = (unsigned)(Rb * K + C) * 2u; }
    const size_t kstep = (size_t)(BK * 2);
    const size_t hstep = (size_t)HALF * K * 2, hstepA = (size_t)HALF * LDA * 2;
    const size_t tstep = 2 * hstep, tstepA = 2 * hstepA;
    const unsigned ldsw = (unsigned)wid * 1024u;
    const int aoff = lds_byte(wr * 64 + fr, fq * 8), boff = lds_byte(wc * 32 + fr, fq * 8);
#define PG8_SA(b, h) (((b) * 2 + (h)) * HTB)
#define PG8_SB(b, h) ((4 + (b) * 2 + (h)) * HTB)
#define PG8_STAGE(bufoff, gbase, voff) do { _Pragma("unroll") for (int _i = 0; _i < 2; ++_i) \
        __builtin_amdgcn_global_load_lds((const unsigned*)((const char*)(gbase) + (voff)[_i]), (LAS unsigned*)(lds + (bufoff) + ldsw + _i * 8192), 16, 0, 0); } while (0)
#define PG8_LDA(dst, b, h) do { _Pragma("unroll") for (int m = 0; m < 4; ++m) _Pragma("unroll") for (int k = 0; k < 2; ++k) dst[m][k] = *(const LAS bf16x8*)(lds + PG8_SA(b, h) + aoff + m * 2048 + k * 1024); } while (0)
#define PG8_LDB(dst, b, h) do { _Pragma("unroll") for (int n = 0; n < 2; ++n) _Pragma("unroll") for (int k = 0; k < 2; ++k) dst[n][k] = *(const LAS bf16x8*)(lds + PG8_SB(b, h) + boff + n * 2048 + k * 1024); } while (0)
#define PG8_MMA(ai, bj, At, Bt) do { __builtin_amdgcn_s_setprio(1); _Pragma("unroll") for (int m = 0; m < 4; ++m) _Pragma("unroll") for (int n = 0; n < 2; ++n) _Pragma("unroll") for (int k = 0; k < 2; ++k) \
        acc[ai][bj][m][n] = __builtin_amdgcn_mfma_f32_16x16x32_bf16(Bt[n][k], At[m][k], acc[ai][bj][m][n], 0, 0, 0); __builtin_amdgcn_s_setprio(0); } while (0)
#define PG8_WAIT_V(n) asm volatile("s_waitcnt vmcnt(" #n ")" ::: "memory")
#define PG8_WAIT_L(n) asm volatile("s_waitcnt lgkmcnt(" #n ")" ::: "memory")
#define PG8_BAR __builtin_amdgcn_s_barrier()
#define PG8_SCHED __builtin_amdgcn_sched_barrier(0)
    Unit cur, nxt; int ui = 0;
    if (!S.next(0, cur)) return;
    f32x4 acc[2][2][4][2];
#pragma unroll
    for (int a = 0; a < 2; ++a)
#pragma unroll
        for (int b = 0; b < 2; ++b)
#pragma unroll
            for (int m = 0; m < 4; ++m)
#pragma unroll
                for (int n = 0; n < 2; ++n) acc[a][b][m][n] = (f32x4){0.f, 0.f, 0.f, 0.f};
    bf16x8 At[4][2], B0[2][2], B1[2][2];
    const int ksw = g.ksw ? g.ksw : nt;
    const char* cA = (const char*)g.A + (size_t)cur.pm * tstepA; const char* cB = (const char*)(g.Bt + (size_t)cur.e * g.bt_estride) + (size_t)cur.pn * tstep;
    const char* cA2 = g.ksw ? (const char*)g.A2 + (size_t)cur.pm * tstepA : cA;
    S.a_ready(cur);
    if constexpr (SP2) {
        PG8_STAGE(PG8_SB(0, 0), cB, voffB); PG8_STAGE(PG8_SB(0, 1), cB + hstep, voffB); PG8_STAGE(PG8_SA(0, 0), cA, voffA); PG8_STAGE(PG8_SA(0, 1), cA + hstepA, voffA);
        if (wr == 1) PG8_BAR;
        PG8_WAIT_V(2); PG8_BAR;
        PG8_STAGE(PG8_SB(1, 0), cB + kstep, voffB); PG8_STAGE(PG8_SA(1, 0), cA + kstep, voffA); PG8_STAGE(PG8_SB(1, 1), cB + hstep + kstep, voffB);
        PG8_WAIT_V(6); PG8_BAR;
    } else {
        PG8_STAGE(PG8_SB(0, 0), cB, voffB); PG8_STAGE(PG8_SA(0, 0), cA, voffA); PG8_STAGE(PG8_SB(0, 1), cB + hstep, voffB); PG8_STAGE(PG8_SA(0, 1), cA + hstepA, voffA);
        if (wr == 1) PG8_BAR;
        PG8_WAIT_V(4); PG8_BAR;
        PG8_STAGE(PG8_SB(1, 0), cB + kstep, voffB); PG8_STAGE(PG8_SA(1, 0), cA + kstep, voffA); PG8_STAGE(PG8_SB(1, 1), cB + hstep + kstep, voffB);
        PG8_WAIT_V(6); PG8_BAR;
    }
    for (;;) {
        const bool has_next = S.next(ui + 1, nxt);
        const char* nA = has_next ? (const char*)g.A + (size_t)nxt.pm * tstepA : cA;
        const char* nA2 = (has_next && g.ksw) ? (const char*)g.A2 + (size_t)nxt.pm * tstepA : cA2;
        const char* nB = has_next ? (const char*)(g.Bt + (size_t)nxt.e * g.bt_estride) + (size_t)nxt.pn * tstep : cB;
        for (int t = 0; t < nt; t += 2) {
            const bool last = (t == nt - 2);
            const char* a1 = (t + 1 < ksw) ? cA + (size_t)(t + 1) * kstep : cA2 + (size_t)(t + 1 - ksw) * kstep;
            const char* a2 = last ? nA : ((t + 2 < ksw) ? cA + (size_t)(t + 2) * kstep : cA2 + (size_t)(t + 2 - ksw) * kstep); const char* b2 = last ? nB : cB + (size_t)(t + 2) * kstep;
            const char* a3 = a2 + kstep; const char* b3 = b2 + kstep;
            if (last && has_next) S.a_ready(nxt);
            if constexpr (Epi::HAS_MID) { if (t == ksw) E.mid(acc, cur, wr, wc, fr, fq); }
            if constexpr (SP2) {
            PG8_LDB(B0, 0, 0); PG8_LDB(B1, 0, 1); PG8_SCHED; PG8_LDA(At, 0, 0); PG8_STAGE(PG8_SA(1, 1), a1 + hstepA, voffA);
            PG8_WAIT_V(8); PG8_WAIT_L(0); PG8_BAR; PG8_MMA(0, 0, At, B0); PG8_MMA(0, 1, At, B1); PG8_BAR; PG8_SCHED;
            PG8_LDA(At, 0, 1); PG8_STAGE(PG8_SB(0, 0), b2, voffB); PG8_STAGE(PG8_SB(0, 1), b2 + hstep, voffB); PG8_STAGE(PG8_SA(0, 0), a2, voffA);
            PG8_WAIT_V(8); PG8_WAIT_L(0); PG8_BAR; PG8_MMA(1, 0, At, B0); PG8_MMA(1, 1, At, B1); PG8_BAR; PG8_SCHED;
            PG8_LDB(B0, 1, 0); PG8_LDB(B1, 1, 1); PG8_SCHED; PG8_LDA(At, 1, 0); PG8_STAGE(PG8_SA(0, 1), a2 + hstepA, voffA);
            PG8_WAIT_V(8); PG8_WAIT_L(0); PG8_BAR; PG8_MMA(0, 0, At, B0); PG8_MMA(0, 1, At, B1); PG8_BAR; PG8_SCHED;
            PG8_LDA(At, 1, 1); PG8_STAGE(PG8_SB(1, 0), b3, voffB); PG8_STAGE(PG8_SB(1, 1), b3 + hstep, voffB); PG8_STAGE(PG8_SA(1, 0), a3, voffA);
            PG8_WAIT_V(8); PG8_WAIT_L(0); PG8_BAR; PG8_MMA(1, 0, At, B0); PG8_MMA(1, 1, At, B1); PG8_BAR; PG8_SCHED;
            } else {
            PG8_LDB(B0, 0, 0); PG8_SCHED; PG8_LDA(At, 0, 0); PG8_STAGE(PG8_SA(1, 1), a1 + hstepA, voffA);
            PG8_WAIT_L(8); PG8_BAR; PG8_WAIT_L(0); PG8_MMA(0, 0, At, B0); PG8_BAR; PG8_SCHED;
            PG8_LDB(B1, 0, 1); PG8_STAGE(PG8_SB(0, 0), b2, voffB);
            PG8_BAR; PG8_WAIT_L(0); PG8_MMA(0, 1, At, B1); PG8_BAR;
            PG8_LDA(At, 0, 1); PG8_STAGE(PG8_SA(0, 0), a2, voffA);
            PG8_BAR; PG8_WAIT_L(0); PG8_MMA(1, 0, At, B0); PG8_BAR; PG8_SCHED;
            PG8_STAGE(PG8_SB(0, 1), b2 + hstep, voffB);
            PG8_WAIT_V(6); PG8_BAR; PG8_MMA(1, 1, At, B1); PG8_BAR;
            PG8_LDB(B0, 1, 0); PG8_SCHED; PG8_LDA(At, 1, 0); PG8_STAGE(PG8_SA(0, 1), a2 + hstepA, voffA);
            PG8_WAIT_L(8); PG8_BAR; PG8_WAIT_L(0); PG8_MMA(0, 0, At, B0); PG8_BAR; PG8_SCHED;
            PG8_LDB(B1, 1, 1); PG8_STAGE(PG8_SB(1, 0), b3, voffB);
            PG8_BAR; PG8_WAIT_L(0); PG8_MMA(0, 1, At, B1); PG8_BAR;
            PG8_LDA(At, 1, 1); PG8_STAGE(PG8_SA(1, 0), a3, voffA);
            PG8_BAR; PG8_WAIT_L(0); PG8_MMA(1, 0, At, B0); PG8_BAR; PG8_SCHED;
            PG8_STAGE(PG8_SB(1, 1), b3 + hstep, voffB);
            PG8_WAIT_V(6); PG8_BAR; PG8_MMA(1, 1, At, B1); PG8_BAR;
            }
        }
        if constexpr (ALIGN_EPI) { if (wr == 0) PG8_BAR; }
        E(acc, cur, wr, wc, fr, fq); S.done(cur);
        if (!has_next) break;
#pragma unroll
        for (int a = 0; a < 2; ++a)
#pragma unroll
            for (int b = 0; b < 2; ++b)
#pragma unroll
                for (int m = 0; m < 4; ++m)
#pragma unroll
                    for (int n = 0; n < 2; ++n) acc[a][b][m][n] = (f32x4){0.f, 0.f, 0.f, 0.f};
        cur = nxt; cA = nA; cA2 = nA2; cB = nB; ++ui;
        if constexpr (ALIGN_EPI) { if (wr == 1) PG8_BAR; }
    }
    PG8_WAIT_V(0);
    if constexpr (!ALIGN_EPI) { if (wr == 0) PG8_BAR; }
    PG8_BAR;
#undef PG8_SA
#undef PG8_SB
#undef PG8_STAGE
#undef PG8_LDA
#undef PG8_LDB
#undef PG8_MMA
#undef PG8_WAIT_V
#undef PG8_WAIT_L
#undef PG8_BAR
#undef PG8_SCHED
}
}

#define XB_TMO      128
#define XB_XCNT(j)  (256  + 64 * (j))
#define XB_XSUB(j)  (1280 + 64 * (j))
#define XB_XGEN(j)  (2304 + 64 * (j))
#define XB_TOP      3328
#define XB_TOPGEN   3392
#define XCD_BAR_WORDS 3456
#define XB_SPIN_CAP (1u << 18)
__device__ __forceinline__ unsigned xb_ld(unsigned* p)              { return __hip_atomic_load(p, __ATOMIC_RELAXED, __HIP_MEMORY_SCOPE_AGENT); }
__device__ __forceinline__ unsigned xb_add(unsigned* p, unsigned v) { return __hip_atomic_fetch_add(p, v, __ATOMIC_RELAXED, __HIP_MEMORY_SCOPE_AGENT); }
__device__ __forceinline__ unsigned xb_xcc_id() { return (unsigned)__builtin_amdgcn_s_getreg((3 << 11) | 20) & 0xFu; }
#define XB_SPIN(cond, bar) do { unsigned _sp = 0; while (cond) { __builtin_amdgcn_s_sleep(1); \
    if ((++_sp & 255u) == 0u) { if (xb_ld(&(bar)[XB_TMO])) break; if (_sp > XB_SPIN_CAP) { atomicAdd(&(bar)[XB_TMO], 1u); break; } } } } while (0)
struct XcdBarrier { unsigned* bar; unsigned x; volatile LAS unsigned* st; };
__device__ __forceinline__ XcdBarrier xcd_barrier_post(unsigned* bar, volatile LAS unsigned* st, const bool leader) {
    XcdBarrier b; b.bar = bar; b.x = xb_xcc_id(); b.st = st;
    if (leader) (void)xb_add(&bar[XB_XCNT(b.x)], 1u);
    return b;
}
__device__ __forceinline__ void xcd_barrier_complete(unsigned* bar, unsigned x, unsigned& nloc, unsigned& nx) {
    const unsigned G = gridDim.x * gridDim.y * gridDim.z;
    unsigned sum, cnt, mine, sp = 0u;
    for (;;) {
        sum = 0u; cnt = 0u; mine = 0u;
#pragma unroll
        for (unsigned j = 0; j < 16; ++j) { const unsigned c = xb_ld(&bar[XB_XCNT(j)]); sum += c; cnt += (c > 0u) ? 1u : 0u; mine = (j == x) ? c : mine; }
        if (sum == G) break;
        __builtin_amdgcn_s_sleep(1);
        if ((++sp & 255u) == 0u) { if (xb_ld(&bar[XB_TMO])) break; if (sp > XB_SPIN_CAP) { atomicAdd(&bar[XB_TMO], 1u); break; } }
    }
    nloc = mine > 0u ? mine : 1u; nx = cnt > 0u ? cnt : 1u;
}
__device__ __forceinline__ void xcd_barrier(const XcdBarrier& b, const bool leader) {
    asm volatile("s_waitcnt vmcnt(0)" ::: "memory");
    __syncthreads();
    if (leader) {
        unsigned* bar = b.bar;
        __builtin_amdgcn_s_waitcnt(0);
        unsigned nloc = b.st[0], nx = b.st[1];
        if (nloc == 0u) { xcd_barrier_complete(bar, b.x, nloc, nx); b.st[0] = nloc; b.st[1] = nx; }
        const unsigned old = xb_add(&bar[XB_XSUB(b.x)], 1u);
        const unsigned gen = old / nloc;
        if (old + 1u == (gen + 1u) * nloc) {
            __builtin_amdgcn_fence(__ATOMIC_RELEASE, "agent");
            asm volatile("s_waitcnt vmcnt(0)" ::: "memory");
            const unsigned og = xb_add(&bar[XB_TOP], 1u);
            const unsigned tg = og / nx;
            if (og + 1u == (tg + 1u) * nx) xb_add(&bar[XB_TOPGEN], 1u);
            else XB_SPIN(xb_ld(&bar[XB_TOPGEN]) == tg, bar);
            __builtin_amdgcn_fence(__ATOMIC_ACQUIRE, "agent");
            xb_add(&bar[XB_XGEN(b.x)], 1u);
            asm volatile("s_waitcnt vmcnt(0)" ::: "memory");
        } else {
            XB_SPIN(xb_ld(&bar[XB_XGEN(b.x)]) == gen, bar);
            __builtin_amdgcn_fence(__ATOMIC_ACQUIRE, "agent");
            asm volatile("s_waitcnt vmcnt(0)" ::: "memory");
        }
    }
    __syncthreads();
}

constexpr int NB = 4, SEQ = 8192, DM = 1024, NT = NB * SEQ;
constexpr int NINP = 5632;
constexpr int FF0 = 2752, FF0P = 2816, FFE = 3584, NEXP = 8;
constexpr int NWAVES = 8, NTHR = 512;
constexpr int LDS_BYTES = 155648;
constexpr int MISC_OFF = LDS_BYTES - 64;
constexpr float DN_ALPHA = 1.41421356237309515f;
constexpr int MAXPANELS = 272;
constexpr int MAXCHUNK = 5;

constexpr size_t al256(size_t x) { return (x + 255) & ~(size_t)255; }
constexpr size_t WS_CTL = 0;
constexpr size_t CTL_BYTES = 65536;
constexpr size_t CW_BAR = 0;
constexpr size_t CW_BLKCNT = 16384;
constexpr size_t CW_META = 16384 + 8192;
constexpr size_t CW_PANELE = 16384 + 8192 + 256;
constexpr size_t CW_PE32 = 16384 + 8192 + 2048;
constexpr size_t CW_PROBE = 16384 + 8192 + 4096;
constexpr size_t WS_LBS = WS_CTL + CTL_BYTES;
constexpr size_t WS_KC = WS_LBS + 4096;
constexpr size_t WS_VC = WS_KC + 1048576;
constexpr size_t WS_DEC = WS_VC + 1048576;
constexpr size_t WS_TOPI = WS_DEC + 1048576;
constexpr size_t WS_TOPG = WS_TOPI + (size_t)NT * 4;
constexpr size_t WS_ROWINFO = WS_TOPG + (size_t)NT * 8;
constexpr size_t WS_HID = al256(WS_ROWINFO + (size_t)MAXPANELS * 256 * 4);
constexpr size_t WS_B1 = WS_HID + (size_t)8192 * 128 * 2;
constexpr size_t WS_BIG = al256(WS_B1 + 4096);
constexpr size_t SZ_WIN = (size_t)NINP * DM * 2, SZ_WBR = (size_t)DM * 512 * 2, SZ_WOUT = (size_t)DM * DM * 2;
constexpr size_t WS_WIN0 = WS_BIG, WS_WIN1 = WS_WIN0 + SZ_WIN;
constexpr size_t WS_WBA0 = WS_WIN1 + SZ_WIN, WS_WBA1 = WS_WBA0 + SZ_WBR, WS_WBB0 = WS_WBA1 + SZ_WBR, WS_WBB1 = WS_WBB0 + SZ_WBR;
constexpr size_t WS_WOUT0 = WS_WBB1 + SZ_WBR, WS_WOUT1 = WS_WOUT0 + SZ_WOUT;
constexpr size_t WS_WGU0 = WS_WOUT1 + SZ_WOUT;
constexpr size_t WS_WDN0 = WS_WGU0 + (size_t)NINP * DM * 2;
constexpr size_t WS_W1T = WS_WDN0 + (size_t)DM * FF0P * 2;
constexpr size_t WS_XB = WS_W1T + (size_t)2 * 2 * 256 * 2048 * 2;
constexpr size_t WS_US = WS_XB;
constexpr size_t WS_PROJ = WS_XB + (size_t)NT * DM * 2;
constexpr size_t WS_QHG = WS_PROJ;
constexpr size_t WS_HF = WS_QHG + (size_t)NT * 512 * 2;
constexpr size_t WS_HI = WS_HF + (size_t)NT * 512 * 4;
constexpr size_t WS_HG = WS_HI + (size_t)NT * 512 * 2;
constexpr size_t WS_NQ = WS_HG + (size_t)NT * 512 * 2;
constexpr size_t WS_KV6 = WS_NQ + (size_t)NT * 512 * 2;
constexpr size_t WS_GA = WS_KV6 + (size_t)NT * 768 * 2;
constexpr size_t WS_GB = WS_GA + (size_t)NT * DM * 2;
constexpr size_t WS_NG = WS_GB + (size_t)NT * DM * 2;
constexpr size_t WS_MIX_END = WS_NG + (size_t)NT * 32 * 4;
constexpr size_t WS_H0 = WS_PROJ;
constexpr size_t WS_MGU = WS_BIG;
constexpr size_t WS_MDN = WS_MGU + (size_t)NEXP * 2 * FFE * DM * 2;
constexpr size_t WS_XS = WS_MDN + (size_t)NEXP * DM * FFE * 2;
constexpr size_t WS_HM = WS_XS + (size_t)MAXPANELS * 256 * DM * 2;
constexpr size_t WS_YM = WS_HM + (size_t)64 * 256 * FFE * 2;
constexpr size_t WS_MOE_END = WS_YM + (size_t)NT * 2 * DM * 2;
constexpr size_t WS_END = WS_MOE_END > WS_MIX_END ? WS_MOE_END : WS_MIX_END;

struct Args {
    const float* in[22]; float* out; unsigned char* ws; int ph_lo, ph_hi;
};
typedef const __attribute__((address_space(4))) Args* KArgsP;

struct EpiInProj {
    static constexpr bool PERM = false, HAS_MID = false;
    unsigned char* ws;
    __device__ __forceinline__ void operator()(const f32x4 (&acc)[2][2][4][2], const pg8::Unit& u, int wr, int wc, int fr, int fq) const {
        const int row0 = u.pm * 256 + wr * 64 + fr;
#pragma unroll
        for (int bj = 0; bj < 2; ++bj)
#pragma unroll
            for (int n = 0; n < 2; ++n) {
                const int cb = u.pn * 256 + bj * 128 + wc * 32 + n * 16;
                const int c = cb + 4 * fq;
                int kind = 0, ld = 512, co = 0; size_t base = 0; float sc = 1.f;
                if (cb < 512) { base = WS_QHG; co = c; }
                else if (cb < 1024) { kind = 1; base = WS_HF; co = c - 512; }
                else if (cb < 1536) { base = WS_HI; co = c - 1024; }
                else if (cb < 2048) { base = WS_HG; co = c - 1536; }
                else if (cb < 2560) { base = WS_NQ; co = c - 2048; sc = 0.125f * 1.4426950408889634f; }
                else if (cb < 3328) { kind = 3; base = WS_KV6; const int idx = cb - 2560; co = ((idx >> 7) * 8 + ((idx >> 6) & 1)) * SEQ * 64 + (idx & 63) + 4 * fq; }
                else if (cb < 4352) { base = WS_GA; co = c - 3328; ld = 1024; }
                else if (cb < 5376) { base = WS_GB; co = c - 4352; ld = 1024; }
                else if (cb < 5408) { kind = 1; base = WS_NG; co = c - 5376; ld = 32; }
                else kind = 2;
                if (kind == 2) continue;
#pragma unroll
                for (int ai = 0; ai < 2; ++ai)
#pragma unroll
                    for (int m = 0; m < 4; ++m) {
                        const int row = row0 + ai * 128 + m * 16;
                        const f32x4 v = acc[ai][bj][m][n];
                        if (kind == 0) { u32x2 w; w.x = cvt_pk_bf16(v[0] * sc, v[1] * sc); w.y = cvt_pk_bf16(v[2] * sc, v[3] * sc); *(u32x2*)((bf16*)(ws + base) + (size_t)row * ld + co) = w; }
                        else if (kind == 3) { u32x2 w; w.x = cvt_pk_bf16(v[0], v[1]); w.y = cvt_pk_bf16(v[2], v[3]); *(u32x2*)((bf16*)(ws + base) + (size_t)co + ((size_t)(row >> 13) * 2 * SEQ + (row & (SEQ - 1))) * 64) = w; }
                        else *(f32x4*)((float*)(ws + base) + (size_t)row * ld + co) = v;
                    }
            }
    }
};
struct EpiCmpHid {
    static constexpr bool PERM = false, HAS_MID = false;
    bf16* HID; const float* B1;
    __device__ __forceinline__ void operator()(const f32x4 (&acc)[2][2][4][2], const pg8::Unit& u, int wr, int wc, int fr, int fq) const {
        const int row0 = u.pm * 256 + wr * 64 + fr, col0 = wc * 32 + 4 * fq;
#pragma unroll
        for (int n = 0; n < 2; ++n) { const f32x4 bq = *(const f32x4*)(B1 + u.e * 128 + col0 + n * 16);
#pragma unroll
            for (int ai = 0; ai < 2; ++ai)
#pragma unroll
                for (int m = 0; m < 4; ++m) { const f32x4 v = acc[ai][0][m][n] + bq; float o[4];
#pragma unroll
                    for (int q = 0; q < 4; ++q) { const float x = v[q]; o[q] = 0.5f * x * (1.f + tanhf(0.7978845608028654f * (x + 0.044715f * x * x * x))); }
                    u32x2 w; w.x = cvt_pk_bf16(o[0], o[1]); w.y = cvt_pk_bf16(o[2], o[3]);
                    *(u32x2*)(HID + (size_t)(row0 + ai * 128 + m * 16) * 128 + col0 + n * 16) = w; } }
    }
};
template <bool FIRST> struct EpiGate {
    static constexpr bool PERM = false, HAS_MID = false;
    bf16* Y; const bf16* G;
    __device__ __forceinline__ void operator()(const f32x4 (&acc)[2][2][4][2], const pg8::Unit& u, int wr, int wc, int fr, int fq) const {
        const int row0 = u.pm * 256 + wr * 64 + fr, col0 = u.pn * 256 + wc * 32 + 4 * fq;
#pragma unroll
        for (int ai = 0; ai < 2; ++ai)
#pragma unroll
            for (int m = 0; m < 4; ++m)
#pragma unroll
                for (int bj = 0; bj < 2; ++bj)
#pragma unroll
                    for (int n = 0; n < 2; ++n) {
                        const size_t off = (size_t)(row0 + ai * 128 + m * 16) * DM + col0 + bj * 128 + n * 16;
                        const u32x2 gq = *(const u32x2*)(G + off);
                        const f32x4 v = acc[ai][bj][m][n];
                        float o0 = sigmoidf_(bflo(gq.x)) * v[0], o1 = sigmoidf_(bfhi(gq.x)) * v[1], o2 = sigmoidf_(bflo(gq.y)) * v[2], o3 = sigmoidf_(bfhi(gq.y)) * v[3];
                        if (!FIRST) { const u32x2 yq = *(const u32x2*)(Y + off); o0 += bflo(yq.x); o1 += bfhi(yq.x); o2 += bflo(yq.y); o3 += bfhi(yq.y); }
                        u32x2 w; w.x = cvt_pk_bf16(o0, o1); w.y = cvt_pk_bf16(o2, o3); *(u32x2*)(Y + off) = w;
                    }
    }
};
struct EpiGate2 {
    static constexpr bool PERM = false, HAS_MID = true;
    bf16* Y; const bf16* GA; const bf16* GB;
    static __device__ __forceinline__ float cl(float x) { return fminf(fmaxf(x, -30.f), 30.f); }
    __device__ __forceinline__ void mid(f32x4 (&acc)[2][2][4][2], const pg8::Unit& u, int wr, int wc, int fr, int fq) const {
        int row0 = u.pm * 256 + wr * 64 + fr; const int col0 = u.pn * 256 + wc * 32 + 4 * fq;
        asm volatile("" : "+v"(row0));
#pragma unroll
        for (int ai = 0; ai < 2; ++ai)
#pragma unroll
            for (int m = 0; m < 4; ++m) {
#pragma unroll
                for (int bj = 0; bj < 2; ++bj)
#pragma unroll
                    for (int n = 0; n < 2; ++n) {
                        const size_t off = (size_t)(row0 + ai * 128 + m * 16) * DM + col0 + bj * 128 + n * 16;
                        const u32x2 ga = *(const u32x2*)(GA + off), gb = *(const u32x2*)(GB + off);
                        f32x4 r;
                        r[0] = (1.f + __expf(-cl(bflo(gb.x)))) * __builtin_amdgcn_rcpf(1.f + __expf(-cl(bflo(ga.x))));
                        r[1] = (1.f + __expf(-cl(bfhi(gb.x)))) * __builtin_amdgcn_rcpf(1.f + __expf(-cl(bfhi(ga.x))));
                        r[2] = (1.f + __expf(-cl(bflo(gb.y)))) * __builtin_amdgcn_rcpf(1.f + __expf(-cl(bflo(ga.y))));
                        r[3] = (1.f + __expf(-cl(bfhi(gb.y)))) * __builtin_amdgcn_rcpf(1.f + __expf(-cl(bfhi(ga.y))));
                        acc[ai][bj][m][n] = acc[ai][bj][m][n] * r;
                    }
                asm volatile("" : "+v"(acc[ai][0][m][0]), "+v"(acc[ai][0][m][1]), "+v"(acc[ai][1][m][0]), "+v"(acc[ai][1][m][1]) :: "memory");
            }
    }
    __device__ __forceinline__ void operator()(const f32x4 (&acc)[2][2][4][2], const pg8::Unit& u, int wr, int wc, int fr, int fq) const {
        const int row0 = u.pm * 256 + wr * 64 + fr, col0 = u.pn * 256 + wc * 32 + 4 * fq;
#pragma unroll
        for (int ai = 0; ai < 2; ++ai)
#pragma unroll
            for (int m = 0; m < 4; ++m)
#pragma unroll
                for (int bj = 0; bj < 2; ++bj)
#pragma unroll
                    for (int n = 0; n < 2; ++n) {
                        const size_t off = (size_t)(row0 + ai * 128 + m * 16) * DM + col0 + bj * 128 + n * 16;
                        const u32x2 gb = *(const u32x2*)(GB + off);
                        const f32x4 v = acc[ai][bj][m][n];
                        u32x2 w; w.x = cvt_pk_bf16(v[0] * sigmoidf_(cl(bflo(gb.x))), v[1] * sigmoidf_(cl(bfhi(gb.x)))); w.y = cvt_pk_bf16(v[2] * sigmoidf_(cl(bflo(gb.y))), v[3] * sigmoidf_(cl(bfhi(gb.y))));
                        *(u32x2*)(Y + off) = w;
                    }
    }
};
struct EpiResid {
    static constexpr bool PERM = false, HAS_MID = false;
    const float* XI; float* XO;
    __device__ __forceinline__ void operator()(const f32x4 (&acc)[2][2][4][2], const pg8::Unit& u, int wr, int wc, int fr, int fq) const {
        const int row0 = u.pm * 256 + wr * 64 + fr, col0 = u.pn * 256 + wc * 32 + 4 * fq;
#pragma unroll
        for (int ai = 0; ai < 2; ++ai)
#pragma unroll
            for (int m = 0; m < 4; ++m)
#pragma unroll
                for (int bj = 0; bj < 2; ++bj)
#pragma unroll
                    for (int n = 0; n < 2; ++n) {
                        const size_t off = (size_t)(row0 + ai * 128 + m * 16) * DM + col0 + bj * 128 + n * 16;
                        const f32x4 xi = *(const f32x4*)(XI + off);
                        *(f32x4*)(XO + off) = xi * DN_ALPHA + acc[ai][bj][m][n];
                    }
    }
};
struct EpiSwiglu {
    static constexpr bool PERM = false, HAS_MID = false;
    bf16* H; int ldh;
    __device__ __forceinline__ void operator()(const f32x4 (&acc)[2][2][4][2], const pg8::Unit& u, int wr, int wc, int fr, int fq) const {
        const int row0 = u.pm * 256 + wr * 64 + fr, col0 = u.pn * 128 + wc * 32 + 4 * fq;
#pragma unroll
        for (int ai = 0; ai < 2; ++ai)
#pragma unroll
            for (int m = 0; m < 4; ++m)
#pragma unroll
                for (int n = 0; n < 2; ++n) {
                    const f32x4 gq = acc[ai][0][m][n], uq = acc[ai][1][m][n];
                    u32x2 w; w.x = cvt_pk_bf16(siluf_(gq[0]) * uq[0], siluf_(gq[1]) * uq[1]); w.y = cvt_pk_bf16(siluf_(gq[2]) * uq[2], siluf_(gq[3]) * uq[3]);
                    *(u32x2*)(H + (size_t)(row0 + ai * 128 + m * 16) * ldh + col0 + n * 16) = w;
                }
    }
};
struct EpiScatter {
    static constexpr bool PERM = false, HAS_MID = false;
    bf16* Y; const int* rowinfo;
    __device__ __forceinline__ void operator()(const f32x4 (&acc)[2][2][4][2], const pg8::Unit& u, int wr, int wc, int fr, int fq) const {
        const int row0 = u.pm * 256 + wr * 64 + fr, col0 = u.pn * 256 + wc * 32 + 4 * fq;
#pragma unroll
        for (int ai = 0; ai < 2; ++ai)
#pragma unroll
            for (int m = 0; m < 4; ++m) {
                const int info = rowinfo[row0 + ai * 128 + m * 16];
                if (info < 0) continue;
#pragma unroll
                for (int bj = 0; bj < 2; ++bj)
#pragma unroll
                    for (int n = 0; n < 2; ++n) {
                        const f32x4 v = acc[ai][bj][m][n];
                        u32x2 w; w.x = cvt_pk_bf16(v[0], v[1]); w.y = cvt_pk_bf16(v[2], v[3]);
                        *(u32x2*)(Y + (size_t)info * DM + col0 + bj * 128 + n * 16) = w;
                    }
            }
    }
};

__device__ __forceinline__ int rel_bucket(int n) {
    if (n < 16) return n;
    return 16 + (n >= 22) + (n >= 30) + (n >= 40) + (n >= 54) + (n >= 73) + (n >= 99) + (n >= 134) + (n >= 182) + (n >= 246) + (n >= 332) + (n >= 450) + (n >= 609) + (n >= 825) + (n >= 1117) + (n >= 1513);
}
template <class F>
__device__ __forceinline__ void tr_item(F colptr, int ld, int Kvalid, bf16* dst, int dstld, int n0, int k0, LAS float* scr, int lane) {
    const float* cp = colptr(n0 + 4 * (lane & 7));
#pragma unroll
    for (int i = 0; i < 8; ++i) { const int kk = 8 * i + (lane >> 3), k = k0 + kk; f32x4 v = (f32x4){0.f, 0.f, 0.f, 0.f}; if (cp && k < Kvalid) v = *(const f32x4*)(cp + (size_t)k * ld);
        LAS float* s = scr + kk * 33 + 4 * (lane & 7); s[0] = v[0]; s[1] = v[1]; s[2] = v[2]; s[3] = v[3]; }
    WAVE_SYNC();
    const int c = lane & 7;
#pragma unroll
    for (int j = 0; j < 4; ++j) { const int n = (lane >> 3) + 8 * j; const LAS float* s = scr + (8 * c) * 33 + n;
        u32x4 o; o.x = cvt_pk_bf16(s[0 * 33], s[1 * 33]); o.y = cvt_pk_bf16(s[2 * 33], s[3 * 33]); o.z = cvt_pk_bf16(s[4 * 33], s[5 * 33]); o.w = cvt_pk_bf16(s[6 * 33], s[7 * 33]);
        *(u32x4*)(dst + (size_t)(n0 + n) * dstld + k0 + 8 * c) = o; }
    WAVE_SYNC();
}

__global__ void __launch_bounds__(NTHR, 2) mega_fwd(Args args) {
    extern __shared__ __attribute__((aligned(16))) unsigned char lds_raw[];
    LAS unsigned char* lds = (LAS unsigned char*)lds_raw;
    const int G = gridDim.x, bid = blockIdx.x;
    const int nwaves = G * NWAVES;
    KArgsP kap = (KArgsP)__builtin_amdgcn_kernarg_segment_ptr();
    unsigned char* ws0 = kap->ws;
#if ONE_LAUNCH
    constexpr int lo = 0, hi = 64;
#else
    const int lo = kap->ph_lo, hi = kap->ph_hi;
#endif

    volatile LAS unsigned* misc = (volatile LAS unsigned*)(lds + MISC_OFF);
    const int wave_s = __builtin_amdgcn_readfirstlane((int)threadIdx.x >> 6);
    if (wave_s == 0 && lane_id() < 16) misc[lane_id()] = 0u;
    __syncthreads();
    XcdBarrier bar; bar.bar = (unsigned*)(ws0 + WS_CTL + CW_BAR); bar.x = 0; bar.st = misc;
    const bool multi = (hi - lo) > 1;
    if (multi) bar = xcd_barrier_post((unsigned*)(ws0 + WS_CTL + CW_BAR), misc, wave_s == 0 && lane_id() == 0);
#ifndef EN_MASK
#define EN_MASK 0xFFFFFFFFu
#endif
#define EN(b) (((EN_MASK) >> (b)) & 1u)
#define IN(k) (lo <= (k) && (k) < hi)
#ifndef PROBE_GRP
#define PROBE_GRP -1
#endif
#define PROBE_K 4
#ifndef SELREP
#define SELREP 1
#endif
#define WINREP 1
#define NSA_SGB 1
#define NSA_DUP_A 0
#define NSA_DUP_B 0
#define NSA_DUP_C 0
#ifndef PROBE_SCALE
#define PROBE_SCALE 1e-6f
#endif
#if PROBE_GRP >= 0
    unsigned long long pr_last = __builtin_amdgcn_s_memrealtime(), pr_acc = 0ull;
#define PMARK(g) do { const unsigned long long _n = __builtin_amdgcn_s_memrealtime(); if ((g) == PROBE_GRP) pr_acc += _n - pr_last; pr_last = _n; } while (0)
#else
    const unsigned long long pr_acc = 0ull; (void)pr_acc;
#define PMARK(g) do { } while (0)
#endif
#define SEAM(k, g) do { if (IN(k) && IN((k) + 1)) { XcdBarrier b_ = bar; asm volatile("" : "+s"(b_.bar)); unsigned bx_ = b_.x; asm volatile("" : "+s"(bx_)); b_.x = bx_; \
        xcd_barrier(b_, wave_s == 0 && lane_id() == 0); } PMARK(g); } while (0)


    if (EN(0) && IN(0)) { PHASE_IDS();
        LAS float* scr = (LAS float*)(lds + wave * 16384);
        constexpr int I_WIN = 16 * (NINP / 32), I_BR = 8 * 32, I_OUT = 16 * 32, I_GU = 16 * (NINP / 32), I_DN = (FF0P / 64) * 32;
        constexpr int I_W1 = 32 * 8;
        constexpr int NITEMS = 2 * (I_WIN + 2 * I_BR + I_OUT) + I_GU + I_DN + 4 * I_W1;
        for (int it = gwave; it < NITEMS; it += nwaves) {
            int r = it;
            if (r < 2 * I_WIN) { const int l = r / I_WIN; r %= I_WIN; const int nb = r % (NINP / 32), kb = r / (NINP / 32);
                const float* W = ap->in[1] + (size_t)l * DM * 5400;
                auto cp = [=](int n) -> const float* { int c; if (n < 3328) c = n; else if (n < 5376) c = n + 24; else if (n < 5400) c = n - 5376 + 3328; else return nullptr; return W + c; };
                tr_item(cp, 5400, DM, (bf16*)(ws + (l ? WS_WIN1 : WS_WIN0)), DM, nb * 32, kb * 64, scr, lane); continue; }
            r -= 2 * I_WIN;
            if (r < 4 * I_BR) { const int which = r / I_BR; r %= I_BR; const int l = which & 1, ab = which >> 1; const int nb = r % 32, kb = r / 32;
                const float* W = ap->in[ab ? 9 : 8] + (size_t)l * 512 * DM;
                auto cp = [=](int n) -> const float* { return W + n; };
                tr_item(cp, DM, 512, (bf16*)(ws + WS_WBA0 + (size_t)l * 2 * SZ_WBR) + ab * 512, DM, nb * 32, kb * 64, scr, lane); continue; }
            r -= 4 * I_BR;
            if (r < 2 * I_OUT) { const int l = r / I_OUT; r %= I_OUT; const int nb = r % 32, kb = r / 32;
                const float* W = ap->in[10] + (size_t)l * DM * DM;
                auto cp = [=](int n) -> const float* { return W + n; };
                tr_item(cp, DM, DM, (bf16*)(ws + (l ? WS_WOUT1 : WS_WOUT0)), DM, nb * 32, kb * 64, scr, lane); continue; }
            r -= 2 * I_OUT;
            if (r < I_GU) { const int nb = r % (NINP / 32), kb = r / (NINP / 32);
                const float* Wg = ap->in[15]; const float* Wu = ap->in[16];
                auto cp = [=](int n) -> const float* { const int pn = n >> 8, hf = (n >> 7) & 1, c = pn * 128 + (n & 127); if (c >= FF0) return nullptr; return (hf ? Wu : Wg) + c; };
                tr_item(cp, FF0, DM, (bf16*)(ws + WS_WGU0), DM, nb * 32, kb * 64, scr, lane); continue; }
            r -= I_GU;
            if (r >= I_DN) { r -= I_DN; const int lk = r / I_W1; r %= I_W1; const int nb = r % 8, kb = r / 8;
                const float* W = ap->in[5] + (size_t)lk * 2048 * 128;
                auto cp = [=](int n) -> const float* { return n < 128 ? W + n : nullptr; };
                tr_item(cp, 128, 2048, (bf16*)(ws + WS_W1T) + (size_t)lk * 256 * 2048, 2048, nb * 32, kb * 64, scr, lane); continue; }
            { const int nb = r % 32, kb = r / 32;
                const float* W = ap->in[17];
                auto cp = [=](int n) -> const float* { return W + n; };
                tr_item(cp, DM, FF0, (bf16*)(ws + WS_WDN0), FF0P, nb * 32, kb * 64, scr, lane); }
        }
        for (int row = gwave; row < NT; row += nwaves) {
            const f32x4* xr = (const f32x4*)(x_in + (size_t)row * DM);
            u32x2* o = (u32x2*)(XB + (size_t)row * DM);
#pragma unroll
            for (int j = 0; j < 4; ++j) { const f32x4 v = xr[64 * j + lane]; u32x2 w; w.x = cvt_pk_bf16(v[0], v[1]); w.y = cvt_pk_bf16(v[2], v[3]); o[64 * j + lane] = w; }
        }
        for (int o = gwave; o < 4 * 128; o += nwaves) { const int lk = o >> 7, j = o & 127; const float* PS = ap->in[4] + (size_t)lk * 2048; const float* W = ap->in[5] + (size_t)lk * 2048 * 128;
            float s = 0.f; for (int k = lane; k < 2048; k += 64) s += PS[k] * W[(size_t)k * 128 + j];
            s = wave_sum(s); if (lane == 0) ((float*)(ws + WS_B1))[o] = s; }
        if (bid == 0 && tid < 32) ((int*)(ws + WS_CTL + CW_PE32))[tid] = tid >> 4;
        if (bid == 0) {
            const float* lg = ap->in[2];
            const float a = lg[tid], b = lg[512 + tid], m = fmaxf(a, b), ea = expf(a - m), eb = expf(b - m), s = ea + eb, p0 = ea / s, p1 = eb / s;
            LBS[tid] = p0 - p0; LBS[512 + tid] = (p0 + p1) - p0;
        }
    }
    SEAM(0, 0);

    for (int l = 0; l < 2; ++l) {
        const int pb = 1 + l * 10;

        if (EN(1) && IN(pb + 0)) { PHASE_IDS();
            pg8::Gemm g{XB, (const bf16*)(ws + (l ? WS_WIN1 : WS_WIN0)), NT, NINP, DM, 0, 0, nullptr, 0};
            pg8::StaticOrder S; S.init(NT, NINP, G, bid);
            EpiInProj E{ws};
            pg8::gemm_phase<EpiInProj, pg8::StaticOrder>(lds, g, S, E, wave_s);
        }
        SEAM(pb + 0, 1);

        if (EN(2) && IN(pb + 1)) { PHASE_IDS();
            {
                constexpr int RS = 272;
                LAS float* bsf = (LAS float*)lds;
                LAS unsigned char* kd = lds + 32768;
                LAS unsigned char* vt = lds + 32768 + 64 * RS;
                const bf16* HI = (const bf16*)(ws + WS_HI); const float* HF = (const float*)(ws + WS_HF);
                bf16* US = (bf16*)(ws + WS_US); float* DEC = (float*)(ws + WS_DEC);
                const int d = tid & 127, tp = tid >> 7;
                float zr[16];
                auto ld_z = [&](int it) { const int h = it & 3, ci = (it >> 2) & 127, b = it >> 9; const size_t tok0 = (size_t)b * SEQ + ci * 64;
#pragma unroll
                    for (int i = 0; i < 16; ++i) zr[i] = HF[(tok0 + tp + 4 * i) * 512 + h * 128 + d]; };
                ld_z(bid);
                for (int item = bid; item < NB * 128 * 4; item += G) {
                    const int h = item & 3, ci = (item >> 2) & 127, b = item >> 9, bh = b * 4 + h;
                    const size_t tok0 = (size_t)b * SEQ + ci * 64;
                    const float lb = LBS[l * 512 + h * 128 + d];
                    float kk[16];
#pragma unroll
                    for (int i = 0; i < 16; ++i) { const int t = tp + 4 * i;
                        kk[i] = (1.f - lb) * __builtin_amdgcn_rcpf(1.f + __expf(zr[i])); bsf[t * 128 + d] = __logf(1.f - kk[i]); }
                    { const int t = tid >> 3, c8 = tid & 7;
                        const u32x4* src = (const u32x4*)(HI + (tok0 + t) * 512 + h * 128) + c8 * 2;
                        const u32x4 a0 = src[0], a1 = src[1]; *(LAS u32x4*)(vt + t * RS + c8 * 32) = a0; *(LAS u32x4*)(vt + t * RS + c8 * 32 + 16) = a1; }
                    __syncthreads();
                    { float run = 0.f;
#pragma unroll
                        for (int i = 0; i < 16; ++i) { run += bsf[(16 * tp + i) * 128 + d]; bsf[(16 * tp + i) * 128 + d] = run; } }
                    __syncthreads();
                    float off = 0.f;
                    for (int p = 0; p < tp; ++p) off += bsf[(16 * p + 15) * 128 + d];
                    __syncthreads();
#pragma unroll
                    for (int i = 0; i < 16; ++i) bsf[(16 * tp + i) * 128 + d] += off;
                    __syncthreads();
                    { const float blast = bsf[63 * 128 + d];
                        if (tp == 0) DEC[((size_t)bh * 128 + ci) * 128 + d] = __expf(blast);
#pragma unroll
                        for (int i = 0; i < 16; ++i) { const int t = tp + 4 * i; *(LAS bf16*)(kd + t * RS + d * 2) = f2bf(kk[i] * __expf(blast - bsf[t * 128 + d])); } }
                    __syncthreads();
                    if (item + G < NB * 128 * 4) ld_z(item + G);
                    {
                        const int mi = wave >> 1, r31 = lane & 31, hh = lane >> 5, i16 = lane & 15, sub = (lane >> 4) & 1;
                        f32x16 acc[2];
#pragma unroll
                        for (int q = 0; q < 2; ++q)
#pragma unroll
                            for (int r = 0; r < 16; ++r) acc[q][r] = 0.f;
#pragma unroll
                        for (int st = 0; st < 4; ++st) {
                            const LAS unsigned char* ka = kd + (16 * st + 8 * hh + (i16 >> 2)) * RS + (32 * mi + 16 * sub + 4 * (i16 & 3)) * 2;
                            const s16x4 k0 = __builtin_amdgcn_ds_read_tr16_b64_v4i16((LAS s16x4*)ka), k1 = __builtin_amdgcn_ds_read_tr16_b64_v4i16((LAS s16x4*)(ka + 4 * RS));
                            const bf16x8 af = __builtin_shufflevector(k0, k1, 0, 1, 2, 3, 4, 5, 6, 7);
#pragma unroll
                            for (int q = 0; q < 2; ++q) { const int ni = 2 * (wave & 1) + q;
                                const LAS unsigned char* va = vt + (16 * st + 8 * hh + (i16 >> 2)) * RS + (32 * ni + 16 * sub + 4 * (i16 & 3)) * 2;
                                const s16x4 v0 = __builtin_amdgcn_ds_read_tr16_b64_v4i16((LAS s16x4*)va), v1 = __builtin_amdgcn_ds_read_tr16_b64_v4i16((LAS s16x4*)(va + 4 * RS));
                                const bf16x8 bf = __builtin_shufflevector(v0, v1, 0, 1, 2, 3, 4, 5, 6, 7);
                                acc[q] = __builtin_amdgcn_mfma_f32_32x32x16_bf16(af, bf, acc[q], 0, 0, 0); } }
                        bf16* u = US + ((size_t)bh * 128 + ci) * 16384;
#pragma unroll
                        for (int q = 0; q < 2; ++q) { const int dv = 32 * (2 * (wave & 1) + q) + r31;
#pragma unroll
                            for (int rq = 0; rq < 4; ++rq) { u32x2 w; w.x = cvt_pk_bf16(acc[q][4 * rq], acc[q][4 * rq + 1]); w.y = cvt_pk_bf16(acc[q][4 * rq + 2], acc[q][4 * rq + 3]);
                                *(u32x2*)(u + dv * 128 + 32 * mi + 8 * rq + 4 * hh) = w; } }
                    }
                    __syncthreads();
                }
            }
            {
                pg8::Gemm g{(const bf16*)(ws + WS_KV6), (const bf16*)(ws + WS_W1T) + (size_t)l * 2 * 256 * 2048, 8192, 256, 2048, (size_t)256 * 2048, 1024, nullptr, 0};
                pg8::StaticOrder S; S.init(8192, 256, G, bid, (const int*)(ws + WS_CTL + CW_PE32));
                EpiCmpHid E{(bf16*)(ws + WS_HID), (const float*)(ws + WS_B1) + l * 256};
                pg8::gemm_phase<EpiCmpHid, pg8::StaticOrder>(lds, g, S, E, wave_s);
            }
        }
        SEAM(pb + 1, 2);

        if (EN(3) && IN(pb + 2)) { PHASE_IDS();
            {
                unsigned* US32 = (unsigned*)(ws + WS_US); const float* DEC = (const float*)(ws + WS_DEC);
                for (int e2 = bid * NTHR + tid; e2 < 16 * 8192; e2 += G * NTHR) {
                    const int bh = e2 >> 13, dv2 = e2 & 8191, d = (2 * dv2) & 127;
                    float s0 = 0.f, s1 = 0.f;
#pragma unroll 4
                    for (int c = 0; c < 128; ++c) {
                        const size_t o = ((size_t)bh * 128 + c) * 8192 + dv2;
                        const unsigned u = US32[o]; const f32x2 dec = *(const f32x2*)(DEC + ((size_t)bh * 128 + c) * 128 + d);
                        US32[o] = cvt_pk_bf16(s0, s1);
                        s0 = dec[0] * s0 + bflo(u); s1 = dec[1] * s1 + bfhi(u);
                    }
                }
            }
            {
                const bf16* HID = (const bf16*)(ws + WS_HID); bf16* KCb = (bf16*)(ws + WS_KC);
                for (int row = gwave; row < 8192; row += nwaves) { const int kind = row >> 12;
                    const float* W2 = ap->in[6] + ((size_t)l * 2 + kind) * 128 * 64;
                    const unsigned hv = ((const unsigned*)(HID + (size_t)row * 128))[lane];
                    float o = 0.f;
#pragma unroll 8
                    for (int j = 0; j < 64; ++j) { const unsigned hj = (unsigned)__builtin_amdgcn_readlane((int)hv, j); o += bflo(hj) * W2[(2 * j) * 64 + lane] + bfhi(hj) * W2[(2 * j + 1) * 64 + lane]; }
                    KCb[(size_t)row * 64 + lane] = f2bf(o); }
            }
        }
        SEAM(pb + 2, 3);

        if (EN(4) && IN(pb + 3)) {
          if (EN(16)) { PHASE_IDS();
            {
                constexpr int RS = 272;
                LAS float* bsf = (LAS float*)lds;
                LAS unsigned char* qh = lds + 32768;
                LAS unsigned char* q1 = qh + 64 * RS;
                LAS unsigned char* k0 = q1 + 32 * RS;
                LAS unsigned char* k1 = k0 + 32 * RS;
                LAS unsigned char* vt = k1 + 64 * RS;
                LAS float* ssq = (LAS float*)(vt + 64 * RS);
                bf16* QHG = (bf16*)(ws + WS_QHG); const bf16* HI = (const bf16*)(ws + WS_HI); const bf16* HG = (const bf16*)(ws + WS_HG); const float* HF = (const float*)(ws + WS_HF);
                const bf16* US = (const bf16*)(ws + WS_US);
                const float* NW = ap->in[3] + l * 512;
                const int d = tid & 127, tp = tid >> 7;
                for (int item = bid; item < NB * 128 * 4; item += G) {
                    const int h = item & 3, ci = (item >> 2) & 127, b = item >> 9, bh = b * 4 + h;
                    const size_t tok0 = (size_t)b * SEQ + ci * 64;
                    const float lb = LBS[l * 512 + h * 128 + d];
                    bf16x8 sf[8];
                    { const bf16* Sg = US + ((size_t)bh * 128 + ci) * 16384 + (size_t)(32 * (wave & 3) + (lane & 31)) * 128 + 8 * (lane >> 5);
#pragma unroll
                        for (int st = 0; st < 8; ++st) sf[st] = *(const bf16x8*)(Sg + 16 * st); }
                    float kk[16], qv[16];
#pragma unroll
                    for (int i = 0; i < 16; ++i) { const int t = tp + 4 * i; const size_t go = (tok0 + t) * 512 + h * 128 + d; const float z = HF[go];
                        kk[i] = (1.f - lb) * __builtin_amdgcn_rcpf(1.f + __expf(z)); bsf[t * 128 + d] = __logf(1.f - kk[i]); qv[i] = bf2f(QHG[go]); }
                    { const int t = tid >> 3, c8 = tid & 7;
                        const u32x4* src = (const u32x4*)(HI + (tok0 + t) * 512 + h * 128) + c8 * 2;
                        const u32x4 a0 = src[0], a1 = src[1]; *(LAS u32x4*)(vt + t * RS + c8 * 32) = a0; *(LAS u32x4*)(vt + t * RS + c8 * 32 + 16) = a1; }
                    __syncthreads();
                    { float run = 0.f;
#pragma unroll
                        for (int i = 0; i < 16; ++i) { run += bsf[(16 * tp + i) * 128 + d]; bsf[(16 * tp + i) * 128 + d] = run; } }
                    __syncthreads();
                    float off = 0.f;
                    for (int p = 0; p < tp; ++p) off += bsf[(16 * p + 15) * 128 + d];
                    __syncthreads();
#pragma unroll
                    for (int i = 0; i < 16; ++i) bsf[(16 * tp + i) * 128 + d] += off;
                    __syncthreads();
                    { const float b31 = bsf[31 * 128 + d];
#pragma unroll
                        for (int i = 0; i < 16; ++i) { const int t = tp + 4 * i; const float bt = bsf[t * 128 + d];
                            *(LAS bf16*)(qh + t * RS + d * 2) = f2bf(qv[i] * __expf(bt));
                            *(LAS bf16*)(k1 + t * RS + d * 2) = f2bf(kk[i] * __expf(fminf(b31 - bt, 80.f)));
                            if (t < 32) *(LAS bf16*)(k0 + t * RS + d * 2) = f2bf(kk[i] * __expf(fminf(-bt, 80.f)));
                            else *(LAS bf16*)(q1 + (t - 32) * RS + d * 2) = f2bf(qv[i] * __expf(bt - b31)); } }
                    __syncthreads();
                    {
                        const int ni = wave & 3, mi = wave >> 2, r31 = lane & 31, hh = lane >> 5, i16 = lane & 15, sub = (lane >> 4) & 1;
                        f32x16 acc;
#pragma unroll
                        for (int r = 0; r < 16; ++r) acc[r] = 0.f;
#pragma unroll
                        for (int st = 0; st < 8; ++st) { const bf16x8 bq = *(const LAS bf16x8*)(qh + (32 * mi + r31) * RS + (16 * st + 8 * hh) * 2);
                            acc = __builtin_amdgcn_mfma_f32_32x32x16_bf16(sf[st], bq, acc, 0, 0, 0); }
#pragma unroll
                        for (int jb = 0; jb < 2; ++jb) { if (jb > mi) continue;
                            f32x16 x;
#pragma unroll
                            for (int r = 0; r < 16; ++r) x[r] = 0.f;
                            const LAS unsigned char* kb = (mi == 0) ? k0 : (k1 + 32 * jb * RS);
                            const LAS unsigned char* qb = (mi == 0) ? qh : q1;
#pragma unroll
                            for (int st = 0; st < 8; ++st) { const bf16x8 ka = *(const LAS bf16x8*)(kb + r31 * RS + (16 * st + 8 * hh) * 2), qq = *(const LAS bf16x8*)(qb + r31 * RS + (16 * st + 8 * hh) * 2);
                                x = __builtin_amdgcn_mfma_f32_32x32x16_bf16(ka, qq, x, 0, 0, 0); }
                            if (jb == mi) {
#pragma unroll
                                for (int r = 0; r < 16; ++r) { const int key = (r & 3) + 8 * (r >> 2) + 4 * hh; if (key > r31) x[r] = 0.f; } }
#pragma unroll
                            for (int s2 = 0; s2 < 2; ++s2) { u32x4 w; w.x = cvt_pk_bf16(x[8 * s2], x[8 * s2 + 1]); w.y = cvt_pk_bf16(x[8 * s2 + 2], x[8 * s2 + 3]); w.z = cvt_pk_bf16(x[8 * s2 + 4], x[8 * s2 + 5]); w.w = cvt_pk_bf16(x[8 * s2 + 6], x[8 * s2 + 7]);
                                const bf16x8 xb = __builtin_bit_cast(bf16x8, w);
                                const LAS unsigned char* va = vt + (32 * jb + 16 * s2 + 4 * hh + (i16 >> 2)) * RS + (32 * ni + 16 * sub + 4 * (i16 & 3)) * 2;
                                const s16x4 v0 = __builtin_amdgcn_ds_read_tr16_b64_v4i16((LAS s16x4*)va), v1 = __builtin_amdgcn_ds_read_tr16_b64_v4i16((LAS s16x4*)(va + 8 * RS));
                                const bf16x8 vf = __builtin_shufflevector(v0, v1, 0, 1, 2, 3, 4, 5, 6, 7);
                                acc = __builtin_amdgcn_mfma_f32_32x32x16_bf16(vf, xb, acc, 0, 0, 0); } }
                        u32x2 gq4[4];
                        { const size_t gg = (tok0 + 32 * mi + r31) * 512 + h * 128 + 32 * ni + 4 * hh;
#pragma unroll
                          for (int rq = 0; rq < 4; ++rq) gq4[rq] = *(const u32x2*)(HG + gg + 8 * rq); }
                        float ss = 0.f;
#pragma unroll
                        for (int r = 0; r < 16; ++r) ss += acc[r] * acc[r];
                        ss += __shfl_xor(ss, 32);
                        if (hh == 0) ssq[ni * 64 + 32 * mi + r31] = ss;
                        __syncthreads();
                        const int tl = 32 * mi + r31;
                        const float tot = ssq[tl] + ssq[64 + tl] + ssq[128 + tl] + ssq[192 + tl];
                        const float rn = rsqrtf(tot * (1.f / 128.f) + 1e-6f);
                        const size_t go = (tok0 + tl) * 512 + h * 128 + 32 * ni + 4 * hh;
#pragma unroll
                        for (int rq = 0; rq < 4; ++rq) { const u32x2 gq = gq4[rq]; const f32x4 nw = *(const f32x4*)(NW + h * 128 + 32 * ni + 4 * hh + 8 * rq);
                            u32x2 w; w.x = cvt_pk_bf16(acc[4 * rq] * rn * nw[0] * siluf_(bflo(gq.x)), acc[4 * rq + 1] * rn * nw[1] * siluf_(bfhi(gq.x)));
                            w.y = cvt_pk_bf16(acc[4 * rq + 2] * rn * nw[2] * siluf_(bflo(gq.y)), acc[4 * rq + 3] * rn * nw[3] * siluf_(bfhi(gq.y)));
                            *(u32x2*)(QHG + go + 8 * rq) = w; }
                    }
                    __syncthreads();
                }
            }
          }
          PMARK(15);
          if (EN(17)) { PHASE_IDS();
            {
                constexpr int KST = 144, TB = 9216;
                constexpr float LOG2E = 1.4426950408889634f;
                LAS unsigned char* kvb = lds;
                LAS float* lut = (LAS float*)(lds + 4 * TB);
                LAS float* impW = (LAS float*)(lds + 4 * TB + 32768 + wave * 8192);
                LAS float* ocl = impW + lane;
                LAS unsigned* selm = (LAS unsigned*)(lds + 4 * TB + 32768 + 65536);
                const bf16* NQ = (const bf16*)(ws + WS_NQ); const bf16* KVT = (const bf16*)(ws + WS_KV6); const bf16* KCb = (const bf16*)(ws + WS_KC);
                const float* NG = (const float*)(ws + WS_NG); const float* RB = ap->in[7];
                bf16* OB = (bf16*)(ws + WS_NQ);
                const int col = lane & 15, q4 = lane >> 4, head = col & 3, ti = col >> 2;
                const float NINF = -__builtin_inff();
                for (int pq = bid; pq < 512; pq += G)
#pragma unroll 1
                for (int odd = 0; odd < 2; ++odd) {
                    const int bg = pq & 7, xx = pq >> 3, tile = odd ? 127 - xx : xx, b = bg >> 1, g = bg & 1, t0 = tile * 64, cur = tile;
                    const size_t tokw = (size_t)b * SEQ + t0 + 8 * wave;
                    int tq[2]; bf16x8 qf[2][2];
                    auto gatev = [&](int gq, int br) -> float { return sigmoidf_(NG[(tokw + 4 * gq + ti) * 32 + (g * 4 + head) * 3 + br]); };
#pragma unroll
                    for (int gq = 0; gq < 2; ++gq) { tq[gq] = t0 + 8 * wave + 4 * gq + ti; const size_t tok = tokw + 4 * gq + ti;
#pragma unroll
                        for (int s = 0; s < 2; ++s) qf[gq][s] = *(const bf16x8*)(NQ + tok * 512 + (g * 4 + head) * 64 + 32 * s + 8 * q4);
                    }
                    const float bfar = RB[31 * 8 + g * 4 + head] * LOG2E;
                    __syncthreads();
                    for (int d = tid; d < 2048; d += NTHR) { const int bk = rel_bucket(d); *(LAS f32x4*)(lut + d * 4) = *(const f32x4*)(RB + bk * 8 + g * 4) * LOG2E; }
                    for (int i = lane; i < 8 * 128; i += 64) impW[i] = 0.f;
                    f32x4 O[2][4], Ls[2];
                    float m[2], l[2], m1[2] = {0.f, 0.f}, linv[2] = {0.f, 0.f}, carry[2] = {0.f, 0.f};
                    const bf16x8 ones8 = {0x3F80, 0x3F80, 0x3F80, 0x3F80, 0x3F80, 0x3F80, 0x3F80, 0x3F80};
                    auto soft = [&](const int mode, const int gq, f32x4 (&st)[4], bf16x8 (&pb)[2], const int pos0, const bool far, const bool full, const float cbias, const bool colsel, const int sblk0) {
                        float tmax = NINF;
                        if (far) {
#pragma unroll
                            for (int kt = 0; kt < 4; ++kt)
#pragma unroll
                                for (int r = 0; r < 4; ++r) tmax = fmaxf(tmax, st[kt][r]);
                            tmax += cbias;
                        } else if (mode >= 2) {
                            const int dbase = tq[gq] - (pos0 + 4 * q4);
                            const LAS float* lb = lut + (dbase - 51) * 4 + head;
                            const float cadd = (mode == 2 && !colsel) ? NINF : 0.f;
                            float bv[4][4];
#pragma unroll
                            for (int kt = 0; kt < 4; ++kt)
#pragma unroll
                                for (int r = 0; r < 4; ++r) bv[kt][r] = lb[(51 - 16 * kt - r) * 4];
                            asm volatile("" : "+v"(bv[0][0]), "+v"(bv[0][1]), "+v"(bv[0][2]), "+v"(bv[0][3]), "+v"(bv[1][0]), "+v"(bv[1][1]), "+v"(bv[1][2]), "+v"(bv[1][3]));
                            asm volatile("" : "+v"(bv[2][0]), "+v"(bv[2][1]), "+v"(bv[2][2]), "+v"(bv[2][3]), "+v"(bv[3][0]), "+v"(bv[3][1]), "+v"(bv[3][2]), "+v"(bv[3][3]));
#pragma unroll
                            for (int kt = 0; kt < 4; ++kt)
#pragma unroll
                                for (int r = 0; r < 4; ++r) { float sv = st[kt][r] + bv[kt][r];
                                    if (mode == 2) sv += cadd;
                                    if (!full) { const int dist = dbase - (16 * kt + r); const bool valid = (mode == 3) ? ((unsigned)dist < 512u) : (dist >= 0); sv = valid ? sv : NINF; }
                                    st[kt][r] = sv; tmax = fmaxf(tmax, sv); }
                        } else {
                            const int dbase = tq[gq] - 16 * (pos0 + 4 * q4) - 31;
                            float bv[4][4];
#pragma unroll
                            for (int kt = 0; kt < 4; ++kt)
#pragma unroll
                                for (int r = 0; r < 4; ++r) { const int dist = dbase - 16 * (16 * kt + r); const unsigned di = (unsigned)dist < 2047u ? (unsigned)dist : 2047u; bv[kt][r] = lut[di * 4 + head]; }
#pragma unroll
                            for (int kt = 0; kt < 4; ++kt)
#pragma unroll
                                for (int r = 0; r < 4; ++r) { float sv = st[kt][r] + bv[kt][r];
                                    if (!full) { const int dist = dbase - 16 * (16 * kt + r); sv = (dist >= 0) ? sv : NINF; }
                                    st[kt][r] = sv; tmax = fmaxf(tmax, sv); }
                        }
                        float muse;
                        if (mode == 1) muse = m1[gq];
                        else {
                            tmax = max_x16(tmax); tmax = max_x32(tmax);
                            const float mnew = fmaxf(m[gq], tmax);
                            if (__any(mnew != m[gq])) {
                                const float mu = (mnew == NINF) ? 0.f : mnew;
                                const float alpha = __builtin_amdgcn_exp2f(m[gq] - mu);
                                m[gq] = mnew; l[gq] *= alpha;
                                if (mode >= 2) { Ls[gq] = Ls[gq] * alpha;
#pragma unroll
                                    for (int mt = 0; mt < 4; ++mt) O[gq][mt] = O[gq][mt] * alpha; }
                            }
                            muse = (m[gq] == NINF) ? 0.f : m[gq];
                        }
                        const float esub = far ? muse - cbias : muse;
                        float ls = 0.f;
#pragma unroll
                        for (int kt = 0; kt < 4; ++kt)
#pragma unroll
                            for (int r = 0; r < 4; ++r) { float p = __builtin_amdgcn_exp2f(st[kt][r] - esub); if (mode == 1) p *= linv[gq]; st[kt][r] = p; if (mode <= 1) ls += p; }
#if NSA_DUP_B
                        if (mode == 2) { float acc2 = 0.f;
#pragma unroll
                            for (int kt = 0; kt < 4; ++kt)
#pragma unroll
                                for (int r = 0; r < 4; ++r) { float x = st[kt][r]; asm volatile("" : "+v"(x)); const float p2 = __builtin_amdgcn_exp2f(x * 0.5f - esub); acc2 = fmaxf(acc2, p2 + x); }
                            asm volatile("" :: "v"(acc2)); }
#endif
                        if (mode <= 1) l[gq] += ls;
                        if (mode == 1) {
                            float a[4], h3[4];
#pragma unroll
                            for (int kt = 0; kt < 4; ++kt) { a[kt] = st[kt][0] + st[kt][1] + st[kt][2] + 0.5f * st[kt][3]; h3[kt] = 0.5f * st[kt][3];
                                a[kt] += dpp_x1(a[kt]); a[kt] += dpp_x2(a[kt]); h3[kt] += dpp_x1(h3[kt]); h3[kt] += dpp_x2(h3[kt]); }
#pragma unroll
                            for (int kt = 0; kt < 4; ++kt) { const float give = (q4 == 3) ? (kt > 0 ? h3[kt - 1] : carry[gq]) : h3[kt];
                                const float prev = __shfl(give, (lane - 16) & 63);
                                if (head == 0) impW[(4 * gq + ti) * 128 + sblk0 + 4 * kt + q4] = a[kt] + prev; }
                            carry[gq] = h3[3];
                        }
                        if (mode != 0) {
#pragma unroll
                            for (int s = 0; s < 2; ++s) { u32x4 w; w.x = cvt_pk_bf16(st[2 * s][0], st[2 * s][1]); w.y = cvt_pk_bf16(st[2 * s][2], st[2 * s][3]);
                                w.z = cvt_pk_bf16(st[2 * s + 1][0], st[2 * s + 1][1]); w.w = cvt_pk_bf16(st[2 * s + 1][2], st[2 * s + 1][3]); pb[s] = __builtin_bit_cast(bf16x8, w); } }
                    };
                    auto tile2 = [&](const int mode, const LAS unsigned char* kbuf, const LAS unsigned char* vbuf, const int pos0, const bool far, const bool full, const bool a0, const bool a1,
                                     const float cb0, const float cb1, const bool cs0, const bool cs1, const int sblk0) {
                        f32x4 st0[4], st1[4]; bf16x8 pb0[2], pb1[2];
#pragma unroll
                        for (int kt = 0; kt < 4; ++kt) {
                            const bf16x8 kf0 = *(const LAS bf16x8*)(kbuf + (16 * kt + col) * KST + 16 * q4), kf1 = *(const LAS bf16x8*)(kbuf + (16 * kt + col) * KST + 64 + 16 * q4);
                            if (a0) { st0[kt] = __builtin_amdgcn_mfma_f32_16x16x32_bf16(kf0, qf[0][0], (f32x4){0.f, 0.f, 0.f, 0.f}, 0, 0, 0); st0[kt] = __builtin_amdgcn_mfma_f32_16x16x32_bf16(kf1, qf[0][1], st0[kt], 0, 0, 0); }
                            if (a1) { st1[kt] = __builtin_amdgcn_mfma_f32_16x16x32_bf16(kf0, qf[1][0], (f32x4){0.f, 0.f, 0.f, 0.f}, 0, 0, 0); st1[kt] = __builtin_amdgcn_mfma_f32_16x16x32_bf16(kf1, qf[1][1], st1[kt], 0, 0, 0); } }
#if NSA_DUP_A
                        if (mode == 2) {
#pragma unroll
                            for (int kt = 0; kt < 4; ++kt) {
                                const bf16x8 kf0 = *(const LAS bf16x8*)(kbuf + (16 * kt + col) * KST + 16 * q4 + 32), kf1 = *(const LAS bf16x8*)(kbuf + (16 * kt + col) * KST + 64 + 16 * q4 - 32);
                                f32x4 d0 = __builtin_amdgcn_mfma_f32_16x16x32_bf16(kf0, qf[0][0], (f32x4){0.f, 0.f, 0.f, 0.f}, 0, 0, 0); d0 = __builtin_amdgcn_mfma_f32_16x16x32_bf16(kf1, qf[0][1], d0, 0, 0, 0);
                                f32x4 d1 = __builtin_amdgcn_mfma_f32_16x16x32_bf16(kf0, qf[1][0], (f32x4){0.f, 0.f, 0.f, 0.f}, 0, 0, 0); d1 = __builtin_amdgcn_mfma_f32_16x16x32_bf16(kf1, qf[1][1], d1, 0, 0, 0);
                                asm volatile("" :: "v"(d0), "v"(d1)); } }
#endif
                        if (a0) soft(mode, 0, st0, pb0, pos0, far, full, cb0, cs0, sblk0);
                        if (a1) soft(mode, 1, st1, pb1, pos0, far, full, cb1, cs1, sblk0);
                        if (mode == 0) return;
#pragma unroll
                        for (int mt = 0; mt < 4; ++mt)
#pragma unroll
                            for (int s = 0; s < 2; ++s) { const LAS unsigned char* a = vbuf + (32 * s + 4 * q4 + (col >> 2)) * KST + (16 * mt + 4 * (col & 3)) * 2;
                                const s16x4 lo = __builtin_amdgcn_ds_read_tr16_b64_v4i16((LAS s16x4*)a), hi = __builtin_amdgcn_ds_read_tr16_b64_v4i16((LAS s16x4*)(a + 16 * KST));
                                const bf16x8 vfs = __builtin_shufflevector(lo, hi, 0, 1, 2, 3, 4, 5, 6, 7);
                                if (a0) O[0][mt] = __builtin_amdgcn_mfma_f32_16x16x32_bf16(vfs, pb0[s], O[0][mt], 0, 0, 0);
                                if (a1) O[1][mt] = __builtin_amdgcn_mfma_f32_16x16x32_bf16(vfs, pb1[s], O[1][mt], 0, 0, 0); }
                        if (mode >= 2) {
#pragma unroll
                            for (int s = 0; s < 2; ++s) { if (a0) Ls[0] = __builtin_amdgcn_mfma_f32_16x16x32_bf16(ones8, pb0[s], Ls[0], 0, 0, 0); if (a1) Ls[1] = __builtin_amdgcn_mfma_f32_16x16x32_bf16(ones8, pb1[s], Ls[1], 0, 0, 0); } }
                    };
                    auto soft_far = [&](const int gq, f32x4 (&st)[4], bf16x8 (&pb)[2], const float cbias) {
                        float tmax = fmaxf(fmaxf(fmaxf(st[0][0], st[0][1]), fmaxf(st[0][2], st[0][3])), fmaxf(fmaxf(st[1][0], st[1][1]), fmaxf(st[1][2], st[1][3])));
                        tmax = fmaxf(tmax, fmaxf(fmaxf(fmaxf(st[2][0], st[2][1]), fmaxf(st[2][2], st[2][3])), fmaxf(fmaxf(st[3][0], st[3][1]), fmaxf(st[3][2], st[3][3]))));
                        tmax += cbias; tmax = max_x16(tmax); tmax = max_x32(tmax);
                        const float mnew = fmaxf(m[gq], tmax), mu = (mnew == NINF) ? 0.f : mnew, alpha = __builtin_amdgcn_exp2f(m[gq] - mu);
                        m[gq] = mnew; Ls[gq] = Ls[gq] * alpha;
#pragma unroll
                        for (int mt = 0; mt < 4; ++mt) O[gq][mt] = O[gq][mt] * alpha;
                        const float esub = mu - cbias;
#pragma unroll
                        for (int kt = 0; kt < 4; ++kt)
#pragma unroll
                            for (int r = 0; r < 4; ++r) st[kt][r] = __builtin_amdgcn_exp2f(st[kt][r] - esub);
#pragma unroll
                        for (int s = 0; s < 2; ++s) { u32x4 w; w.x = cvt_pk_bf16(st[2 * s][0], st[2 * s][1]); w.y = cvt_pk_bf16(st[2 * s][2], st[2 * s][3]);
                            w.z = cvt_pk_bf16(st[2 * s + 1][0], st[2 * s + 1][1]); w.w = cvt_pk_bf16(st[2 * s + 1][2], st[2 * s + 1][3]); pb[s] = __builtin_bit_cast(bf16x8, w); }
                    };
                    auto tile_far2 = [&](const LAS unsigned char* kbuf, const LAS unsigned char* vbuf, const float cb0, const float cb1) {
                        f32x4 st0[4], st1[4]; bf16x8 pb0[2], pb1[2];
#pragma unroll
                        for (int kt = 0; kt < 4; ++kt) { const bf16x8 kf0 = *(const LAS bf16x8*)(kbuf + (16 * kt + col) * KST + 16 * q4), kf1 = *(const LAS bf16x8*)(kbuf + (16 * kt + col) * KST + 64 + 16 * q4);
                            st0[kt] = __builtin_amdgcn_mfma_f32_16x16x32_bf16(kf0, qf[0][0], (f32x4){0.f, 0.f, 0.f, 0.f}, 0, 0, 0); st0[kt] = __builtin_amdgcn_mfma_f32_16x16x32_bf16(kf1, qf[0][1], st0[kt], 0, 0, 0);
                            st1[kt] = __builtin_amdgcn_mfma_f32_16x16x32_bf16(kf0, qf[1][0], (f32x4){0.f, 0.f, 0.f, 0.f}, 0, 0, 0); st1[kt] = __builtin_amdgcn_mfma_f32_16x16x32_bf16(kf1, qf[1][1], st1[kt], 0, 0, 0); }
                        soft_far(0, st0, pb0, cb0);
                        soft_far(1, st1, pb1, cb1);
#pragma unroll
                        for (int mt = 0; mt < 4; ++mt)
#pragma unroll
                            for (int s = 0; s < 2; ++s) { const LAS unsigned char* a = vbuf + (32 * s + 4 * q4 + (col >> 2)) * KST + (16 * mt + 4 * (col & 3)) * 2;
                                const s16x4 lo = __builtin_amdgcn_ds_read_tr16_b64_v4i16((LAS s16x4*)a), hi = __builtin_amdgcn_ds_read_tr16_b64_v4i16((LAS s16x4*)(a + 16 * KST));
                                const bf16x8 vfs = __builtin_shufflevector(lo, hi, 0, 1, 2, 3, 4, 5, 6, 7);
                                O[0][mt] = __builtin_amdgcn_mfma_f32_16x16x32_bf16(vfs, pb0[s], O[0][mt], 0, 0, 0);
                                O[1][mt] = __builtin_amdgcn_mfma_f32_16x16x32_bf16(vfs, pb1[s], O[1][mt], 0, 0, 0); }
#pragma unroll
                        for (int s = 0; s < 2; ++s) { Ls[0] = __builtin_amdgcn_mfma_f32_16x16x32_bf16(ones8, pb0[s], Ls[0], 0, 0, 0); Ls[1] = __builtin_amdgcn_mfma_f32_16x16x32_bf16(ones8, pb1[s], Ls[1], 0, 0, 0); }
#if NSA_SGB
                        __builtin_amdgcn_sched_group_barrier(0x100, 8, 0); __builtin_amdgcn_sched_group_barrier(0x008, 16, 0);
                        __builtin_amdgcn_sched_group_barrier(0x002, 64, 0); __builtin_amdgcn_sched_group_barrier(0x400, 17, 0); __builtin_amdgcn_sched_group_barrier(0x002, 40, 0);
                        __builtin_amdgcn_sched_group_barrier(0x100, 16, 0);
#pragma unroll
                        for (int i = 0; i < 10; ++i) { __builtin_amdgcn_sched_group_barrier(0x008, 1, 0); __builtin_amdgcn_sched_group_barrier(0x002, 7, 0); __builtin_amdgcn_sched_group_barrier(0x400, 2, 0); }
                        __builtin_amdgcn_sched_group_barrier(0x002, 40, 0);
                        __builtin_amdgcn_sched_group_barrier(0x008, 10, 0);
#endif
                    };
                    auto ld_tile = [&](const bf16* src) -> u32x4 { return *(const u32x4*)(src + tid * 8); };
                    auto st_tile = [&](LAS unsigned char* buf, const u32x4 v) { *(LAS u32x4*)(buf + (tid >> 3) * KST + (tid & 7) * 16) = v; };
                    auto zeroO = [&]() {
#pragma unroll
                        for (int gq = 0; gq < 2; ++gq) { m[gq] = NINF; l[gq] = 0.f; Ls[gq] = (f32x4){0.f, 0.f, 0.f, 0.f};
#pragma unroll
                            for (int mt = 0; mt < 4; ++mt) O[gq][mt] = (f32x4){0.f, 0.f, 0.f, 0.f}; } };
                    const int ntc = (4 * tile + 3 + 63) >> 6;
                    const bf16* kcb = KCb + (size_t)bg * 512 * 64; const bf16* vcb = KCb + (size_t)(8 + bg) * 512 * 64;
                    {
                        zeroO();
                        u32x4 rk = ld_tile(kcb);
                        st_tile(kvb, rk); if (ntc > 1) rk = ld_tile(kcb + 4096);
                        __syncthreads();
#pragma unroll 1
                        for (int i = 0; i < ntc; ++i) { LAS unsigned char* cb = kvb + (i & 1) * 2 * TB;
                            if (i + 1 < ntc) st_tile(kvb + ((i + 1) & 1) * 2 * TB, rk);
                            if (i + 2 < ntc) rk = ld_tile(kcb + (size_t)(i + 2) * 4096);
                            const bool far = (t0 - (16 * (64 * i + 63) + 31)) >= 1513;
                            tile2(0, cb, cb + TB, 64 * i, far, (16 * (64 * i + 63) + 31) <= t0, true, true, bfar, bfar, true, true, 0);
                            __syncthreads(); }
                    }
#pragma unroll
                    for (int gq = 0; gq < 2; ++gq) { float lt = sum_x32(sum_x16(l[gq])); linv[gq] = 1.f / fmaxf(lt, 1e-30f); m1[gq] = (m[gq] == NINF) ? 0.f : m[gq]; }
                    {
                        zeroO();
                        u32x4 rk = ld_tile(kcb), rv = ld_tile(vcb);
                        st_tile(kvb, rk); st_tile(kvb + TB, rv); if (ntc > 1) { rk = ld_tile(kcb + 4096); rv = ld_tile(vcb + 4096); }
                        __syncthreads();
#pragma unroll 1
                        for (int i = 0; i < ntc; ++i) { LAS unsigned char* cb = kvb + (i & 1) * 2 * TB;
                            if (i + 1 < ntc) { LAS unsigned char* nb = kvb + ((i + 1) & 1) * 2 * TB; st_tile(nb, rk); st_tile(nb + TB, rv); }
                            if (i + 2 < ntc) { rk = ld_tile(kcb + (size_t)(i + 2) * 4096); rv = ld_tile(vcb + (size_t)(i + 2) * 4096); }
                            const bool far = (t0 - (16 * (64 * i + 63) + 31)) >= 1513;
                            tile2(1, cb, cb + TB, 64 * i, far, (16 * (64 * i + 63) + 31) <= t0, true, true, bfar, bfar, true, true, 16 * i);
                            __syncthreads(); }
                    }
                    WAVE_SYNC();
                    {
                        const int tt = lane >> 3, sub = lane & 7;
                        unsigned key[16];
                        const LAS f32x4* ip = (const LAS f32x4*)(impW + tt * 128 + sub * 16);
#pragma unroll
                        for (int q = 0; q < 4; ++q) { const f32x4 v = ip[q];
#pragma unroll
                            for (int e2 = 0; e2 < 4; ++e2) { const int i = 4 * q + e2, s = sub * 16 + i;
                                const bool forced = (s == 0) || (s == cur) || (s == cur - 1);
                                const unsigned k = forced ? 0x7FFFFF80u : ((__float_as_uint(v[e2]) & 0xFFFFFF80u) + 128u);
                                key[i] = (s <= cur) ? (k | (unsigned)(127 - s)) : 0u; } }
                        unsigned w0 = 0u, w1 = 0u, w2 = 0u, w3 = 0u;
#pragma unroll 1
                        for (int k = 0; k < 16; ++k) {
                            unsigned best = key[0];
#pragma unroll
                            for (int i = 1; i < 16; ++i) best = best > key[i] ? best : key[i];
                            { const unsigned o1 = (unsigned)__builtin_amdgcn_mov_dpp((int)best, 0xB1, 0xF, 0xF, true); best = best > o1 ? best : o1;
                              const unsigned o2 = (unsigned)__builtin_amdgcn_mov_dpp((int)best, 0x4E, 0xF, 0xF, true); best = best > o2 ? best : o2;
                              const unsigned o3 = (unsigned)__builtin_amdgcn_mov_dpp((int)best, 0x141, 0xF, 0xF, true); best = best > o3 ? best : o3; }
#pragma unroll
                            for (int i = 0; i < 16; ++i) key[i] = (key[i] == best) ? 0u : key[i];
                            if (best != 0u) { const int idx = 127 - (int)(best & 127u); const unsigned bit = 1u << (idx & 31); const int wd = idx >> 5;
                                w0 |= wd == 0 ? bit : 0u; w1 |= wd == 1 ? bit : 0u; w2 |= wd == 2 ? bit : 0u; w3 |= wd == 3 ? bit : 0u; }
                        }
                        if (sub == 0) { LAS unsigned* sp = selm + (8 * wave + tt) * 4; sp[0] = w0; sp[1] = w1; sp[2] = w2; sp[3] = w3; }
                    }
                    WAVE_SYNC();
#pragma unroll
                    for (int gq = 0; gq < 2; ++gq) { const float g0 = gatev(gq, 0);
#pragma unroll
                        for (int mt = 0; mt < 4; ++mt)
#pragma unroll
                            for (int r = 0; r < 4; ++r) ocl[((gq * 4 + mt) * 4 + r) * 64] = O[gq][mt][r] * g0; }
                    __syncthreads();
                    unsigned long long Ulo, Uhi;
                    { unsigned u[4];
#pragma unroll
                      for (int k = 0; k < 4; ++k) { unsigned x = selm[lane * 4 + k];
#pragma unroll
                        for (int o = 1; o < 64; o <<= 1) x |= __shfl_xor(x, o);
                        u[k] = __builtin_amdgcn_readfirstlane(x); }
                      Ulo = ((unsigned long long)u[1] << 32) | u[0]; Uhi = ((unsigned long long)u[3] << 32) | u[2]; }
                    auto nextj = [&](int j) -> int {
                        if (j < 64) { const unsigned long long x = Ulo >> j; if (x) return j + __builtin_ctzll(x); j = 64; }
                        if (j < 128) { const unsigned long long x = Uhi >> (j - 64); if (x) return j + __builtin_ctzll(x); }
                        return 128; };
                    {
                        const bf16* ksb = KVT + (size_t)(2 * 8 + bg) * SEQ * 64; const bf16* vsb = KVT + (size_t)(3 * 8 + bg) * SEQ * 64;
#pragma unroll 1
                        for (int rep = 0; rep < SELREP; ++rep) {
                        zeroO();
                        int j = nextj(0), jn = nextj(j + 1), it = 0;
                        u32x4 rk = ld_tile(ksb + (size_t)j * 4096), rv = ld_tile(vsb + (size_t)j * 4096);
                        st_tile(kvb, rk); st_tile(kvb + TB, rv);
                        if (jn <= cur) { rk = ld_tile(ksb + (size_t)jn * 4096); rv = ld_tile(vsb + (size_t)jn * 4096); }
                        __syncthreads();
#pragma unroll 1
                        while (j <= cur) { LAS unsigned char* cb = kvb + (it & 1) * 2 * TB;
                            const int jnn = jn <= cur ? nextj(jn + 1) : 128;
                            if (jn <= cur) { LAS unsigned char* nb = kvb + ((it + 1) & 1) * 2 * TB; st_tile(nb, rk); st_tile(nb + TB, rv); }
                            if (jnn <= cur) { rk = ld_tile(ksb + (size_t)jnn * 4096); rv = ld_tile(vsb + (size_t)jnn * 4096); }
                            const bool cs0 = (selm[(8 * wave + ti) * 4 + (j >> 5)] >> (j & 31)) & 1u, cs1 = (selm[(8 * wave + 4 + ti) * 4 + (j >> 5)] >> (j & 31)) & 1u;
                            const bool act0 = __ballot(cs0) != 0ull, act1 = __ballot(cs1) != 0ull;
                            const bool far = (t0 - (64 * j + 63)) >= 1513;
                            const float cb0 = cs0 ? bfar : NINF, cb1 = cs1 ? bfar : NINF;
                            const bool full = j < cur;
                            if (act0 && act1 && far) tile_far2(cb, cb + TB, cb0, cb1);
                            else if (act0 && act1) tile2(2, cb, cb + TB, 64 * j, far, full, true, true, cb0, cb1, cs0, cs1, 0);
                            else if (act0) tile2(2, cb, cb + TB, 64 * j, far, full, true, false, cb0, cb1, cs0, cs1, 0);
                            else if (act1) tile2(2, cb, cb + TB, 64 * j, far, full, false, true, cb0, cb1, cs0, cs1, 0);
#if NSA_DUP_C
                            __syncthreads();
#endif
                            __syncthreads();
                            j = jn; jn = jnn; ++it;
                        }
                        }
#pragma unroll
                        for (int gq = 0; gq < 2; ++gq) { const float lt = Ls[gq][0]; const float sc = gatev(gq, 1) / fmaxf(lt, 1e-30f);
#pragma unroll
                            for (int mt = 0; mt < 4; ++mt)
#pragma unroll
                                for (int r = 0; r < 4; ++r) ocl[((gq * 4 + mt) * 4 + r) * 64] += O[gq][mt][r] * sc; }
                    }
                    {
                        const bf16* kwb = KVT + (size_t)(4 * 8 + bg) * SEQ * 64; const bf16* vwb = KVT + (size_t)(5 * 8 + bg) * SEQ * 64;
                        const int j0 = cur - 8 < 0 ? 0 : cur - 8, nw = cur - j0 + 1;
#pragma unroll 1
                        for (int wrep = 0; wrep < WINREP; ++wrep) {
                        zeroO();
                        u32x4 rk = ld_tile(kwb + (size_t)j0 * 4096), rv = ld_tile(vwb + (size_t)j0 * 4096);
                        st_tile(kvb, rk); st_tile(kvb + TB, rv);
                        if (nw > 1) { rk = ld_tile(kwb + (size_t)(j0 + 1) * 4096); rv = ld_tile(vwb + (size_t)(j0 + 1) * 4096); }
                        __syncthreads();
#pragma unroll 1
                        for (int i = 0; i < nw; ++i) { LAS unsigned char* cb = kvb + (i & 1) * 2 * TB;
                            if (i + 1 < nw) { LAS unsigned char* nb = kvb + ((i + 1) & 1) * 2 * TB; st_tile(nb, rk); st_tile(nb + TB, rv); }
                            if (i + 2 < nw) { rk = ld_tile(kwb + (size_t)(j0 + i + 2) * 4096); rv = ld_tile(vwb + (size_t)(j0 + i + 2) * 4096); }
                            tile2(3, cb, cb + TB, 64 * (j0 + i), false, (j0 + i > cur - 8) && (j0 + i < cur), true, true, 0.f, 0.f, true, true, 0);
                            __syncthreads(); }
                        }
#pragma unroll
                        for (int gq = 0; gq < 2; ++gq) { const float lt = Ls[gq][0]; const float sc = gatev(gq, 2) / fmaxf(lt, 1e-30f);
#pragma unroll
                            for (int mt = 0; mt < 4; ++mt)
#pragma unroll
                                for (int r = 0; r < 4; ++r) O[gq][mt][r] = ocl[((gq * 4 + mt) * 4 + r) * 64] + O[gq][mt][r] * sc; }
                    }
#pragma unroll
                    for (int gq = 0; gq < 2; ++gq)
#pragma unroll
                        for (int mt = 0; mt < 4; ++mt) { u32x2 w; w.x = cvt_pk_bf16(O[gq][mt][0], O[gq][mt][1]); w.y = cvt_pk_bf16(O[gq][mt][2], O[gq][mt][3]);
                            *(u32x2*)(OB + (tokw + 4 * gq + ti) * 512 + (g * 4 + head) * 64 + 16 * mt + 4 * q4) = w; }
                }
            }
          }
        }
        SEAM(pb + 3, 4);

        if (EN(5) && IN(pb + 4)) { PHASE_IDS();
            pg8::Gemm g{(const bf16*)(ws + WS_QHG), (const bf16*)(ws + WS_WBA0 + (size_t)l * 2 * SZ_WBR), NT, DM, DM, 0, 512, (const bf16*)(ws + WS_NQ), 8};
            pg8::StaticOrder S; S.init(NT, DM, G, bid); EpiGate2 E{(bf16*)(ws + WS_GA), (const bf16*)(ws + WS_GA), (const bf16*)(ws + WS_GB)};
            pg8::gemm_phase<EpiGate2, pg8::StaticOrder>(lds, g, S, E, wave_s);
        }
        SEAM(pb + 4, 5);

        if (EN(6) && IN(pb + 5)) { PHASE_IDS();
            pg8::Gemm g{(const bf16*)(ws + WS_GA), (const bf16*)(ws + (l ? WS_WOUT1 : WS_WOUT0)), NT, DM, DM, 0, 0, nullptr, 0};
            const float* XI = l ? (const float*)X : x_in;
            pg8::StaticOrder S; S.init(NT, DM, G, bid); EpiResid E{XI, X};
            pg8::gemm_phase<EpiResid, pg8::StaticOrder>(lds, g, S, E, wave_s);
        }
        SEAM(pb + 5, 6);

        if (EN(7) && IN(pb + 6)) { PHASE_IDS();
            const float* gam = ap->in[11] + l * DM; const float* bet = ap->in[12] + l * DM;
            LAS int* hist = (LAS int*)(lds + 8 * 16384);
            if (l == 1) { if (tid < 8) hist[tid] = 0; __syncthreads(); }
            const int rpb = (NT + G - 1) / G;
            for (int i = wave; i < rpb; i += NWAVES) {
                const int row = bid * rpb + i; if (row >= NT) break;
                f32x4* xr = (f32x4*)(X + (size_t)row * DM);
                f32x4 v[4]; float s = 0.f;
#pragma unroll
                for (int j = 0; j < 4; ++j) { v[j] = xr[64 * j + lane]; s += (v[j][0] + v[j][1]) + (v[j][2] + v[j][3]); }
                const float mean = wave_sum(s) * (1.f / DM); float s2 = 0.f;
#pragma unroll
                for (int j = 0; j < 4; ++j) { v[j] = v[j] - mean; s2 += (v[j][0] * v[j][0] + v[j][1] * v[j][1]) + (v[j][2] * v[j][2] + v[j][3] * v[j][3]); }
                const float rstd = rsqrtf(wave_sum(s2) * (1.f / DM) + 1e-5f);
#pragma unroll
                for (int j = 0; j < 4; ++j) { const f32x4 gq = ((const f32x4*)gam)[64 * j + lane], bq = ((const f32x4*)bet)[64 * j + lane]; v[j] = v[j] * rstd * gq + bq; xr[64 * j + lane] = v[j]; }
                if (l == 0) { u32x2* o = (u32x2*)(XB + (size_t)row * DM);
#pragma unroll
                    for (int j = 0; j < 4; ++j) { u32x2 w; w.x = cvt_pk_bf16(v[j][0], v[j][1]); w.y = cvt_pk_bf16(v[j][2], v[j][3]); o[64 * j + lane] = w; }
                } else {
                    const float* WR = ap->in[18];
                    float lg[8];
#pragma unroll
                    for (int e = 0; e < 8; ++e) lg[e] = 0.f;
#pragma unroll
                    for (int j = 0; j < 4; ++j)
#pragma unroll
                        for (int q = 0; q < 4; ++q) { const int c = 4 * (64 * j + lane) + q; const f32x4 w0 = *(const f32x4*)(WR + c * 8), w1 = *(const f32x4*)(WR + c * 8 + 4); const float xv = v[j][q];
                            lg[0] += xv * w0[0]; lg[1] += xv * w0[1]; lg[2] += xv * w0[2]; lg[3] += xv * w0[3]; lg[4] += xv * w1[0]; lg[5] += xv * w1[1]; lg[6] += xv * w1[2]; lg[7] += xv * w1[3]; }
#pragma unroll
                    for (int e = 0; e < 8; ++e) lg[e] = wave_sum(lg[e]);
                    int e1 = 0; float v1 = lg[0];
#pragma unroll
                    for (int e = 1; e < 8; ++e) if (lg[e] > v1) { v1 = lg[e]; e1 = e; }
                    int e2 = -1; float v2 = -3e38f;
#pragma unroll
                    for (int e = 0; e < 8; ++e) if (e != e1 && lg[e] > v2) { v2 = lg[e]; e2 = e; }
                    if (lane == 0) { const float g2 = 1.f / (1.f + expf(v1 - v2)), g1 = 1.f - g2;
                        ((int*)(ws + WS_TOPI))[row] = e1 | (e2 << 8); ((float*)(ws + WS_TOPG))[row * 2] = g1; ((float*)(ws + WS_TOPG))[row * 2 + 1] = g2;
                        atomicAdd((int*)&hist[e1], 1); atomicAdd((int*)&hist[e2], 1); }
                }
            }
            if (l == 1) {
                __syncthreads();
                if (tid < 8) ((int*)(ws + WS_CTL + CW_BLKCNT))[bid * 8 + tid] = hist[tid];
                LAS float* scr = (LAS float*)(lds + wave * 16384);
                constexpr int I_GU = 16 * (2 * FFE / 32), I_DN = (FFE / 64) * 32;
                for (int it = gwave; it < NEXP * (I_GU + I_DN); it += nwaves) {
                    const int e = it / (I_GU + I_DN); int r = it % (I_GU + I_DN);
                    if (r < I_GU) { const int nb = r % (2 * FFE / 32), kb = r / (2 * FFE / 32);
                        const float* Wg = ap->in[19] + (size_t)e * DM * FFE; const float* Wu = ap->in[20] + (size_t)e * DM * FFE;
                        auto cp = [=](int n) -> const float* { const int pn = n >> 8, hf = (n >> 7) & 1, c = pn * 128 + (n & 127); return (hf ? Wu : Wg) + c; };
                        tr_item(cp, FFE, DM, (bf16*)(ws + WS_MGU) + (size_t)e * 2 * FFE * DM, DM, nb * 32, kb * 64, scr, lane); }
                    else { r -= I_GU; const int nb = r % 32, kb = r / 32;
                        const float* W = ap->in[21] + (size_t)e * FFE * DM;
                        auto cp = [=](int n) -> const float* { return W + n; };
                        tr_item(cp, DM, FFE, (bf16*)(ws + WS_MDN) + (size_t)e * DM * FFE, FFE, nb * 32, kb * 64, scr, lane); }
                }
            }
        }
        SEAM(pb + 6, 7);

        if (l == 0) {
            if (EN(8) && IN(pb + 7)) { PHASE_IDS();
                pg8::Gemm g{XB, (const bf16*)(ws + WS_WGU0), NT, NINP, DM, 0, 0, nullptr, 0};
                pg8::StaticOrder S; S.init(NT, NINP, G, bid); EpiSwiglu E{(bf16*)(ws + WS_H0), FF0P};
                pg8::gemm_phase<EpiSwiglu, pg8::StaticOrder>(lds, g, S, E, wave_s);
            }
            SEAM(pb + 7, 8);
            if (EN(9) && IN(pb + 8)) { PHASE_IDS();
                pg8::Gemm g{(const bf16*)(ws + WS_H0), (const bf16*)(ws + WS_WDN0), NT, DM, FF0P, 0, 0, nullptr, 0};
                pg8::StaticOrder S; S.init(NT, DM, G, bid); EpiResid E{X, X};
                pg8::gemm_phase<EpiResid, pg8::StaticOrder>(lds, g, S, E, wave_s);
            }
            SEAM(pb + 8, 9);
            if (EN(10) && IN(pb + 9)) { PHASE_IDS();
                const float* gam = ap->in[13]; const float* bet = ap->in[14];
                for (int row = gwave; row < NT; row += nwaves) {
                    f32x4* xr = (f32x4*)(X + (size_t)row * DM);
                    f32x4 v[4]; float s = 0.f;
#pragma unroll
                    for (int j = 0; j < 4; ++j) { v[j] = xr[64 * j + lane]; s += (v[j][0] + v[j][1]) + (v[j][2] + v[j][3]); }
                    const float mean = wave_sum(s) * (1.f / DM); float s2 = 0.f;
#pragma unroll
                    for (int j = 0; j < 4; ++j) { v[j] = v[j] - mean; s2 += (v[j][0] * v[j][0] + v[j][1] * v[j][1]) + (v[j][2] * v[j][2] + v[j][3] * v[j][3]); }
                    const float rstd = rsqrtf(wave_sum(s2) * (1.f / DM) + 1e-5f);
                    u32x2* o = (u32x2*)(XB + (size_t)row * DM);
#pragma unroll
                    for (int j = 0; j < 4; ++j) { const f32x4 gq = ((const f32x4*)gam)[64 * j + lane], bq = ((const f32x4*)bet)[64 * j + lane]; v[j] = v[j] * rstd * gq + bq; xr[64 * j + lane] = v[j];
                        u32x2 w; w.x = cvt_pk_bf16(v[j][0], v[j][1]); w.y = cvt_pk_bf16(v[j][2], v[j][3]); o[64 * j + lane] = w; }
                }
            }
            SEAM(pb + 9, 10);
        } else {
            if (EN(11) && IN(pb + 7)) { PHASE_IDS(); int* META = (int*)(ws + WS_CTL + CW_META); int* PANELE = (int*)(ws + WS_CTL + CW_PANELE); int* ROWINFO = (int*)(ws + WS_ROWINFO); bf16* XS = (bf16*)(ws + WS_XS); (void)META; (void)PANELE; (void)ROWINFO; (void)XS;
                LAS int* sh = (LAS int*)lds;
                const int* BC = (const int*)(ws + WS_CTL + CW_BLKCNT);
                if (tid < 8) { int tot = 0, pre = 0; for (int bb = 0; bb < G; ++bb) { const int c = BC[bb * 8 + tid]; if (bb < bid) pre += c; tot += c; } sh[tid] = tot; sh[8 + tid] = pre; sh[24 + tid] = 0; }
                __syncthreads();
                if (tid == 0) { int base = 0;
#pragma unroll 1
                    for (int e = 0; e < 8; ++e) { sh[16 + e] = base; base += (sh[e] + 255) & ~255; }
                    sh[32] = base; }
                __syncthreads();
                if (bid == 0) { const int base = sh[32]; if (tid == 0) { META[0] = base / 256; META[1] = (base / 256 + 63) / 64; }
                    if (tid < 8) { META[8 + tid] = sh[16 + tid]; META[16 + tid] = sh[tid]; }
                    for (int p = tid; p < base / 256; p += NTHR) { int e = 0;
#pragma unroll 1
                        for (int q = 1; q < 8; ++q) if (p * 256 >= sh[16 + q]) e = q;
                        PANELE[p] = e; } }
                __syncthreads();
                if (bid < 8) { const int e = bid, r0 = sh[16 + e] + sh[e], r1 = sh[16 + e] + ((sh[e] + 255) & ~255);
                    for (int r = r0 + wave; r < r1; r += NWAVES) { if (lane == 0) ROWINFO[r] = -1;
#pragma unroll
                        for (int j = 0; j < 4; ++j) ((u32x2*)(XS + (size_t)r * DM))[64 * j + lane] = (u32x2){0u, 0u}; } }
                const int rpb = (NT + G - 1) / G;
                for (int i = wave; i < rpb; i += NWAVES) {
                    const int row = bid * rpb + i; if (row >= NT) break;
                    const int ti = ((const int*)(ws + WS_TOPI))[row]; const int e1 = ti & 255, e2 = ti >> 8;
                    int s1 = 0, s2 = 0;
                    if (lane == 0) { s1 = sh[16 + e1] + sh[8 + e1] + atomicAdd((int*)&sh[24 + e1], 1); s2 = sh[16 + e2] + sh[8 + e2] + atomicAdd((int*)&sh[24 + e2], 1); ROWINFO[s1] = row * 2; ROWINFO[s2] = row * 2 + 1; }
                    s1 = __builtin_amdgcn_readfirstlane(s1); s2 = __builtin_amdgcn_readfirstlane(s2);
                    const f32x4* xr = (const f32x4*)(X + (size_t)row * DM);
#pragma unroll
                    for (int j = 0; j < 4; ++j) { const f32x4 v = xr[64 * j + lane]; u32x2 w; w.x = cvt_pk_bf16(v[0], v[1]); w.y = cvt_pk_bf16(v[2], v[3]);
                        ((u32x2*)(XS + (size_t)s1 * DM))[64 * j + lane] = w; ((u32x2*)(XS + (size_t)s2 * DM))[64 * j + lane] = w; }
                }
            }
            SEAM(pb + 7, 11);
            for (int c = 0; c < MAXCHUNK; ++c) {
                if (EN(12) && IN(pb + 8 + 2 * c)) { PHASE_IDS(); int* META = (int*)(ws + WS_CTL + CW_META); int* PANELE = (int*)(ws + WS_CTL + CW_PANELE); int* ROWINFO = (int*)(ws + WS_ROWINFO); bf16* XS = (bf16*)(ws + WS_XS); (void)META; (void)PANELE; (void)ROWINFO; (void)XS;
                    const int P = META[0], nch = META[1];
                    if (c < nch) { const int p0 = (int)((long)c * P / nch), p1 = (int)((long)(c + 1) * P / nch);
                        pg8::Gemm g{XS + (size_t)p0 * 256 * DM, (const bf16*)(ws + WS_MGU), (p1 - p0) * 256, 2 * FFE, DM, (size_t)2 * FFE * DM, 0, nullptr, 0};
                        pg8::StaticOrder S; S.init((p1 - p0) * 256, 2 * FFE, G, bid, PANELE + p0); EpiSwiglu E{(bf16*)(ws + WS_HM), FFE};
                        pg8::gemm_phase<EpiSwiglu, pg8::StaticOrder>(lds, g, S, E, wave_s); }
                }
                SEAM(pb + 8 + 2 * c, 12);
                if (EN(13) && IN(pb + 9 + 2 * c)) { PHASE_IDS(); int* META = (int*)(ws + WS_CTL + CW_META); int* PANELE = (int*)(ws + WS_CTL + CW_PANELE); int* ROWINFO = (int*)(ws + WS_ROWINFO); bf16* XS = (bf16*)(ws + WS_XS); (void)META; (void)PANELE; (void)ROWINFO; (void)XS;
                    const int P = META[0], nch = META[1];
                    if (c < nch) { const int p0 = (int)((long)c * P / nch), p1 = (int)((long)(c + 1) * P / nch);
                        pg8::Gemm g{(const bf16*)(ws + WS_HM), (const bf16*)(ws + WS_MDN), (p1 - p0) * 256, DM, FFE, (size_t)DM * FFE, 0, nullptr, 0};
                        pg8::StaticOrder S; S.init((p1 - p0) * 256, DM, G, bid, PANELE + p0); EpiScatter E{(bf16*)(ws + WS_YM), ROWINFO + p0 * 256};
                        pg8::gemm_phase<EpiScatter, pg8::StaticOrder>(lds, g, S, E, wave_s); }
                }
                if (PROBE_GRP >= 0 && c == MAXCHUNK - 1) { PMARK(13); if (bid == 0 && wave_s == 0 && lane_id() == 0) *(unsigned long long*)(ws0 + WS_CTL + CW_PROBE) = pr_acc; }
                SEAM(pb + 9 + 2 * c, 13);
            }
            if (EN(14) && IN(pb + 8 + 2 * MAXCHUNK)) { PHASE_IDS();
                const float* gam = ap->in[13] + DM; const float* bet = ap->in[14] + DM;
                const bf16* YM = (const bf16*)(ws + WS_YM); const float* TG = (const float*)(ws + WS_TOPG);
                const float pscale = 1.f;
                for (int row = gwave; row < NT; row += nwaves) {
                    f32x4* xr = (f32x4*)(X + (size_t)row * DM);
                    const float g1 = TG[row * 2], g2 = TG[row * 2 + 1];
                    const u32x2* y1 = (const u32x2*)(YM + (size_t)(row * 2) * DM); const u32x2* y2 = (const u32x2*)(YM + (size_t)(row * 2 + 1) * DM);
                    f32x4 v[4]; float s = 0.f;
#pragma unroll
                    for (int j = 0; j < 4; ++j) { const f32x4 xv = xr[64 * j + lane]; const u32x2 a = y1[64 * j + lane], bq = y2[64 * j + lane];
                        v[j][0] = xv[0] * DN_ALPHA + g1 * bflo(a.x) + g2 * bflo(bq.x); v[j][1] = xv[1] * DN_ALPHA + g1 * bfhi(a.x) + g2 * bfhi(bq.x);
                        v[j][2] = xv[2] * DN_ALPHA + g1 * bflo(a.y) + g2 * bflo(bq.y); v[j][3] = xv[3] * DN_ALPHA + g1 * bfhi(a.y) + g2 * bfhi(bq.y);
                        s += (v[j][0] + v[j][1]) + (v[j][2] + v[j][3]); }
                    const float mean = wave_sum(s) * (1.f / DM); float s2 = 0.f;
#pragma unroll
                    for (int j = 0; j < 4; ++j) { v[j] = v[j] - mean; s2 += (v[j][0] * v[j][0] + v[j][1] * v[j][1]) + (v[j][2] * v[j][2] + v[j][3] * v[j][3]); }
                    const float rstd = rsqrtf(wave_sum(s2) * (1.f / DM) + 1e-5f);
#pragma unroll
                    for (int j = 0; j < 4; ++j) { const f32x4 gq = ((const f32x4*)gam)[64 * j + lane], bq = ((const f32x4*)bet)[64 * j + lane]; xr[64 * j + lane] = (v[j] * rstd * gq + bq) * pscale; }
                }
#if PROBE_GRP >= 0
                {
                    const unsigned long long dt = *(const unsigned long long*)(ws + WS_CTL + CW_PROBE) * (unsigned long long)PROBE_K;
                    const unsigned long long t0 = __builtin_amdgcn_s_memrealtime();
                    while (__builtin_amdgcn_s_memrealtime() - t0 < dt) __builtin_amdgcn_s_sleep(8);
                }
#endif
            }
        }
    }
#undef IN
#undef SEAM
}

constexpr int NPHASES = 1 + 10 + 8 + 2 * MAXCHUNK + 1;

extern "C" void kernel_launch(void* const* d_in, const int* in_sizes, int n_in, void* d_out, int out_size, void* d_ws, size_t ws_size, hipStream_t stream) {
    static int grid = 0;
    if (grid == 0) {
        if (n_in != 22 || out_size != NT * DM || ws_size < WS_END) { fprintf(stderr, "kernel_launch: need 22 inputs, %d outputs, >= %zu bytes of workspace; got %d, %d, %zu\n", NT * DM, (size_t)WS_END, n_in, out_size, ws_size); grid = -1; return; }
        int dev = 0, cus = 0, per_cu = 0;
        if (hipGetDevice(&dev) != hipSuccess || hipDeviceGetAttribute(&cus, hipDeviceAttributeMultiprocessorCount, dev) != hipSuccess) { grid = -1; return; }
        if (hipFuncSetAttribute((const void*)mega_fwd, hipFuncAttributeMaxDynamicSharedMemorySize, LDS_BYTES) != hipSuccess) { fprintf(stderr, "kernel_launch: hipFuncSetAttribute failed\n"); grid = -1; return; }
        if (hipOccupancyMaxActiveBlocksPerMultiprocessor(&per_cu, (const void*)mega_fwd, NTHR, LDS_BYTES) != hipSuccess || per_cu < 1) fprintf(stderr, "kernel_launch: occupancy query reports %d\n", per_cu);
        (void)hipGetLastError();
        grid = cus > 256 ? 256 : cus;
    }
    if (grid < 0) return;
    (void)hipMemsetAsync((char*)d_ws + WS_CTL, 0, CTL_BYTES, stream);
    Args a{};
    for (int i = 0; i < 22; ++i) a.in[i] = (const float*)d_in[i];
    a.out = (float*)d_out; a.ws = (unsigned char*)d_ws;
#if ONE_LAUNCH
    a.ph_lo = 0; a.ph_hi = NPHASES;
    hipLaunchKernelGGL(mega_fwd, dim3(grid), dim3(NTHR), LDS_BYTES, stream, a);
#else
    for (int p = 0; p < NPHASES; ++p) { a.ph_lo = p; a.ph_hi = p + 1; hipLaunchKernelGGL(mega_fwd, dim3(grid), dim3(NTHR), LDS_BYTES, stream, a); }
#endif
}
```

```cpp
#include <hip/hip_runtime.h>
#include <cstdio>
#include <cstdint>

#ifndef ONE_LAUNCH
#define ONE_LAUNCH 1
#endif

#define LAS __attribute__((address_space(3)))
typedef unsigned short bf16;
typedef short bf16x8 __attribute__((ext_vector_type(8)));
typedef short s16x4 __attribute__((ext_vector_type(4)));
typedef float f32x4 __attribute__((ext_vector_type(4)));
typedef float f32x16 __attribute__((ext_vector_type(16)));
typedef float f32x2 __attribute__((ext_vector_type(2)));
typedef unsigned u32x4 __attribute__((ext_vector_type(4)));
typedef unsigned u32x2 __attribute__((ext_vector_type(2)));

typedef __bf16 bf16x2_t __attribute__((ext_vector_type(2)));
__device__ __forceinline__ unsigned cvt_pk_bf16(float lo, float hi) { bf16x2_t v; v[0] = (__bf16)lo; v[1] = (__bf16)hi; return __builtin_bit_cast(unsigned, v); }
__device__ __forceinline__ bf16 f2bf(float f) { unsigned u = __float_as_uint(f); u += 0x7FFFu + ((u >> 16) & 1u); return (bf16)(u >> 16); }
__device__ __forceinline__ float bf2f(bf16 b) { return __uint_as_float(((unsigned)b) << 16); }
__device__ __forceinline__ float bflo(unsigned u) { return __uint_as_float(u << 16); }
__device__ __forceinline__ float bfhi(unsigned u) { return __uint_as_float(u & 0xFFFF0000u); }
__device__ __forceinline__ float sigmoidf_(float x) { return 1.0f / (1.0f + __expf(-x)); }
__device__ __forceinline__ float siluf_(float x) { return x / (1.0f + __expf(-x)); }
__device__ __forceinline__ float max_x32(float x) { auto r = __builtin_amdgcn_permlane32_swap(__float_as_uint(x), __float_as_uint(x), false, false); return fmaxf(__uint_as_float(r[0]), __uint_as_float(r[1])); }
__device__ __forceinline__ float max_x16(float x) { auto r = __builtin_amdgcn_permlane16_swap(__float_as_uint(x), __float_as_uint(x), false, false); return fmaxf(__uint_as_float(r[0]), __uint_as_float(r[1])); }
__device__ __forceinline__ float sum_x32(float x) { auto r = __builtin_amdgcn_permlane32_swap(__float_as_uint(x), __float_as_uint(x), false, false); return __uint_as_float(r[0]) + __uint_as_float(r[1]); }
__device__ __forceinline__ float sum_x16(float x) { auto r = __builtin_amdgcn_permlane16_swap(__float_as_uint(x), __float_as_uint(x), false, false); return __uint_as_float(r[0]) + __uint_as_float(r[1]); }
__device__ __forceinline__ float dpp_x1(float x) { return __uint_as_float(__builtin_amdgcn_mov_dpp(__float_as_uint(x), 0xB1, 0xF, 0xF, true)); }
__device__ __forceinline__ float dpp_x2(float x) { return __uint_as_float(__builtin_amdgcn_mov_dpp(__float_as_uint(x), 0x4E, 0xF, 0xF, true)); }
__device__ __forceinline__ float dpp_hm(float x) { return __uint_as_float(__builtin_amdgcn_mov_dpp(__float_as_uint(x), 0x141, 0xF, 0xF, true)); }
__device__ __forceinline__ float dpp_rm(float x) { return __uint_as_float(__builtin_amdgcn_mov_dpp(__float_as_uint(x), 0x140, 0xF, 0xF, true)); }
__device__ __forceinline__ float wave_sum(float v) { v += dpp_x1(v); v += dpp_x2(v); v += dpp_hm(v); v += dpp_rm(v); v = sum_x16(v); return sum_x32(v); }
__device__ __forceinline__ float wave_max(float v) { v = fmaxf(v, dpp_x1(v)); v = fmaxf(v, dpp_x2(v)); v = fmaxf(v, dpp_hm(v)); v = fmaxf(v, dpp_rm(v)); v = max_x16(v); return max_x32(v); }
__device__ __forceinline__ int lane_id() { int l; asm volatile("v_mbcnt_lo_u32_b32 %0, -1, 0\n\tv_mbcnt_hi_u32_b32 %0, -1, %0" : "=v"(l)); return l; }
#define WAVE_SYNC() do { asm volatile("s_waitcnt lgkmcnt(0)" ::: "memory"); __builtin_amdgcn_wave_barrier(); } while (0)

#define PHASE_IDS() int tid_ph = wave_s * 64 + lane_id(); asm volatile("" : "+v"(tid_ph)); const int tid = tid_ph, lane = tid & 63, wave = __builtin_amdgcn_readfirstlane(tid >> 6), gwave = bid * NWAVES + wave; (void)tid; (void)lane; (void)wave; (void)gwave; \
    KArgsP ap = kap; asm volatile("" : "+s"(ap));     \
    unsigned char* ws = ap->ws; float* X = ap->out; const float* x_in = ap->in[0]; bf16* XB = (bf16*)(ws + WS_XB); float* LBS = (float*)(ws + WS_LBS); (void)X; (void)x_in; (void)XB; (void)LBS
namespace pg8 {
constexpr int BM = 256, BK = 64, HALF = 128, HTB = HALF * BK * 2, STAGE_BYTES = 8 * HTB, NXCD = 8, WGM = 8;
__host__ __device__ __forceinline__ int lds_byte(int r, int c) { const int st = (r >> 4) * 2 + (c >> 5), rr = r & 15, cc = c & 31, ob = rr * 64 + cc * 2; return st * 1024 + (ob ^ (((ob >> 9) & 1) << 5)); }
__host__ __device__ __forceinline__ void stage_rc(int b, int& R, int& C) { const int st = b / 1024, sb = b % 1024, swz = sb ^ (((sb >> 9) & 1) << 5); R = (st >> 1) * 16 + swz / 64; C = (st & 1) * 32 + (swz % 64) / 2; }
__host__ __device__ __forceinline__ int perm32(int rho) { const int n = rho >> 4, i = rho & 15; return 8 * (i >> 2) + 4 * n + (i & 3); }

struct Unit { int pm, pn, e; };
struct Gemm { const bf16* A; const bf16* Bt; int M, N, K; size_t bt_estride; int lda; const bf16* A2; int ksw; };

struct StaticOrder {
    int nM, nN, nwg, G, c; const int* pe;
    __device__ void init(int M, int N, int G_, int c_, const int* pe_ = nullptr) { nM = M / BM; nN = N / BM; nwg = nM * nN; G = G_; c = c_; pe = pe_; }
    __device__ bool next(int i, Unit& u) const {
        const long L = (long)i * G + c; if (L >= nwg) return false;
        int wgid = (int)L; { const int q = nwg / NXCD, r = nwg % NXCD, xcd = wgid % NXCD, off = wgid / NXCD; wgid = (xcd < r ? xcd * (q + 1) : r * (q + 1) + (xcd - r) * q) + off; }
        const int nig = WGM * nN, gid = wgid / nig, fm = gid * WGM, gsz = (nM - fm) < WGM ? (nM - fm) : WGM;
        u.pm = fm + ((wgid % nig) % gsz); u.pn = (wgid % nig) / gsz; u.e = pe ? pe[u.pm] : 0; return true;
    }
    __device__ __forceinline__ void a_ready(const Unit&) const {}
    __device__ __forceinline__ void done(const Unit&) const {}
};

template <class Epi, class Sched, bool ALIGN_EPI = true, bool SP2 = true>
__device__ __forceinline__ void gemm_phase(LAS unsigned char* lds, const Gemm g, const Sched& S, const Epi& E, const int wave_s) {
    int tid_l = wave_s * 64 + lane_id(); asm volatile("" : "+v"(tid_l));
    const int tid = tid_l, wid = __builtin_amdgcn_readfirstlane(tid >> 6), lane = tid & 63, wr = wid >> 2, wc = wid & 3, fr = lane & 15, fq = lane >> 4;
    const int K = g.K, nt = K / BK, LDA = g.lda ? g.lda : g.K;
    unsigned voffA[2], voffB[2];
#pragma unroll
    for (int i = 0; i < 2; ++i) { int R, C; stage_rc(tid * 16 + i * 8192, R, C); const int Rb = Epi::PERM ? ((R & ~31) + perm32(R & 31)) : R;
        voffA[i] = (unsigned)(R * LDA + C) * 2u; voffB[i] = (unsigned)(Rb * K + C) * 2u; }
    const size_t kstep = (size_t)(BK * 2);
    const size_t hstep = (size_t)HALF * K * 2, hstepA = (size_t)HALF * LDA * 2;
    const size_t tstep = 2 * hstep, tstepA = 2 * hstepA;
    const unsigned ldsw = (unsigned)wid * 1024u;
    const int aoff = lds_byte(wr * 64 + fr, fq * 8), boff = lds_byte(wc * 32 + fr, fq * 8);
#define PG8_SA(b, h) (((b) * 2 + (h)) * HTB)
#define PG8_SB(b, h) ((4 + (b) * 2 + (h)) * HTB)
#define PG8_STAGE(bufoff, gbase, voff) do { _Pragma("unroll") for (int _i = 0; _i < 2; ++_i) \
        __builtin_amdgcn_global_load_lds((const unsigned*)((const char*)(gbase) + (voff)[_i]), (LAS unsigned*)(lds + (bufoff) + ldsw + _i * 8192), 16, 0, 0); } while (0)
#define PG8_LDA(dst, b, h) do { _Pragma("unroll") for (int m = 0; m < 4; ++m) _Pragma("unroll") for (int k = 0; k < 2; ++k) dst[m][k] = *(const LAS bf16x8*)(lds + PG8_SA(b, h) + aoff + m * 2048 + k * 1024); } while (0)
#define PG8_LDB(dst, b, h) do { _Pragma("unroll") for (int n = 0; n < 2; ++n) _Pragma("unroll") for (int k = 0; k < 2; ++k) dst[n][k] = *(const LAS bf16x8*)(lds + PG8_SB(b, h) + boff + n * 2048 + k * 1024); } while (0)
#define PG8_MMA(ai, bj, At, Bt) do { __builtin_amdgcn_s_setprio(1); _Pragma("unroll") for (int m = 0; m < 4; ++m) _Pragma("unroll") for (int n = 0; n < 2; ++n) _Pragma("unroll") for (int k = 0; k < 2; ++k) \
        acc[ai][bj][m][n] = __builtin_amdgcn_mfma_f32_16x16x32_bf16(Bt[n][k], At[m][k], acc[ai][bj][m][n], 0, 0, 0); __builtin_amdgcn_s_setprio(0); } while (0)
#define PG8_WAIT_V(n) asm volatile("s_waitcnt vmcnt(" #n ")" ::: "memory")
#define PG8_WAIT_L(n) asm volatile("s_waitcnt lgkmcnt(" #n ")" ::: "memory")
#define PG8_BAR __builtin_amdgcn_s_barrier()
#define PG8_SCHED __builtin_amdgcn_sched_barrier(0)
    Unit cur, nxt; int ui = 0;
    if (!S.next(0, cur)) return;
    f32x4 acc[2][2][4][2];
#pragma unroll
    for (int a = 0; a < 2; ++a)
#pragma unroll
        for (int b = 0; b < 2; ++b)
#pragma unroll
            for (int m = 0; m < 4; ++m)
#pragma unroll
                for (int n = 0; n < 2; ++n) acc[a][b][m][n] = (f32x4){0.f, 0.f, 0.f, 0.f};
    bf16x8 At[4][2], B0[2][2], B1[2][2];
    const int ksw = g.ksw ? g.ksw : nt;
    const char* cA = (const char*)g.A + (size_t)cur.pm * tstepA; const char* cB = (const char*)(g.Bt + (size_t)cur.e * g.bt_estride) + (size_t)cur.pn * tstep;
    const char* cA2 = g.ksw ? (const char*)g.A2 + (size_t)cur.pm * tstepA : cA;
    S.a_ready(cur);
    if constexpr (SP2) {
        PG8_STAGE(PG8_SB(0, 0), cB, voffB); PG8_STAGE(PG8_SB(0, 1), cB + hstep, voffB); PG8_STAGE(PG8_SA(0, 0), cA, voffA); PG8_STAGE(PG8_SA(0, 1), cA + hstepA, voffA);
        if (wr == 1) PG8_BAR;
        PG8_WAIT_V(2); PG8_BAR;
        PG8_STAGE(PG8_SB(1, 0), cB + kstep, voffB); PG8_STAGE(PG8_SA(1, 0), cA + kstep, voffA); PG8_STAGE(PG8_SB(1, 1), cB + hstep + kstep, voffB);
        PG8_WAIT_V(6); PG8_BAR;
    } else {
        PG8_STAGE(PG8_SB(0, 0), cB, voffB); PG8_STAGE(PG8_SA(0, 0), cA, voffA); PG8_STAGE(PG8_SB(0, 1), cB + hstep, voffB); PG8_STAGE(PG8_SA(0, 1), cA + hstepA, voffA);
        if (wr == 1) PG8_BAR;
        PG8_WAIT_V(4); PG8_BAR;
        PG8_STAGE(PG8_SB(1, 0), cB + kstep, voffB); PG8_STAGE(PG8_SA(1, 0), cA + kstep, voffA); PG8_STAGE(PG8_SB(1, 1), cB + hstep + kstep, voffB);
        PG8_WAIT_V(6); PG8_BAR;
    }
    for (;;) {
        const bool has_next = S.next(ui + 1, nxt);
        const char* nA = has_next ? (const char*)g.A + (size_t)nxt.pm * tstepA : cA;
        const char* nA2 = (has_next && g.ksw) ? (const char*)g.A2 + (size_t)nxt.pm * tstepA : cA2;
        const char* nB = has_next ? (const char*)(g.Bt + (size_t)nxt.e * g.bt_estride) + (size_t)nxt.pn * tstep : cB;
        for (int t = 0; t < nt; t += 2) {
            const bool last = (t == nt - 2);
            const char* a1 = (t + 1 < ksw) ? cA + (size_t)(t + 1) * kstep : cA2 + (size_t)(t + 1 - ksw) * kstep;
            const char* a2 = last ? nA : ((t + 2 < ksw) ? cA + (size_t)(t + 2) * kstep : cA2 + (size_t)(t + 2 - ksw) * kstep); const char* b2 = last ? nB : cB + (size_t)(t + 2) * kstep;
            const char* a3 = a2 + kstep; const char* b3 = b2 + kstep;
            if (last && has_next) S.a_ready(nxt);
            if constexpr (Epi::HAS_MID) { if (t == ksw) E.mid(acc, cur, wr, wc, fr, fq); }
            if constexpr (SP2) {
            PG8_LDB(B0, 0, 0); PG8_LDB(B1, 0, 1); PG8_SCHED; PG8_LDA(At, 0, 0); PG8_STAGE(PG8_SA(1, 1), a1 + hstepA, voffA);
            PG8_WAIT_V(8); PG8_WAIT_L(0); PG8_BAR; PG8_MMA(0, 0, At, B0); PG8_MMA(0, 1, At, B1); PG8_BAR; PG8_SCHED;
            PG8_LDA(At, 0, 1); PG8_STAGE(PG8_SB(0, 0), b2, voffB); PG8_STAGE(PG8_SB(0, 1), b2 + hstep, voffB); PG8_STAGE(PG8_SA(0, 0), a2, voffA);
            PG8_WAIT_V(8); PG8_WAIT_L(0); PG8_BAR; PG8_MMA(1, 0, At, B0); PG8_MMA(1, 1, At, B1); PG8_BAR; PG8_SCHED;
            PG8_LDB(B0, 1, 0); PG8_LDB(B1, 1, 1); PG8_SCHED; PG8_LDA(At, 1, 0); PG8_STAGE(PG8_SA(0, 1), a2 + hstepA, voffA);
            PG8_WAIT_V(8); PG8_WAIT_L(0); PG8_BAR; PG8_MMA(0, 0, At, B0); PG8_MMA(0, 1, At, B1); PG8_BAR; PG8_SCHED;
            PG8_LDA(At, 1, 1); PG8_STAGE(PG8_SB(1, 0), b3, voffB); PG8_STAGE(PG8_SB(1, 1), b3 + hstep, voffB); PG8_STAGE(PG8_SA(1, 0), a3, voffA);
            PG8_WAIT_V(8); PG8_WAIT_L(0); PG8_BAR; PG8_MMA(1, 0, At, B0); PG8_MMA(1, 1, At, B1); PG8_BAR; PG8_SCHED;
            } else {
            PG8_LDB(B0, 0, 0); PG8_SCHED; PG8_LDA(At, 0, 0); PG8_STAGE(PG8_SA(1, 1), a1 + hstepA, voffA);
            PG8_WAIT_L(8); PG8_BAR; PG8_WAIT_L(0); PG8_MMA(0, 0, At, B0); PG8_BAR; PG8_SCHED;
            PG8_LDB(B1, 0, 1); PG8_STAGE(PG8_SB(0, 0), b2, voffB);
            PG8_BAR; PG8_WAIT_L(0); PG8_MMA(0, 1, At, B1); PG8_BAR;
            PG8_LDA(At, 0, 1); PG8_STAGE(PG8_SA(0, 0), a2, voffA);
            PG8_BAR; PG8_WAIT_L(0); PG8_MMA(1, 0, At, B0); PG8_BAR; PG8_SCHED;
            PG8_STAGE(PG8_SB(0, 1), b2 + hstep, voffB);
            PG8_WAIT_V(6); PG8_BAR; PG8_MMA(1, 1, At, B1); PG8_BAR;
            PG8_LDB(B0, 1, 0); PG8_SCHED; PG8_LDA(At, 1, 0); PG8_STAGE(PG8_SA(0, 1), a2 + hstepA, voffA);
            PG8_WAIT_L(8); PG8_BAR; PG8_WAIT_L(0); PG8_MMA(0, 0, At, B0); PG8_BAR; PG8_SCHED;
            PG8_LDB(B1, 1, 1); PG8_STAGE(PG8_SB(1, 0), b3, voffB);
            PG8_BAR; PG8_WAIT_L(0); PG8_MMA(0, 1, At, B1); PG8_BAR;
            PG8_LDA(At, 1, 1); PG8_STAGE(PG8_SA(1, 0), a3, voffA);
            PG8_BAR; PG8_WAIT_L(0); PG8_MMA(1, 0, At, B0); PG8_BAR; PG8_SCHED;
            PG8_STAGE(PG8_SB(1, 1), b3 + hstep, voffB);
            PG8_WAIT_V(6); PG8_BAR; PG8_MMA(1, 1, At, B1); PG8_BAR;
            }
        }
        if constexpr (ALIGN_EPI) { if (wr == 0) PG8_BAR; }
        E(acc, cur, wr, wc, fr, fq); S.done(cur);
        if (!has_next) break;
#pragma unroll
        for (int a = 0; a < 2; ++a)
#pragma unroll
            for (int b = 0; b < 2; ++b)
#pragma unroll
                for (int m = 0; m < 4; ++m)
#pragma unroll
                    for (int n = 0; n < 2; ++n) acc[a][b][m][n] = (f32x4){0.f, 0.f, 0.f, 0.f};
        cur = nxt; cA = nA; cA2 = nA2; cB = nB; ++ui;
        if constexpr (ALIGN_EPI) { if (wr == 1) PG8_BAR; }
    }
    PG8_WAIT_V(0);
    if constexpr (!ALIGN_EPI) { if (wr == 0) PG8_BAR; }
    PG8_BAR;
#undef PG8_SA
#undef PG8_SB
#undef PG8_STAGE
#undef PG8_LDA
#undef PG8_LDB
#undef PG8_MMA
#undef PG8_WAIT_V
#undef PG8_WAIT_L
#undef PG8_BAR
#undef PG8_SCHED
}
}

#define XB_TMO      128
#define XB_XCNT(j)  (256  + 64 * (j))
#define XB_XSUB(j)  (1280 + 64 * (j))
#define XB_XGEN(j)  (2304 + 64 * (j))
#define XB_TOP      3328
#define XB_TOPGEN   3392
#define XCD_BAR_WORDS 3456
#define XB_SPIN_CAP (1u << 18)
__device__ __forceinline__ unsigned xb_ld(unsigned* p)              { return __hip_atomic_load(p, __ATOMIC_RELAXED, __HIP_MEMORY_SCOPE_AGENT); }
__device__ __forceinline__ unsigned xb_add(unsigned* p, unsigned v) { return __hip_atomic_fetch_add(p, v, __ATOMIC_RELAXED, __HIP_MEMORY_SCOPE_AGENT); }
__device__ __forceinline__ unsigned xb_xcc_id() { return (unsigned)__builtin_amdgcn_s_getreg((3 << 11) | 20) & 0xFu; }
#define XB_SPIN(cond, bar) do { unsigned _sp = 0; while (cond) { __builtin_amdgcn_s_sleep(1); \
    if ((++_sp & 255u) == 0u) { if (xb_ld(&(bar)[XB_TMO])) break; if (_sp > XB_SPIN_CAP) { atomicAdd(&(bar)[XB_TMO], 1u); break; } } } } while (0)
struct XcdBarrier { unsigned* bar; unsigned x; volatile LAS unsigned* st; };
__device__ __forceinline__ XcdBarrier xcd_barrier_post(unsigned* bar, volatile LAS unsigned* st, const bool leader) {
    XcdBarrier b; b.bar = bar; b.x = xb_xcc_id(); b.st = st;
    if (leader) (void)xb_add(&bar[XB_XCNT(b.x)], 1u);
    return b;
}
__device__ __forceinline__ void xcd_barrier_complete(unsigned* bar, unsigned x, unsigned& nloc, unsigned& nx) {
    const unsigned G = gridDim.x * gridDim.y * gridDim.z;
    unsigned sum, cnt, mine, sp = 0u;
    for (;;) {
        sum = 0u; cnt = 0u; mine = 0u;
#pragma unroll
        for (unsigned j = 0; j < 16; ++j) { const unsigned c = xb_ld(&bar[XB_XCNT(j)]); sum += c; cnt += (c > 0u) ? 1u : 0u; mine = (j == x) ? c : mine; }
        if (sum == G) break;
        __builtin_amdgcn_s_sleep(1);
        if ((++sp & 255u) == 0u) { if (xb_ld(&bar[XB_TMO])) break; if (sp > XB_SPIN_CAP) { atomicAdd(&bar[XB_TMO], 1u); break; } }
    }
    nloc = mine > 0u ? mine : 1u; nx = cnt > 0u ? cnt : 1u;
}
__device__ __forceinline__ void xcd_barrier(const XcdBarrier& b, const bool leader) {
    asm volatile("s_waitcnt vmcnt(0)" ::: "memory");
    __syncthreads();
    if (leader) {
        unsigned* bar = b.bar;
        __builtin_amdgcn_s_waitcnt(0);
        unsigned nloc = b.st[0], nx = b.st[1];
        if (nloc == 0u) { xcd_barrier_complete(bar, b.x, nloc, nx); b.st[0] = nloc; b.st[1] = nx; }
        const unsigned old = xb_add(&bar[XB_XSUB(b.x)], 1u);
        const unsigned gen = old / nloc;
        if (old + 1u == (gen + 1u) * nloc) {
            __builtin_amdgcn_fence(__ATOMIC_RELEASE, "agent");
            asm volatile("s_waitcnt vmcnt(0)" ::: "memory");
            const unsigned og = xb_add(&bar[XB_TOP], 1u);
            const unsigned tg = og / nx;
            if (og + 1u == (tg + 1u) * nx) xb_add(&bar[XB_TOPGEN], 1u);
            else XB_SPIN(xb_ld(&bar[XB_TOPGEN]) == tg, bar);
            __builtin_amdgcn_fence(__ATOMIC_ACQUIRE, "agent");
            xb_add(&bar[XB_XGEN(b.x)], 1u);
            asm volatile("s_waitcnt vmcnt(0)" ::: "memory");
        } else {
            XB_SPIN(xb_ld(&bar[XB_XGEN(b.x)]) == gen, bar);
            __builtin_amdgcn_fence(__ATOMIC_ACQUIRE, "agent");
            asm volatile("s_waitcnt vmcnt(0)" ::: "memory");
        }
    }
    __syncthreads();
}

constexpr int NB = 4, SEQ = 8192, DM = 1024, NT = NB * SEQ;
constexpr int NINP = 5632;
constexpr int FF0 = 2752, FF0P = 2816, FFE = 3584, NEXP = 8;
constexpr int NWAVES = 8, NTHR = 512;
constexpr int LDS_BYTES = 155648;
constexpr int MISC_OFF = LDS_BYTES - 64;
constexpr float DN_ALPHA = 1.41421356237309515f;
constexpr int MAXPANELS = 272;
constexpr int MAXCHUNK = 5;

constexpr size_t al256(size_t x) { return (x + 255) & ~(size_t)255; }
constexpr size_t WS_CTL = 0;
constexpr size_t CTL_BYTES = 65536;
constexpr size_t CW_BAR = 0;
constexpr size_t CW_BLKCNT = 16384;
constexpr size_t CW_META = 16384 + 8192;
constexpr size_t CW_PANELE = 16384 + 8192 + 256;
constexpr size_t CW_PE32 = 16384 + 8192 + 2048;
constexpr size_t CW_PROBE = 16384 + 8192 + 4096;
constexpr size_t WS_LBS = WS_CTL + CTL_BYTES;
constexpr size_t WS_KC = WS_LBS + 4096;
constexpr size_t WS_VC = WS_KC + 1048576;
constexpr size_t WS_DEC = WS_VC + 1048576;
constexpr size_t WS_TOPI = WS_DEC + 1048576;
constexpr size_t WS_TOPG = WS_TOPI + (size_t)NT * 4;
constexpr size_t WS_ROWINFO = WS_TOPG + (size_t)NT * 8;
constexpr size_t WS_HID = al256(WS_ROWINFO + (size_t)MAXPANELS * 256 * 4);
constexpr size_t WS_B1 = WS_HID + (size_t)8192 * 128 * 2;
constexpr size_t WS_BIG = al256(WS_B1 + 4096);
constexpr size_t SZ_WIN = (size_t)NINP * DM * 2, SZ_WBR = (size_t)DM * 512 * 2, SZ_WOUT = (size_t)DM * DM * 2;
constexpr size_t WS_WIN0 = WS_BIG, WS_WIN1 = WS_WIN0 + SZ_WIN;
constexpr size_t WS_WBA0 = WS_WIN1 + SZ_WIN, WS_WBA1 = WS_WBA0 + SZ_WBR, WS_WBB0 = WS_WBA1 + SZ_WBR, WS_WBB1 = WS_WBB0 + SZ_WBR;
constexpr size_t WS_WOUT0 = WS_WBB1 + SZ_WBR, WS_WOUT1 = WS_WOUT0 + SZ_WOUT;
constexpr size_t WS_WGU0 = WS_WOUT1 + SZ_WOUT;
constexpr size_t WS_WDN0 = WS_WGU0 + (size_t)NINP * DM * 2;
constexpr size_t WS_W1T = WS_WDN0 + (size_t)DM * FF0P * 2;
constexpr size_t WS_XB = WS_W1T + (size_t)2 * 2 * 256 * 2048 * 2;
constexpr size_t WS_US = WS_XB;
constexpr size_t WS_PROJ = WS_XB + (size_t)NT * DM * 2;
constexpr size_t WS_QHG = WS_PROJ;
constexpr size_t WS_HF = WS_QHG + (size_t)NT * 512 * 2;
constexpr size_t WS_HI = WS_HF + (size_t)NT * 512 * 4;
constexpr size_t WS_HG = WS_HI + (size_t)NT * 512 * 2;
constexpr size_t WS_NQ = WS_HG + (size_t)NT * 512 * 2;
constexpr size_t WS_KV6 = WS_NQ + (size_t)NT * 512 * 2;
constexpr size_t WS_GA = WS_KV6 + (size_t)NT * 768 * 2;
constexpr size_t WS_GB = WS_GA + (size_t)NT * DM * 2;
constexpr size_t WS_NG = WS_GB + (size_t)NT * DM * 2;
constexpr size_t WS_MIX_END = WS_NG + (size_t)NT * 32 * 4;
constexpr size_t WS_H0 = WS_PROJ;
constexpr size_t WS_MGU = WS_BIG;
constexpr size_t WS_MDN = WS_MGU + (size_t)NEXP * 2 * FFE * DM * 2;
constexpr size_t WS_XS = WS_MDN + (size_t)NEXP * DM * FFE * 2;
constexpr size_t WS_HM = WS_XS + (size_t)MAXPANELS * 256 * DM * 2;
constexpr size_t WS_YM = WS_HM + (size_t)64 * 256 * FFE * 2;
constexpr size_t WS_MOE_END = WS_YM + (size_t)NT * 2 * DM * 2;
constexpr size_t WS_END = WS_MOE_END > WS_MIX_END ? WS_MOE_END : WS_MIX_END;

struct Args {
    const float* in[22]; float* out; unsigned char* ws; int ph_lo, ph_hi;
};
typedef const __attribute__((address_space(4))) Args* KArgsP;

struct EpiInProj {
    static constexpr bool PERM = false, HAS_MID = false;
    unsigned char* ws;
    __device__ __forceinline__ void operator()(const f32x4 (&acc)[2][2][4][2], const pg8::Unit& u, int wr, int wc, int fr, int fq) const {
        const int row0 = u.pm * 256 + wr * 64 + fr;
#pragma unroll
        for (int bj = 0; bj < 2; ++bj)
#pragma unroll
            for (int n = 0; n < 2; ++n) {
                const int cb = u.pn * 256 + bj * 128 + wc * 32 + n * 16;
                const int c = cb + 4 * fq;
                int kind = 0, ld = 512, co = 0; size_t base = 0; float sc = 1.f;
                if (cb < 512) { base = WS_QHG; co = c; }
                else if (cb < 1024) { kind = 1; base = WS_HF; co = c - 512; }
                else if (cb < 1536) { base = WS_HI; co = c - 1024; }
                else if (cb < 2048) { base = WS_HG; co = c - 1536; }
                else if (cb < 2560) { base = WS_NQ; co = c - 2048; sc = 0.125f * 1.4426950408889634f; }
                else if (cb < 3328) { kind = 3; base = WS_KV6; const int idx = cb - 2560; co = ((idx >> 7) * 8 + ((idx >> 6) & 1)) * SEQ * 64 + (idx & 63) + 4 * fq; }
                else if (cb < 4352) { base = WS_GA; co = c - 3328; ld = 1024; }
                else if (cb < 5376) { base = WS_GB; co = c - 4352; ld = 1024; }
                else if (cb < 5408) { kind = 1; base = WS_NG; co = c - 5376; ld = 32; }
                else kind = 2;
                if (kind == 2) continue;
#pragma unroll
                for (int ai = 0; ai < 2; ++ai)
#pragma unroll
                    for (int m = 0; m < 4; ++m) {
                        const int row = row0 + ai * 128 + m * 16;
                        const f32x4 v = acc[ai][bj][m][n];
                        if (kind == 0) { u32x2 w; w.x = cvt_pk_bf16(v[0] * sc, v[1] * sc); w.y = cvt_pk_bf16(v[2] * sc, v[3] * sc); *(u32x2*)((bf16*)(ws + base) + (size_t)row * ld + co) = w; }
                        else if (kind == 3) { u32x2 w; w.x = cvt_pk_bf16(v[0], v[1]); w.y = cvt_pk_bf16(v[2], v[3]); *(u32x2*)((bf16*)(ws + base) + (size_t)co + ((size_t)(row >> 13) * 2 * SEQ + (row & (SEQ - 1))) * 64) = w; }
                        else *(f32x4*)((float*)(ws + base) + (size_t)row * ld + co) = v;
                    }
            }
    }
};
struct EpiCmpHid {
    static constexpr bool PERM = false, HAS_MID = false;
    bf16* HID; const float* B1;
    __device__ __forceinline__ void operator()(const f32x4 (&acc)[2][2][4][2], const pg8::Unit& u, int wr, int wc, int fr, int fq) const {
        const int row0 = u.pm * 256 + wr * 64 + fr, col0 = wc * 32 + 4 * fq;
#pragma unroll
        for (int n = 0; n < 2; ++n) { const f32x4 bq = *(const f32x4*)(B1 + u.e * 128 + col0 + n * 16);
#pragma unroll
            for (int ai = 0; ai < 2; ++ai)
#pragma unroll
                for (int m = 0; m < 4; ++m) { const f32x4 v = acc[ai][0][m][n] + bq; float o[4];
#pragma unroll
                    for (int q = 0; q < 4; ++q) { const float x = v[q]; o[q] = 0.5f * x * (1.f + tanhf(0.7978845608028654f * (x + 0.044715f * x * x * x))); }
                    u32x2 w; w.x = cvt_pk_bf16(o[0], o[1]); w.y = cvt_pk_bf16(o[2], o[3]);
                    *(u32x2*)(HID + (size_t)(row0 + ai * 128 + m * 16) * 128 + col0 + n * 16) = w; } }
    }
};
template <bool FIRST> struct EpiGate {
    static constexpr bool PERM = false, HAS_MID = false;
    bf16* Y; const bf16* G;
    __device__ __forceinline__ void operator()(const f32x4 (&acc)[2][2][4][2], const pg8::Unit& u, int wr, int wc, int fr, int fq) const {
        const int row0 = u.pm * 256 + wr * 64 + fr, col0 = u.pn * 256 + wc * 32 + 4 * fq;
#pragma unroll
        for (int ai = 0; ai < 2; ++ai)
#pragma unroll
            for (int m = 0; m < 4; ++m)
#pragma unroll
                for (int bj = 0; bj < 2; ++bj)
#pragma unroll
                    for (int n = 0; n < 2; ++n) {
                        const size_t off = (size_t)(row0 + ai * 128 + m * 16) * DM + col0 + bj * 128 + n * 16;
                        const u32x2 gq = *(const u32x2*)(G + off);
                        const f32x4 v = acc[ai][bj][m][n];
                        float o0 = sigmoidf_(bflo(gq.x)) * v[0], o1 = sigmoidf_(bfhi(gq.x)) * v[1], o2 = sigmoidf_(bflo(gq.y)) * v[2], o3 = sigmoidf_(bfhi(gq.y)) * v[3];
                        if (!FIRST) { const u32x2 yq = *(const u32x2*)(Y + off); o0 += bflo(yq.x); o1 += bfhi(yq.x); o2 += bflo(yq.y); o3 += bfhi(yq.y); }
                        u32x2 w; w.x = cvt_pk_bf16(o0, o1); w.y = cvt_pk_bf16(o2, o3); *(u32x2*)(Y + off) = w;
                    }
    }
};
struct EpiGate2 {
    static constexpr bool PERM = false, HAS_MID = true;
    bf16* Y; const bf16* GA; const bf16* GB;
    static __device__ __forceinline__ float cl(float x) { return fminf(fmaxf(x, -30.f), 30.f); }
    __device__ __forceinline__ void mid(f32x4 (&acc)[2][2][4][2], const pg8::Unit& u, int wr, int wc, int fr, int fq) const {
        int row0 = u.pm * 256 + wr * 64 + fr; const int col0 = u.pn * 256 + wc * 32 + 4 * fq;
        asm volatile("" : "+v"(row0));
#pragma unroll
        for (int ai = 0; ai < 2; ++ai)
#pragma unroll
            for (int m = 0; m < 4; ++m) {
#pragma unroll
                for (int bj = 0; bj < 2; ++bj)
#pragma unroll
                    for (int n = 0; n < 2; ++n) {
                        const size_t off = (size_t)(row0 + ai * 128 + m * 16) * DM + col0 + bj * 128 + n * 16;
                        const u32x2 ga = *(const u32x2*)(GA + off), gb = *(const u32x2*)(GB + off);
                        f32x4 r;
                        r[0] = (1.f + __expf(-cl(bflo(gb.x)))) * __builtin_amdgcn_rcpf(1.f + __expf(-cl(bflo(ga.x))));
                        r[1] = (1.f + __expf(-cl(bfhi(gb.x)))) * __builtin_amdgcn_rcpf(1.f + __expf(-cl(bfhi(ga.x))));
                        r[2] = (1.f + __expf(-cl(bflo(gb.y)))) * __builtin_amdgcn_rcpf(1.f + __expf(-cl(bflo(ga.y))));
                        r[3] = (1.f + __expf(-cl(bfhi(gb.y)))) * __builtin_amdgcn_rcpf(1.f + __expf(-cl(bfhi(ga.y))));
                        acc[ai][bj][m][n] = acc[ai][bj][m][n] * r;
                    }
                asm volatile("" : "+v"(acc[ai][0][m][0]), "+v"(acc[ai][0][m][1]), "+v"(acc[ai][1][m][0]), "+v"(acc[ai][1][m][1]) :: "memory");
            }
    }
    __device__ __forceinline__ void operator()(const f32x4 (&acc)[2][2][4][2], const pg8::Unit& u, int wr, int wc, int fr, int fq) const {
        const int row0 = u.pm * 256 + wr * 64 + fr, col0 = u.pn * 256 + wc * 32 + 4 * fq;
#pragma unroll
        for (int ai = 0; ai < 2; ++ai)
#pragma unroll
            for (int m = 0; m < 4; ++m)
#pragma unroll
                for (int bj = 0; bj < 2; ++bj)
#pragma unroll
                    for (int n = 0; n < 2; ++n) {
                        const size_t off = (size_t)(row0 + ai * 128 + m * 16) * DM + col0 + bj * 128 + n * 16;
                        const u32x2 gb = *(const u32x2*)(GB + off);
                        const f32x4 v = acc[ai][bj][m][n];
                        u32x2 w; w.x = cvt_pk_bf16(v[0] * sigmoidf_(cl(bflo(gb.x))), v[1] * sigmoidf_(cl(bfhi(gb.x)))); w.y = cvt_pk_bf16(v[2] * sigmoidf_(cl(bflo(gb.y))), v[3] * sigmoidf_(cl(bfhi(gb.y))));
                        *(u32x2*)(Y + off) = w;
                    }
    }
};
struct EpiResid {
    static constexpr bool PERM = false, HAS_MID = false;
    const float* XI; float* XO;
    __device__ __forceinline__ void operator()(const f32x4 (&acc)[2][2][4][2], const pg8::Unit& u, int wr, int wc, int fr, int fq) const {
        const int row0 = u.pm * 256 + wr * 64 + fr, col0 = u.pn * 256 + wc * 32 + 4 * fq;
#pragma unroll
        for (int ai = 0; ai < 2; ++ai)
#pragma unroll
            for (int m = 0; m < 4; ++m)
#pragma unroll
                for (int bj = 0; bj < 2; ++bj)
#pragma unroll
                    for (int n = 0; n < 2; ++n) {
                        const size_t off = (size_t)(row0 + ai * 128 + m * 16) * DM + col0 + bj * 128 + n * 16;
                        const f32x4 xi = *(const f32x4*)(XI + off);
                        *(f32x4*)(XO + off) = xi * DN_ALPHA + acc[ai][bj][m][n];
                    }
    }
};
struct EpiSwiglu {
    static constexpr bool PERM = false, HAS_MID = false;
    bf16* H; int ldh;
    __device__ __forceinline__ void operator()(const f32x4 (&acc)[2][2][4][2], const pg8::Unit& u, int wr, int wc, int fr, int fq) const {
        const int row0 = u.pm * 256 + wr * 64 + fr, col0 = u.pn * 128 + wc * 32 + 4 * fq;
#pragma unroll
        for (int ai = 0; ai < 2; ++ai)
#pragma unroll
            for (int m = 0; m < 4; ++m)
#pragma unroll
                for (int n = 0; n < 2; ++n) {
                    const f32x4 gq = acc[ai][0][m][n], uq = acc[ai][1][m][n];
                    u32x2 w; w.x = cvt_pk_bf16(siluf_(gq[0]) * uq[0], siluf_(gq[1]) * uq[1]); w.y = cvt_pk_bf16(siluf_(gq[2]) * uq[2], siluf_(gq[3]) * uq[3]);
                    *(u32x2*)(H + (size_t)(row0 + ai * 128 + m * 16) * ldh + col0 + n * 16) = w;
                }
    }
};
struct EpiScatter {
    static constexpr bool PERM = false, HAS_MID = false;
    bf16* Y; const int* rowinfo;
    __device__ __forceinline__ void operator()(const f32x4 (&acc)[2][2][4][2], const pg8::Unit& u, int wr, int wc, int fr, int fq) const {
        const int row0 = u.pm * 256 + wr * 64 + fr, col0 = u.pn * 256 + wc * 32 + 4 * fq;
#pragma unroll
        for (int ai = 0; ai < 2; ++ai)
#pragma unroll
            for (int m = 0; m < 4; ++m) {
                const int info = rowinfo[row0 + ai * 128 + m * 16];
                if (info < 0) continue;
#pragma unroll
                for (int bj = 0; bj < 2; ++bj)
#pragma unroll
                    for (int n = 0; n < 2; ++n) {
                        const f32x4 v = acc[ai][bj][m][n];
                        u32x2 w; w.x = cvt_pk_bf16(v[0], v[1]); w.y = cvt_pk_bf16(v[2], v[3]);
                        *(u32x2*)(Y + (size_t)info * DM + col0 + bj * 128 + n * 16) = w;
                    }
            }
    }
};

__device__ __forceinline__ int rel_bucket(int n) {
    if (n < 16) return n;
    return 16 + (n >= 22) + (n >= 30) + (n >= 40) + (n >= 54) + (n >= 73) + (n >= 99) + (n >= 134) + (n >= 182) + (n >= 246) + (n >= 332) + (n >= 450) + (n >= 609) + (n >= 825) + (n >= 1117) + (n >= 1513);
}
template <class F>
__device__ __forceinline__ void tr_item(F colptr, int ld, int Kvalid, bf16* dst, int dstld, int n0, int k0, LAS float* scr, int lane) {
    const float* cp = colptr(n0 + 4 * (lane & 7));
#pragma unroll
    for (int i = 0; i < 8; ++i) { const int kk = 8 * i + (lane >> 3), k = k0 + kk; f32x4 v = (f32x4){0.f, 0.f, 0.f, 0.f}; if (cp && k < Kvalid) v = *(const f32x4*)(cp + (size_t)k * ld);
        LAS float* s = scr + kk * 33 + 4 * (lane & 7); s[0] = v[0]; s[1] = v[1]; s[2] = v[2]; s[3] = v[3]; }
    WAVE_SYNC();
    const int c = lane & 7;
#pragma unroll
    for (int j = 0; j < 4; ++j) { const int n = (lane >> 3) + 8 * j; const LAS float* s = scr + (8 * c) * 33 + n;
        u32x4 o; o.x = cvt_pk_bf16(s[0 * 33], s[1 * 33]); o.y = cvt_pk_bf16(s[2 * 33], s[3 * 33]); o.z = cvt_pk_bf16(s[4 * 33], s[5 * 33]); o.w = cvt_pk_bf16(s[6 * 33], s[7 * 33]);
        *(u32x4*)(dst + (size_t)(n0 + n) * dstld + k0 + 8 * c) = o; }
    WAVE_SYNC();
}

__global__ void __launch_bounds__(NTHR, 2) mega_fwd(Args args) {
    extern __shared__ __attribute__((aligned(16))) unsigned char lds_raw[];
    LAS unsigned char* lds = (LAS unsigned char*)lds_raw;
    const int G = gridDim.x, bid = blockIdx.x;
    const int nwaves = G * NWAVES;
    KArgsP kap = (KArgsP)__builtin_amdgcn_kernarg_segment_ptr();
    unsigned char* ws0 = kap->ws;
#if ONE_LAUNCH
    constexpr int lo = 0, hi = 64;
#else
    const int lo = kap->ph_lo, hi = kap->ph_hi;
#endif

    volatile LAS unsigned* misc = (volatile LAS unsigned*)(lds + MISC_OFF);
    const int wave_s = __builtin_amdgcn_readfirstlane((int)threadIdx.x >> 6);
    if (wave_s == 0 && lane_id() < 16) misc[lane_id()] = 0u;
    __syncthreads();
    XcdBarrier bar; bar.bar = (unsigned*)(ws0 + WS_CTL + CW_BAR); bar.x = 0; bar.st = misc;
    const bool multi = (hi - lo) > 1;
    if (multi) bar = xcd_barrier_post((unsigned*)(ws0 + WS_CTL + CW_BAR), misc, wave_s == 0 && lane_id() == 0);
#ifndef EN_MASK
#define EN_MASK 0xFFFFFFFFu
#endif
#define EN(b) (((EN_MASK) >> (b)) & 1u)
#define IN(k) (lo <= (k) && (k) < hi)
#ifndef PROBE_GRP
#define PROBE_GRP -1
#endif
#define PROBE_K 4
#ifndef SELREP
#define SELREP 1
#endif
#define WINREP 1
#define NSA_SGB 1
#define NSA_DUP_A 0
#define NSA_DUP_B 0
#define NSA_DUP_C 0
#ifndef PROBE_SCALE
#define PROBE_SCALE 1e-6f
#endif
#if PROBE_GRP >= 0
    unsigned long long pr_last = __builtin_amdgcn_s_memrealtime(), pr_acc = 0ull;
#define PMARK(g) do { const unsigned long long _n = __builtin_amdgcn_s_memrealtime(); if ((g) == PROBE_GRP) pr_acc += _n - pr_last; pr_last = _n; } while (0)
#else
    const unsigned long long pr_acc = 0ull; (void)pr_acc;
#define PMARK(g) do { } while (0)
#endif
#define SEAM(k, g) do { if (IN(k) && IN((k) + 1)) { XcdBarrier b_ = bar; asm volatile("" : "+s"(b_.bar)); unsigned bx_ = b_.x; asm volatile("" : "+s"(bx_)); b_.x = bx_; \
        xcd_barrier(b_, wave_s == 0 && lane_id() == 0); } PMARK(g); } while (0)


    if (EN(0) && IN(0)) { PHASE_IDS();
        LAS float* scr = (LAS float*)(lds + wave * 16384);
        constexpr int I_WIN = 16 * (NINP / 32), I_BR = 8 * 32, I_OUT = 16 * 32, I_GU = 16 * (NINP / 32), I_DN = (FF0P / 64) * 32;
        constexpr int I_W1 = 32 * 8;
        constexpr int NITEMS = 2 * (I_WIN + 2 * I_BR + I_OUT) + I_GU + I_DN + 4 * I_W1;
        for (int it = gwave; it < NITEMS; it += nwaves) {
            int r = it;
            if (r < 2 * I_WIN) { const int l = r / I_WIN; r %= I_WIN; const int nb = r % (NINP / 32), kb = r / (NINP / 32);
                const float* W = ap->in[1] + (size_t)l * DM * 5400;
                auto cp = [=](int n) -> const float* { int c; if (n < 3328) c = n; else if (n < 5376) c = n + 24; else if (n < 5400) c = n - 5376 + 3328; else return nullptr; return W + c; };
                tr_item(cp, 5400, DM, (bf16*)(ws + (l ? WS_WIN1 : WS_WIN0)), DM, nb * 32, kb * 64, scr, lane); continue; }
            r -= 2 * I_WIN;
            if (r < 4 * I_BR) { const int which = r / I_BR; r %= I_BR; const int l = which & 1, ab = which >> 1; const int nb = r % 32, kb = r / 32;
                const float* W = ap->in[ab ? 9 : 8] + (size_t)l * 512 * DM;
                auto cp = [=](int n) -> const float* { return W + n; };
                tr_item(cp, DM, 512, (bf16*)(ws + WS_WBA0 + (size_t)l * 2 * SZ_WBR) + ab * 512, DM, nb * 32, kb * 64, scr, lane); continue; }
            r -= 4 * I_BR;
            if (r < 2 * I_OUT) { const int l = r / I_OUT; r %= I_OUT; const int nb = r % 32, kb = r / 32;
                const float* W = ap->in[10] + (size_t)l * DM * DM;
                auto cp = [=](int n) -> const float* { return W + n; };
                tr_item(cp, DM, DM, (bf16*)(ws + (l ? WS_WOUT1 : WS_WOUT0)), DM, nb * 32, kb * 64, scr, lane); continue; }
            r -= 2 * I_OUT;
            if (r < I_GU) { const int nb = r % (NINP / 32), kb = r / (NINP / 32);
                const float* Wg = ap->in[15]; const float* Wu = ap->in[16];
                auto cp = [=](int n) -> const float* { const int pn = n >> 8, hf = (n >> 7) & 1, c = pn * 128 + (n & 127); if (c >= FF0) return nullptr; return (hf ? Wu : Wg) + c; };
                tr_item(cp, FF0, DM, (bf16*)(ws + WS_WGU0), DM, nb * 32, kb * 64, scr, lane); continue; }
            r -= I_GU;
            if (r >= I_DN) { r -= I_DN; const int lk = r / I_W1; r %= I_W1; const int nb = r % 8, kb = r / 8;
                const float* W = ap->in[5] + (size_t)lk * 2048 * 128;
                auto cp = [=](int n) -> const float* { return n < 128 ? W + n : nullptr; };
                tr_item(cp, 128, 2048, (bf16*)(ws + WS_W1T) + (size_t)lk * 256 * 2048, 2048, nb * 32, kb * 64, scr, lane); continue; }
            { const int nb = r % 32, kb = r / 32;
                const float* W = ap->in[17];
                auto cp = [=](int n) -> const float* { return W + n; };
                tr_item(cp, DM, FF0, (bf16*)(ws + WS_WDN0), FF0P, nb * 32, kb * 64, scr, lane); }
        }
        for (int row = gwave; row < NT; row += nwaves) {
            const f32x4* xr = (const f32x4*)(x_in + (size_t)row * DM);
            u32x2* o = (u32x2*)(XB + (size_t)row * DM);
#pragma unroll
            for (int j = 0; j < 4; ++j) { const f32x4 v = xr[64 * j + lane]; u32x2 w; w.x = cvt_pk_bf16(v[0], v[1]); w.y = cvt_pk_bf16(v[2], v[3]); o[64 * j + lane] = w; }
        }
        for (int o = gwave; o < 4 * 128; o += nwaves) { const int lk = o >> 7, j = o & 127; const float* PS = ap->in[4] + (size_t)lk * 2048; const float* W = ap->in[5] + (size_t)lk * 2048 * 128;
            float s = 0.f; for (int k = lane; k < 2048; k += 64) s += PS[k] * W[(size_t)k * 128 + j];
            s = wave_sum(s); if (lane == 0) ((float*)(ws + WS_B1))[o] = s; }
        if (bid == 0 && tid < 32) ((int*)(ws + WS_CTL + CW_PE32))[tid] = tid >> 4;
        if (bid == 0) {
            const float* lg = ap->in[2];
            const float a = lg[tid], b = lg[512 + tid], m = fmaxf(a, b), ea = expf(a - m), eb = expf(b - m), s = ea + eb, p0 = ea / s, p1 = eb / s;
            LBS[tid] = p0 - p0; LBS[512 + tid] = (p0 + p1) - p0;
        }
    }
    SEAM(0, 0);

    for (int l = 0; l < 2; ++l) {
        const int pb = 1 + l * 10;

        if (EN(1) && IN(pb + 0)) { PHASE_IDS();
            pg8::Gemm g{XB, (const bf16*)(ws + (l ? WS_WIN1 : WS_WIN0)), NT, NINP, DM, 0, 0, nullptr, 0};
            pg8::StaticOrder S; S.init(NT, NINP, G, bid);
            EpiInProj E{ws};
            pg8::gemm_phase<EpiInProj, pg8::StaticOrder>(lds, g, S, E, wave_s);
        }
        SEAM(pb + 0, 1);

        if (EN(2) && IN(pb + 1)) { PHASE_IDS();
            {
                constexpr int RS = 272;
                LAS float* bsf = (LAS float*)lds;
                LAS unsigned char* kd = lds + 32768;
                LAS unsigned char* vt = lds + 32768 + 64 * RS;
                const bf16* HI = (const bf16*)(ws + WS_HI); const float* HF = (const float*)(ws + WS_HF);
                bf16* US = (bf16*)(ws + WS_US); float* DEC = (float*)(ws + WS_DEC);
                const int d = tid & 127, tp = tid >> 7;
                float zr[16];
                auto ld_z = [&](int it) { const int h = it & 3, ci = (it >> 2) & 127, b = it >> 9; const size_t tok0 = (size_t)b * SEQ + ci * 64;
#pragma unroll
                    for (int i = 0; i < 16; ++i) zr[i] = HF[(tok0 + tp + 4 * i) * 512 + h * 128 + d]; };
                ld_z(bid);
                for (int item = bid; item < NB * 128 * 4; item += G) {
                    const int h = item & 3, ci = (item >> 2) & 127, b = item >> 9, bh = b * 4 + h;
                    const size_t tok0 = (size_t)b * SEQ + ci * 64;
                    const float lb = LBS[l * 512 + h * 128 + d];
                    float kk[16];
#pragma unroll
                    for (int i = 0; i < 16; ++i) { const int t = tp + 4 * i;
                        kk[i] = (1.f - lb) * __builtin_amdgcn_rcpf(1.f + __expf(zr[i])); bsf[t * 128 + d] = __logf(1.f - kk[i]); }
                    { const int t = tid >> 3, c8 = tid & 7;
                        const u32x4* src = (const u32x4*)(HI + (tok0 + t) * 512 + h * 128) + c8 * 2;
                        const u32x4 a0 = src[0], a1 = src[1]; *(LAS u32x4*)(vt + t * RS + c8 * 32) = a0; *(LAS u32x4*)(vt + t * RS + c8 * 32 + 16) = a1; }
                    __syncthreads();
                    { float run = 0.f;
#pragma unroll
                        for (int i = 0; i < 16; ++i) { run += bsf[(16 * tp + i) * 128 + d]; bsf[(16 * tp + i) * 128 + d] = run; } }
                    __syncthreads();
                    float off = 0.f;
                    for (int p = 0; p < tp; ++p) off += bsf[(16 * p + 15) * 128 + d];
                    __syncthreads();
#pragma unroll
                    for (int i = 0; i < 16; ++i) bsf[(16 * tp + i) * 128 + d] += off;
                    __syncthreads();
                    { const float blast = bsf[63 * 128 + d];
                        if (tp == 0) DEC[((size_t)bh * 128 + ci) * 128 + d] = __expf(blast);
#pragma unroll
                        for (int i = 0; i < 16; ++i) { const int t = tp + 4 * i; *(LAS bf16*)(kd + t * RS + d * 2) = f2bf(kk[i] * __expf(blast - bsf[t * 128 + d])); } }
                    __syncthreads();
                    if (item + G < NB * 128 * 4) ld_z(item + G);
                    {
                        const int mi = wave >> 1, r31 = lane & 31, hh = lane >> 5, i16 = lane & 15, sub = (lane >> 4) & 1;
                        f32x16 acc[2];
#pragma unroll
                        for (int q = 0; q < 2; ++q)
#pragma unroll
                            for (int r = 0; r < 16; ++r) acc[q][r] = 0.f;
#pragma unroll
                        for (int st = 0; st < 4; ++st) {
                            const LAS unsigned char* ka = kd + (16 * st + 8 * hh + (i16 >> 2)) * RS + (32 * mi + 16 * sub + 4 * (i16 & 3)) * 2;
                            const s16x4 k0 = __builtin_amdgcn_ds_read_tr16_b64_v4i16((LAS s16x4*)ka), k1 = __builtin_amdgcn_ds_read_tr16_b64_v4i16((LAS s16x4*)(ka + 4 * RS));
                            const bf16x8 af = __builtin_shufflevector(k0, k1, 0, 1, 2, 3, 4, 5, 6, 7);
#pragma unroll
                            for (int q = 0; q < 2; ++q) { const int ni = 2 * (wave & 1) + q;
                                const LAS unsigned char* va = vt + (16 * st + 8 * hh + (i16 >> 2)) * RS + (32 * ni + 16 * sub + 4 * (i16 & 3)) * 2;
                                const s16x4 v0 = __builtin_amdgcn_ds_read_tr16_b64_v4i16((LAS s16x4*)va), v1 = __builtin_amdgcn_ds_read_tr16_b64_v4i16((LAS s16x4*)(va + 4 * RS));
                                const bf16x8 bf = __builtin_shufflevector(v0, v1, 0, 1, 2, 3, 4, 5, 6, 7);
                                acc[q] = __builtin_amdgcn_mfma_f32_32x32x16_bf16(af, bf, acc[q], 0, 0, 0); } }
                        bf16* u = US + ((size_t)bh * 128 + ci) * 16384;
#pragma unroll
                        for (int q = 0; q < 2; ++q) { const int dv = 32 * (2 * (wave & 1) + q) + r31;
#pragma unroll
                            for (int rq = 0; rq < 4; ++rq) { u32x2 w; w.x = cvt_pk_bf16(acc[q][4 * rq], acc[q][4 * rq + 1]); w.y = cvt_pk_bf16(acc[q][4 * rq + 2], acc[q][4 * rq + 3]);
                                *(u32x2*)(u + dv * 128 + 32 * mi + 8 * rq + 4 * hh) = w; } }
                    }
                    __syncthreads();
                }
            }
            {
                pg8::Gemm g{(const bf16*)(ws + WS_KV6), (const bf16*)(ws + WS_W1T) + (size_t)l * 2 * 256 * 2048, 8192, 256, 2048, (size_t)256 * 2048, 1024, nullptr, 0};
                pg8::StaticOrder S; S.init(8192, 256, G, bid, (const int*)(ws + WS_CTL + CW_PE32));
                EpiCmpHid E{(bf16*)(ws + WS_HID), (const float*)(ws + WS_B1) + l * 256};
                pg8::gemm_phase<EpiCmpHid, pg8::StaticOrder>(lds, g, S, E, wave_s);
            }
        }
        SEAM(pb + 1, 2);

        if (EN(3) && IN(pb + 2)) { PHASE_IDS();
            {
                unsigned* US32 = (unsigned*)(ws + WS_US); const float* DEC = (const float*)(ws + WS_DEC);
                for (int e2 = bid * NTHR + tid; e2 < 16 * 8192; e2 += G * NTHR) {
                    const int bh = e2 >> 13, dv2 = e2 & 8191, d = (2 * dv2) & 127;
                    float s0 = 0.f, s1 = 0.f;
#pragma unroll 1
                    for (int c0 = 0; c0 < 128; c0 += 16) {
                        unsigned u[16]; f32x2 dec[16];
#pragma unroll
                        for (int i = 0; i < 16; ++i) { u[i] = US32[((size_t)bh * 128 + c0 + i) * 8192 + dv2]; dec[i] = *(const f32x2*)(DEC + ((size_t)bh * 128 + c0 + i) * 128 + d); }
#pragma unroll
                        for (int i = 0; i < 16; ++i) { US32[((size_t)bh * 128 + c0 + i) * 8192 + dv2] = cvt_pk_bf16(s0, s1); s0 = dec[i][0] * s0 + bflo(u[i]); s1 = dec[i][1] * s1 + bfhi(u[i]); }
                    }
                }
            }
            {
                const bf16* HID = (const bf16*)(ws + WS_HID); bf16* KCb = (bf16*)(ws + WS_KC);
                for (int row = gwave; row < 8192; row += nwaves) { const int kind = row >> 12;
                    const float* W2 = ap->in[6] + ((size_t)l * 2 + kind) * 128 * 64;
                    const unsigned hv = ((const unsigned*)(HID + (size_t)row * 128))[lane];
                    float o = 0.f;
#pragma unroll 8
                    for (int j = 0; j < 64; ++j) { const unsigned hj = (unsigned)__builtin_amdgcn_readlane((int)hv, j); o += bflo(hj) * W2[(2 * j) * 64 + lane] + bfhi(hj) * W2[(2 * j + 1) * 64 + lane]; }
                    KCb[(size_t)row * 64 + lane] = f2bf(o); }
            }
        }
        SEAM(pb + 2, 3);

        if (EN(4) && IN(pb + 3)) {
          if (EN(16)) { PHASE_IDS();
            {
                constexpr int RS = 272;
                LAS float* bsf = (LAS float*)lds;
                LAS unsigned char* qh = lds + 32768;
                LAS unsigned char* q1 = qh + 64 * RS;
                LAS unsigned char* k0 = q1 + 32 * RS;
                LAS unsigned char* k1 = k0 + 32 * RS;
                LAS unsigned char* vt = k1 + 64 * RS;
                LAS float* ssq = (LAS float*)(vt + 64 * RS);
                bf16* QHG = (bf16*)(ws + WS_QHG); const bf16* HI = (const bf16*)(ws + WS_HI); const bf16* HG = (const bf16*)(ws + WS_HG); const float* HF = (const float*)(ws + WS_HF);
                const bf16* US = (const bf16*)(ws + WS_US);
                const float* NW = ap->in[3] + l * 512;
                const int d = tid & 127, tp = tid >> 7;
                for (int item = bid; item < NB * 128 * 4; item += G) {
                    const int h = item & 3, ci = (item >> 2) & 127, b = item >> 9, bh = b * 4 + h;
                    const size_t tok0 = (size_t)b * SEQ + ci * 64;
                    const float lb = LBS[l * 512 + h * 128 + d];
                    bf16x8 sf[8];
                    { const bf16* Sg = US + ((size_t)bh * 128 + ci) * 16384 + (size_t)(32 * (wave & 3) + (lane & 31)) * 128 + 8 * (lane >> 5);
#pragma unroll
                        for (int st = 0; st < 8; ++st) sf[st] = *(const bf16x8*)(Sg + 16 * st); }
                    float kk[16], qv[16];
#pragma unroll
                    for (int i = 0; i < 16; ++i) { const int t = tp + 4 * i; const size_t go = (tok0 + t) * 512 + h * 128 + d; const float z = HF[go];
                        kk[i] = (1.f - lb) * __builtin_amdgcn_rcpf(1.f + __expf(z)); bsf[t * 128 + d] = __logf(1.f - kk[i]); qv[i] = bf2f(QHG[go]); }
                    { const int t = tid >> 3, c8 = tid & 7;
                        const u32x4* src = (const u32x4*)(HI + (tok0 + t) * 512 + h * 128) + c8 * 2;
                        const u32x4 a0 = src[0], a1 = src[1]; *(LAS u32x4*)(vt + t * RS + c8 * 32) = a0; *(LAS u32x4*)(vt + t * RS + c8 * 32 + 16) = a1; }
                    __syncthreads();
                    { float run = 0.f;
#pragma unroll
                        for (int i = 0; i < 16; ++i) { run += bsf[(16 * tp + i) * 128 + d]; bsf[(16 * tp + i) * 128 + d] = run; } }
                    __syncthreads();
                    float off = 0.f;
                    for (int p = 0; p < tp; ++p) off += bsf[(16 * p + 15) * 128 + d];
                    __syncthreads();
#pragma unroll
                    for (int i = 0; i < 16; ++i) bsf[(16 * tp + i) * 128 + d] += off;
                    __syncthreads();
                    { const float b31 = bsf[31 * 128 + d];
#pragma unroll
                        for (int i = 0; i < 16; ++i) { const int t = tp + 4 * i; const float bt = bsf[t * 128 + d];
                            *(LAS bf16*)(qh + t * RS + d * 2) = f2bf(qv[i] * __expf(bt));
                            *(LAS bf16*)(k1 + t * RS + d * 2) = f2bf(kk[i] * __expf(fminf(b31 - bt, 80.f)));
                            if (t < 32) *(LAS bf16*)(k0 + t * RS + d * 2) = f2bf(kk[i] * __expf(fminf(-bt, 80.f)));
                            else *(LAS bf16*)(q1 + (t - 32) * RS + d * 2) = f2bf(qv[i] * __expf(bt - b31)); } }
                    __syncthreads();
                    {
                        const int ni = wave & 3, mi = wave >> 2, r31 = lane & 31, hh = lane >> 5, i16 = lane & 15, sub = (lane >> 4) & 1;
                        f32x16 acc;
#pragma unroll
                        for (int r = 0; r < 16; ++r) acc[r] = 0.f;
#pragma unroll
                        for (int st = 0; st < 8; ++st) { const bf16x8 bq = *(const LAS bf16x8*)(qh + (32 * mi + r31) * RS + (16 * st + 8 * hh) * 2);
                            acc = __builtin_amdgcn_mfma_f32_32x32x16_bf16(sf[st], bq, acc, 0, 0, 0); }
#pragma unroll
                        for (int jb = 0; jb < 2; ++jb) { if (jb > mi) continue;
                            f32x16 x;
#pragma unroll
                            for (int r = 0; r < 16; ++r) x[r] = 0.f;
                            const LAS unsigned char* kb = (mi == 0) ? k0 : (k1 + 32 * jb * RS);
                            const LAS unsigned char* qb = (mi == 0) ? qh : q1;
#pragma unroll
                            for (int st = 0; st < 8; ++st) { const bf16x8 ka = *(const LAS bf16x8*)(kb + r31 * RS + (16 * st + 8 * hh) * 2), qq = *(const LAS bf16x8*)(qb + r31 * RS + (16 * st + 8 * hh) * 2);
                                x = __builtin_amdgcn_mfma_f32_32x32x16_bf16(ka, qq, x, 0, 0, 0); }
                            if (jb == mi) {
#pragma unroll
                                for (int r = 0; r < 16; ++r) { const int key = (r & 3) + 8 * (r >> 2) + 4 * hh; if (key > r31) x[r] = 0.f; } }
#pragma unroll
                            for (int s2 = 0; s2 < 2; ++s2) { u32x4 w; w.x = cvt_pk_bf16(x[8 * s2], x[8 * s2 + 1]); w.y = cvt_pk_bf16(x[8 * s2 + 2], x[8 * s2 + 3]); w.z = cvt_pk_bf16(x[8 * s2 + 4], x[8 * s2 + 5]); w.w = cvt_pk_bf16(x[8 * s2 + 6], x[8 * s2 + 7]);
                                const bf16x8 xb = __builtin_bit_cast(bf16x8, w);
                                const LAS unsigned char* va = vt + (32 * jb + 16 * s2 + 4 * hh + (i16 >> 2)) * RS + (32 * ni + 16 * sub + 4 * (i16 & 3)) * 2;
                                const s16x4 v0 = __builtin_amdgcn_ds_read_tr16_b64_v4i16((LAS s16x4*)va), v1 = __builtin_amdgcn_ds_read_tr16_b64_v4i16((LAS s16x4*)(va + 8 * RS));
                                const bf16x8 vf = __builtin_shufflevector(v0, v1, 0, 1, 2, 3, 4, 5, 6, 7);
                                acc = __builtin_amdgcn_mfma_f32_32x32x16_bf16(vf, xb, acc, 0, 0, 0); } }
                        u32x2 gq4[4];
                        { const size_t gg = (tok0 + 32 * mi + r31) * 512 + h * 128 + 32 * ni + 4 * hh;
#pragma unroll
                          for (int rq = 0; rq < 4; ++rq) gq4[rq] = *(const u32x2*)(HG + gg + 8 * rq); }
                        float ss = 0.f;
#pragma unroll
                        for (int r = 0; r < 16; ++r) ss += acc[r] * acc[r];
                        ss += __shfl_xor(ss, 32);
                        if (hh == 0) ssq[ni * 64 + 32 * mi + r31] = ss;
                        __syncthreads();
                        const int tl = 32 * mi + r31;
                        const float tot = ssq[tl] + ssq[64 + tl] + ssq[128 + tl] + ssq[192 + tl];
                        const float rn = rsqrtf(tot * (1.f / 128.f) + 1e-6f);
                        const size_t go = (tok0 + tl) * 512 + h * 128 + 32 * ni + 4 * hh;
#pragma unroll
                        for (int rq = 0; rq < 4; ++rq) { const u32x2 gq = gq4[rq]; const f32x4 nw = *(const f32x4*)(NW + h * 128 + 32 * ni + 4 * hh + 8 * rq);
                            u32x2 w; w.x = cvt_pk_bf16(acc[4 * rq] * rn * nw[0] * siluf_(bflo(gq.x)), acc[4 * rq + 1] * rn * nw[1] * siluf_(bfhi(gq.x)));
                            w.y = cvt_pk_bf16(acc[4 * rq + 2] * rn * nw[2] * siluf_(bflo(gq.y)), acc[4 * rq + 3] * rn * nw[3] * siluf_(bfhi(gq.y)));
                            *(u32x2*)(QHG + go + 8 * rq) = w; }
                    }
                    __syncthreads();
                }
            }
          }
          PMARK(15);
          if (EN(17)) { PHASE_IDS();
            {
                constexpr int KST = 144, TB = 9216;
                constexpr float LOG2E = 1.4426950408889634f;
                LAS unsigned char* kvb = lds;
                LAS float* lut = (LAS float*)(lds + 4 * TB);
                LAS float* impW = (LAS float*)(lds + 4 * TB + 32768 + wave * 8192);
                LAS float* ocl = impW + lane;
                LAS unsigned* selm = (LAS unsigned*)(lds + 4 * TB + 32768 + 65536);
                const bf16* NQ = (const bf16*)(ws + WS_NQ); const bf16* KVT = (const bf16*)(ws + WS_KV6); const bf16* KCb = (const bf16*)(ws + WS_KC);
                const float* NG = (const float*)(ws + WS_NG); const float* RB = ap->in[7];
                bf16* OB = (bf16*)(ws + WS_NQ);
                const int col = lane & 15, q4 = lane >> 4, head = col & 3, ti = col >> 2;
                const float NINF = -__builtin_inff();
                for (int pq = bid; pq < 512; pq += G)
#pragma unroll 1
                for (int odd = 0; odd < 2; ++odd) {
                    const int bg = pq & 7, xx = pq >> 3, tile = odd ? 127 - xx : xx, b = bg >> 1, g = bg & 1, t0 = tile * 64, cur = tile;
                    const size_t tokw = (size_t)b * SEQ + t0 + 8 * wave;
                    int tq[2]; bf16x8 qf[2][2];
                    auto gatev = [&](int gq, int br) -> float { return sigmoidf_(NG[(tokw + 4 * gq + ti) * 32 + (g * 4 + head) * 3 + br]); };
#pragma unroll
                    for (int gq = 0; gq < 2; ++gq) { tq[gq] = t0 + 8 * wave + 4 * gq + ti; const size_t tok = tokw + 4 * gq + ti;
#pragma unroll
                        for (int s = 0; s < 2; ++s) qf[gq][s] = *(const bf16x8*)(NQ + tok * 512 + (g * 4 + head) * 64 + 32 * s + 8 * q4);
                    }
                    const float bfar = RB[31 * 8 + g * 4 + head] * LOG2E;
                    __syncthreads();
                    for (int d = tid; d < 2048; d += NTHR) { const int bk = rel_bucket(d); *(LAS f32x4*)(lut + d * 4) = *(const f32x4*)(RB + bk * 8 + g * 4) * LOG2E; }
                    for (int i = lane; i < 8 * 128; i += 64) impW[i] = 0.f;
                    f32x4 O[2][4], Ls[2];
                    float m[2], l[2], m1[2] = {0.f, 0.f}, linv[2] = {0.f, 0.f}, carry[2] = {0.f, 0.f};
                    const bf16x8 ones8 = {0x3F80, 0x3F80, 0x3F80, 0x3F80, 0x3F80, 0x3F80, 0x3F80, 0x3F80};
                    auto soft = [&](const int mode, const int gq, f32x4 (&st)[4], bf16x8 (&pb)[2], const int pos0, const bool far, const bool full, const float cbias, const bool colsel, const int sblk0) {
                        float tmax = NINF;
                        if (far) {
#pragma unroll
                            for (int kt = 0; kt < 4; ++kt)
#pragma unroll
                                for (int r = 0; r < 4; ++r) tmax = fmaxf(tmax, st[kt][r]);
                            tmax += cbias;
                        } else if (mode >= 2) {
                            const int dbase = tq[gq] - (pos0 + 4 * q4);
                            const LAS float* lb = lut + (dbase - 51) * 4 + head;
                            const float cadd = (mode == 2 && !colsel) ? NINF : 0.f;
                            float bv[4][4];
#pragma unroll
                            for (int kt = 0; kt < 4; ++kt)
#pragma unroll
                                for (int r = 0; r < 4; ++r) bv[kt][r] = lb[(51 - 16 * kt - r) * 4];
                            asm volatile("" : "+v"(bv[0][0]), "+v"(bv[0][1]), "+v"(bv[0][2]), "+v"(bv[0][3]), "+v"(bv[1][0]), "+v"(bv[1][1]), "+v"(bv[1][2]), "+v"(bv[1][3]));
                            asm volatile("" : "+v"(bv[2][0]), "+v"(bv[2][1]), "+v"(bv[2][2]), "+v"(bv[2][3]), "+v"(bv[3][0]), "+v"(bv[3][1]), "+v"(bv[3][2]), "+v"(bv[3][3]));
#pragma unroll
                            for (int kt = 0; kt < 4; ++kt)
#pragma unroll
                                for (int r = 0; r < 4; ++r) { float sv = st[kt][r] + bv[kt][r];
                                    if (mode == 2) sv += cadd;
                                    if (!full) { const int dist = dbase - (16 * kt + r); const bool valid = (mode == 3) ? ((unsigned)dist < 512u) : (dist >= 0); sv = valid ? sv : NINF; }
                                    st[kt][r] = sv; tmax = fmaxf(tmax, sv); }
                        } else {
                            const int dbase = tq[gq] - 16 * (pos0 + 4 * q4) - 31;
                            float bv[4][4];
#pragma unroll
                            for (int kt = 0; kt < 4; ++kt)
#pragma unroll
                                for (int r = 0; r < 4; ++r) { const int dist = dbase - 16 * (16 * kt + r); const unsigned di = (unsigned)dist < 2047u ? (unsigned)dist : 2047u; bv[kt][r] = lut[di * 4 + head]; }
#pragma unroll
                            for (int kt = 0; kt < 4; ++kt)
#pragma unroll
                                for (int r = 0; r < 4; ++r) { float sv = st[kt][r] + bv[kt][r];
                                    if (!full) { const int dist = dbase - 16 * (16 * kt + r); sv = (dist >= 0) ? sv : NINF; }
                                    st[kt][r] = sv; tmax = fmaxf(tmax, sv); }
                        }
                        float muse;
                        if (mode == 1) muse = m1[gq];
                        else {
                            tmax = max_x16(tmax); tmax = max_x32(tmax);
                            const float mnew = fmaxf(m[gq], tmax);
                            if (__any(mnew != m[gq])) {
                                const float mu = (mnew == NINF) ? 0.f : mnew;
                                const float alpha = __builtin_amdgcn_exp2f(m[gq] - mu);
                                m[gq] = mnew; l[gq] *= alpha;
                                if (mode >= 2) { Ls[gq] = Ls[gq] * alpha;
#pragma unroll
                                    for (int mt = 0; mt < 4; ++mt) O[gq][mt] = O[gq][mt] * alpha; }
                            }
                            muse = (m[gq] == NINF) ? 0.f : m[gq];
                        }
                        const float esub = far ? muse - cbias : muse;
                        float ls = 0.f;
#pragma unroll
                        for (int kt = 0; kt < 4; ++kt)
#pragma unroll
                            for (int r = 0; r < 4; ++r) { float p = __builtin_amdgcn_exp2f(st[kt][r] - esub); if (mode == 1) p *= linv[gq]; st[kt][r] = p; if (mode <= 1) ls += p; }
#if NSA_DUP_B
                        if (mode == 2) { float acc2 = 0.f;
#pragma unroll
                            for (int kt = 0; kt < 4; ++kt)
#pragma unroll
                                for (int r = 0; r < 4; ++r) { float x = st[kt][r]; asm volatile("" : "+v"(x)); const float p2 = __builtin_amdgcn_exp2f(x * 0.5f - esub); acc2 = fmaxf(acc2, p2 + x); }
                            asm volatile("" :: "v"(acc2)); }
#endif
                        if (mode <= 1) l[gq] += ls;
                        if (mode == 1) {
                            float a[4], h3[4];
#pragma unroll
                            for (int kt = 0; kt < 4; ++kt) { a[kt] = st[kt][0] + st[kt][1] + st[kt][2] + 0.5f * st[kt][3]; h3[kt] = 0.5f * st[kt][3];
                                a[kt] += dpp_x1(a[kt]); a[kt] += dpp_x2(a[kt]); h3[kt] += dpp_x1(h3[kt]); h3[kt] += dpp_x2(h3[kt]); }
#pragma unroll
                            for (int kt = 0; kt < 4; ++kt) { const float give = (q4 == 3) ? (kt > 0 ? h3[kt - 1] : carry[gq]) : h3[kt];
                                const float prev = __shfl(give, (lane - 16) & 63);
                                if (head == 0) impW[(4 * gq + ti) * 128 + sblk0 + 4 * kt + q4] = a[kt] + prev; }
                            carry[gq] = h3[3];
                        }
                        if (mode != 0) {
#pragma unroll
                            for (int s = 0; s < 2; ++s) { u32x4 w; w.x = cvt_pk_bf16(st[2 * s][0], st[2 * s][1]); w.y = cvt_pk_bf16(st[2 * s][2], st[2 * s][3]);
                                w.z = cvt_pk_bf16(st[2 * s + 1][0], st[2 * s + 1][1]); w.w = cvt_pk_bf16(st[2 * s + 1][2], st[2 * s + 1][3]); pb[s] = __builtin_bit_cast(bf16x8, w); } }
                    };
                    auto tile2 = [&](const int mode, const LAS unsigned char* kbuf, const LAS unsigned char* vbuf, const int pos0, const bool far, const bool full, const bool a0, const bool a1,
                                     const float cb0, const float cb1, const bool cs0, const bool cs1, const int sblk0) {
                        f32x4 st0[4], st1[4]; bf16x8 pb0[2], pb1[2];
#pragma unroll
                        for (int kt = 0; kt < 4; ++kt) {
                            const bf16x8 kf0 = *(const LAS bf16x8*)(kbuf + (16 * kt + col) * KST + 16 * q4), kf1 = *(const LAS bf16x8*)(kbuf + (16 * kt + col) * KST + 64 + 16 * q4);
                            if (a0) { st0[kt] = __builtin_amdgcn_mfma_f32_16x16x32_bf16(kf0, qf[0][0], (f32x4){0.f, 0.f, 0.f, 0.f}, 0, 0, 0); st0[kt] = __builtin_amdgcn_mfma_f32_16x16x32_bf16(kf1, qf[0][1], st0[kt], 0, 0, 0); }
                            if (a1) { st1[kt] = __builtin_amdgcn_mfma_f32_16x16x32_bf16(kf0, qf[1][0], (f32x4){0.f, 0.f, 0.f, 0.f}, 0, 0, 0); st1[kt] = __builtin_amdgcn_mfma_f32_16x16x32_bf16(kf1, qf[1][1], st1[kt], 0, 0, 0); } }
#if NSA_DUP_A
                        if (mode == 2) {
#pragma unroll
                            for (int kt = 0; kt < 4; ++kt) {
                                const bf16x8 kf0 = *(const LAS bf16x8*)(kbuf + (16 * kt + col) * KST + 16 * q4 + 32), kf1 = *(const LAS bf16x8*)(kbuf + (16 * kt + col) * KST + 64 + 16 * q4 - 32);
                                f32x4 d0 = __builtin_amdgcn_mfma_f32_16x16x32_bf16(kf0, qf[0][0], (f32x4){0.f, 0.f, 0.f, 0.f}, 0, 0, 0); d0 = __builtin_amdgcn_mfma_f32_16x16x32_bf16(kf1, qf[0][1], d0, 0, 0, 0);
                                f32x4 d1 = __builtin_amdgcn_mfma_f32_16x16x32_bf16(kf0, qf[1][0], (f32x4){0.f, 0.f, 0.f, 0.f}, 0, 0, 0); d1 = __builtin_amdgcn_mfma_f32_16x16x32_bf16(kf1, qf[1][1], d1, 0, 0, 0);
                                asm volatile("" :: "v"(d0), "v"(d1)); } }
#endif
                        if (a0) soft(mode, 0, st0, pb0, pos0, far, full, cb0, cs0, sblk0);
                        if (a1) soft(mode, 1, st1, pb1, pos0, far, full, cb1, cs1, sblk0);
                        if (mode == 0) return;
#pragma unroll
                        for (int mt = 0; mt < 4; ++mt)
#pragma unroll
                            for (int s = 0; s < 2; ++s) { const LAS unsigned char* a = vbuf + (32 * s + 4 * q4 + (col >> 2)) * KST + (16 * mt + 4 * (col & 3)) * 2;
                                const s16x4 lo = __builtin_amdgcn_ds_read_tr16_b64_v4i16((LAS s16x4*)a), hi = __builtin_amdgcn_ds_read_tr16_b64_v4i16((LAS s16x4*)(a + 16 * KST));
                                const bf16x8 vfs = __builtin_shufflevector(lo, hi, 0, 1, 2, 3, 4, 5, 6, 7);
                                if (a0) O[0][mt] = __builtin_amdgcn_mfma_f32_16x16x32_bf16(vfs, pb0[s], O[0][mt], 0, 0, 0);
                                if (a1) O[1][mt] = __builtin_amdgcn_mfma_f32_16x16x32_bf16(vfs, pb1[s], O[1][mt], 0, 0, 0); }
                        if (mode >= 2) {
#pragma unroll
                            for (int s = 0; s < 2; ++s) { if (a0) Ls[0] = __builtin_amdgcn_mfma_f32_16x16x32_bf16(ones8, pb0[s], Ls[0], 0, 0, 0); if (a1) Ls[1] = __builtin_amdgcn_mfma_f32_16x16x32_bf16(ones8, pb1[s], Ls[1], 0, 0, 0); } }
                    };
                    auto soft_far = [&](const int gq, f32x4 (&st)[4], bf16x8 (&pb)[2], const float cbias) {
                        float tmax = fmaxf(fmaxf(fmaxf(st[0][0], st[0][1]), fmaxf(st[0][2], st[0][3])), fmaxf(fmaxf(st[1][0], st[1][1]), fmaxf(st[1][2], st[1][3])));
                        tmax = fmaxf(tmax, fmaxf(fmaxf(fmaxf(st[2][0], st[2][1]), fmaxf(st[2][2], st[2][3])), fmaxf(fmaxf(st[3][0], st[3][1]), fmaxf(st[3][2], st[3][3]))));
                        tmax += cbias; tmax = max_x16(tmax); tmax = max_x32(tmax);
                        const float mnew = fmaxf(m[gq], tmax), mu = (mnew == NINF) ? 0.f : mnew, alpha = __builtin_amdgcn_exp2f(m[gq] - mu);
                        m[gq] = mnew; Ls[gq] = Ls[gq] * alpha;
#pragma unroll
                        for (int mt = 0; mt < 4; ++mt) O[gq][mt] = O[gq][mt] * alpha;
                        const float esub = mu - cbias;
#pragma unroll
                        for (int kt = 0; kt < 4; ++kt)
#pragma unroll
                            for (int r = 0; r < 4; ++r) st[kt][r] = __builtin_amdgcn_exp2f(st[kt][r] - esub);
#pragma unroll
                        for (int s = 0; s < 2; ++s) { u32x4 w; w.x = cvt_pk_bf16(st[2 * s][0], st[2 * s][1]); w.y = cvt_pk_bf16(st[2 * s][2], st[2 * s][3]);
                            w.z = cvt_pk_bf16(st[2 * s + 1][0], st[2 * s + 1][1]); w.w = cvt_pk_bf16(st[2 * s + 1][2], st[2 * s + 1][3]); pb[s] = __builtin_bit_cast(bf16x8, w); }
                    };
                    auto tile_far2 = [&](const LAS unsigned char* kbuf, const LAS unsigned char* vbuf, const float cb0, const float cb1) {
                        f32x4 st0[4], st1[4]; bf16x8 pb0[2], pb1[2];
#pragma unroll
                        for (int kt = 0; kt < 4; ++kt) { const bf16x8 kf0 = *(const LAS bf16x8*)(kbuf + (16 * kt + col) * KST + 16 * q4), kf1 = *(const LAS bf16x8*)(kbuf + (16 * kt + col) * KST + 64 + 16 * q4);
                            st0[kt] = __builtin_amdgcn_mfma_f32_16x16x32_bf16(kf0, qf[0][0], (f32x4){0.f, 0.f, 0.f, 0.f}, 0, 0, 0); st0[kt] = __builtin_amdgcn_mfma_f32_16x16x32_bf16(kf1, qf[0][1], st0[kt], 0, 0, 0);
                            st1[kt] = __builtin_amdgcn_mfma_f32_16x16x32_bf16(kf0, qf[1][0], (f32x4){0.f, 0.f, 0.f, 0.f}, 0, 0, 0); st1[kt] = __builtin_amdgcn_mfma_f32_16x16x32_bf16(kf1, qf[1][1], st1[kt], 0, 0, 0); }
                        soft_far(0, st0, pb0, cb0);
                        soft_far(1, st1, pb1, cb1);
#pragma unroll
                        for (int mt = 0; mt < 4; ++mt)
#pragma unroll
                            for (int s = 0; s < 2; ++s) { const LAS unsigned char* a = vbuf + (32 * s + 4 * q4 + (col >> 2)) * KST + (16 * mt + 4 * (col & 3)) * 2;
                                const s16x4 lo = __builtin_amdgcn_ds_read_tr16_b64_v4i16((LAS s16x4*)a), hi = __builtin_amdgcn_ds_read_tr16_b64_v4i16((LAS s16x4*)(a + 16 * KST));
                                const bf16x8 vfs = __builtin_shufflevector(lo, hi, 0, 1, 2, 3, 4, 5, 6, 7);
                                O[0][mt] = __builtin_amdgcn_mfma_f32_16x16x32_bf16(vfs, pb0[s], O[0][mt], 0, 0, 0);
                                O[1][mt] = __builtin_amdgcn_mfma_f32_16x16x32_bf16(vfs, pb1[s], O[1][mt], 0, 0, 0); }
#pragma unroll
                        for (int s = 0; s < 2; ++s) { Ls[0] = __builtin_amdgcn_mfma_f32_16x16x32_bf16(ones8, pb0[s], Ls[0], 0, 0, 0); Ls[1] = __builtin_amdgcn_mfma_f32_16x16x32_bf16(ones8, pb1[s], Ls[1], 0, 0, 0); }
#if NSA_SGB
                        __builtin_amdgcn_sched_group_barrier(0x100, 8, 0); __builtin_amdgcn_sched_group_barrier(0x008, 16, 0);
                        __builtin_amdgcn_sched_group_barrier(0x002, 64, 0); __builtin_amdgcn_sched_group_barrier(0x400, 17, 0); __builtin_amdgcn_sched_group_barrier(0x002, 40, 0);
                        __builtin_amdgcn_sched_group_barrier(0x100, 16, 0);
#pragma unroll
                        for (int i = 0; i < 10; ++i) { __builtin_amdgcn_sched_group_barrier(0x008, 1, 0); __builtin_amdgcn_sched_group_barrier(0x002, 7, 0); __builtin_amdgcn_sched_group_barrier(0x400, 2, 0); }
                        __builtin_amdgcn_sched_group_barrier(0x002, 40, 0);
                        __builtin_amdgcn_sched_group_barrier(0x008, 10, 0);
#endif
                    };
                    auto ld_tile = [&](const bf16* src) -> u32x4 { return *(const u32x4*)(src + tid * 8); };
                    auto st_tile = [&](LAS unsigned char* buf, const u32x4 v) { *(LAS u32x4*)(buf + (tid >> 3) * KST + (tid & 7) * 16) = v; };
                    auto zeroO = [&]() {
#pragma unroll
                        for (int gq = 0; gq < 2; ++gq) { m[gq] = NINF; l[gq] = 0.f; Ls[gq] = (f32x4){0.f, 0.f, 0.f, 0.f};
#pragma unroll
                            for (int mt = 0; mt < 4; ++mt) O[gq][mt] = (f32x4){0.f, 0.f, 0.f, 0.f}; } };
                    const int ntc = (4 * tile + 3 + 63) >> 6;
                    const bf16* kcb = KCb + (size_t)bg * 512 * 64; const bf16* vcb = KCb + (size_t)(8 + bg) * 512 * 64;
                    {
                        zeroO();
                        u32x4 rk = ld_tile(kcb);
                        st_tile(kvb, rk); if (ntc > 1) rk = ld_tile(kcb + 4096);
                        __syncthreads();
#pragma unroll 1
                        for (int i = 0; i < ntc; ++i) { LAS unsigned char* cb = kvb + (i & 1) * 2 * TB;
                            if (i + 1 < ntc) st_tile(kvb + ((i + 1) & 1) * 2 * TB, rk);
                            if (i + 2 < ntc) rk = ld_tile(kcb + (size_t)(i + 2) * 4096);
                            const bool far = (t0 - (16 * (64 * i + 63) + 31)) >= 1513;
                            tile2(0, cb, cb + TB, 64 * i, far, (16 * (64 * i + 63) + 31) <= t0, true, true, bfar, bfar, true, true, 0);
                            __syncthreads(); }
                    }
#pragma unroll
                    for (int gq = 0; gq < 2; ++gq) { float lt = sum_x32(sum_x16(l[gq])); linv[gq] = 1.f / fmaxf(lt, 1e-30f); m1[gq] = (m[gq] == NINF) ? 0.f : m[gq]; }
                    {
                        zeroO();
                        u32x4 rk = ld_tile(kcb), rv = ld_tile(vcb);
                        st_tile(kvb, rk); st_tile(kvb + TB, rv); if (ntc > 1) { rk = ld_tile(kcb + 4096); rv = ld_tile(vcb + 4096); }
                        __syncthreads();
#pragma unroll 1
                        for (int i = 0; i < ntc; ++i) { LAS unsigned char* cb = kvb + (i & 1) * 2 * TB;
                            if (i + 1 < ntc) { LAS unsigned char* nb = kvb + ((i + 1) & 1) * 2 * TB; st_tile(nb, rk); st_tile(nb + TB, rv); }
                            if (i + 2 < ntc) { rk = ld_tile(kcb + (size_t)(i + 2) * 4096); rv = ld_tile(vcb + (size_t)(i + 2) * 4096); }
                            const bool far = (t0 - (16 * (64 * i + 63) + 31)) >= 1513;
                            tile2(1, cb, cb + TB, 64 * i, far, (16 * (64 * i + 63) + 31) <= t0, true, true, bfar, bfar, true, true, 16 * i);
                            __syncthreads(); }
                    }
                    WAVE_SYNC();
                    {
                        const int tt = lane >> 3, sub = lane & 7;
                        unsigned key[16];
                        const LAS f32x4* ip = (const LAS f32x4*)(impW + tt * 128 + sub * 16);
#pragma unroll
                        for (int q = 0; q < 4; ++q) { const f32x4 v = ip[q];
#pragma unroll
                            for (int e2 = 0; e2 < 4; ++e2) { const int i = 4 * q + e2, s = sub * 16 + i;
                                const bool forced = (s == 0) || (s == cur) || (s == cur - 1);
                                const unsigned k = forced ? 0x7FFFFF80u : ((__float_as_uint(v[e2]) & 0xFFFFFF80u) + 128u);
                                key[i] = (s <= cur) ? (k | (unsigned)(127 - s)) : 0u; } }
                        unsigned w0 = 0u, w1 = 0u, w2 = 0u, w3 = 0u;
#pragma unroll 1
                        for (int k = 0; k < 16; ++k) {
                            unsigned best = key[0];
#pragma unroll
                            for (int i = 1; i < 16; ++i) best = best > key[i] ? best : key[i];
                            { const unsigned o1 = (unsigned)__builtin_amdgcn_mov_dpp((int)best, 0xB1, 0xF, 0xF, true); best = best > o1 ? best : o1;
                              const unsigned o2 = (unsigned)__builtin_amdgcn_mov_dpp((int)best, 0x4E, 0xF, 0xF, true); best = best > o2 ? best : o2;
                              const unsigned o3 = (unsigned)__builtin_amdgcn_mov_dpp((int)best, 0x141, 0xF, 0xF, true); best = best > o3 ? best : o3; }
#pragma unroll
                            for (int i = 0; i < 16; ++i) key[i] = (key[i] == best) ? 0u : key[i];
                            if (best != 0u) { const int idx = 127 - (int)(best & 127u); const unsigned bit = 1u << (idx & 31); const int wd = idx >> 5;
                                w0 |= wd == 0 ? bit : 0u; w1 |= wd == 1 ? bit : 0u; w2 |= wd == 2 ? bit : 0u; w3 |= wd == 3 ? bit : 0u; }
                        }
                        if (sub == 0) { LAS unsigned* sp = selm + (8 * wave + tt) * 4; sp[0] = w0; sp[1] = w1; sp[2] = w2; sp[3] = w3; }
                    }
                    WAVE_SYNC();
#pragma unroll
                    for (int gq = 0; gq < 2; ++gq) { const float g0 = gatev(gq, 0);
#pragma unroll
                        for (int mt = 0; mt < 4; ++mt)
#pragma unroll
                            for (int r = 0; r < 4; ++r) ocl[((gq * 4 + mt) * 4 + r) * 64] = O[gq][mt][r] * g0; }
                    __syncthreads();
                    unsigned long long Ulo, Uhi;
                    { unsigned u[4];
#pragma unroll
                      for (int k = 0; k < 4; ++k) { unsigned x = selm[lane * 4 + k];
#pragma unroll
                        for (int o = 1; o < 64; o <<= 1) x |= __shfl_xor(x, o);
                        u[k] = __builtin_amdgcn_readfirstlane(x); }
                      Ulo = ((unsigned long long)u[1] << 32) | u[0]; Uhi = ((unsigned long long)u[3] << 32) | u[2]; }
                    auto nextj = [&](int j) -> int {
                        if (j < 64) { const unsigned long long x = Ulo >> j; if (x) return j + __builtin_ctzll(x); j = 64; }
                        if (j < 128) { const unsigned long long x = Uhi >> (j - 64); if (x) return j + __builtin_ctzll(x); }
                        return 128; };
                    {
                        const bf16* ksb = KVT + (size_t)(2 * 8 + bg) * SEQ * 64; const bf16* vsb = KVT + (size_t)(3 * 8 + bg) * SEQ * 64;
#pragma unroll 1
                        for (int rep = 0; rep < SELREP; ++rep) {
                        zeroO();
                        int j = nextj(0), jn = nextj(j + 1), it = 0;
                        u32x4 rk = ld_tile(ksb + (size_t)j * 4096), rv = ld_tile(vsb + (size_t)j * 4096);
                        st_tile(kvb, rk); st_tile(kvb + TB, rv);
                        if (jn <= cur) { rk = ld_tile(ksb + (size_t)jn * 4096); rv = ld_tile(vsb + (size_t)jn * 4096); }
                        __syncthreads();
#pragma unroll 1
                        while (j <= cur) { LAS unsigned char* cb = kvb + (it & 1) * 2 * TB;
                            const int jnn = jn <= cur ? nextj(jn + 1) : 128;
                            if (jn <= cur) { LAS unsigned char* nb = kvb + ((it + 1) & 1) * 2 * TB; st_tile(nb, rk); st_tile(nb + TB, rv); }
                            if (jnn <= cur) { rk = ld_tile(ksb + (size_t)jnn * 4096); rv = ld_tile(vsb + (size_t)jnn * 4096); }
                            const bool cs0 = (selm[(8 * wave + ti) * 4 + (j >> 5)] >> (j & 31)) & 1u, cs1 = (selm[(8 * wave + 4 + ti) * 4 + (j >> 5)] >> (j & 31)) & 1u;
                            const bool act0 = __ballot(cs0) != 0ull, act1 = __ballot(cs1) != 0ull;
                            const bool far = (t0 - (64 * j + 63)) >= 1513;
                            const float cb0 = cs0 ? bfar : NINF, cb1 = cs1 ? bfar : NINF;
                            const bool full = j < cur;
                            if (act0 && act1 && far) tile_far2(cb, cb + TB, cb0, cb1);
                            else if (act0 && act1) tile2(2, cb, cb + TB, 64 * j, far, full, true, true, cb0, cb1, cs0, cs1, 0);
                            else if (act0) tile2(2, cb, cb + TB, 64 * j, far, full, true, false, cb0, cb1, cs0, cs1, 0);
                            else if (act1) tile2(2, cb, cb + TB, 64 * j, far, full, false, true, cb0, cb1, cs0, cs1, 0);
#if NSA_DUP_C
                            __syncthreads();
#endif
                            __syncthreads();
                            j = jn; jn = jnn; ++it;
                        }
                        }
#pragma unroll
                        for (int gq = 0; gq < 2; ++gq) { const float lt = Ls[gq][0]; const float sc = gatev(gq, 1) / fmaxf(lt, 1e-30f);
#pragma unroll
                            for (int mt = 0; mt < 4; ++mt)
#pragma unroll
                                for (int r = 0; r < 4; ++r) ocl[((gq * 4 + mt) * 4 + r) * 64] += O[gq][mt][r] * sc; }
                    }
                    {
                        const bf16* kwb = KVT + (size_t)(4 * 8 + bg) * SEQ * 64; const bf16* vwb = KVT + (size_t)(5 * 8 + bg) * SEQ * 64;
                        const int j0 = cur - 8 < 0 ? 0 : cur - 8, nw = cur - j0 + 1;
#pragma unroll 1
                        for (int wrep = 0; wrep < WINREP; ++wrep) {
                        zeroO();
                        u32x4 rk = ld_tile(kwb + (size_t)j0 * 4096), rv = ld_tile(vwb + (size_t)j0 * 4096);
                        st_tile(kvb, rk); st_tile(kvb + TB, rv);
                        if (nw > 1) { rk = ld_tile(kwb + (size_t)(j0 + 1) * 4096); rv = ld_tile(vwb + (size_t)(j0 + 1) * 4096); }
                        __syncthreads();
#pragma unroll 1
                        for (int i = 0; i < nw; ++i) { LAS unsigned char* cb = kvb + (i & 1) * 2 * TB;
                            if (i + 1 < nw) { LAS unsigned char* nb = kvb + ((i + 1) & 1) * 2 * TB; st_tile(nb, rk); st_tile(nb + TB, rv); }
                            if (i + 2 < nw) { rk = ld_tile(kwb + (size_t)(j0 + i + 2) * 4096); rv = ld_tile(vwb + (size_t)(j0 + i + 2) * 4096); }
                            tile2(3, cb, cb + TB, 64 * (j0 + i), false, (j0 + i > cur - 8) && (j0 + i < cur), true, true, 0.f, 0.f, true, true, 0);
                            __syncthreads(); }
                        }
#pragma unroll
                        for (int gq = 0; gq < 2; ++gq) { const float lt = Ls[gq][0]; const float sc = gatev(gq, 2) / fmaxf(lt, 1e-30f);
#pragma unroll
                            for (int mt = 0; mt < 4; ++mt)
#pragma unroll
                                for (int r = 0; r < 4; ++r) O[gq][mt][r] = ocl[((gq * 4 + mt) * 4 + r) * 64] + O[gq][mt][r] * sc; }
                    }
#pragma unroll
                    for (int gq = 0; gq < 2; ++gq)
#pragma unroll
                        for (int mt = 0; mt < 4; ++mt) { u32x2 w; w.x = cvt_pk_bf16(O[gq][mt][0], O[gq][mt][1]); w.y = cvt_pk_bf16(O[gq][mt][2], O[gq][mt][3]);
                            *(u32x2*)(OB + (tokw + 4 * gq + ti) * 512 + (g * 4 + head) * 64 + 16 * mt + 4 * q4) = w; }
                }
            }
          }
        }
        SEAM(pb + 3, 4);

        if (EN(5) && IN(pb + 4)) { PHASE_IDS();
            pg8::Gemm g{(const bf16*)(ws + WS_QHG), (const bf16*)(ws + WS_WBA0 + (size_t)l * 2 * SZ_WBR), NT, DM, DM, 0, 512, (const bf16*)(ws + WS_NQ), 8};
            pg8::StaticOrder S; S.init(NT, DM, G, bid); EpiGate2 E{(bf16*)(ws + WS_GA), (const bf16*)(ws + WS_GA), (const bf16*)(ws + WS_GB)};
            pg8::gemm_phase<EpiGate2, pg8::StaticOrder>(lds, g, S, E, wave_s);
        }
        SEAM(pb + 4, 5);

        if (EN(6) && IN(pb + 5)) { PHASE_IDS();
            pg8::Gemm g{(const bf16*)(ws + WS_GA), (const bf16*)(ws + (l ? WS_WOUT1 : WS_WOUT0)), NT, DM, DM, 0, 0, nullptr, 0};
            const float* XI = l ? (const float*)X : x_in;
            pg8::StaticOrder S; S.init(NT, DM, G, bid); EpiResid E{XI, X};
            pg8::gemm_phase<EpiResid, pg8::StaticOrder>(lds, g, S, E, wave_s);
        }
        SEAM(pb + 5, 6);

        if (EN(7) && IN(pb + 6)) { PHASE_IDS();
            const float* gam = ap->in[11] + l * DM; const float* bet = ap->in[12] + l * DM;
            LAS int* hist = (LAS int*)(lds + 8 * 16384);
            if (l == 1) { if (tid < 8) hist[tid] = 0; __syncthreads(); }
            const int rpb = (NT + G - 1) / G;
            for (int i = wave; i < rpb; i += NWAVES) {
                const int row = bid * rpb + i; if (row >= NT) break;
                f32x4* xr = (f32x4*)(X + (size_t)row * DM);
                f32x4 v[4]; float s = 0.f;
#pragma unroll
                for (int j = 0; j < 4; ++j) { v[j] = xr[64 * j + lane]; s += (v[j][0] + v[j][1]) + (v[j][2] + v[j][3]); }
                const float mean = wave_sum(s) * (1.f / DM); float s2 = 0.f;
#pragma unroll
                for (int j = 0; j < 4; ++j) { v[j] = v[j] - mean; s2 += (v[j][0] * v[j][0] + v[j][1] * v[j][1]) + (v[j][2] * v[j][2] + v[j][3] * v[j][3]); }
                const float rstd = rsqrtf(wave_sum(s2) * (1.f / DM) + 1e-5f);
#pragma unroll
                for (int j = 0; j < 4; ++j) { const f32x4 gq = ((const f32x4*)gam)[64 * j + lane], bq = ((const f32x4*)bet)[64 * j + lane]; v[j] = v[j] * rstd * gq + bq; xr[64 * j + lane] = v[j]; }
                if (l == 0) { u32x2* o = (u32x2*)(XB + (size_t)row * DM);
#pragma unroll
                    for (int j = 0; j < 4; ++j) { u32x2 w; w.x = cvt_pk_bf16(v[j][0], v[j][1]); w.y = cvt_pk_bf16(v[j][2], v[j][3]); o[64 * j + lane] = w; }
                } else {
                    const float* WR = ap->in[18];
                    float lg[8];
#pragma unroll
                    for (int e = 0; e < 8; ++e) lg[e] = 0.f;
#pragma unroll
                    for (int j = 0; j < 4; ++j)
#pragma unroll
                        for (int q = 0; q < 4; ++q) { const int c = 4 * (64 * j + lane) + q; const f32x4 w0 = *(const f32x4*)(WR + c * 8), w1 = *(const f32x4*)(WR + c * 8 + 4); const float xv = v[j][q];
                            lg[0] += xv * w0[0]; lg[1] += xv * w0[1]; lg[2] += xv * w0[2]; lg[3] += xv * w0[3]; lg[4] += xv * w1[0]; lg[5] += xv * w1[1]; lg[6] += xv * w1[2]; lg[7] += xv * w1[3]; }
#pragma unroll
                    for (int e = 0; e < 8; ++e) lg[e] = wave_sum(lg[e]);
                    int e1 = 0; float v1 = lg[0];
#pragma unroll
                    for (int e = 1; e < 8; ++e) if (lg[e] > v1) { v1 = lg[e]; e1 = e; }
                    int e2 = -1; float v2 = -3e38f;
#pragma unroll
                    for (int e = 0; e < 8; ++e) if (e != e1 && lg[e] > v2) { v2 = lg[e]; e2 = e; }
                    if (lane == 0) { const float g2 = 1.f / (1.f + expf(v1 - v2)), g1 = 1.f - g2;
                        ((int*)(ws + WS_TOPI))[row] = e1 | (e2 << 8); ((float*)(ws + WS_TOPG))[row * 2] = g1; ((float*)(ws + WS_TOPG))[row * 2 + 1] = g2;
                        atomicAdd((int*)&hist[e1], 1); atomicAdd((int*)&hist[e2], 1); }
                }
            }
            if (l == 1) {
                __syncthreads();
                if (tid < 8) ((int*)(ws + WS_CTL + CW_BLKCNT))[bid * 8 + tid] = hist[tid];
                LAS float* scr = (LAS float*)(lds + wave * 16384);
                constexpr int I_GU = 16 * (2 * FFE / 32), I_DN = (FFE / 64) * 32;
                for (int it = gwave; it < NEXP * (I_GU + I_DN); it += nwaves) {
                    const int e = it / (I_GU + I_DN); int r = it % (I_GU + I_DN);
                    if (r < I_GU) { const int nb = r % (2 * FFE / 32), kb = r / (2 * FFE / 32);
                        const float* Wg = ap->in[19] + (size_t)e * DM * FFE; const float* Wu = ap->in[20] + (size_t)e * DM * FFE;
                        auto cp = [=](int n) -> const float* { const int pn = n >> 8, hf = (n >> 7) & 1, c = pn * 128 + (n & 127); return (hf ? Wu : Wg) + c; };
                        tr_item(cp, FFE, DM, (bf16*)(ws + WS_MGU) + (size_t)e * 2 * FFE * DM, DM, nb * 32, kb * 64, scr, lane); }
                    else { r -= I_GU; const int nb = r % 32, kb = r / 32;
                        const float* W = ap->in[21] + (size_t)e * FFE * DM;
                        auto cp = [=](int n) -> const float* { return W + n; };
                        tr_item(cp, DM, FFE, (bf16*)(ws + WS_MDN) + (size_t)e * DM * FFE, FFE, nb * 32, kb * 64, scr, lane); }
                }
            }
        }
        SEAM(pb + 6, 7);

        if (l == 0) {
            if (EN(8) && IN(pb + 7)) { PHASE_IDS();
                pg8::Gemm g{XB, (const bf16*)(ws + WS_WGU0), NT, NINP, DM, 0, 0, nullptr, 0};
                pg8::StaticOrder S; S.init(NT, NINP, G, bid); EpiSwiglu E{(bf16*)(ws + WS_H0), FF0P};
                pg8::gemm_phase<EpiSwiglu, pg8::StaticOrder>(lds, g, S, E, wave_s);
            }
            SEAM(pb + 7, 8);
            if (EN(9) && IN(pb + 8)) { PHASE_IDS();
                pg8::Gemm g{(const bf16*)(ws + WS_H0), (const bf16*)(ws + WS_WDN0), NT, DM, FF0P, 0, 0, nullptr, 0};
                pg8::StaticOrder S; S.init(NT, DM, G, bid); EpiResid E{X, X};
                pg8::gemm_phase<EpiResid, pg8::StaticOrder>(lds, g, S, E, wave_s);
            }
            SEAM(pb + 8, 9);
            if (EN(10) && IN(pb + 9)) { PHASE_IDS();
                const float* gam = ap->in[13]; const float* bet = ap->in[14];
                for (int row = gwave; row < NT; row += nwaves) {
                    f32x4* xr = (f32x4*)(X + (size_t)row * DM);
                    f32x4 v[4]; float s = 0.f;
#pragma unroll
                    for (int j = 0; j < 4; ++j) { v[j] = xr[64 * j + lane]; s += (v[j][0] + v[j][1]) + (v[j][2] + v[j][3]); }
                    const float mean = wave_sum(s) * (1.f / DM); float s2 = 0.f;
#pragma unroll
                    for (int j = 0; j < 4; ++j) { v[j] = v[j] - mean; s2 += (v[j][0] * v[j][0] + v[j][1] * v[j][1]) + (v[j][2] * v[j][2] + v[j][3] * v[j][3]); }
                    const float rstd = rsqrtf(wave_sum(s2) * (1.f / DM) + 1e-5f);
                    u32x2* o = (u32x2*)(XB + (size_t)row * DM);
#pragma unroll
                    for (int j = 0; j < 4; ++j) { const f32x4 gq = ((const f32x4*)gam)[64 * j + lane], bq = ((const f32x4*)bet)[64 * j + lane]; v[j] = v[j] * rstd * gq + bq; xr[64 * j + lane] = v[j];
                        u32x2 w; w.x = cvt_pk_bf16(v[j][0], v[j][1]); w.y = cvt_pk_bf16(v[j][2], v[j][3]); o[64 * j + lane] = w; }
                }
            }
            SEAM(pb + 9, 10);
        } else {
            if (EN(11) && IN(pb + 7)) { PHASE_IDS(); int* META = (int*)(ws + WS_CTL + CW_META); int* PANELE = (int*)(ws + WS_CTL + CW_PANELE); int* ROWINFO = (int*)(ws + WS_ROWINFO); bf16* XS = (bf16*)(ws + WS_XS); (void)META; (void)PANELE; (void)ROWINFO; (void)XS;
                LAS int* sh = (LAS int*)lds;
                const int* BC = (const int*)(ws + WS_CTL + CW_BLKCNT);
                if (tid < 8) { int tot = 0, pre = 0; for (int bb = 0; bb < G; ++bb) { const int c = BC[bb * 8 + tid]; if (bb < bid) pre += c; tot += c; } sh[tid] = tot; sh[8 + tid] = pre; sh[24 + tid] = 0; }
                __syncthreads();
                if (tid == 0) { int base = 0;
#pragma unroll 1
                    for (int e = 0; e < 8; ++e) { sh[16 + e] = base; base += (sh[e] + 255) & ~255; }
                    sh[32] = base; }
                __syncthreads();
                if (bid == 0) { const int base = sh[32]; if (tid == 0) { META[0] = base / 256; META[1] = (base / 256 + 63) / 64; }
                    if (tid < 8) { META[8 + tid] = sh[16 + tid]; META[16 + tid] = sh[tid]; }
                    for (int p = tid; p < base / 256; p += NTHR) { int e = 0;
#pragma unroll 1
                        for (int q = 1; q < 8; ++q) if (p * 256 >= sh[16 + q]) e = q;
                        PANELE[p] = e; } }
                __syncthreads();
                if (bid < 8) { const int e = bid, r0 = sh[16 + e] + sh[e], r1 = sh[16 + e] + ((sh[e] + 255) & ~255);
                    for (int r = r0 + wave; r < r1; r += NWAVES) { if (lane == 0) ROWINFO[r] = -1;
#pragma unroll
                        for (int j = 0; j < 4; ++j) ((u32x2*)(XS + (size_t)r * DM))[64 * j + lane] = (u32x2){0u, 0u}; } }
                const int rpb = (NT + G - 1) / G;
                for (int i = wave; i < rpb; i += NWAVES) {
                    const int row = bid * rpb + i; if (row >= NT) break;
                    const int ti = ((const int*)(ws + WS_TOPI))[row]; const int e1 = ti & 255, e2 = ti >> 8;
                    int s1 = 0, s2 = 0;
                    if (lane == 0) { s1 = sh[16 + e1] + sh[8 + e1] + atomicAdd((int*)&sh[24 + e1], 1); s2 = sh[16 + e2] + sh[8 + e2] + atomicAdd((int*)&sh[24 + e2], 1); ROWINFO[s1] = row * 2; ROWINFO[s2] = row * 2 + 1; }
                    s1 = __builtin_amdgcn_readfirstlane(s1); s2 = __builtin_amdgcn_readfirstlane(s2);
                    const f32x4* xr = (const f32x4*)(X + (size_t)row * DM);
#pragma unroll
                    for (int j = 0; j < 4; ++j) { const f32x4 v = xr[64 * j + lane]; u32x2 w; w.x = cvt_pk_bf16(v[0], v[1]); w.y = cvt_pk_bf16(v[2], v[3]);
                        ((u32x2*)(XS + (size_t)s1 * DM))[64 * j + lane] = w; ((u32x2*)(XS + (size_t)s2 * DM))[64 * j + lane] = w; }
                }
            }
            SEAM(pb + 7, 11);
            for (int c = 0; c < MAXCHUNK; ++c) {
                if (EN(12) && IN(pb + 8 + 2 * c)) { PHASE_IDS(); int* META = (int*)(ws + WS_CTL + CW_META); int* PANELE = (int*)(ws + WS_CTL + CW_PANELE); int* ROWINFO = (int*)(ws + WS_ROWINFO); bf16* XS = (bf16*)(ws + WS_XS); (void)META; (void)PANELE; (void)ROWINFO; (void)XS;
                    const int P = META[0], nch = META[1];
                    if (c < nch) { const int p0 = (int)((long)c * P / nch), p1 = (int)((long)(c + 1) * P / nch);
                        pg8::Gemm g{XS + (size_t)p0 * 256 * DM, (const bf16*)(ws + WS_MGU), (p1 - p0) * 256, 2 * FFE, DM, (size_t)2 * FFE * DM, 0, nullptr, 0};
                        pg8::StaticOrder S; S.init((p1 - p0) * 256, 2 * FFE, G, bid, PANELE + p0); EpiSwiglu E{(bf16*)(ws + WS_HM), FFE};
                        pg8::gemm_phase<EpiSwiglu, pg8::StaticOrder>(lds, g, S, E, wave_s); }
                }
                SEAM(pb + 8 + 2 * c, 12);
                if (EN(13) && IN(pb + 9 + 2 * c)) { PHASE_IDS(); int* META = (int*)(ws + WS_CTL + CW_META); int* PANELE = (int*)(ws + WS_CTL + CW_PANELE); int* ROWINFO = (int*)(ws + WS_ROWINFO); bf16* XS = (bf16*)(ws + WS_XS); (void)META; (void)PANELE; (void)ROWINFO; (void)XS;
                    const int P = META[0], nch = META[1];
                    if (c < nch) { const int p0 = (int)((long)c * P / nch), p1 = (int)((long)(c + 1) * P / nch);
                        pg8::Gemm g{(const bf16*)(ws + WS_HM), (const bf16*)(ws + WS_MDN), (p1 - p0) * 256, DM, FFE, (size_t)DM * FFE, 0, nullptr, 0};
                        pg8::StaticOrder S; S.init((p1 - p0) * 256, DM, G, bid, PANELE + p0); EpiScatter E{(bf16*)(ws + WS_YM), ROWINFO + p0 * 256};
                        pg8::gemm_phase<EpiScatter, pg8::StaticOrder>(lds, g, S, E, wave_s); }
                }
                if (PROBE_GRP >= 0 && c == MAXCHUNK - 1) { PMARK(13); if (bid == 0 && wave_s == 0 && lane_id() == 0) *(unsigned long long*)(ws0 + WS_CTL + CW_PROBE) = pr_acc; }
                SEAM(pb + 9 + 2 * c, 13);
            }
            if (EN(14) && IN(pb + 8 + 2 * MAXCHUNK)) { PHASE_IDS();
                const float* gam = ap->in[13] + DM; const float* bet = ap->in[14] + DM;
                const bf16* YM = (const bf16*)(ws + WS_YM); const float* TG = (const float*)(ws + WS_TOPG);
                const float pscale = 1.f;
                for (int row = gwave; row < NT; row += nwaves) {
                    f32x4* xr = (f32x4*)(X + (size_t)row * DM);
                    const float g1 = TG[row * 2], g2 = TG[row * 2 + 1];
                    const u32x2* y1 = (const u32x2*)(YM + (size_t)(row * 2) * DM); const u32x2* y2 = (const u32x2*)(YM + (size_t)(row * 2 + 1) * DM);
                    f32x4 v[4]; float s = 0.f;
#pragma unroll
                    for (int j = 0; j < 4; ++j) { const f32x4 xv = xr[64 * j + lane]; const u32x2 a = y1[64 * j + lane], bq = y2[64 * j + lane];
                        v[j][0] = xv[0] * DN_ALPHA + g1 * bflo(a.x) + g2 * bflo(bq.x); v[j][1] = xv[1] * DN_ALPHA + g1 * bfhi(a.x) + g2 * bfhi(bq.x);
                        v[j][2] = xv[2] * DN_ALPHA + g1 * bflo(a.y) + g2 * bflo(bq.y); v[j][3] = xv[3] * DN_ALPHA + g1 * bfhi(a.y) + g2 * bfhi(bq.y);
                        s += (v[j][0] + v[j][1]) + (v[j][2] + v[j][3]); }
                    const float mean = wave_sum(s) * (1.f / DM); float s2 = 0.f;
#pragma unroll
                    for (int j = 0; j < 4; ++j) { v[j] = v[j] - mean; s2 += (v[j][0] * v[j][0] + v[j][1] * v[j][1]) + (v[j][2] * v[j][2] + v[j][3] * v[j][3]); }
                    const float rstd = rsqrtf(wave_sum(s2) * (1.f / DM) + 1e-5f);
#pragma unroll
                    for (int j = 0; j < 4; ++j) { const f32x4 gq = ((const f32x4*)gam)[64 * j + lane], bq = ((const f32x4*)bet)[64 * j + lane]; xr[64 * j + lane] = (v[j] * rstd * gq + bq) * pscale; }
                }
#if PROBE_GRP >= 0
                {
                    const unsigned long long dt = *(const unsigned long long*)(ws + WS_CTL + CW_PROBE) * (unsigned long long)PROBE_K;
                    const unsigned long long t0 = __builtin_amdgcn_s_memrealtime();
                    while (__builtin_amdgcn_s_memrealtime() - t0 < dt) __builtin_amdgcn_s_sleep(8);
                }
#endif
            }
        }
    }
#undef IN
#undef SEAM
}

constexpr int NPHASES = 1 + 10 + 8 + 2 * MAXCHUNK + 1;

extern "C" void kernel_launch(void* const* d_in, const int* in_sizes, int n_in, void* d_out, int out_size, void* d_ws, size_t ws_size, hipStream_t stream) {
    static int grid = 0;
    if (grid == 0) {
        if (n_in != 22 || out_size != NT * DM || ws_size < WS_END) { fprintf(stderr, "kernel_launch: need 22 inputs, %d outputs, >= %zu bytes of workspace; got %d, %d, %zu\n", NT * DM, (size_t)WS_END, n_in, out_size, ws_size); grid = -1; return; }
        int dev = 0, cus = 0, per_cu = 0;
        if (hipGetDevice(&dev) != hipSuccess || hipDeviceGetAttribute(&cus, hipDeviceAttributeMultiprocessorCount, dev) != hipSuccess) { grid = -1; return; }
        if (hipFuncSetAttribute((const void*)mega_fwd, hipFuncAttributeMaxDynamicSharedMemorySize, LDS_BYTES) != hipSuccess) { fprintf(stderr, "kernel_launch: hipFuncSetAttribute failed\n"); grid = -1; return; }
        if (hipOccupancyMaxActiveBlocksPerMultiprocessor(&per_cu, (const void*)mega_fwd, NTHR, LDS_BYTES) != hipSuccess || per_cu < 1) fprintf(stderr, "kernel_launch: occupancy query reports %d\n", per_cu);
        (void)hipGetLastError();
        grid = cus > 256 ? 256 : cus;
    }
    if (grid < 0) return;
    (void)hipMemsetAsync((char*)d_ws + WS_CTL, 0, CTL_BYTES, stream);
    Args a{};
    for (int i = 0; i < 22; ++i) a.in[i] = (const float*)d_in[i];
    a.out = (float*)d_out; a.ws = (unsigned char*)d_ws;
#if ONE_LAUNCH
    a.ph_lo = 0; a.ph_hi = NPHASES;
    hipLaunchKernelGGL(mega_fwd, dim3(grid), dim3(NTHR), LDS_BYTES, stream, a);
#else
    for (int p = 0; p < NPHASES; ++p) { a.ph_lo = p; a.ph_hi = p + 1; hipLaunchKernelGGL(mega_fwd, dim3(grid), dim3(NTHR), LDS_BYTES, stream, a); }
#endif
}
```

```cpp
#include <hip/hip_runtime.h>
#include <cstdio>
#include <cstdint>

#ifndef ONE_LAUNCH
#define ONE_LAUNCH 1
#endif

#define LAS __attribute__((address_space(3)))
typedef unsigned short bf16;
typedef short bf16x8 __attribute__((ext_vector_type(8)));
typedef short s16x4 __attribute__((ext_vector_type(4)));
typedef float f32x4 __attribute__((ext_vector_type(4)));
typedef float f32x16 __attribute__((ext_vector_type(16)));
typedef float f32x2 __attribute__((ext_vector_type(2)));
typedef unsigned u32x4 __attribute__((ext_vector_type(4)));
typedef unsigned u32x2 __attribute__((ext_vector_type(2)));

typedef __bf16 bf16x2_t __attribute__((ext_vector_type(2)));
__device__ __forceinline__ unsigned cvt_pk_bf16(float lo, float hi) { bf16x2_t v; v[0] = (__bf16)lo; v[1] = (__bf16)hi; return __builtin_bit_cast(unsigned, v); }
__device__ __forceinline__ bf16 f2bf(float f) { unsigned u = __float_as_uint(f); u += 0x7FFFu + ((u >> 16) & 1u); return (bf16)(u >> 16); }
__device__ __forceinline__ float bf2f(bf16 b) { return __uint_as_float(((unsigned)b) << 16); }
__device__ __forceinline__ float bflo(unsigned u) { return __uint_as_float(u << 16); }
__device__ __forceinline__ float bfhi(unsigned u) { return __uint_as_float(u & 0xFFFF0000u); }
__device__ __forceinline__ float sigmoidf_(float x) { return 1.0f / (1.0f + __expf(-x)); }
__device__ __forceinline__ float siluf_(float x) { return x / (1.0f + __expf(-x)); }
__device__ __forceinline__ float max_x32(float x) { auto r = __builtin_amdgcn_permlane32_swap(__float_as_uint(x), __float_as_uint(x), false, false); return fmaxf(__uint_as_float(r[0]), __uint_as_float(r[1])); }
__device__ __forceinline__ float max_x16(float x) { auto r = __builtin_amdgcn_permlane16_swap(__float_as_uint(x), __float_as_uint(x), false, false); return fmaxf(__uint_as_float(r[0]), __uint_as_float(r[1])); }
__device__ __forceinline__ float sum_x32(float x) { auto r = __builtin_amdgcn_permlane32_swap(__float_as_uint(x), __float_as_uint(x), false, false); return __uint_as_float(r[0]) + __uint_as_float(r[1]); }
__device__ __forceinline__ float sum_x16(float x) { auto r = __builtin_amdgcn_permlane16_swap(__float_as_uint(x), __float_as_uint(x), false, false); return __uint_as_float(r[0]) + __uint_as_float(r[1]); }
__device__ __forceinline__ float dpp_x1(float x) { return __uint_as_float(__builtin_amdgcn_mov_dpp(__float_as_uint(x), 0xB1, 0xF, 0xF, true)); }
__device__ __forceinline__ float dpp_x2(float x) { return __uint_as_float(__builtin_amdgcn_mov_dpp(__float_as_uint(x), 0x4E, 0xF, 0xF, true)); }
__device__ __forceinline__ float dpp_hm(float x) { return __uint_as_float(__builtin_amdgcn_mov_dpp(__float_as_uint(x), 0x141, 0xF, 0xF, true)); }
__device__ __forceinline__ float dpp_rm(float x) { return __uint_as_float(__builtin_amdgcn_mov_dpp(__float_as_uint(x), 0x140, 0xF, 0xF, true)); }
__device__ __forceinline__ float wave_sum(float v) { v += dpp_x1(v); v += dpp_x2(v); v += dpp_hm(v); v += dpp_rm(v); v = sum_x16(v); return sum_x32(v); }
__device__ __forceinline__ float wave_max(float v) { v = fmaxf(v, dpp_x1(v)); v = fmaxf(v, dpp_x2(v)); v = fmaxf(v, dpp_hm(v)); v = fmaxf(v, dpp_rm(v)); v = max_x16(v); return max_x32(v); }
__device__ __forceinline__ int lane_id() { int l; asm volatile("v_mbcnt_lo_u32_b32 %0, -1, 0\n\tv_mbcnt_hi_u32_b32 %0, -1, %0" : "=v"(l)); return l; }
#define WAVE_SYNC() do { asm volatile("s_waitcnt lgkmcnt(0)" ::: "memory"); __builtin_amdgcn_wave_barrier(); } while (0)

#define PHASE_IDS() int tid_ph = wave_s * 64 + lane_id(); asm volatile("" : "+v"(tid_ph)); const int tid = tid_ph, lane = tid & 63, wave = __builtin_amdgcn_readfirstlane(tid >> 6), gwave = bid * NWAVES + wave; (void)tid; (void)lane; (void)wave; (void)gwave; \
    KArgsP ap = kap; asm volatile("" : "+s"(ap));     \
    unsigned char* ws = ap->ws; float* X = ap->out; const float* x_in = ap->in[0]; bf16* XB = (bf16*)(ws + WS_XB); float* LBS = (float*)(ws + WS_LBS); (void)X; (void)x_in; (void)XB; (void)LBS
namespace pg8 {
constexpr int BM = 256, BK = 64, HALF = 128, HTB = HALF * BK * 2, STAGE_BYTES = 8 * HTB, NXCD = 8, WGM = 8;
__host__ __device__ __forceinline__ int lds_byte(int r, int c) { const int st = (r >> 4) * 2 + (c >> 5), rr = r & 15, cc = c & 31, ob = rr * 64 + cc * 2; return st * 1024 + (ob ^ (((ob >> 9) & 1) << 5)); }
__host__ __device__ __forceinline__ void stage_rc(int b, int& R, int& C) { const int st = b / 1024, sb = b % 1024, swz = sb ^ (((sb >> 9) & 1) << 5); R = (st >> 1) * 16 + swz / 64; C = (st & 1) * 32 + (swz % 64) / 2; }
__host__ __device__ __forceinline__ int perm32(int rho) { const int n = rho >> 4, i = rho & 15; return 8 * (i >> 2) + 4 * n + (i & 3); }

struct Unit { int pm, pn, e; };
struct Gemm { const bf16* A; const bf16* Bt; int M, N, K; size_t bt_estride; int lda; const bf16* A2; int ksw; };

struct StaticOrder {
    int nM, nN, nwg, G, c; const int* pe;
    __device__ void init(int M, int N, int G_, int c_, const int* pe_ = nullptr) { nM = M / BM; nN = N / BM; nwg = nM * nN; G = G_; c = c_; pe = pe_; }
    __device__ bool next(int i, Unit& u) const {
        const long L = (long)i * G + c; if (L >= nwg) return false;
        int wgid = (int)L; { const int q = nwg / NXCD, r = nwg % NXCD, xcd = wgid % NXCD, off = wgid / NXCD; wgid = (xcd < r ? xcd * (q + 1) : r * (q + 1) + (xcd - r) * q) + off; }
        const int nig = WGM * nN, gid = wgid / nig, fm = gid * WGM, gsz = (nM - fm) < WGM ? (nM - fm) : WGM;
        u.pm = fm + ((wgid % nig) % gsz); u.pn = (wgid % nig) / gsz; u.e = pe ? pe[u.pm] : 0; return true;
    }
    __device__ __forceinline__ void a_ready(const Unit&) const {}
    __device__ __forceinline__ void done(const Unit&) const {}
};

template <class Epi, class Sched, bool ALIGN_EPI = true, bool SP2 = true>
__device__ __forceinline__ void gemm_phase(LAS unsigned char* lds, const Gemm g, const Sched& S, const Epi& E, const int wave_s) {
    int tid_l = wave_s * 64 + lane_id(); asm volatile("" : "+v"(tid_l));
    const int tid = tid_l, wid = __builtin_amdgcn_readfirstlane(tid >> 6), lane = tid & 63, wr = wid >> 2, wc = wid & 3, fr = lane & 15, fq = lane >> 4;
    const int K = g.K, nt = K / BK, LDA = g.lda ? g.lda : g.K;
    unsigned voffA[2], voffB[2];
#pragma unroll
    for (int i = 0; i < 2; ++i) { int R, C; stage_rc(tid * 16 + i * 8192, R, C); const int Rb = Epi::PERM ? ((R & ~31) + perm32(R & 31)) : R;
        voffA[i] = (unsigned)(R * LDA + C) * 2u; voffB[i] = (unsigned)(Rb * K + C) * 2u; }
    const size_t kstep = (size_t)(BK * 2);
    const size_t hstep = (size_t)HALF * K * 2, hstepA = (size_t)HALF * LDA * 2;
    const size_t tstep = 2 * hstep, tstepA = 2 * hstepA;
    const unsigned ldsw = (unsigned)wid * 1024u;
    const int aoff = lds_byte(wr * 64 + fr, fq * 8), boff = lds_byte(wc * 32 + fr, fq * 8);
#define PG8_SA(b, h) (((b) * 2 + (h)) * HTB)
#define PG8_SB(b, h) ((4 + (b) * 2 + (h)) * HTB)
#define PG8_STAGE(bufoff, gbase, voff) do { _Pragma("unroll") for (int _i = 0; _i < 2; ++_i) \
        __builtin_amdgcn_global_load_lds((const unsigned*)((const char*)(gbase) + (voff)[_i]), (LAS unsigned*)(lds + (bufoff) + ldsw + _i * 8192), 16, 0, 0); } while (0)
#define PG8_LDA(dst, b, h) do { _Pragma("unroll") for (int m = 0; m < 4; ++m) _Pragma("unroll") for (int k = 0; k < 2; ++k) dst[m][k] = *(const LAS bf16x8*)(lds + PG8_SA(b, h) + aoff + m * 2048 + k * 1024); } while (0)
#define PG8_LDB(dst, b, h) do { _Pragma("unroll") for (int n = 0; n < 2; ++n) _Pragma("unroll") for (int k = 0; k < 2; ++k) dst[n][k] = *(const LAS bf16x8*)(lds + PG8_SB(b, h) + boff + n * 2048 + k * 1024); } while (0)
#define PG8_MMA(ai, bj, At, Bt) do { __builtin_amdgcn_s_setprio(1); _Pragma("unroll") for (int m = 0; m < 4; ++m) _Pragma("unroll") for (int n = 0; n < 2; ++n) _Pragma("unroll") for (int k = 0; k < 2; ++k) \
        acc[ai][bj][m][n] = __builtin_amdgcn_mfma_f32_16x16x32_bf16(Bt[n][k], At[m][k], acc[ai][bj][m][n], 0, 0, 0); __builtin_amdgcn_s_setprio(0); } while (0)
#define PG8_WAIT_V(n) asm volatile("s_waitcnt vmcnt(" #n ")" ::: "memory")
#define PG8_WAIT_L(n) asm volatile("s_waitcnt lgkmcnt(" #n ")" ::: "memory")
#define PG8_BAR __builtin_amdgcn_s_barrier()
#define PG8_SCHED __builtin_amdgcn_sched_barrier(0)
    Unit cur, nxt; int ui = 0;
    if (!S.next(0, cur)) return;
    f32x4 acc[2][2][4][2];
#pragma unroll
    for (int a = 0; a < 2; ++a)
#pragma unroll
        for (int b = 0; b < 2; ++b)
#pragma unroll
            for (int m = 0; m < 4; ++m)
#pragma unroll
                for (int n = 0; n < 2; ++n) acc[a][b][m][n] = (f32x4){0.f, 0.f, 0.f, 0.f};
    bf16x8 At[4][2], B0[2][2], B1[2][2];
    const int ksw = g.ksw ? g.ksw : nt;
    const char* cA = (const char*)g.A + (size_t)cur.pm * tstepA; const char* cB = (const char*)(g.Bt + (size_t)cur.e * g.bt_estride) + (size_t)cur.pn * tstep;
    const char* cA2 = g.ksw ? (const char*)g.A2 + (size_t)cur.pm * tstepA : cA;
    S.a_ready(cur);
    if constexpr (SP2) {
        PG8_STAGE(PG8_SB(0, 0), cB, voffB); PG8_STAGE(PG8_SB(0, 1), cB + hstep, voffB); PG8_STAGE(PG8_SA(0, 0), cA, voffA); PG8_STAGE(PG8_SA(0, 1), cA + hstepA, voffA);
        if (wr == 1) PG8_BAR;
        PG8_WAIT_V(2); PG8_BAR;
        PG8_STAGE(PG8_SB(1, 0), cB + kstep, voffB); PG8_STAGE(PG8_SA(1, 0), cA + kstep, voffA); PG8_STAGE(PG8_SB(1, 1), cB + hstep + kstep, voffB);
        PG8_WAIT_V(6); PG8_BAR;
    } else {
        PG8_STAGE(PG8_SB(0, 0), cB, voffB); PG8_STAGE(PG8_SA(0, 0), cA, voffA); PG8_STAGE(PG8_SB(0, 1), cB + hstep, voffB); PG8_STAGE(PG8_SA(0, 1), cA + hstepA, voffA);
        if (wr == 1) PG8_BAR;
        PG8_WAIT_V(4); PG8_BAR;
        PG8_STAGE(PG8_SB(1, 0), cB + kstep, voffB); PG8_STAGE(PG8_SA(1, 0), cA + kstep, voffA); PG8_STAGE(PG8_SB(1, 1), cB + hstep + kstep, voffB);
        PG8_WAIT_V(6); PG8_BAR;
    }
    for (;;) {
        const bool has_next = S.next(ui + 1, nxt);
        const char* nA = has_next ? (const char*)g.A + (size_t)nxt.pm * tstepA : cA;
        const char* nA2 = (has_next && g.ksw) ? (const char*)g.A2 + (size_t)nxt.pm * tstepA : cA2;
        const char* nB = has_next ? (const char*)(g.Bt + (size_t)nxt.e * g.bt_estride) + (size_t)nxt.pn * tstep : cB;
        for (int t = 0; t < nt; t += 2) {
            const bool last = (t == nt - 2);
            const char* a1 = (t + 1 < ksw) ? cA + (size_t)(t + 1) * kstep : cA2 + (size_t)(t + 1 - ksw) * kstep;
            const char* a2 = last ? nA : ((t + 2 < ksw) ? cA + (size_t)(t + 2) * kstep : cA2 + (size_t)(t + 2 - ksw) * kstep); const char* b2 = last ? nB : cB + (size_t)(t + 2) * kstep;
            const char* a3 = a2 + kstep; const char* b3 = b2 + kstep;
            if (last && has_next) S.a_ready(nxt);
            if constexpr (Epi::HAS_MID) { if (t == ksw) E.mid(acc, cur, wr, wc, fr, fq); }
            if constexpr (SP2) {
            PG8_LDB(B0, 0, 0); PG8_LDB(B1, 0, 1); PG8_SCHED; PG8_LDA(At, 0, 0); PG8_STAGE(PG8_SA(1, 1), a1 + hstepA, voffA);
            PG8_WAIT_V(8); PG8_WAIT_L(0); PG8_BAR; PG8_MMA(0, 0, At, B0); PG8_MMA(0, 1, At, B1); PG8_BAR; PG8_SCHED;
            PG8_LDA(At, 0, 1); PG8_STAGE(PG8_SB(0, 0), b2, voffB); PG8_STAGE(PG8_SB(0, 1), b2 + hstep, voffB); PG8_STAGE(PG8_SA(0, 0), a2, voffA);
            PG8_WAIT_V(8); PG8_WAIT_L(0); PG8_BAR; PG8_MMA(1, 0, At, B0); PG8_MMA(1, 1, At, B1); PG8_BAR; PG8_SCHED;
            PG8_LDB(B0, 1, 0); PG8_LDB(B1, 1, 1); PG8_SCHED; PG8_LDA(At, 1, 0); PG8_STAGE(PG8_SA(0, 1), a2 + hstepA, voffA);
            PG8_WAIT_V(8); PG8_WAIT_L(0); PG8_BAR; PG8_MMA(0, 0, At, B0); PG8_MMA(0, 1, At, B1); PG8_BAR; PG8_SCHED;
            PG8_LDA(At, 1, 1); PG8_STAGE(PG8_SB(1, 0), b3, voffB); PG8_STAGE(PG8_SB(1, 1), b3 + hstep, voffB); PG8_STAGE(PG8_SA(1, 0), a3, voffA);
            PG8_WAIT_V(8); PG8_WAIT_L(0); PG8_BAR; PG8_MMA(1, 0, At, B0); PG8_MMA(1, 1, At, B1); PG8_BAR; PG8_SCHED;
            } else {
            PG8_LDB(B0, 0, 0); PG8_SCHED; PG8_LDA(At, 0, 0); PG8_STAGE(PG8_SA(1, 1), a1 + hstepA, voffA);
            PG8_WAIT_L(8); PG8_BAR; PG8_WAIT_L(0); PG8_MMA(0, 0, At, B0); PG8_BAR; PG8_SCHED;
            PG8_LDB(B1, 0, 1); PG8_STAGE(PG8_SB(0, 0), b2, voffB);
            PG8_BAR; PG8_WAIT_L(0); PG8_MMA(0, 1, At, B1); PG8_BAR;
            PG8_LDA(At, 0, 1); PG8_STAGE(PG8_SA(0, 0), a2, voffA);
            PG8_BAR; PG8_WAIT_L(0); PG8_MMA(1, 0, At, B0); PG8_BAR; PG8_SCHED;
            PG8_STAGE(PG8_SB(0, 1), b2 + hstep, voffB);
            PG8_WAIT_V(6); PG8_BAR; PG8_MMA(1, 1, At, B1); PG8_BAR;
            PG8_LDB(B0, 1, 0); PG8_SCHED; PG8_LDA(At, 1, 0); PG8_STAGE(PG8_SA(0, 1), a2 + hstepA, voffA);
            PG8_WAIT_L(8); PG8_BAR; PG8_WAIT_L(0); PG8_MMA(0, 0, At, B0); PG8_BAR; PG8_SCHED;
            PG8_LDB(B1, 1, 1); PG8_STAGE(PG8_SB(1, 0), b3, voffB);
            PG8_BAR; PG8_WAIT_L(0); PG8_MMA(0, 1, At, B1); PG8_BAR;
            PG8_LDA(At, 1, 1); PG8_STAGE(PG8_SA(1, 0), a3, voffA);
            PG8_BAR; PG8_WAIT_L(0); PG8_MMA(1, 0, At, B0); PG8_BAR; PG8_SCHED;
            PG8_STAGE(PG8_SB(1, 1), b3 + hstep, voffB);
            PG8_WAIT_V(6); PG8_BAR; PG8_MMA(1, 1, At, B1); PG8_BAR;
            }
        }
        if constexpr (ALIGN_EPI) { if (wr == 0) PG8_BAR; }
        E(acc, cur, wr, wc, fr, fq); S.done(cur);
        if (!has_next) break;
#pragma unroll
        for (int a = 0; a < 2; ++a)
#pragma unroll
            for (int b = 0; b < 2; ++b)
#pragma unroll
                for (int m = 0; m < 4; ++m)
#pragma unroll
                    for (int n = 0; n < 2; ++n) acc[a][b][m][n] = (f32x4){0.f, 0.f, 0.f, 0.f};
        cur = nxt; cA = nA; cA2 = nA2; cB = nB; ++ui;
        if constexpr (ALIGN_EPI) { if (wr == 1) PG8_BAR; }
    }
    PG8_WAIT_V(0);
    if constexpr (!ALIGN_EPI) { if (wr == 0) PG8_BAR; }
    PG8_BAR;
#undef PG8_SA
#undef PG8_SB
#undef PG8_STAGE
#undef PG8_LDA
#undef PG8_LDB
#undef PG8_MMA
#undef PG8_WAIT_V
#undef PG8_WAIT_L
#undef PG8_BAR
#undef PG8_SCHED
}
}

#define XB_TMO      128
#define XB_XCNT(j)  (256  + 64 * (j))
#define XB_XSUB(j)  (1280 + 64 * (j))
#define XB_XGEN(j)  (2304 + 64 * (j))
#define XB_TOP      3328
#define XB_TOPGEN   3392
#define XCD_BAR_WORDS 3456
#define XB_SPIN_CAP (1u << 18)
__device__ __forceinline__ unsigned xb_ld(unsigned* p)              { return __hip_atomic_load(p, __ATOMIC_RELAXED, __HIP_MEMORY_SCOPE_AGENT); }
__device__ __forceinline__ unsigned xb_add(unsigned* p, unsigned v) { return __hip_atomic_fetch_add(p, v, __ATOMIC_RELAXED, __HIP_MEMORY_SCOPE_AGENT); }
__device__ __forceinline__ unsigned xb_xcc_id() { return (unsigned)__builtin_amdgcn_s_getreg((3 << 11) | 20) & 0xFu; }
#define XB_SPIN(cond, bar) do { unsigned _sp = 0; while (cond) { __builtin_amdgcn_s_sleep(1); \
    if ((++_sp & 255u) == 0u) { if (xb_ld(&(bar)[XB_TMO])) break; if (_sp > XB_SPIN_CAP) { atomicAdd(&(bar)[XB_TMO], 1u); break; } } } } while (0)
struct XcdBarrier { unsigned* bar; unsigned x; volatile LAS unsigned* st; };
__device__ __forceinline__ XcdBarrier xcd_barrier_post(unsigned* bar, volatile LAS unsigned* st, const bool leader) {
    XcdBarrier b; b.bar = bar; b.x = xb_xcc_id(); b.st = st;
    if (leader) (void)xb_add(&bar[XB_XCNT(b.x)], 1u);
    return b;
}
__device__ __forceinline__ void xcd_barrier_complete(unsigned* bar, unsigned x, unsigned& nloc, unsigned& nx) {
    const unsigned G = gridDim.x * gridDim.y * gridDim.z;
    unsigned sum, cnt, mine, sp = 0u;
    for (;;) {
        sum = 0u; cnt = 0u; mine = 0u;
#pragma unroll
        for (unsigned j = 0; j < 16; ++j) { const unsigned c = xb_ld(&bar[XB_XCNT(j)]); sum += c; cnt += (c > 0u) ? 1u : 0u; mine = (j == x) ? c : mine; }
        if (sum == G) break;
        __builtin_amdgcn_s_sleep(1);
        if ((++sp & 255u) == 0u) { if (xb_ld(&bar[XB_TMO])) break; if (sp > XB_SPIN_CAP) { atomicAdd(&bar[XB_TMO], 1u); break; } }
    }
    nloc = mine > 0u ? mine : 1u; nx = cnt > 0u ? cnt : 1u;
}
__device__ __forceinline__ void xcd_barrier(const XcdBarrier& b, const bool leader) {
    asm volatile("s_waitcnt vmcnt(0)" ::: "memory");
    __syncthreads();
    if (leader) {
        unsigned* bar = b.bar;
        __builtin_amdgcn_s_waitcnt(0);
        unsigned nloc = b.st[0], nx = b.st[1];
        if (nloc == 0u) { xcd_barrier_complete(bar, b.x, nloc, nx); b.st[0] = nloc; b.st[1] = nx; }
        const unsigned old = xb_add(&bar[XB_XSUB(b.x)], 1u);
        const unsigned gen = old / nloc;
        if (old + 1u == (gen + 1u) * nloc) {
            __builtin_amdgcn_fence(__ATOMIC_RELEASE, "agent");
            asm volatile("s_waitcnt vmcnt(0)" ::: "memory");
            const unsigned og = xb_add(&bar[XB_TOP], 1u);
            const unsigned tg = og / nx;
            if (og + 1u == (tg + 1u) * nx) xb_add(&bar[XB_TOPGEN], 1u);
            else XB_SPIN(xb_ld(&bar[XB_TOPGEN]) == tg, bar);
            __builtin_amdgcn_fence(__ATOMIC_ACQUIRE, "agent");
            xb_add(&bar[XB_XGEN(b.x)], 1u);
            asm volatile("s_waitcnt vmcnt(0)" ::: "memory");
        } else {
            XB_SPIN(xb_ld(&bar[XB_XGEN(b.x)]) == gen, bar);
            __builtin_amdgcn_fence(__ATOMIC_ACQUIRE, "agent");
            asm volatile("s_waitcnt vmcnt(0)" ::: "memory");
        }
    }
    __syncthreads();
}

constexpr int NB = 4, SEQ = 8192, DM = 1024, NT = NB * SEQ;
constexpr int NINP = 5632;
constexpr int FF0 = 2752, FF0P = 2816, FFE = 3584, NEXP = 8;
constexpr int NWAVES = 8, NTHR = 512;
constexpr int LDS_BYTES = 155648;
constexpr int MISC_OFF = LDS_BYTES - 64;
constexpr float DN_ALPHA = 1.41421356237309515f;
constexpr int MAXPANELS = 272;
constexpr int MAXCHUNK = 5;

constexpr size_t al256(size_t x) { return (x + 255) & ~(size_t)255; }
constexpr size_t WS_CTL = 0;
constexpr size_t CTL_BYTES = 65536;
constexpr size_t CW_BAR = 0;
constexpr size_t CW_BLKCNT = 16384;
constexpr size_t CW_META = 16384 + 8192;
constexpr size_t CW_PANELE = 16384 + 8192 + 256;
constexpr size_t CW_PE32 = 16384 + 8192 + 2048;
constexpr size_t CW_PROBE = 16384 + 8192 + 4096;
constexpr size_t WS_LBS = WS_CTL + CTL_BYTES;
constexpr size_t WS_KC = WS_LBS + 4096;
constexpr size_t WS_VC = WS_KC + 1048576;
constexpr size_t WS_DEC = WS_VC + 1048576;
constexpr size_t WS_TOPI = WS_DEC + 1048576;
constexpr size_t WS_TOPG = WS_TOPI + (size_t)NT * 4;
constexpr size_t WS_ROWINFO = WS_TOPG + (size_t)NT * 8;
constexpr size_t WS_HID = al256(WS_ROWINFO + (size_t)MAXPANELS * 256 * 4);
constexpr size_t WS_B1 = WS_HID + (size_t)8192 * 128 * 2;
constexpr size_t WS_BIG = al256(WS_B1 + 4096);
constexpr size_t SZ_WIN = (size_t)NINP * DM * 2, SZ_WBR = (size_t)DM * 512 * 2, SZ_WOUT = (size_t)DM * DM * 2;
constexpr size_t WS_WIN0 = WS_BIG, WS_WIN1 = WS_WIN0 + SZ_WIN;
constexpr size_t WS_WBA0 = WS_WIN1 + SZ_WIN, WS_WBA1 = WS_WBA0 + SZ_WBR, WS_WBB0 = WS_WBA1 + SZ_WBR, WS_WBB1 = WS_WBB0 + SZ_WBR;
constexpr size_t WS_WOUT0 = WS_WBB1 + SZ_WBR, WS_WOUT1 = WS_WOUT0 + SZ_WOUT;
constexpr size_t WS_WGU0 = WS_WOUT1 + SZ_WOUT;
constexpr size_t WS_WDN0 = WS_WGU0 + (size_t)NINP * DM * 2;
constexpr size_t WS_W1T = WS_WDN0 + (size_t)DM * FF0P * 2;
constexpr size_t WS_XB = WS_W1T + (size_t)2 * 2 * 256 * 2048 * 2;
constexpr size_t WS_US = WS_XB;
constexpr size_t WS_PROJ = WS_XB + (size_t)NT * DM * 2;
constexpr size_t WS_QHG = WS_PROJ;
constexpr size_t WS_HF = WS_QHG + (size_t)NT * 512 * 2;
constexpr size_t WS_HI = WS_HF + (size_t)NT * 512 * 4;
constexpr size_t WS_HG = WS_HI + (size_t)NT * 512 * 2;
constexpr size_t WS_NQ = WS_HG + (size_t)NT * 512 * 2;
constexpr size_t WS_KV6 = WS_NQ + (size_t)NT * 512 * 2;
constexpr size_t WS_GA = WS_KV6 + (size_t)NT * 768 * 2;
constexpr size_t WS_GB = WS_GA + (size_t)NT * DM * 2;
constexpr size_t WS_NG = WS_GB + (size_t)NT * DM * 2;
constexpr size_t WS_MIX_END = WS_NG + (size_t)NT * 32 * 4;
constexpr size_t WS_H0 = WS_PROJ;
constexpr size_t WS_MGU = WS_BIG;
constexpr size_t WS_MDN = WS_MGU + (size_t)NEXP * 2 * FFE * DM * 2;
constexpr size_t WS_XS = WS_MDN + (size_t)NEXP * DM * FFE * 2;
constexpr size_t WS_HM = WS_XS + (size_t)MAXPANELS * 256 * DM * 2;
constexpr size_t WS_YM = WS_HM + (size_t)64 * 256 * FFE * 2;
constexpr size_t WS_MOE_END = WS_YM + (size_t)NT * 2 * DM * 2;
constexpr size_t WS_END = WS_MOE_END > WS_MIX_END ? WS_MOE_END : WS_MIX_END;

struct Args {
    const float* in[22]; float* out; unsigned char* ws; int ph_lo, ph_hi;
};
typedef const __attribute__((address_space(4))) Args* KArgsP;

struct EpiInProj {
    static constexpr bool PERM = false, HAS_MID = false;
    unsigned char* ws;
    __device__ __forceinline__ void operator()(const f32x4 (&acc)[2][2][4][2], const pg8::Unit& u, int wr, int wc, int fr, int fq) const {
        const int row0 = u.pm * 256 + wr * 64 + fr;
#pragma unroll
        for (int bj = 0; bj < 2; ++bj)
#pragma unroll
            for (int n = 0; n < 2; ++n) {
                const int cb = u.pn * 256 + bj * 128 + wc * 32 + n * 16;
                const int c = cb + 4 * fq;
                int kind = 0, ld = 512, co = 0; size_t base = 0; float sc = 1.f;
                if (cb < 512) { base = WS_QHG; co = c; }
                else if (cb < 1024) { kind = 1; base = WS_HF; co = c - 512; }
                else if (cb < 1536) { base = WS_HI; co = c - 1024; }
                else if (cb < 2048) { base = WS_HG; co = c - 1536; }
                else if (cb < 2560) { base = WS_NQ; co = c - 2048; sc = 0.125f * 1.4426950408889634f; }
                else if (cb < 3328) { kind = 3; base = WS_KV6; const int idx = cb - 2560; co = ((idx >> 7) * 8 + ((idx >> 6) & 1)) * SEQ * 64 + (idx & 63) + 4 * fq; }
                else if (cb < 4352) { base = WS_GA; co = c - 3328; ld = 1024; }
                else if (cb < 5376) { base = WS_GB; co = c - 4352; ld = 1024; }
                else if (cb < 5408) { kind = 1; base = WS_NG; co = c - 5376; ld = 32; }
                else kind = 2;
                if (kind == 2) continue;
#pragma unroll
                for (int ai = 0; ai < 2; ++ai)
#pragma unroll
                    for (int m = 0; m < 4; ++m) {
                        const int row = row0 + ai * 128 + m * 16;
                        const f32x4 v = acc[ai][bj][m][n];
                        if (kind == 0) { u32x2 w; w.x = cvt_pk_bf16(v[0] * sc, v[1] * sc); w.y = cvt_pk_bf16(v[2] * sc, v[3] * sc); *(u32x2*)((bf16*)(ws + base) + (size_t)row * ld + co) = w; }
                        else if (kind == 3) { u32x2 w; w.x = cvt_pk_bf16(v[0], v[1]); w.y = cvt_pk_bf16(v[2], v[3]); *(u32x2*)((bf16*)(ws + base) + (size_t)co + ((size_t)(row >> 13) * 2 * SEQ + (row & (SEQ - 1))) * 64) = w; }
                        else *(f32x4*)((float*)(ws + base) + (size_t)row * ld + co) = v;
                    }
            }
    }
};
struct EpiCmpHid {
    static constexpr bool PERM = false, HAS_MID = false;
    bf16* HID; const float* B1;
    __device__ __forceinline__ void operator()(const f32x4 (&acc)[2][2][4][2], const pg8::Unit& u, int wr, int wc, int fr, int fq) const {
        const int row0 = u.pm * 256 + wr * 64 + fr, col0 = wc * 32 + 4 * fq;
#pragma unroll
        for (int n = 0; n < 2; ++n) { const f32x4 bq = *(const f32x4*)(B1 + u.e * 128 + col0 + n * 16);
#pragma unroll
            for (int ai = 0; ai < 2; ++ai)
#pragma unroll
                for (int m = 0; m < 4; ++m) { const f32x4 v = acc[ai][0][m][n] + bq; float o[4];
#pragma unroll
                    for (int q = 0; q < 4; ++q) { const float x = v[q]; o[q] = 0.5f * x * (1.f + tanhf(0.7978845608028654f * (x + 0.044715f * x * x * x))); }
                    u32x2 w; w.x = cvt_pk_bf16(o[0], o[1]); w.y = cvt_pk_bf16(o[2], o[3]);
                    *(u32x2*)(HID + (size_t)(row0 + ai * 128 + m * 16) * 128 + col0 + n * 16) = w; } }
    }
};
template <bool FIRST> struct EpiGate {
    static constexpr bool PERM = false, HAS_MID = false;
    bf16* Y; const bf16* G;
    __device__ __forceinline__ void operator()(const f32x4 (&acc)[2][2][4][2], const pg8::Unit& u, int wr, int wc, int fr, int fq) const {
        const int row0 = u.pm * 256 + wr * 64 + fr, col0 = u.pn * 256 + wc * 32 + 4 * fq;
#pragma unroll
        for (int ai = 0; ai < 2; ++ai)
#pragma unroll
            for (int m = 0; m < 4; ++m)
#pragma unroll
                for (int bj = 0; bj < 2; ++bj)
#pragma unroll
                    for (int n = 0; n < 2; ++n) {
                        const size_t off = (size_t)(row0 + ai * 128 + m * 16) * DM + col0 + bj * 128 + n * 16;
                        const u32x2 gq = *(const u32x2*)(G + off);
                        const f32x4 v = acc[ai][bj][m][n];
                        float o0 = sigmoidf_(bflo(gq.x)) * v[0], o1 = sigmoidf_(bfhi(gq.x)) * v[1], o2 = sigmoidf_(bflo(gq.y)) * v[2], o3 = sigmoidf_(bfhi(gq.y)) * v[3];
                        if (!FIRST) { const u32x2 yq = *(const u32x2*)(Y + off); o0 += bflo(yq.x); o1 += bfhi(yq.x); o2 += bflo(yq.y); o3 += bfhi(yq.y); }
                        u32x2 w; w.x = cvt_pk_bf16(o0, o1); w.y = cvt_pk_bf16(o2, o3); *(u32x2*)(Y + off) = w;
                    }
    }
};
struct EpiGate2 {
    static constexpr bool PERM = false, HAS_MID = true;
    bf16* Y; const bf16* GA; const bf16* GB;
    static __device__ __forceinline__ float cl(float x) { return fminf(fmaxf(x, -30.f), 30.f); }
    __device__ __forceinline__ void mid(f32x4 (&acc)[2][2][4][2], const pg8::Unit& u, int wr, int wc, int fr, int fq) const {
        int row0 = u.pm * 256 + wr * 64 + fr; const int col0 = u.pn * 256 + wc * 32 + 4 * fq;
        asm volatile("" : "+v"(row0));
#pragma unroll
        for (int ai = 0; ai < 2; ++ai)
#pragma unroll
            for (int m = 0; m < 4; ++m) {
#pragma unroll
                for (int bj = 0; bj < 2; ++bj)
#pragma unroll
                    for (int n = 0; n < 2; ++n) {
                        const size_t off = (size_t)(row0 + ai * 128 + m * 16) * DM + col0 + bj * 128 + n * 16;
                        const u32x2 ga = *(const u32x2*)(GA + off), gb = *(const u32x2*)(GB + off);
                        f32x4 r;
                        r[0] = (1.f + __expf(-cl(bflo(gb.x)))) * __builtin_amdgcn_rcpf(1.f + __expf(-cl(bflo(ga.x))));
                        r[1] = (1.f + __expf(-cl(bfhi(gb.x)))) * __builtin_amdgcn_rcpf(1.f + __expf(-cl(bfhi(ga.x))));
                        r[2] = (1.f + __expf(-cl(bflo(gb.y)))) * __builtin_amdgcn_rcpf(1.f + __expf(-cl(bflo(ga.y))));
                        r[3] = (1.f + __expf(-cl(bfhi(gb.y)))) * __builtin_amdgcn_rcpf(1.f + __expf(-cl(bfhi(ga.y))));
                        acc[ai][bj][m][n] = acc[ai][bj][m][n] * r;
                    }
                asm volatile("" : "+v"(acc[ai][0][m][0]), "+v"(acc[ai][0][m][1]), "+v"(acc[ai][1][m][0]), "+v"(acc[ai][1][m][1]) :: "memory");
            }
    }
    __device__ __forceinline__ void operator()(const f32x4 (&acc)[2][2][4][2], const pg8::Unit& u, int wr, int wc, int fr, int fq) const {
        const int row0 = u.pm * 256 + wr * 64 + fr, col0 = u.pn * 256 + wc * 32 + 4 * fq;
#pragma unroll
        for (int ai = 0; ai < 2; ++ai)
#pragma unroll
            for (int m = 0; m < 4; ++m)
#pragma unroll
                for (int bj = 0; bj < 2; ++bj)
#pragma unroll
                    for (int n = 0; n < 2; ++n) {
                        const size_t off = (size_t)(row0 + ai * 128 + m * 16) * DM + col0 + bj * 128 + n * 16;
                        const u32x2 gb = *(const u32x2*)(GB + off);
                        const f32x4 v = acc[ai][bj][m][n];
                        u32x2 w; w.x = cvt_pk_bf16(v[0] * sigmoidf_(cl(bflo(gb.x))), v[1] * sigmoidf_(cl(bfhi(gb.x)))); w.y = cvt_pk_bf16(v[2] * sigmoidf_(cl(bflo(gb.y))), v[3] * sigmoidf_(cl(bfhi(gb.y))));
                        *(u32x2*)(Y + off) = w;
                    }
    }
};
struct EpiResid {
    static constexpr bool PERM = false, HAS_MID = false;
    const float* XI; float* XO;
    __device__ __forceinline__ void operator()(const f32x4 (&acc)[2][2][4][2], const pg8::Unit& u, int wr, int wc, int fr, int fq) const {
        const int row0 = u.pm * 256 + wr * 64 + fr, col0 = u.pn * 256 + wc * 32 + 4 * fq;
#pragma unroll
        for (int ai = 0; ai < 2; ++ai)
#pragma unroll
            for (int m = 0; m < 4; ++m)
#pragma unroll
                for (int bj = 0; bj < 2; ++bj)
#pragma unroll
                    for (int n = 0; n < 2; ++n) {
                        const size_t off = (size_t)(row0 + ai * 128 + m * 16) * DM + col0 + bj * 128 + n * 16;
                        const f32x4 xi = *(const f32x4*)(XI + off);
                        *(f32x4*)(XO + off) = xi * DN_ALPHA + acc[ai][bj][m][n];
                    }
    }
};
struct EpiSwiglu {
    static constexpr bool PERM = false, HAS_MID = false;
    bf16* H; int ldh;
    __device__ __forceinline__ void operator()(const f32x4 (&acc)[2][2][4][2], const pg8::Unit& u, int wr, int wc, int fr, int fq) const {
        const int row0 = u.pm * 256 + wr * 64 + fr, col0 = u.pn * 128 + wc * 32 + 4 * fq;
#pragma unroll
        for (int ai = 0; ai < 2; ++ai)
#pragma unroll
            for (int m = 0; m < 4; ++m)
#pragma unroll
                for (int n = 0; n < 2; ++n) {
                    const f32x4 gq = acc[ai][0][m][n], uq = acc[ai][1][m][n];
                    u32x2 w; w.x = cvt_pk_bf16(siluf_(gq[0]) * uq[0], siluf_(gq[1]) * uq[1]); w.y = cvt_pk_bf16(siluf_(gq[2]) * uq[2], siluf_(gq[3]) * uq[3]);
                    *(u32x2*)(H + (size_t)(row0 + ai * 128 + m * 16) * ldh + col0 + n * 16) = w;
                }
    }
};
struct EpiScatter {
    static constexpr bool PERM = false, HAS_MID = false;
    bf16* Y; const int* rowinfo;
    __device__ __forceinline__ void operator()(const f32x4 (&acc)[2][2][4][2], const pg8::Unit& u, int wr, int wc, int fr, int fq) const {
        const int row0 = u.pm * 256 + wr * 64 + fr, col0 = u.pn * 256 + wc * 32 + 4 * fq;
#pragma unroll
        for (int ai = 0; ai < 2; ++ai)
#pragma unroll
            for (int m = 0; m < 4; ++m) {
                const int info = rowinfo[row0 + ai * 128 + m * 16];
                if (info < 0) continue;
#pragma unroll
                for (int bj = 0; bj < 2; ++bj)
#pragma unroll
                    for (int n = 0; n < 2; ++n) {
                        const f32x4 v = acc[ai][bj][m][n];
                        u32x2 w; w.x = cvt_pk_bf16(v[0], v[1]); w.y = cvt_pk_bf16(v[2], v[3]);
                        *(u32x2*)(Y + (size_t)info * DM + col0 + bj * 128 + n * 16) = w;
                    }
            }
    }
};

__device__ __forceinline__ int rel_bucket(int n) {
    if (n < 16) return n;
    return 16 + (n >= 22) + (n >= 30) + (n >= 40) + (n >= 54) + (n >= 73) + (n >= 99) + (n >= 134) + (n >= 182) + (n >= 246) + (n >= 332) + (n >= 450) + (n >= 609) + (n >= 825) + (n >= 1117) + (n >= 1513);
}
template <class F>
__device__ __forceinline__ void tr_item(F colptr, int ld, int Kvalid, bf16* dst, int dstld, int n0, int k0, LAS float* scr, int lane) {
    const float* cp = colptr(n0 + 4 * (lane & 7));
#pragma unroll
    for (int i = 0; i < 8; ++i) { const int kk = 8 * i + (lane >> 3), k = k0 + kk; f32x4 v = (f32x4){0.f, 0.f, 0.f, 0.f}; if (cp && k < Kvalid) v = *(const f32x4*)(cp + (size_t)k * ld);
        LAS float* s = scr + kk * 33 + 4 * (lane & 7); s[0] = v[0]; s[1] = v[1]; s[2] = v[2]; s[3] = v[3]; }
    WAVE_SYNC();
    const int c = lane & 7;
#pragma unroll
    for (int j = 0; j < 4; ++j) { const int n = (lane >> 3) + 8 * j; const LAS float* s = scr + (8 * c) * 33 + n;
        u32x4 o; o.x = cvt_pk_bf16(s[0 * 33], s[1 * 33]); o.y = cvt_pk_bf16(s[2 * 33], s[3 * 33]); o.z = cvt_pk_bf16(s[4 * 33], s[5 * 33]); o.w = cvt_pk_bf16(s[6 * 33], s[7 * 33]);
        *(u32x4*)(dst + (size_t)(n0 + n) * dstld + k0 + 8 * c) = o; }
    WAVE_SYNC();
}

__global__ void __launch_bounds__(NTHR, 2) mega_fwd(Args args) {
    extern __shared__ __attribute__((aligned(16))) unsigned char lds_raw[];
    LAS unsigned char* lds = (LAS unsigned char*)lds_raw;
    const int G = gridDim.x, bid = blockIdx.x;
    const int nwaves = G * NWAVES;
    KArgsP kap = (KArgsP)__builtin_amdgcn_kernarg_segment_ptr();
    unsigned char* ws0 = kap->ws;
#if ONE_LAUNCH
    constexpr int lo = 0, hi = 64;
#else
    const int lo = kap->ph_lo, hi = kap->ph_hi;
#endif

    volatile LAS unsigned* misc = (volatile LAS unsigned*)(lds + MISC_OFF);
    const int wave_s = __builtin_amdgcn_readfirstlane((int)threadIdx.x >> 6);
    if (wave_s == 0 && lane_id() < 16) misc[lane_id()] = 0u;
    __syncthreads();
    XcdBarrier bar; bar.bar = (unsigned*)(ws0 + WS_CTL + CW_BAR); bar.x = 0; bar.st = misc;
    const bool multi = (hi - lo) > 1;
    if (multi) bar = xcd_barrier_post((unsigned*)(ws0 + WS_CTL + CW_BAR), misc, wave_s == 0 && lane_id() == 0);
#ifndef EN_MASK
#define EN_MASK 0xFFFFFFFFu
#endif
#define EN(b) (((EN_MASK) >> (b)) & 1u)
#define IN(k) (lo <= (k) && (k) < hi)
#ifndef PROBE_GRP
#define PROBE_GRP -1
#endif
#define PROBE_K 4
#ifndef SELREP
#define SELREP 1
#endif
#define WINREP 1
#define NSA_SGB 1
#define NSA_DUP_A 0
#define NSA_DUP_B 0
#define NSA_DUP_C 0
#ifndef PROBE_SCALE
#define PROBE_SCALE 1e-6f
#endif
#if PROBE_GRP >= 0
    unsigned long long pr_last = __builtin_amdgcn_s_memrealtime(), pr_acc = 0ull;
#define PMARK(g) do { const unsigned long long _n = __builtin_amdgcn_s_memrealtime(); if ((g) == PROBE_GRP) pr_acc += _n - pr_last; pr_last = _n; } while (0)
#else
    const unsigned long long pr_acc = 0ull; (void)pr_acc;
#define PMARK(g) do { } while (0)
#endif
#define SEAM(k, g) do { if (IN(k) && IN((k) + 1)) { XcdBarrier b_ = bar; asm volatile("" : "+s"(b_.bar)); unsigned bx_ = b_.x; asm volatile("" : "+s"(bx_)); b_.x = bx_; \
        xcd_barrier(b_, wave_s == 0 && lane_id() == 0); } PMARK(g); } while (0)


    if (EN(0) && IN(0)) { PHASE_IDS();
        LAS float* scr = (LAS float*)(lds + wave * 16384);
        constexpr int I_WIN = 16 * (NINP / 32), I_BR = 8 * 32, I_OUT = 16 * 32, I_GU = 16 * (NINP / 32), I_DN = (FF0P / 64) * 32;
        constexpr int I_W1 = 32 * 8;
        constexpr int NITEMS = 2 * (I_WIN + 2 * I_BR + I_OUT) + I_GU + I_DN + 4 * I_W1;
        for (int it = gwave; it < NITEMS; it += nwaves) {
            int r = it;
            if (r < 2 * I_WIN) { const int l = r / I_WIN; r %= I_WIN; const int nb = r % (NINP / 32), kb = r / (NINP / 32);
                const float* W = ap->in[1] + (size_t)l * DM * 5400;
                auto cp = [=](int n) -> const float* { int c; if (n < 3328) c = n; else if (n < 5376) c = n + 24; else if (n < 5400) c = n - 5376 + 3328; else return nullptr; return W + c; };
                tr_item(cp, 5400, DM, (bf16*)(ws + (l ? WS_WIN1 : WS_WIN0)), DM, nb * 32, kb * 64, scr, lane); continue; }
            r -= 2 * I_WIN;
            if (r < 4 * I_BR) { const int which = r / I_BR; r %= I_BR; const int l = which & 1, ab = which >> 1; const int nb = r % 32, kb = r / 32;
                const float* W = ap->in[ab ? 9 : 8] + (size_t)l * 512 * DM;
                auto cp = [=](int n) -> const float* { return W + n; };
                tr_item(cp, DM, 512, (bf16*)(ws + WS_WBA0 + (size_t)l * 2 * SZ_WBR) + ab * 512, DM, nb * 32, kb * 64, scr, lane); continue; }
            r -= 4 * I_BR;
            if (r < 2 * I_OUT) { const int l = r / I_OUT; r %= I_OUT; const int nb = r % 32, kb = r / 32;
                const float* W = ap->in[10] + (size_t)l * DM * DM;
                auto cp = [=](int n) -> const float* { return W + n; };
                tr_item(cp, DM, DM, (bf16*)(ws + (l ? WS_WOUT1 : WS_WOUT0)), DM, nb * 32, kb * 64, scr, lane); continue; }
            r -= 2 * I_OUT;
            if (r < I_GU) { const int nb = r % (NINP / 32), kb = r / (NINP / 32);
                const float* Wg = ap->in[15]; const float* Wu = ap->in[16];
                auto cp = [=](int n) -> const float* { const int pn = n >> 8, hf = (n >> 7) & 1, c = pn * 128 + (n & 127); if (c >= FF0) return nullptr; return (hf ? Wu : Wg) + c; };
                tr_item(cp, FF0, DM, (bf16*)(ws + WS_WGU0), DM, nb * 32, kb * 64, scr, lane); continue; }
            r -= I_GU;
            if (r >= I_DN) { r -= I_DN; const int lk = r / I_W1; r %= I_W1; const int nb = r % 8, kb = r / 8;
                const float* W = ap->in[5] + (size_t)lk * 2048 * 128;
                auto cp = [=](int n) -> const float* { return n < 128 ? W + n : nullptr; };
                tr_item(cp, 128, 2048, (bf16*)(ws + WS_W1T) + (size_t)lk * 256 * 2048, 2048, nb * 32, kb * 64, scr, lane); continue; }
            { const int nb = r % 32, kb = r / 32;
                const float* W = ap->in[17];
                auto cp = [=](int n) -> const float* { return W + n; };
                tr_item(cp, DM, FF0, (bf16*)(ws + WS_WDN0), FF0P, nb * 32, kb * 64, scr, lane); }
        }
        for (int row = gwave; row < NT; row += nwaves) {
            const f32x4* xr = (const f32x4*)(x_in + (size_t)row * DM);
            u32x2* o = (u32x2*)(XB + (size_t)row * DM);
#pragma unroll
            for (int j = 0; j < 4; ++j) { const f32x4 v = xr[64 * j + lane]; u32x2 w; w.x = cvt_pk_bf16(v[0], v[1]); w.y = cvt_pk_bf16(v[2], v[3]); o[64 * j + lane] = w; }
        }
        for (int o = gwave; o < 4 * 128; o += nwaves) { const int lk = o >> 7, j = o & 127; const float* PS = ap->in[4] + (size_t)lk * 2048; const float* W = ap->in[5] + (size_t)lk * 2048 * 128;
            float s = 0.f; for (int k = lane; k < 2048; k += 64) s += PS[k] * W[(size_t)k * 128 + j];
            s = wave_sum(s); if (lane == 0) ((float*)(ws + WS_B1))[o] = s; }
        if (bid == 0 && tid < 32) ((int*)(ws + WS_CTL + CW_PE32))[tid] = tid >> 4;
        if (bid == 0) {
            const float* lg = ap->in[2];
            const float a = lg[tid], b = lg[512 + tid], m = fmaxf(a, b), ea = expf(a - m), eb = expf(b - m), s = ea + eb, p0 = ea / s, p1 = eb / s;
            LBS[tid] = p0 - p0; LBS[512 + tid] = (p0 + p1) - p0;
        }
    }
    SEAM(0, 0);

    for (int l = 0; l < 2; ++l) {
        const int pb = 1 + l * 10;

        if (EN(1) && IN(pb + 0)) { PHASE_IDS();
            pg8::Gemm g{XB, (const bf16*)(ws + (l ? WS_WIN1 : WS_WIN0)), NT, NINP, DM, 0, 0, nullptr, 0};
            pg8::StaticOrder S; S.init(NT, NINP, G, bid);
            EpiInProj E{ws};
            pg8::gemm_phase<EpiInProj, pg8::StaticOrder>(lds, g, S, E, wave_s);
        }
        SEAM(pb + 0, 1);

        if (EN(2) && IN(pb + 1)) { PHASE_IDS();
            {
                constexpr int RS = 272;
                LAS float* bsf = (LAS float*)lds;
                LAS unsigned char* kd = lds + 32768;
                LAS unsigned char* vt = lds + 32768 + 64 * RS;
                const bf16* HI = (const bf16*)(ws + WS_HI); const float* HF = (const float*)(ws + WS_HF);
                bf16* US = (bf16*)(ws + WS_US); float* DEC = (float*)(ws + WS_DEC);
                const int d = tid & 127, tp = tid >> 7;
                float zr[16];
                auto ld_z = [&](int it) { const int h = it & 3, ci = (it >> 2) & 127, b = it >> 9; const size_t tok0 = (size_t)b * SEQ + ci * 64;
#pragma unroll
                    for (int i = 0; i < 16; ++i) zr[i] = HF[(tok0 + tp + 4 * i) * 512 + h * 128 + d]; };
                ld_z(bid);
                for (int item = bid; item < NB * 128 * 4; item += G) {
                    const int h = item & 3, ci = (item >> 2) & 127, b = item >> 9, bh = b * 4 + h;
                    const size_t tok0 = (size_t)b * SEQ + ci * 64;
                    const float lb = LBS[l * 512 + h * 128 + d];
                    float kk[16];
#pragma unroll
                    for (int i = 0; i < 16; ++i) { const int t = tp + 4 * i;
                        kk[i] = (1.f - lb) * __builtin_amdgcn_rcpf(1.f + __expf(zr[i])); bsf[t * 128 + d] = __logf(1.f - kk[i]); }
                    { const int t = tid >> 3, c8 = tid & 7;
                        const u32x4* src = (const u32x4*)(HI + (tok0 + t) * 512 + h * 128) + c8 * 2;
                        const u32x4 a0 = src[0], a1 = src[1]; *(LAS u32x4*)(vt + t * RS + c8 * 32) = a0; *(LAS u32x4*)(vt + t * RS + c8 * 32 + 16) = a1; }
                    __syncthreads();
                    { float run = 0.f;
#pragma unroll
                        for (int i = 0; i < 16; ++i) { run += bsf[(16 * tp + i) * 128 + d]; bsf[(16 * tp + i) * 128 + d] = run; } }
                    __syncthreads();
                    float off = 0.f;
                    for (int p = 0; p < tp; ++p) off += bsf[(16 * p + 15) * 128 + d];
                    __syncthreads();
#pragma unroll
                    for (int i = 0; i < 16; ++i) bsf[(16 * tp + i) * 128 + d] += off;
                    __syncthreads();
                    { const float blast = bsf[63 * 128 + d];
                        if (tp == 0) DEC[((size_t)bh * 128 + ci) * 128 + d] = __expf(blast);
#pragma unroll
                        for (int i = 0; i < 16; ++i) { const int t = tp + 4 * i; *(LAS bf16*)(kd + t * RS + d * 2) = f2bf(kk[i] * __expf(blast - bsf[t * 128 + d])); } }
                    __syncthreads();
                    if (item + G < NB * 128 * 4) ld_z(item + G);
                    {
                        const int mi = wave >> 1, r31 = lane & 31, hh = lane >> 5, i16 = lane & 15, sub = (lane >> 4) & 1;
                        f32x16 acc[2];
#pragma unroll
                        for (int q = 0; q < 2; ++q)
#pragma unroll
                            for (int r = 0; r < 16; ++r) acc[q][r] = 0.f;
#pragma unroll
                        for (int st = 0; st < 4; ++st) {
                            const LAS unsigned char* ka = kd + (16 * st + 8 * hh + (i16 >> 2)) * RS + (32 * mi + 16 * sub + 4 * (i16 & 3)) * 2;
                            const s16x4 k0 = __builtin_amdgcn_ds_read_tr16_b64_v4i16((LAS s16x4*)ka), k1 = __builtin_amdgcn_ds_read_tr16_b64_v4i16((LAS s16x4*)(ka + 4 * RS));
                            const bf16x8 af = __builtin_shufflevector(k0, k1, 0, 1, 2, 3, 4, 5, 6, 7);
#pragma unroll
                            for (int q = 0; q < 2; ++q) { const int ni = 2 * (wave & 1) + q;
                                const LAS unsigned char* va = vt + (16 * st + 8 * hh + (i16 >> 2)) * RS + (32 * ni + 16 * sub + 4 * (i16 & 3)) * 2;
                                const s16x4 v0 = __builtin_amdgcn_ds_read_tr16_b64_v4i16((LAS s16x4*)va), v1 = __builtin_amdgcn_ds_read_tr16_b64_v4i16((LAS s16x4*)(va + 4 * RS));
                                const bf16x8 bf = __builtin_shufflevector(v0, v1, 0, 1, 2, 3, 4, 5, 6, 7);
                                acc[q] = __builtin_amdgcn_mfma_f32_32x32x16_bf16(af, bf, acc[q], 0, 0, 0); } }
                        bf16* u = US + ((size_t)bh * 128 + ci) * 16384;
#pragma unroll
                        for (int q = 0; q < 2; ++q) { const int dv = 32 * (2 * (wave & 1) + q) + r31;
#pragma unroll
                            for (int rq = 0; rq < 4; ++rq) { u32x2 w; w.x = cvt_pk_bf16(acc[q][4 * rq], acc[q][4 * rq + 1]); w.y = cvt_pk_bf16(acc[q][4 * rq + 2], acc[q][4 * rq + 3]);
                                *(u32x2*)(u + dv * 128 + 32 * mi + 8 * rq + 4 * hh) = w; } }
                    }
                    __syncthreads();
                }
            }
            {
                pg8::Gemm g{(const bf16*)(ws + WS_KV6), (const bf16*)(ws + WS_W1T) + (size_t)l * 2 * 256 * 2048, 8192, 256, 2048, (size_t)256 * 2048, 1024, nullptr, 0};
                pg8::StaticOrder S; S.init(8192, 256, G, bid, (const int*)(ws + WS_CTL + CW_PE32));
                EpiCmpHid E{(bf16*)(ws + WS_HID), (const float*)(ws + WS_B1) + l * 256};
                pg8::gemm_phase<EpiCmpHid, pg8::StaticOrder>(lds, g, S, E, wave_s);
            }
        }
        SEAM(pb + 1, 2);

        if (EN(3) && IN(pb + 2)) { PHASE_IDS();
            {
                unsigned* US32 = (unsigned*)(ws + WS_US); const float* DEC = (const float*)(ws + WS_DEC);
                for (int e2 = bid * NTHR + tid; e2 < 16 * 8192; e2 += G * NTHR) {
                    const int bh = e2 >> 13, dv2 = e2 & 8191, d = (2 * dv2) & 127;
                    float s0 = 0.f, s1 = 0.f;
#pragma unroll 1
                    for (int c0 = 0; c0 < 128; c0 += 16) {
                        unsigned u[16]; f32x2 dec[16];
#pragma unroll
                        for (int i = 0; i < 16; ++i) { u[i] = US32[((size_t)bh * 128 + c0 + i) * 8192 + dv2]; dec[i] = *(const f32x2*)(DEC + ((size_t)bh * 128 + c0 + i) * 128 + d); }
#pragma unroll
                        for (int i = 0; i < 16; ++i) { US32[((size_t)bh * 128 + c0 + i) * 8192 + dv2] = cvt_pk_bf16(s0, s1); s0 = dec[i][0] * s0 + bflo(u[i]); s1 = dec[i][1] * s1 + bfhi(u[i]); }
                    }
                }
            }
            {
                const bf16* HID = (const bf16*)(ws + WS_HID); bf16* KCb = (bf16*)(ws + WS_KC);
                for (int row = gwave; row < 8192; row += nwaves) { const int kind = row >> 12;
                    const float* W2 = ap->in[6] + ((size_t)l * 2 + kind) * 128 * 64;
                    const unsigned hv = ((const unsigned*)(HID + (size_t)row * 128))[lane];
                    float o = 0.f;
#pragma unroll 8
                    for (int j = 0; j < 64; ++j) { const unsigned hj = (unsigned)__builtin_amdgcn_readlane((int)hv, j); o += bflo(hj) * W2[(2 * j) * 64 + lane] + bfhi(hj) * W2[(2 * j + 1) * 64 + lane]; }
                    KCb[(size_t)row * 64 + lane] = f2bf(o); }
            }
        }
        SEAM(pb + 2, 3);

        if (EN(4) && IN(pb + 3)) {
          if (EN(16)) { PHASE_IDS();
            {
                constexpr int RS = 272;
                LAS float* bsf = (LAS float*)lds;
                LAS unsigned char* qh = lds + 32768;
                LAS unsigned char* q1 = qh + 64 * RS;
                LAS unsigned char* k0 = q1 + 32 * RS;
                LAS unsigned char* k1 = k0 + 32 * RS;
                LAS unsigned char* vt = k1 + 64 * RS;
                LAS float* ssq = (LAS float*)(vt + 64 * RS);
                bf16* QHG = (bf16*)(ws + WS_QHG); const bf16* HI = (const bf16*)(ws + WS_HI); const bf16* HG = (const bf16*)(ws + WS_HG); const float* HF = (const float*)(ws + WS_HF);
                const bf16* US = (const bf16*)(ws + WS_US);
                const float* NW = ap->in[3] + l * 512;
                const int d = tid & 127, tp = tid >> 7;
                for (int item = bid; item < NB * 128 * 4; item += G) {
                    const int h = item & 3, ci = (item >> 2) & 127, b = item >> 9, bh = b * 4 + h;
                    const size_t tok0 = (size_t)b * SEQ + ci * 64;
                    const float lb = LBS[l * 512 + h * 128 + d];
                    bf16x8 sf[8];
                    { const bf16* Sg = US + ((size_t)bh * 128 + ci) * 16384 + (size_t)(32 * (wave & 3) + (lane & 31)) * 128 + 8 * (lane >> 5);
#pragma unroll
                        for (int st = 0; st < 8; ++st) sf[st] = *(const bf16x8*)(Sg + 16 * st); }
                    float kk[16], qv[16];
#pragma unroll
                    for (int i = 0; i < 16; ++i) { const int t = tp + 4 * i; const size_t go = (tok0 + t) * 512 + h * 128 + d; const float z = HF[go];
                        kk[i] = (1.f - lb) * __builtin_amdgcn_rcpf(1.f + __expf(z)); bsf[t * 128 + d] = __logf(1.f - kk[i]); qv[i] = bf2f(QHG[go]); }
                    { const int t = tid >> 3, c8 = tid & 7;
                        const u32x4* src = (const u32x4*)(HI + (tok0 + t) * 512 + h * 128) + c8 * 2;
                        const u32x4 a0 = src[0], a1 = src[1]; *(LAS u32x4*)(vt + t * RS + c8 * 32) = a0; *(LAS u32x4*)(vt + t * RS + c8 * 32 + 16) = a1; }
                    __syncthreads();
                    { float run = 0.f;
#pragma unroll
                        for (int i = 0; i < 16; ++i) { run += bsf[(16 * tp + i) * 128 + d]; bsf[(16 * tp + i) * 128 + d] = run; } }
                    __syncthreads();
                    float off = 0.f;
                    for (int p = 0; p < tp; ++p) off += bsf[(16 * p + 15) * 128 + d];
                    __syncthreads();
#pragma unroll
                    for (int i = 0; i < 16; ++i) bsf[(16 * tp + i) * 128 + d] += off;
                    __syncthreads();
                    { const float b31 = bsf[31 * 128 + d];
#pragma unroll
                        for (int i = 0; i < 16; ++i) { const int t = tp + 4 * i; const float bt = bsf[t * 128 + d];
                            *(LAS bf16*)(qh + t * RS + d * 2) = f2bf(qv[i] * __expf(bt));
                            *(LAS bf16*)(k1 + t * RS + d * 2) = f2bf(kk[i] * __expf(fminf(b31 - bt, 80.f)));
                            if (t < 32) *(LAS bf16*)(k0 + t * RS + d * 2) = f2bf(kk[i] * __expf(fminf(-bt, 80.f)));
                            else *(LAS bf16*)(q1 + (t - 32) * RS + d * 2) = f2bf(qv[i] * __expf(bt - b31)); } }
                    __syncthreads();
                    {
                        const int ni = wave & 3, mi = wave >> 2, r31 = lane & 31, hh = lane >> 5, i16 = lane & 15, sub = (lane >> 4) & 1;
                        f32x16 acc;
#pragma unroll
                        for (int r = 0; r < 16; ++r) acc[r] = 0.f;
#pragma unroll
                        for (int st = 0; st < 8; ++st) { const bf16x8 bq = *(const LAS bf16x8*)(qh + (32 * mi + r31) * RS + (16 * st + 8 * hh) * 2);
                            acc = __builtin_amdgcn_mfma_f32_32x32x16_bf16(sf[st], bq, acc, 0, 0, 0); }
#pragma unroll
                        for (int jb = 0; jb < 2; ++jb) { if (jb > mi) continue;
                            f32x16 x;
#pragma unroll
                            for (int r = 0; r < 16; ++r) x[r] = 0.f;
                            const LAS unsigned char* kb = (mi == 0) ? k0 : (k1 + 32 * jb * RS);
                            const LAS unsigned char* qb = (mi == 0) ? qh : q1;
#pragma unroll
                            for (int st = 0; st < 8; ++st) { const bf16x8 ka = *(const LAS bf16x8*)(kb + r31 * RS + (16 * st + 8 * hh) * 2), qq = *(const LAS bf16x8*)(qb + r31 * RS + (16 * st + 8 * hh) * 2);
                                x = __builtin_amdgcn_mfma_f32_32x32x16_bf16(ka, qq, x, 0, 0, 0); }
                            if (jb == mi) {
#pragma unroll
                                for (int r = 0; r < 16; ++r) { const int key = (r & 3) + 8 * (r >> 2) + 4 * hh; if (key > r31) x[r] = 0.f; } }
#pragma unroll
                            for (int s2 = 0; s2 < 2; ++s2) { u32x4 w; w.x = cvt_pk_bf16(x[8 * s2], x[8 * s2 + 1]); w.y = cvt_pk_bf16(x[8 * s2 + 2], x[8 * s2 + 3]); w.z = cvt_pk_bf16(x[8 * s2 + 4], x[8 * s2 + 5]); w.w = cvt_pk_bf16(x[8 * s2 + 6], x[8 * s2 + 7]);
                                const bf16x8 xb = __builtin_bit_cast(bf16x8, w);
                                const LAS unsigned char* va = vt + (32 * jb + 16 * s2 + 4 * hh + (i16 >> 2)) * RS + (32 * ni + 16 * sub + 4 * (i16 & 3)) * 2;
                                const s16x4 v0 = __builtin_amdgcn_ds_read_tr16_b64_v4i16((LAS s16x4*)va), v1 = __builtin_amdgcn_ds_read_tr16_b64_v4i16((LAS s16x4*)(va + 8 * RS));
                                const bf16x8 vf = __builtin_shufflevector(v0, v1, 0, 1, 2, 3, 4, 5, 6, 7);
                                acc = __builtin_amdgcn_mfma_f32_32x32x16_bf16(vf, xb, acc, 0, 0, 0); } }
                        u32x2 gq4[4];
                        { const size_t gg = (tok0 + 32 * mi + r31) * 512 + h * 128 + 32 * ni + 4 * hh;
#pragma unroll
                          for (int rq = 0; rq < 4; ++rq) gq4[rq] = *(const u32x2*)(HG + gg + 8 * rq); }
                        float ss = 0.f;
#pragma unroll
                        for (int r = 0; r < 16; ++r) ss += acc[r] * acc[r];
                        ss += __shfl_xor(ss, 32);
                        if (hh == 0) ssq[ni * 64 + 32 * mi + r31] = ss;
                        __syncthreads();
                        const int tl = 32 * mi + r31;
                        const float tot = ssq[tl] + ssq[64 + tl] + ssq[128 + tl] + ssq[192 + tl];
                        const float rn = rsqrtf(tot * (1.f / 128.f) + 1e-6f);
                        const size_t go = (tok0 + tl) * 512 + h * 128 + 32 * ni + 4 * hh;
#pragma unroll
                        for (int rq = 0; rq < 4; ++rq) { const u32x2 gq = gq4[rq]; const f32x4 nw = *(const f32x4*)(NW + h * 128 + 32 * ni + 4 * hh + 8 * rq);
                            u32x2 w; w.x = cvt_pk_bf16(acc[4 * rq] * rn * nw[0] * siluf_(bflo(gq.x)), acc[4 * rq + 1] * rn * nw[1] * siluf_(bfhi(gq.x)));
                            w.y = cvt_pk_bf16(acc[4 * rq + 2] * rn * nw[2] * siluf_(bflo(gq.y)), acc[4 * rq + 3] * rn * nw[3] * siluf_(bfhi(gq.y)));
                            *(u32x2*)(QHG + go + 8 * rq) = w; }
                    }
                    __syncthreads();
                }
            }
          }
          PMARK(15);
          if (EN(17)) { PHASE_IDS();
            {
                constexpr int KST = 144, TB = 9216;
                constexpr float LOG2E = 1.4426950408889634f;
                LAS unsigned char* kvb = lds;
                LAS float* lut = (LAS float*)(lds + 4 * TB);
                LAS float* impW = (LAS float*)(lds + 4 * TB + 32768 + wave * 8192);
                LAS float* ocl = impW + lane;
                LAS unsigned* selm = (LAS unsigned*)(lds + 4 * TB + 32768 + 65536);
                const bf16* NQ = (const bf16*)(ws + WS_NQ); const bf16* KVT = (const bf16*)(ws + WS_KV6); const bf16* KCb = (const bf16*)(ws + WS_KC);
                const float* NG = (const float*)(ws + WS_NG); const float* RB = ap->in[7];
                bf16* OB = (bf16*)(ws + WS_NQ);
                const int col = lane & 15, q4 = lane >> 4, head = col & 3, ti = col >> 2;
                const float NINF = -__builtin_inff();
                const bool lut_once = (G & 7) == 0;
                LAS float* gld = (LAS float*)(lds + 4 * TB + 32768 + 65536 + 1024) + wave * 96;
                if (lut_once) { const int g = bid & 1; __syncthreads();
                    for (int d = tid; d < 2048; d += NTHR) { const int bk = rel_bucket(d); *(LAS f32x4*)(lut + d * 4) = *(const f32x4*)(RB + bk * 8 + g * 4) * LOG2E; } }
                for (int pq = bid; pq < 512; pq += G)
#pragma unroll 1
                for (int odd = 0; odd < 2; ++odd) {
                    const int bg = pq & 7, xx = pq >> 3, tile = odd ? 127 - xx : xx, b = bg >> 1, g = bg & 1, t0 = tile * 64, cur = tile;
                    const size_t tokw = (size_t)b * SEQ + t0 + 8 * wave;
                    int tq[2]; bf16x8 qf[2][2];
                    auto gatev = [&](int gq, int br) -> float { return gld[(gq * 3 + br) * 16 + col]; };
                    float gl[6];
#pragma unroll
                    for (int gq = 0; gq < 2; ++gq)
#pragma unroll
                        for (int br = 0; br < 3; ++br) gl[gq * 3 + br] = NG[(tokw + 4 * gq + ti) * 32 + (g * 4 + head) * 3 + br];
#pragma unroll
                    for (int gq = 0; gq < 2; ++gq) { tq[gq] = t0 + 8 * wave + 4 * gq + ti; const size_t tok = tokw + 4 * gq + ti;
#pragma unroll
                        for (int s = 0; s < 2; ++s) qf[gq][s] = *(const bf16x8*)(NQ + tok * 512 + (g * 4 + head) * 64 + 32 * s + 8 * q4);
                    }
                    const float bfar = RB[31 * 8 + g * 4 + head] * LOG2E;
                    __syncthreads();
                    if (!lut_once) for (int d = tid; d < 2048; d += NTHR) { const int bk = rel_bucket(d); *(LAS f32x4*)(lut + d * 4) = *(const f32x4*)(RB + bk * 8 + g * 4) * LOG2E; }
                    for (int i = lane; i < 8 * 128; i += 64) impW[i] = 0.f;
                    f32x4 O[2][4], Ls[2];
                    float m[2], l[2], m1[2] = {0.f, 0.f}, linv[2] = {0.f, 0.f}, carry[2] = {0.f, 0.f};
                    const bf16x8 ones8 = {0x3F80, 0x3F80, 0x3F80, 0x3F80, 0x3F80, 0x3F80, 0x3F80, 0x3F80};
                    auto soft = [&](const int mode, const int gq, f32x4 (&st)[4], bf16x8 (&pb)[2], const int pos0, const bool far, const bool full, const float cbias, const bool colsel, const int sblk0) {
                        float tmax = NINF;
                        if (far) {
#pragma unroll
                            for (int kt = 0; kt < 4; ++kt)
#pragma unroll
                                for (int r = 0; r < 4; ++r) tmax = fmaxf(tmax, st[kt][r]);
                            tmax += cbias;
                        } else if (mode >= 2) {
                            const int dbase = tq[gq] - (pos0 + 4 * q4);
                            const LAS float* lb = lut + (dbase - 51) * 4 + head;
                            const float cadd = (mode == 2 && !colsel) ? NINF : 0.f;
                            float bv[4][4];
#pragma unroll
                            for (int kt = 0; kt < 4; ++kt)
#pragma unroll
                                for (int r = 0; r < 4; ++r) bv[kt][r] = lb[(51 - 16 * kt - r) * 4];
                            asm volatile("" : "+v"(bv[0][0]), "+v"(bv[0][1]), "+v"(bv[0][2]), "+v"(bv[0][3]), "+v"(bv[1][0]), "+v"(bv[1][1]), "+v"(bv[1][2]), "+v"(bv[1][3]));
                            asm volatile("" : "+v"(bv[2][0]), "+v"(bv[2][1]), "+v"(bv[2][2]), "+v"(bv[2][3]), "+v"(bv[3][0]), "+v"(bv[3][1]), "+v"(bv[3][2]), "+v"(bv[3][3]));
#pragma unroll
                            for (int kt = 0; kt < 4; ++kt)
#pragma unroll
                                for (int r = 0; r < 4; ++r) { float sv = st[kt][r] + bv[kt][r];
                                    if (mode == 2) sv += cadd;
                                    if (!full) { const int dist = dbase - (16 * kt + r); const bool valid = (mode == 3) ? ((unsigned)dist < 512u) : (dist >= 0); sv = valid ? sv : NINF; }
                                    st[kt][r] = sv; tmax = fmaxf(tmax, sv); }
                        } else {
                            const int dbase = tq[gq] - 16 * (pos0 + 4 * q4) - 31;
                            float bv[4][4];
#pragma unroll
                            for (int kt = 0; kt < 4; ++kt)
#pragma unroll
                                for (int r = 0; r < 4; ++r) { const int dist = dbase - 16 * (16 * kt + r); const unsigned di = (unsigned)dist < 2047u ? (unsigned)dist : 2047u; bv[kt][r] = lut[di * 4 + head]; }
#pragma unroll
                            for (int kt = 0; kt < 4; ++kt)
#pragma unroll
                                for (int r = 0; r < 4; ++r) { float sv = st[kt][r] + bv[kt][r];
                                    if (!full) { const int dist = dbase - 16 * (16 * kt + r); sv = (dist >= 0) ? sv : NINF; }
                                    st[kt][r] = sv; tmax = fmaxf(tmax, sv); }
                        }
                        float muse;
                        if (mode == 1) muse = m1[gq];
                        else {
                            tmax = max_x16(tmax); tmax = max_x32(tmax);
                            const float mnew = fmaxf(m[gq], tmax);
                            if (__any(mnew != m[gq])) {
                                const float mu = (mnew == NINF) ? 0.f : mnew;
                                const float alpha = __builtin_amdgcn_exp2f(m[gq] - mu);
                                m[gq] = mnew; l[gq] *= alpha;
                                if (mode >= 2) { Ls[gq] = Ls[gq] * alpha;
#pragma unroll
                                    for (int mt = 0; mt < 4; ++mt) O[gq][mt] = O[gq][mt] * alpha; }
                            }
                            muse = (m[gq] == NINF) ? 0.f : m[gq];
                        }
                        const float esub = far ? muse - cbias : muse;
                        float ls = 0.f;
#pragma unroll
                        for (int kt = 0; kt < 4; ++kt)
#pragma unroll
                            for (int r = 0; r < 4; ++r) { float p = __builtin_amdgcn_exp2f(st[kt][r] - esub); if (mode == 1) p *= linv[gq]; st[kt][r] = p; if (mode <= 1) ls += p; }
#if NSA_DUP_B
                        if (mode == 2) { float acc2 = 0.f;
#pragma unroll
                            for (int kt = 0; kt < 4; ++kt)
#pragma unroll
                                for (int r = 0; r < 4; ++r) { float x = st[kt][r]; asm volatile("" : "+v"(x)); const float p2 = __builtin_amdgcn_exp2f(x * 0.5f - esub); acc2 = fmaxf(acc2, p2 + x); }
                            asm volatile("" :: "v"(acc2)); }
#endif
                        if (mode <= 1) l[gq] += ls;
                        if (mode == 1) {
                            float a[4], h3[4];
#pragma unroll
                            for (int kt = 0; kt < 4; ++kt) { a[kt] = st[kt][0] + st[kt][1] + st[kt][2] + 0.5f * st[kt][3]; h3[kt] = 0.5f * st[kt][3];
                                a[kt] += dpp_x1(a[kt]); a[kt] += dpp_x2(a[kt]); h3[kt] += dpp_x1(h3[kt]); h3[kt] += dpp_x2(h3[kt]); }
#pragma unroll
                            for (int kt = 0; kt < 4; ++kt) { const float give = (q4 == 3) ? (kt > 0 ? h3[kt - 1] : carry[gq]) : h3[kt];
                                const float prev = __shfl(give, (lane - 16) & 63);
                                if (head == 0) impW[(4 * gq + ti) * 128 + sblk0 + 4 * kt + q4] = a[kt] + prev; }
                            carry[gq] = h3[3];
                        }
                        if (mode != 0) {
#pragma unroll
                            for (int s = 0; s < 2; ++s) { u32x4 w; w.x = cvt_pk_bf16(st[2 * s][0], st[2 * s][1]); w.y = cvt_pk_bf16(st[2 * s][2], st[2 * s][3]);
                                w.z = cvt_pk_bf16(st[2 * s + 1][0], st[2 * s + 1][1]); w.w = cvt_pk_bf16(st[2 * s + 1][2], st[2 * s + 1][3]); pb[s] = __builtin_bit_cast(bf16x8, w); } }
                    };
                    auto tile2 = [&](const int mode, const LAS unsigned char* kbuf, const LAS unsigned char* vbuf, const int pos0, const bool far, const bool full, const bool a0, const bool a1,
                                     const float cb0, const float cb1, const bool cs0, const bool cs1, const int sblk0) {
                        f32x4 st0[4], st1[4]; bf16x8 pb0[2], pb1[2];
#pragma unroll
                        for (int kt = 0; kt < 4; ++kt) {
                            const bf16x8 kf0 = *(const LAS bf16x8*)(kbuf + (16 * kt + col) * KST + 16 * q4), kf1 = *(const LAS bf16x8*)(kbuf + (16 * kt + col) * KST + 64 + 16 * q4);
                            if (a0) { st0[kt] = __builtin_amdgcn_mfma_f32_16x16x32_bf16(kf0, qf[0][0], (f32x4){0.f, 0.f, 0.f, 0.f}, 0, 0, 0); st0[kt] = __builtin_amdgcn_mfma_f32_16x16x32_bf16(kf1, qf[0][1], st0[kt], 0, 0, 0); }
                            if (a1) { st1[kt] = __builtin_amdgcn_mfma_f32_16x16x32_bf16(kf0, qf[1][0], (f32x4){0.f, 0.f, 0.f, 0.f}, 0, 0, 0); st1[kt] = __builtin_amdgcn_mfma_f32_16x16x32_bf16(kf1, qf[1][1], st1[kt], 0, 0, 0); } }
#if NSA_DUP_A
                        if (mode == 2) {
#pragma unroll
                            for (int kt = 0; kt < 4; ++kt) {
                                const bf16x8 kf0 = *(const LAS bf16x8*)(kbuf + (16 * kt + col) * KST + 16 * q4 + 32), kf1 = *(const LAS bf16x8*)(kbuf + (16 * kt + col) * KST + 64 + 16 * q4 - 32);
                                f32x4 d0 = __builtin_amdgcn_mfma_f32_16x16x32_bf16(kf0, qf[0][0], (f32x4){0.f, 0.f, 0.f, 0.f}, 0, 0, 0); d0 = __builtin_amdgcn_mfma_f32_16x16x32_bf16(kf1, qf[0][1], d0, 0, 0, 0);
                                f32x4 d1 = __builtin_amdgcn_mfma_f32_16x16x32_bf16(kf0, qf[1][0], (f32x4){0.f, 0.f, 0.f, 0.f}, 0, 0, 0); d1 = __builtin_amdgcn_mfma_f32_16x16x32_bf16(kf1, qf[1][1], d1, 0, 0, 0);
                                asm volatile("" :: "v"(d0), "v"(d1)); } }
#endif
                        if (a0) soft(mode, 0, st0, pb0, pos0, far, full, cb0, cs0, sblk0);
                        if (a1) soft(mode, 1, st1, pb1, pos0, far, full, cb1, cs1, sblk0);
                        if (mode == 0) return;
#pragma unroll
                        for (int mt = 0; mt < 4; ++mt)
#pragma unroll
                            for (int s = 0; s < 2; ++s) { const LAS unsigned char* a = vbuf + (32 * s + 4 * q4 + (col >> 2)) * KST + (16 * mt + 4 * (col & 3)) * 2;
                                const s16x4 lo = __builtin_amdgcn_ds_read_tr16_b64_v4i16((LAS s16x4*)a), hi = __builtin_amdgcn_ds_read_tr16_b64_v4i16((LAS s16x4*)(a + 16 * KST));
                                const bf16x8 vfs = __builtin_shufflevector(lo, hi, 0, 1, 2, 3, 4, 5, 6, 7);
                                if (a0) O[0][mt] = __builtin_amdgcn_mfma_f32_16x16x32_bf16(vfs, pb0[s], O[0][mt], 0, 0, 0);
                                if (a1) O[1][mt] = __builtin_amdgcn_mfma_f32_16x16x32_bf16(vfs, pb1[s], O[1][mt], 0, 0, 0); }
                        if (mode >= 2) {
#pragma unroll
                            for (int s = 0; s < 2; ++s) { if (a0) Ls[0] = __builtin_amdgcn_mfma_f32_16x16x32_bf16(ones8, pb0[s], Ls[0], 0, 0, 0); if (a1) Ls[1] = __builtin_amdgcn_mfma_f32_16x16x32_bf16(ones8, pb1[s], Ls[1], 0, 0, 0); } }
                    };
                    auto soft_far = [&](const int gq, f32x4 (&st)[4], bf16x8 (&pb)[2], const float cbias) {
                        float tmax = fmaxf(fmaxf(fmaxf(st[0][0], st[0][1]), fmaxf(st[0][2], st[0][3])), fmaxf(fmaxf(st[1][0], st[1][1]), fmaxf(st[1][2], st[1][3])));
                        tmax = fmaxf(tmax, fmaxf(fmaxf(fmaxf(st[2][0], st[2][1]), fmaxf(st[2][2], st[2][3])), fmaxf(fmaxf(st[3][0], st[3][1]), fmaxf(st[3][2], st[3][3]))));
                        tmax += cbias; tmax = max_x16(tmax); tmax = max_x32(tmax);
                        const float mnew = fmaxf(m[gq], tmax), mu = (mnew == NINF) ? 0.f : mnew, alpha = __builtin_amdgcn_exp2f(m[gq] - mu);
                        m[gq] = mnew; Ls[gq] = Ls[gq] * alpha;
#pragma unroll
                        for (int mt = 0; mt < 4; ++mt) O[gq][mt] = O[gq][mt] * alpha;
                        const float esub = mu - cbias;
#pragma unroll
                        for (int kt = 0; kt < 4; ++kt)
#pragma unroll
                            for (int r = 0; r < 4; ++r) st[kt][r] = __builtin_amdgcn_exp2f(st[kt][r] - esub);
#pragma unroll
                        for (int s = 0; s < 2; ++s) { u32x4 w; w.x = cvt_pk_bf16(st[2 * s][0], st[2 * s][1]); w.y = cvt_pk_bf16(st[2 * s][2], st[2 * s][3]);
                            w.z = cvt_pk_bf16(st[2 * s + 1][0], st[2 * s + 1][1]); w.w = cvt_pk_bf16(st[2 * s + 1][2], st[2 * s + 1][3]); pb[s] = __builtin_bit_cast(bf16x8, w); }
                    };
                    auto tile_far2 = [&](const LAS unsigned char* kbuf, const LAS unsigned char* vbuf, const float cb0, const float cb1) {
                        f32x4 st0[4], st1[4]; bf16x8 pb0[2], pb1[2];
#pragma unroll
                        for (int kt = 0; kt < 4; ++kt) { const bf16x8 kf0 = *(const LAS bf16x8*)(kbuf + (16 * kt + col) * KST + 16 * q4), kf1 = *(const LAS bf16x8*)(kbuf + (16 * kt + col) * KST + 64 + 16 * q4);
                            st0[kt] = __builtin_amdgcn_mfma_f32_16x16x32_bf16(kf0, qf[0][0], (f32x4){0.f, 0.f, 0.f, 0.f}, 0, 0, 0); st0[kt] = __builtin_amdgcn_mfma_f32_16x16x32_bf16(kf1, qf[0][1], st0[kt], 0, 0, 0);
                            st1[kt] = __builtin_amdgcn_mfma_f32_16x16x32_bf16(kf0, qf[1][0], (f32x4){0.f, 0.f, 0.f, 0.f}, 0, 0, 0); st1[kt] = __builtin_amdgcn_mfma_f32_16x16x32_bf16(kf1, qf[1][1], st1[kt], 0, 0, 0); }
                        soft_far(0, st0, pb0, cb0);
                        soft_far(1, st1, pb1, cb1);
#pragma unroll
                        for (int mt = 0; mt < 4; ++mt)
#pragma unroll
                            for (int s = 0; s < 2; ++s) { const LAS unsigned char* a = vbuf + (32 * s + 4 * q4 + (col >> 2)) * KST + (16 * mt + 4 * (col & 3)) * 2;
                                const s16x4 lo = __builtin_amdgcn_ds_read_tr16_b64_v4i16((LAS s16x4*)a), hi = __builtin_amdgcn_ds_read_tr16_b64_v4i16((LAS s16x4*)(a + 16 * KST));
                                const bf16x8 vfs = __builtin_shufflevector(lo, hi, 0, 1, 2, 3, 4, 5, 6, 7);
                                O[0][mt] = __builtin_amdgcn_mfma_f32_16x16x32_bf16(vfs, pb0[s], O[0][mt], 0, 0, 0);
                                O[1][mt] = __builtin_amdgcn_mfma_f32_16x16x32_bf16(vfs, pb1[s], O[1][mt], 0, 0, 0); }
#pragma unroll
                        for (int s = 0; s < 2; ++s) { Ls[0] = __builtin_amdgcn_mfma_f32_16x16x32_bf16(ones8, pb0[s], Ls[0], 0, 0, 0); Ls[1] = __builtin_amdgcn_mfma_f32_16x16x32_bf16(ones8, pb1[s], Ls[1], 0, 0, 0); }
#if NSA_SGB
                        __builtin_amdgcn_sched_group_barrier(0x100, 8, 0); __builtin_amdgcn_sched_group_barrier(0x008, 16, 0);
                        __builtin_amdgcn_sched_group_barrier(0x002, 64, 0); __builtin_amdgcn_sched_group_barrier(0x400, 17, 0); __builtin_amdgcn_sched_group_barrier(0x002, 40, 0);
                        __builtin_amdgcn_sched_group_barrier(0x100, 16, 0);
#pragma unroll
                        for (int i = 0; i < 10; ++i) { __builtin_amdgcn_sched_group_barrier(0x008, 1, 0); __builtin_amdgcn_sched_group_barrier(0x002, 7, 0); __builtin_amdgcn_sched_group_barrier(0x400, 2, 0); }
                        __builtin_amdgcn_sched_group_barrier(0x002, 40, 0);
                        __builtin_amdgcn_sched_group_barrier(0x008, 10, 0);
#endif
                    };
                    auto ld_tile = [&](const bf16* src) -> u32x4 { return *(const u32x4*)(src + tid * 8); };
                    auto st_tile = [&](LAS unsigned char* buf, const u32x4 v) { *(LAS u32x4*)(buf + (tid >> 3) * KST + (tid & 7) * 16) = v; };
                    auto zeroO = [&]() {
#pragma unroll
                        for (int gq = 0; gq < 2; ++gq) { m[gq] = NINF; l[gq] = 0.f; Ls[gq] = (f32x4){0.f, 0.f, 0.f, 0.f};
#pragma unroll
                            for (int mt = 0; mt < 4; ++mt) O[gq][mt] = (f32x4){0.f, 0.f, 0.f, 0.f}; } };
                    const int ntc = (4 * tile + 3 + 63) >> 6;
                    const bf16* kcb = KCb + (size_t)bg * 512 * 64; const bf16* vcb = KCb + (size_t)(8 + bg) * 512 * 64;
                    {
                        zeroO();
                        u32x4 rk = ld_tile(kcb);
                        st_tile(kvb, rk); if (ntc > 1) rk = ld_tile(kcb + 4096);
                        __syncthreads();
#pragma unroll 1
                        for (int i = 0; i < ntc; ++i) { LAS unsigned char* cb = kvb + (i & 1) * 2 * TB;
                            if (i + 1 < ntc) st_tile(kvb + ((i + 1) & 1) * 2 * TB, rk);
                            if (i + 2 < ntc) rk = ld_tile(kcb + (size_t)(i + 2) * 4096);
                            const bool far = (t0 - (16 * (64 * i + 63) + 31)) >= 1513;
                            tile2(0, cb, cb + TB, 64 * i, far, (16 * (64 * i + 63) + 31) <= t0, true, true, bfar, bfar, true, true, 0);
                            __syncthreads(); }
                    }
#pragma unroll
                    for (int gq = 0; gq < 2; ++gq) { float lt = sum_x32(sum_x16(l[gq])); linv[gq] = 1.f / fmaxf(lt, 1e-30f); m1[gq] = (m[gq] == NINF) ? 0.f : m[gq]; }
                    if (q4 == 0) {
#pragma unroll
                        for (int k6 = 0; k6 < 6; ++k6) gld[k6 * 16 + col] = sigmoidf_(gl[k6]); }
                    {
                        zeroO();
                        u32x4 rk = ld_tile(kcb), rv = ld_tile(vcb);
                        st_tile(kvb, rk); st_tile(kvb + TB, rv); if (ntc > 1) { rk = ld_tile(kcb + 4096); rv = ld_tile(vcb + 4096); }
                        __syncthreads();
#pragma unroll 1
                        for (int i = 0; i < ntc; ++i) { LAS unsigned char* cb = kvb + (i & 1) * 2 * TB;
                            if (i + 1 < ntc) { LAS unsigned char* nb = kvb + ((i + 1) & 1) * 2 * TB; st_tile(nb, rk); st_tile(nb + TB, rv); }
                            if (i + 2 < ntc) { rk = ld_tile(kcb + (size_t)(i + 2) * 4096); rv = ld_tile(vcb + (size_t)(i + 2) * 4096); }
                            const bool far = (t0 - (16 * (64 * i + 63) + 31)) >= 1513;
                            tile2(1, cb, cb + TB, 64 * i, far, (16 * (64 * i + 63) + 31) <= t0, true, true, bfar, bfar, true, true, 16 * i);
                            __syncthreads(); }
                    }
                    WAVE_SYNC();
                    {
                        const int tt = lane >> 3, sub = lane & 7;
                        unsigned key[16];
                        const LAS f32x4* ip = (const LAS f32x4*)(impW + tt * 128 + sub * 16);
#pragma unroll
                        for (int q = 0; q < 4; ++q) { const f32x4 v = ip[q];
#pragma unroll
                            for (int e2 = 0; e2 < 4; ++e2) { const int i = 4 * q + e2, s = sub * 16 + i;
                                const bool forced = (s == 0) || (s == cur) || (s == cur - 1);
                                const unsigned k = forced ? 0x7FFFFF80u : ((__float_as_uint(v[e2]) & 0xFFFFFF80u) + 128u);
                                key[i] = (s <= cur) ? (k | (unsigned)(127 - s)) : 0u; } }
                        unsigned w0 = 0u, w1 = 0u, w2 = 0u, w3 = 0u;
#pragma unroll 1
                        for (int k = 0; k < 16; ++k) {
                            unsigned best = key[0];
#pragma unroll
                            for (int i = 1; i < 16; ++i) best = best > key[i] ? best : key[i];
                            { const unsigned o1 = (unsigned)__builtin_amdgcn_mov_dpp((int)best, 0xB1, 0xF, 0xF, true); best = best > o1 ? best : o1;
                              const unsigned o2 = (unsigned)__builtin_amdgcn_mov_dpp((int)best, 0x4E, 0xF, 0xF, true); best = best > o2 ? best : o2;
                              const unsigned o3 = (unsigned)__builtin_amdgcn_mov_dpp((int)best, 0x141, 0xF, 0xF, true); best = best > o3 ? best : o3; }
#pragma unroll
                            for (int i = 0; i < 16; ++i) key[i] = (key[i] == best) ? 0u : key[i];
                            if (best != 0u) { const int idx = 127 - (int)(best & 127u); const unsigned bit = 1u << (idx & 31); const int wd = idx >> 5;
                                w0 |= wd == 0 ? bit : 0u; w1 |= wd == 1 ? bit : 0u; w2 |= wd == 2 ? bit : 0u; w3 |= wd == 3 ? bit : 0u; }
                        }
                        if (sub == 0) { LAS unsigned* sp = selm + (8 * wave + tt) * 4; sp[0] = w0; sp[1] = w1; sp[2] = w2; sp[3] = w3; }
                    }
                    WAVE_SYNC();
#pragma unroll
                    for (int gq = 0; gq < 2; ++gq) { const float g0 = gatev(gq, 0);
#pragma unroll
                        for (int mt = 0; mt < 4; ++mt)
#pragma unroll
                            for (int r = 0; r < 4; ++r) ocl[((gq * 4 + mt) * 4 + r) * 64] = O[gq][mt][r] * g0; }
                    __syncthreads();
                    unsigned long long Ulo, Uhi;
                    { unsigned u[4];
#pragma unroll
                      for (int k = 0; k < 4; ++k) { unsigned x = selm[lane * 4 + k];
#pragma unroll
                        for (int o = 1; o < 64; o <<= 1) x |= __shfl_xor(x, o);
                        u[k] = __builtin_amdgcn_readfirstlane(x); }
                      Ulo = ((unsigned long long)u[1] << 32) | u[0]; Uhi = ((unsigned long long)u[3] << 32) | u[2]; }
                    auto nextj = [&](int j) -> int {
                        if (j < 64) { const unsigned long long x = Ulo >> j; if (x) return j + __builtin_ctzll(x); j = 64; }
                        if (j < 128) { const unsigned long long x = Uhi >> (j - 64); if (x) return j + __builtin_ctzll(x); }
                        return 128; };
                    {
                        const bf16* ksb = KVT + (size_t)(2 * 8 + bg) * SEQ * 64; const bf16* vsb = KVT + (size_t)(3 * 8 + bg) * SEQ * 64;
#pragma unroll 1
                        for (int rep = 0; rep < SELREP; ++rep) {
                        zeroO();
                        int j = nextj(0), jn = nextj(j + 1), it = 0;
                        u32x4 rk = ld_tile(ksb + (size_t)j * 4096), rv = ld_tile(vsb + (size_t)j * 4096);
                        st_tile(kvb, rk); st_tile(kvb + TB, rv);
                        if (jn <= cur) { rk = ld_tile(ksb + (size_t)jn * 4096); rv = ld_tile(vsb + (size_t)jn * 4096); }
                        __syncthreads();
#pragma unroll 1
                        while (j <= cur) { LAS unsigned char* cb = kvb + (it & 1) * 2 * TB;
                            const int jnn = jn <= cur ? nextj(jn + 1) : 128;
                            if (jn <= cur) { LAS unsigned char* nb = kvb + ((it + 1) & 1) * 2 * TB; st_tile(nb, rk); st_tile(nb + TB, rv); }
                            if (jnn <= cur) { rk = ld_tile(ksb + (size_t)jnn * 4096); rv = ld_tile(vsb + (size_t)jnn * 4096); }
                            const bool cs0 = (selm[(8 * wave + ti) * 4 + (j >> 5)] >> (j & 31)) & 1u, cs1 = (selm[(8 * wave + 4 + ti) * 4 + (j >> 5)] >> (j & 31)) & 1u;
                            const bool act0 = __ballot(cs0) != 0ull, act1 = __ballot(cs1) != 0ull;
                            const bool far = (t0 - (64 * j + 63)) >= 1513;
                            const float cb0 = cs0 ? bfar : NINF, cb1 = cs1 ? bfar : NINF;
                            const bool full = j < cur;
                            if (act0 && act1 && far) tile_far2(cb, cb + TB, cb0, cb1);
                            else if (act0 && act1) tile2(2, cb, cb + TB, 64 * j, far, full, true, true, cb0, cb1, cs0, cs1, 0);
                            else if (act0) tile2(2, cb, cb + TB, 64 * j, far, full, true, false, cb0, cb1, cs0, cs1, 0);
                            else if (act1) tile2(2, cb, cb + TB, 64 * j, far, full, false, true, cb0, cb1, cs0, cs1, 0);
#if NSA_DUP_C
                            __syncthreads();
#endif
                            __syncthreads();
                            j = jn; jn = jnn; ++it;
                        }
                        }
#pragma unroll
                        for (int gq = 0; gq < 2; ++gq) { const float lt = Ls[gq][0]; const float sc = gatev(gq, 1) / fmaxf(lt, 1e-30f);
#pragma unroll
                            for (int mt = 0; mt < 4; ++mt)
#pragma unroll
                                for (int r = 0; r < 4; ++r) ocl[((gq * 4 + mt) * 4 + r) * 64] += O[gq][mt][r] * sc; }
                    }
                    {
                        const bf16* kwb = KVT + (size_t)(4 * 8 + bg) * SEQ * 64; const bf16* vwb = KVT + (size_t)(5 * 8 + bg) * SEQ * 64;
                        const int j0 = cur - 8 < 0 ? 0 : cur - 8, nw = cur - j0 + 1;
#pragma unroll 1
                        for (int wrep = 0; wrep < WINREP; ++wrep) {
                        zeroO();
                        u32x4 rk = ld_tile(kwb + (size_t)j0 * 4096), rv = ld_tile(vwb + (size_t)j0 * 4096);
                        st_tile(kvb, rk); st_tile(kvb + TB, rv);
                        if (nw > 1) { rk = ld_tile(kwb + (size_t)(j0 + 1) * 4096); rv = ld_tile(vwb + (size_t)(j0 + 1) * 4096); }
                        __syncthreads();
#pragma unroll 1
                        for (int i = 0; i < nw; ++i) { LAS unsigned char* cb = kvb + (i & 1) * 2 * TB;
                            if (i + 1 < nw) { LAS unsigned char* nb = kvb + ((i + 1) & 1) * 2 * TB; st_tile(nb, rk); st_tile(nb + TB, rv); }
                            if (i + 2 < nw) { rk = ld_tile(kwb + (size_t)(j0 + i + 2) * 4096); rv = ld_tile(vwb + (size_t)(j0 + i + 2) * 4096); }
                            tile2(3, cb, cb + TB, 64 * (j0 + i), false, (j0 + i > cur - 8) && (j0 + i < cur), true, true, 0.f, 0.f, true, true, 0);
                            __syncthreads(); }
                        }
#pragma unroll
                        for (int gq = 0; gq < 2; ++gq) { const float lt = Ls[gq][0]; const float sc = gatev(gq, 2) / fmaxf(lt, 1e-30f);
#pragma unroll
                            for (int mt = 0; mt < 4; ++mt)
#pragma unroll
                                for (int r = 0; r < 4; ++r) O[gq][mt][r] = ocl[((gq * 4 + mt) * 4 + r) * 64] + O[gq][mt][r] * sc; }
                    }
#pragma unroll
                    for (int gq = 0; gq < 2; ++gq)
#pragma unroll
                        for (int mt = 0; mt < 4; ++mt) { u32x2 w; w.x = cvt_pk_bf16(O[gq][mt][0], O[gq][mt][1]); w.y = cvt_pk_bf16(O[gq][mt][2], O[gq][mt][3]);
                            *(u32x2*)(OB + (tokw + 4 * gq + ti) * 512 + (g * 4 + head) * 64 + 16 * mt + 4 * q4) = w; }
                }
            }
          }
        }
        SEAM(pb + 3, 4);

        if (EN(5) && IN(pb + 4)) { PHASE_IDS();
            pg8::Gemm g{(const bf16*)(ws + WS_QHG), (const bf16*)(ws + WS_WBA0 + (size_t)l * 2 * SZ_WBR), NT, DM, DM, 0, 512, (const bf16*)(ws + WS_NQ), 8};
            pg8::StaticOrder S; S.init(NT, DM, G, bid); EpiGate2 E{(bf16*)(ws + WS_GA), (const bf16*)(ws + WS_GA), (const bf16*)(ws + WS_GB)};
            pg8::gemm_phase<EpiGate2, pg8::StaticOrder>(lds, g, S, E, wave_s);
        }
        SEAM(pb + 4, 5);

        if (EN(6) && IN(pb + 5)) { PHASE_IDS();
            pg8::Gemm g{(const bf16*)(ws + WS_GA), (const bf16*)(ws + (l ? WS_WOUT1 : WS_WOUT0)), NT, DM, DM, 0, 0, nullptr, 0};
            const float* XI = l ? (const float*)X : x_in;
            pg8::StaticOrder S; S.init(NT, DM, G, bid); EpiResid E{XI, X};
            pg8::gemm_phase<EpiResid, pg8::StaticOrder>(lds, g, S, E, wave_s);
        }
        SEAM(pb + 5, 6);

        if (EN(7) && IN(pb + 6)) { PHASE_IDS();
            const float* gam = ap->in[11] + l * DM; const float* bet = ap->in[12] + l * DM;
            LAS int* hist = (LAS int*)(lds + 8 * 16384);
            if (l == 1) { if (tid < 8) hist[tid] = 0; __syncthreads(); }
            const int rpb = (NT + G - 1) / G;
            for (int i = wave; i < rpb; i += NWAVES) {
                const int row = bid * rpb + i; if (row >= NT) break;
                f32x4* xr = (f32x4*)(X + (size_t)row * DM);
                f32x4 v[4]; float s = 0.f;
#pragma unroll
                for (int j = 0; j < 4; ++j) { v[j] = xr[64 * j + lane]; s += (v[j][0] + v[j][1]) + (v[j][2] + v[j][3]); }
                const float mean = wave_sum(s) * (1.f / DM); float s2 = 0.f;
#pragma unroll
                for (int j = 0; j < 4; ++j) { v[j] = v[j] - mean; s2 += (v[j][0] * v[j][0] + v[j][1] * v[j][1]) + (v[j][2] * v[j][2] + v[j][3] * v[j][3]); }
                const float rstd = rsqrtf(wave_sum(s2) * (1.f / DM) + 1e-5f);
#pragma unroll
                for (int j = 0; j < 4; ++j) { const f32x4 gq = ((const f32x4*)gam)[64 * j + lane], bq = ((const f32x4*)bet)[64 * j + lane]; v[j] = v[j] * rstd * gq + bq; xr[64 * j + lane] = v[j]; }
                if (l == 0) { u32x2* o = (u32x2*)(XB + (size_t)row * DM);
#pragma unroll
                    for (int j = 0; j < 4; ++j) { u32x2 w; w.x = cvt_pk_bf16(v[j][0], v[j][1]); w.y = cvt_pk_bf16(v[j][2], v[j][3]); o[64 * j + lane] = w; }
                } else {
                    const float* WR = ap->in[18];
                    float lg[8];
#pragma unroll
                    for (int e = 0; e < 8; ++e) lg[e] = 0.f;
#pragma unroll
                    for (int j = 0; j < 4; ++j)
#pragma unroll
                        for (int q = 0; q < 4; ++q) { const int c = 4 * (64 * j + lane) + q; const f32x4 w0 = *(const f32x4*)(WR + c * 8), w1 = *(const f32x4*)(WR + c * 8 + 4); const float xv = v[j][q];
                            lg[0] += xv * w0[0]; lg[1] += xv * w0[1]; lg[2] += xv * w0[2]; lg[3] += xv * w0[3]; lg[4] += xv * w1[0]; lg[5] += xv * w1[1]; lg[6] += xv * w1[2]; lg[7] += xv * w1[3]; }
#pragma unroll
                    for (int e = 0; e < 8; ++e) lg[e] = wave_sum(lg[e]);
                    int e1 = 0; float v1 = lg[0];
#pragma unroll
                    for (int e = 1; e < 8; ++e) if (lg[e] > v1) { v1 = lg[e]; e1 = e; }
                    int e2 = -1; float v2 = -3e38f;
#pragma unroll
                    for (int e = 0; e < 8; ++e) if (e != e1 && lg[e] > v2) { v2 = lg[e]; e2 = e; }
                    if (lane == 0) { const float g2 = 1.f / (1.f + expf(v1 - v2)), g1 = 1.f - g2;
                        ((int*)(ws + WS_TOPI))[row] = e1 | (e2 << 8); ((float*)(ws + WS_TOPG))[row * 2] = g1; ((float*)(ws + WS_TOPG))[row * 2 + 1] = g2;
                        atomicAdd((int*)&hist[e1], 1); atomicAdd((int*)&hist[e2], 1); }
                }
            }
            if (l == 1) {
                __syncthreads();
                if (tid < 8) ((int*)(ws + WS_CTL + CW_BLKCNT))[bid * 8 + tid] = hist[tid];
                LAS float* scr = (LAS float*)(lds + wave * 16384);
                constexpr int I_GU = 16 * (2 * FFE / 32), I_DN = (FFE / 64) * 32;
                for (int it = gwave; it < NEXP * (I_GU + I_DN); it += nwaves) {
                    const int e = it / (I_GU + I_DN); int r = it % (I_GU + I_DN);
                    if (r < I_GU) { const int nb = r % (2 * FFE / 32), kb = r / (2 * FFE / 32);
                        const float* Wg = ap->in[19] + (size_t)e * DM * FFE; const float* Wu = ap->in[20] + (size_t)e * DM * FFE;
                        auto cp = [=](int n) -> const float* { const int pn = n >> 8, hf = (n >> 7) & 1, c = pn * 128 + (n & 127); return (hf ? Wu : Wg) + c; };
                        tr_item(cp, FFE, DM, (bf16*)(ws + WS_MGU) + (size_t)e * 2 * FFE * DM, DM, nb * 32, kb * 64, scr, lane); }
                    else { r -= I_GU; const int nb = r % 32, kb = r / 32;
                        const float* W = ap->in[21] + (size_t)e * FFE * DM;
                        auto cp = [=](int n) -> const float* { return W + n; };
                        tr_item(cp, DM, FFE, (bf16*)(ws + WS_MDN) + (size_t)e * DM * FFE, FFE, nb * 32, kb * 64, scr, lane); }
                }
            }
        }
        SEAM(pb + 6, 7);

        if (l == 0) {
            if (EN(8) && IN(pb + 7)) { PHASE_IDS();
                pg8::Gemm g{XB, (const bf16*)(ws + WS_WGU0), NT, NINP, DM, 0, 0, nullptr, 0};
                pg8::StaticOrder S; S.init(NT, NINP, G, bid); EpiSwiglu E{(bf16*)(ws + WS_H0), FF0P};
                pg8::gemm_phase<EpiSwiglu, pg8::StaticOrder>(lds, g, S, E, wave_s);
            }
            SEAM(pb + 7, 8);
            if (EN(9) && IN(pb + 8)) { PHASE_IDS();
                pg8::Gemm g{(const bf16*)(ws + WS_H0), (const bf16*)(ws + WS_WDN0), NT, DM, FF0P, 0, 0, nullptr, 0};
                pg8::StaticOrder S; S.init(NT, DM, G, bid); EpiResid E{X, X};
                pg8::gemm_phase<EpiResid, pg8::StaticOrder>(lds, g, S, E, wave_s);
            }
            SEAM(pb + 8, 9);
            if (EN(10) && IN(pb + 9)) { PHASE_IDS();
                const float* gam = ap->in[13]; const float* bet = ap->in[14];
                for (int row = gwave; row < NT; row += nwaves) {
                    f32x4* xr = (f32x4*)(X + (size_t)row * DM);
                    f32x4 v[4]; float s = 0.f;
#pragma unroll
                    for (int j = 0; j < 4; ++j) { v[j] = xr[64 * j + lane]; s += (v[j][0] + v[j][1]) + (v[j][2] + v[j][3]); }
                    const float mean = wave_sum(s) * (1.f / DM); float s2 = 0.f;
#pragma unroll
                    for (int j = 0; j < 4; ++j) { v[j] = v[j] - mean; s2 += (v[j][0] * v[j][0] + v[j][1] * v[j][1]) + (v[j][2] * v[j][2] + v[j][3] * v[j][3]); }
                    const float rstd = rsqrtf(wave_sum(s2) * (1.f / DM) + 1e-5f);
                    u32x2* o = (u32x2*)(XB + (size_t)row * DM);
#pragma unroll
                    for (int j = 0; j < 4; ++j) { const f32x4 gq = ((const f32x4*)gam)[64 * j + lane], bq = ((const f32x4*)bet)[64 * j + lane]; v[j] = v[j] * rstd * gq + bq; xr[64 * j + lane] = v[j];
                        u32x2 w; w.x = cvt_pk_bf16(v[j][0], v[j][1]); w.y = cvt_pk_bf16(v[j][2], v[j][3]); o[64 * j + lane] = w; }
                }
            }
            SEAM(pb + 9, 10);
        } else {
            if (EN(11) && IN(pb + 7)) { PHASE_IDS(); int* META = (int*)(ws + WS_CTL + CW_META); int* PANELE = (int*)(ws + WS_CTL + CW_PANELE); int* ROWINFO = (int*)(ws + WS_ROWINFO); bf16* XS = (bf16*)(ws + WS_XS); (void)META; (void)PANELE; (void)ROWINFO; (void)XS;
                LAS int* sh = (LAS int*)lds;
                const int* BC = (const int*)(ws + WS_CTL + CW_BLKCNT);
                {
                    float tot = 0.f, pre = 0.f;
                    for (int bb = lane; bb < G; bb += 64) { const float c = (float)BC[bb * 8 + wave]; tot += c; pre += (bb < bid) ? c : 0.f; }
                    tot = wave_sum(tot); pre = wave_sum(pre);
                    if (lane == 0) { sh[wave] = (int)tot; sh[8 + wave] = (int)pre; sh[24 + wave] = 0; } }
                __syncthreads();
                if (tid == 0) { int base = 0;
#pragma unroll 1
                    for (int e = 0; e < 8; ++e) { sh[16 + e] = base; base += (sh[e] + 255) & ~255; }
                    sh[32] = base; }
                __syncthreads();
                if (bid == 0) { const int base = sh[32]; if (tid == 0) { META[0] = base / 256; META[1] = (base / 256 + 63) / 64; }
                    if (tid < 8) { META[8 + tid] = sh[16 + tid]; META[16 + tid] = sh[tid]; }
                    for (int p = tid; p < base / 256; p += NTHR) { int e = 0;
#pragma unroll 1
                        for (int q = 1; q < 8; ++q) if (p * 256 >= sh[16 + q]) e = q;
                        PANELE[p] = e; } }
                __syncthreads();
                if (bid < 8) { const int e = bid, r0 = sh[16 + e] + sh[e], r1 = sh[16 + e] + ((sh[e] + 255) & ~255);
                    for (int r = r0 + wave; r < r1; r += NWAVES) { if (lane == 0) ROWINFO[r] = -1;
#pragma unroll
                        for (int j = 0; j < 4; ++j) ((u32x2*)(XS + (size_t)r * DM))[64 * j + lane] = (u32x2){0u, 0u}; } }
                const int rpb = (NT + G - 1) / G;
                for (int i = wave; i < rpb; i += NWAVES) {
                    const int row = bid * rpb + i; if (row >= NT) break;
                    const int ti = ((const int*)(ws + WS_TOPI))[row]; const int e1 = ti & 255, e2 = ti >> 8;
                    int s1 = 0, s2 = 0;
                    if (lane == 0) { s1 = sh[16 + e1] + sh[8 + e1] + atomicAdd((int*)&sh[24 + e1], 1); s2 = sh[16 + e2] + sh[8 + e2] + atomicAdd((int*)&sh[24 + e2], 1); ROWINFO[s1] = row * 2; ROWINFO[s2] = row * 2 + 1; }
                    s1 = __builtin_amdgcn_readfirstlane(s1); s2 = __builtin_amdgcn_readfirstlane(s2);
                    const f32x4* xr = (const f32x4*)(X + (size_t)row * DM);
#pragma unroll
                    for (int j = 0; j < 4; ++j) { const f32x4 v = xr[64 * j + lane]; u32x2 w; w.x = cvt_pk_bf16(v[0], v[1]); w.y = cvt_pk_bf16(v[2], v[3]);
                        ((u32x2*)(XS + (size_t)s1 * DM))[64 * j + lane] = w; ((u32x2*)(XS + (size_t)s2 * DM))[64 * j + lane] = w; }
                }
            }
            SEAM(pb + 7, 11);
            for (int c = 0; c < MAXCHUNK; ++c) {
                if (EN(12) && IN(pb + 8 + 2 * c)) { PHASE_IDS(); int* META = (int*)(ws + WS_CTL + CW_META); int* PANELE = (int*)(ws + WS_CTL + CW_PANELE); int* ROWINFO = (int*)(ws + WS_ROWINFO); bf16* XS = (bf16*)(ws + WS_XS); (void)META; (void)PANELE; (void)ROWINFO; (void)XS;
                    const int P = META[0], nch = META[1];
                    if (c < nch) { const int p0 = (int)((long)c * P / nch), p1 = (int)((long)(c + 1) * P / nch);
                        pg8::Gemm g{XS + (size_t)p0 * 256 * DM, (const bf16*)(ws + WS_MGU), (p1 - p0) * 256, 2 * FFE, DM, (size_t)2 * FFE * DM, 0, nullptr, 0};
                        pg8::StaticOrder S; S.init((p1 - p0) * 256, 2 * FFE, G, bid, PANELE + p0); EpiSwiglu E{(bf16*)(ws + WS_HM), FFE};
                        pg8::gemm_phase<EpiSwiglu, pg8::StaticOrder>(lds, g, S, E, wave_s); }
                }
                SEAM(pb + 8 + 2 * c, 12);
                if (EN(13) && IN(pb + 9 + 2 * c)) { PHASE_IDS(); int* META = (int*)(ws + WS_CTL + CW_META); int* PANELE = (int*)(ws + WS_CTL + CW_PANELE); int* ROWINFO = (int*)(ws + WS_ROWINFO); bf16* XS = (bf16*)(ws + WS_XS); (void)META; (void)PANELE; (void)ROWINFO; (void)XS;
                    const int P = META[0], nch = META[1];
                    if (c < nch) { const int p0 = (int)((long)c * P / nch), p1 = (int)((long)(c + 1) * P / nch);
                        pg8::Gemm g{(const bf16*)(ws + WS_HM), (const bf16*)(ws + WS_MDN), (p1 - p0) * 256, DM, FFE, (size_t)DM * FFE, 0, nullptr, 0};
                        pg8::StaticOrder S; S.init((p1 - p0) * 256, DM, G, bid, PANELE + p0); EpiScatter E{(bf16*)(ws + WS_YM), ROWINFO + p0 * 256};
                        pg8::gemm_phase<EpiScatter, pg8::StaticOrder>(lds, g, S, E, wave_s); }
                }
                if (PROBE_GRP >= 0 && c == MAXCHUNK - 1) { PMARK(13); if (bid == 0 && wave_s == 0 && lane_id() == 0) *(unsigned long long*)(ws0 + WS_CTL + CW_PROBE) = pr_acc; }
                SEAM(pb + 9 + 2 * c, 13);
            }
            if (EN(14) && IN(pb + 8 + 2 * MAXCHUNK)) { PHASE_IDS();
                const float* gam = ap->in[13] + DM; const float* bet = ap->in[14] + DM;
                const bf16* YM = (const bf16*)(ws + WS_YM); const float* TG = (const float*)(ws + WS_TOPG);
                const float pscale = 1.f;
                for (int row = gwave; row < NT; row += nwaves) {
                    f32x4* xr = (f32x4*)(X + (size_t)row * DM);
                    const float g1 = TG[row * 2], g2 = TG[row * 2 + 1];
                    const u32x2* y1 = (const u32x2*)(YM + (size_t)(row * 2) * DM); const u32x2* y2 = (const u32x2*)(YM + (size_t)(row * 2 + 1) * DM);
                    f32x4 v[4]; float s = 0.f;
#pragma unroll
                    for (int j = 0; j < 4; ++j) { const f32x4 xv = xr[64 * j + lane]; const u32x2 a = y1[64 * j + lane], bq = y2[64 * j + lane];
                        v[j][0] = xv[0] * DN_ALPHA + g1 * bflo(a.x) + g2 * bflo(bq.x); v[j][1] = xv[1] * DN_ALPHA + g1 * bfhi(a.x) + g2 * bfhi(bq.x);
                        v[j][2] = xv[2] * DN_ALPHA + g1 * bflo(a.y) + g2 * bflo(bq.y); v[j][3] = xv[3] * DN_ALPHA + g1 * bfhi(a.y) + g2 * bfhi(bq.y);
                        s += (v[j][0] + v[j][1]) + (v[j][2] + v[j][3]); }
                    const float mean = wave_sum(s) * (1.f / DM); float s2 = 0.f;
#pragma unroll
                    for (int j = 0; j < 4; ++j) { v[j] = v[j] - mean; s2 += (v[j][0] * v[j][0] + v[j][1] * v[j][1]) + (v[j][2] * v[j][2] + v[j][3] * v[j][3]); }
                    const float rstd = rsqrtf(wave_sum(s2) * (1.f / DM) + 1e-5f);
#pragma unroll
                    for (int j = 0; j < 4; ++j) { const f32x4 gq = ((const f32x4*)gam)[64 * j + lane], bq = ((const f32x4*)bet)[64 * j + lane]; xr[64 * j + lane] = (v[j] * rstd * gq + bq) * pscale; }
                }
#if PROBE_GRP >= 0
                {
                    const unsigned long long dt = *(const unsigned long long*)(ws + WS_CTL + CW_PROBE) * (unsigned long long)PROBE_K;
                    const unsigned long long t0 = __builtin_amdgcn_s_memrealtime();
                    while (__builtin_amdgcn_s_memrealtime() - t0 < dt) __builtin_amdgcn_s_sleep(8);
                }
#endif
            }
        }
    }
#undef IN
#undef SEAM
}

constexpr int NPHASES = 1 + 10 + 8 + 2 * MAXCHUNK + 1;

extern "C" void kernel_launch(void* const* d_in, const int* in_sizes, int n_in, void* d_out, int out_size, void* d_ws, size_t ws_size, hipStream_t stream) {
    static int grid = 0;
    if (grid == 0) {
        if (n_in != 22 || out_size != NT * DM || ws_size < WS_END) { fprintf(stderr, "kernel_launch: need 22 inputs, %d outputs, >= %zu bytes of workspace; got %d, %d, %zu\n", NT * DM, (size_t)WS_END, n_in, out_size, ws_size); grid = -1; return; }
        int dev = 0, cus = 0, per_cu = 0;
        if (hipGetDevice(&dev) != hipSuccess || hipDeviceGetAttribute(&cus, hipDeviceAttributeMultiprocessorCount, dev) != hipSuccess) { grid = -1; return; }
        if (hipFuncSetAttribute((const void*)mega_fwd, hipFuncAttributeMaxDynamicSharedMemorySize, LDS_BYTES) != hipSuccess) { fprintf(stderr, "kernel_launch: hipFuncSetAttribute failed\n"); grid = -1; return; }
        if (hipOccupancyMaxActiveBlocksPerMultiprocessor(&per_cu, (const void*)mega_fwd, NTHR, LDS_BYTES) != hipSuccess || per_cu < 1) fprintf(stderr, "kernel_launch: occupancy query reports %d\n", per_cu);
        (void)hipGetLastError();
        grid = cus > 256 ? 256 : cus;
    }
    if (grid < 0) return;
    (void)hipMemsetAsync((char*)d_ws + WS_CTL, 0, CTL_BYTES, stream);
    Args a{};
    for (int i = 0; i < 22; ++i) a.in[i] = (const float*)d_in[i];
    a.out = (float*)d_out; a.ws = (unsigned char*)d_ws;
#if ONE_LAUNCH
    a.ph_lo = 0; a.ph_hi = NPHASES;
    hipLaunchKernelGGL(mega_fwd, dim3(grid), dim3(NTHR), LDS_BYTES, stream, a);
#else
    for (int p = 0; p < NPHASES; ++p) { a.ph_lo = p; a.ph_hi = p + 1; hipLaunchKernelGGL(mega_fwd, dim3(grid), dim3(NTHR), LDS_BYTES, stream, a); }
#endif
}
```

```cpp
#include <hip/hip_runtime.h>
#include <cstdio>
#include <cstdint>

#ifndef ONE_LAUNCH
#define ONE_LAUNCH 1
#endif

#define LAS __attribute__((address_space(3)))
typedef unsigned short bf16;
typedef short bf16x8 __attribute__((ext_vector_type(8)));
typedef short s16x4 __attribute__((ext_vector_type(4)));
typedef float f32x4 __attribute__((ext_vector_type(4)));
typedef float f32x16 __attribute__((ext_vector_type(16)));
typedef float f32x2 __attribute__((ext_vector_type(2)));
typedef unsigned u32x4 __attribute__((ext_vector_type(4)));
typedef unsigned u32x2 __attribute__((ext_vector_type(2)));

typedef __bf16 bf16x2_t __attribute__((ext_vector_type(2)));
__device__ __forceinline__ unsigned cvt_pk_bf16(float lo, float hi) { bf16x2_t v; v[0] = (__bf16)lo; v[1] = (__bf16)hi; return __builtin_bit_cast(unsigned, v); }
__device__ __forceinline__ bf16 f2bf(float f) { unsigned u = __float_as_uint(f); u += 0x7FFFu + ((u >> 16) & 1u); return (bf16)(u >> 16); }
__device__ __forceinline__ float bf2f(bf16 b) { return __uint_as_float(((unsigned)b) << 16); }
__device__ __forceinline__ float bflo(unsigned u) { return __uint_as_float(u << 16); }
__device__ __forceinline__ float bfhi(unsigned u) { return __uint_as_float(u & 0xFFFF0000u); }
__device__ __forceinline__ float sigmoidf_(float x) { return 1.0f / (1.0f + __expf(-x)); }
__device__ __forceinline__ float siluf_(float x) { return x / (1.0f + __expf(-x)); }
__device__ __forceinline__ float max_x32(float x) { auto r = __builtin_amdgcn_permlane32_swap(__float_as_uint(x), __float_as_uint(x), false, false); return fmaxf(__uint_as_float(r[0]), __uint_as_float(r[1])); }
__device__ __forceinline__ float max_x16(float x) { auto r = __builtin_amdgcn_permlane16_swap(__float_as_uint(x), __float_as_uint(x), false, false); return fmaxf(__uint_as_float(r[0]), __uint_as_float(r[1])); }
__device__ __forceinline__ float sum_x32(float x) { auto r = __builtin_amdgcn_permlane32_swap(__float_as_uint(x), __float_as_uint(x), false, false); return __uint_as_float(r[0]) + __uint_as_float(r[1]); }
__device__ __forceinline__ float sum_x16(float x) { auto r = __builtin_amdgcn_permlane16_swap(__float_as_uint(x), __float_as_uint(x), false, false); return __uint_as_float(r[0]) + __uint_as_float(r[1]); }
__device__ __forceinline__ float dpp_x1(float x) { return __uint_as_float(__builtin_amdgcn_mov_dpp(__float_as_uint(x), 0xB1, 0xF, 0xF, true)); }
__device__ __forceinline__ float dpp_x2(float x) { return __uint_as_float(__builtin_amdgcn_mov_dpp(__float_as_uint(x), 0x4E, 0xF, 0xF, true)); }
__device__ __forceinline__ float dpp_hm(float x) { return __uint_as_float(__builtin_amdgcn_mov_dpp(__float_as_uint(x), 0x141, 0xF, 0xF, true)); }
__device__ __forceinline__ float dpp_rm(float x) { return __uint_as_float(__builtin_amdgcn_mov_dpp(__float_as_uint(x), 0x140, 0xF, 0xF, true)); }
__device__ __forceinline__ float wave_sum(float v) { v += dpp_x1(v); v += dpp_x2(v); v += dpp_hm(v); v += dpp_rm(v); v = sum_x16(v); return sum_x32(v); }
__device__ __forceinline__ float wave_max(float v) { v = fmaxf(v, dpp_x1(v)); v = fmaxf(v, dpp_x2(v)); v = fmaxf(v, dpp_hm(v)); v = fmaxf(v, dpp_rm(v)); v = max_x16(v); return max_x32(v); }
__device__ __forceinline__ int lane_id() { int l; asm volatile("v_mbcnt_lo_u32_b32 %0, -1, 0\n\tv_mbcnt_hi_u32_b32 %0, -1, %0" : "=v"(l)); return l; }
#define WAVE_SYNC() do { asm volatile("s_waitcnt lgkmcnt(0)" ::: "memory"); __builtin_amdgcn_wave_barrier(); } while (0)

#define PHASE_IDS() int tid_ph = wave_s * 64 + lane_id(); asm volatile("" : "+v"(tid_ph)); const int tid = tid_ph, lane = tid & 63, wave = __builtin_amdgcn_readfirstlane(tid >> 6), gwave = bid * NWAVES + wave; (void)tid; (void)lane; (void)wave; (void)gwave; \
    KArgsP ap = kap; asm volatile("" : "+s"(ap));     \
    unsigned char* ws = ap->ws; float* X = ap->out; const float* x_in = ap->in[0]; bf16* XB = (bf16*)(ws + WS_XB); float* LBS = (float*)(ws + WS_LBS); (void)X; (void)x_in; (void)XB; (void)LBS
namespace pg8 {
constexpr int BM = 256, BK = 64, HALF = 128, HTB = HALF * BK * 2, STAGE_BYTES = 8 * HTB, NXCD = 8, WGM = 8;
__host__ __device__ __forceinline__ int lds_byte(int r, int c) { const int st = (r >> 4) * 2 + (c >> 5), rr = r & 15, cc = c & 31, ob = rr * 64 + cc * 2; return st * 1024 + (ob ^ (((ob >> 9) & 1) << 5)); }
__host__ __device__ __forceinline__ void stage_rc(int b, int& R, int& C) { const int st = b / 1024, sb = b % 1024, swz = sb ^ (((sb >> 9) & 1) << 5); R = (st >> 1) * 16 + swz / 64; C = (st & 1) * 32 + (swz % 64) / 2; }
__host__ __device__ __forceinline__ int perm32(int rho) { const int n = rho >> 4, i = rho & 15; return 8 * (i >> 2) + 4 * n + (i & 3); }

struct Unit { int pm, pn, e; };
struct Gemm { const bf16* A; const bf16* Bt; int M, N, K; size_t bt_estride; int lda; const bf16* A2; int ksw; };

struct StaticOrder {
    int nM, nN, nwg, G, c; const int* pe;
    __device__ void init(int M, int N, int G_, int c_, const int* pe_ = nullptr) { nM = M / BM; nN = N / BM; nwg = nM * nN; G = G_; c = c_; pe = pe_; }
    __device__ bool next(int i, Unit& u) const {
        const long L = (long)i * G + c; if (L >= nwg) return false;
        int wgid = (int)L; { const int q = nwg / NXCD, r = nwg % NXCD, xcd = wgid % NXCD, off = wgid / NXCD; wgid = (xcd < r ? xcd * (q + 1) : r * (q + 1) + (xcd - r) * q) + off; }
        const int nig = WGM * nN, gid = wgid / nig, fm = gid * WGM, gsz = (nM - fm) < WGM ? (nM - fm) : WGM;
        u.pm = fm + ((wgid % nig) % gsz); u.pn = (wgid % nig) / gsz; u.e = pe ? pe[u.pm] : 0; return true;
    }
    __device__ __forceinline__ void a_ready(const Unit&) const {}
    __device__ __forceinline__ void done(const Unit&) const {}
};

template <class Epi, class Sched, bool ALIGN_EPI = true, bool SP2 = true>
__device__ __forceinline__ void gemm_phase(LAS unsigned char* lds, const Gemm g, const Sched& S, const Epi& E, const int wave_s) {
    int tid_l = wave_s * 64 + lane_id(); asm volatile("" : "+v"(tid_l));
    const int tid = tid_l, wid = __builtin_amdgcn_readfirstlane(tid >> 6), lane = tid & 63, wr = wid >> 2, wc = wid & 3, fr = lane & 15, fq = lane >> 4;
    const int K = g.K, nt = K / BK, LDA = g.lda ? g.lda : g.K;
    unsigned voffA[2], voffB[2];
#pragma unroll
    for (int i = 0; i < 2; ++i) { int R, C; stage_rc(tid * 16 + i * 8192, R, C); const int Rb = Epi::PERM ? ((R & ~31) + perm32(R & 31)) : R;
        voffA[i] = (unsigned)(R * LDA + C) * 2u; voffB[i] = (unsigned)(Rb * K + C) * 2u; }
    const size_t kstep = (size_t)(BK * 2);
    const size_t hstep = (size_t)HALF * K * 2, hstepA = (size_t)HALF * LDA * 2;
    const size_t tstep = 2 * hstep, tstepA = 2 * hstepA;
    const unsigned ldsw = (unsigned)wid * 1024u;
    const int aoff = lds_byte(wr * 64 + fr, fq * 8), boff = lds_byte(wc * 32 + fr, fq * 8);
#define PG8_SA(b, h) (((b) * 2 + (h)) * HTB)
#define PG8_SB(b, h) ((4 + (b) * 2 + (h)) * HTB)
#define PG8_STAGE(bufoff, gbase, voff) do { _Pragma("unroll") for (int _i = 0; _i < 2; ++_i) \
        __builtin_amdgcn_global_load_lds((const unsigned*)((const char*)(gbase) + (voff)[_i]), (LAS unsigned*)(lds + (bufoff) + ldsw + _i * 8192), 16, 0, 0); } while (0)
#define PG8_LDA(dst, b, h) do { _Pragma("unroll") for (int m = 0; m < 4; ++m) _Pragma("unroll") for (int k = 0; k < 2; ++k) dst[m][k] = *(const LAS bf16x8*)(lds + PG8_SA(b, h) + aoff + m * 2048 + k * 1024); } while (0)
#define PG8_LDB(dst, b, h) do { _Pragma("unroll") for (int n = 0; n < 2; ++n) _Pragma("unroll") for (int k = 0; k < 2; ++k) dst[n][k] = *(const LAS bf16x8*)(lds + PG8_SB(b, h) + boff + n * 2048 + k * 1024); } while (0)
#define PG8_MMA(ai, bj, At, Bt) do { __builtin_amdgcn_s_setprio(1); _Pragma("unroll") for (int m = 0; m < 4; ++m) _Pragma("unroll") for (int n = 0; n < 2; ++n) _Pragma("unroll") for (int k = 0; k < 2; ++k) \
        acc[ai][bj][m][n] = __builtin_amdgcn_mfma_f32_16x16x32_bf16(Bt[n][k], At[m][k], acc[ai][bj][m][n], 0, 0, 0); __builtin_amdgcn_s_setprio(0); } while (0)
#define PG8_WAIT_V(n) asm volatile("s_waitcnt vmcnt(" #n ")" ::: "memory")
#define PG8_WAIT_L(n) asm volatile("s_waitcnt lgkmcnt(" #n ")" ::: "memory")
#define PG8_BAR __builtin_amdgcn_s_barrier()
#define PG8_SCHED __builtin_amdgcn_sched_barrier(0)
    Unit cur, nxt; int ui = 0;
    if (!S.next(0, cur)) return;
    f32x4 acc[2][2][4][2];
#pragma unroll
    for (int a = 0; a < 2; ++a)
#pragma unroll
        for (int b = 0; b < 2; ++b)
#pragma unroll
            for (int m = 0; m < 4; ++m)
#pragma unroll
                for (int n = 0; n < 2; ++n) acc[a][b][m][n] = (f32x4){0.f, 0.f, 0.f, 0.f};
    bf16x8 At[4][2], B0[2][2], B1[2][2];
    const int ksw = g.ksw ? g.ksw : nt;
    const char* cA = (const char*)g.A + (size_t)cur.pm * tstepA; const char* cB = (const char*)(g.Bt + (size_t)cur.e * g.bt_estride) + (size_t)cur.pn * tstep;
    const char* cA2 = g.ksw ? (const char*)g.A2 + (size_t)cur.pm * tstepA : cA;
    S.a_ready(cur);
    if constexpr (SP2) {
        PG8_STAGE(PG8_SB(0, 0), cB, voffB); PG8_STAGE(PG8_SB(0, 1), cB + hstep, voffB); PG8_STAGE(PG8_SA(0, 0), cA, voffA); PG8_STAGE(PG8_SA(0, 1), cA + hstepA, voffA);
        if (wr == 1) PG8_BAR;
        PG8_WAIT_V(2); PG8_BAR;
        PG8_STAGE(PG8_SB(1, 0), cB + kstep, voffB); PG8_STAGE(PG8_SA(1, 0), cA + kstep, voffA); PG8_STAGE(PG8_SB(1, 1), cB + hstep + kstep, voffB);
        PG8_WAIT_V(6); PG8_BAR;
    } else {
        PG8_STAGE(PG8_SB(0, 0), cB, voffB); PG8_STAGE(PG8_SA(0, 0), cA, voffA); PG8_STAGE(PG8_SB(0, 1), cB + hstep, voffB); PG8_STAGE(PG8_SA(0, 1), cA + hstepA, voffA);
        if (wr == 1) PG8_BAR;
        PG8_WAIT_V(4); PG8_BAR;
        PG8_STAGE(PG8_SB(1, 0), cB + kstep, voffB); PG8_STAGE(PG8_SA(1, 0), cA + kstep, voffA); PG8_STAGE(PG8_SB(1, 1), cB + hstep + kstep, voffB);
        PG8_WAIT_V(6); PG8_BAR;
    }
    for (;;) {
        const bool has_next = S.next(ui + 1, nxt);
        const char* nA = has_next ? (const char*)g.A + (size_t)nxt.pm * tstepA : cA;
        const char* nA2 = (has_next && g.ksw) ? (const char*)g.A2 + (size_t)nxt.pm * tstepA : cA2;
        const char* nB = has_next ? (const char*)(g.Bt + (size_t)nxt.e * g.bt_estride) + (size_t)nxt.pn * tstep : cB;
        for (int t = 0; t < nt; t += 2) {
            const bool last = (t == nt - 2);
            const char* a1 = (t + 1 < ksw) ? cA + (size_t)(t + 1) * kstep : cA2 + (size_t)(t + 1 - ksw) * kstep;
            const char* a2 = last ? nA : ((t + 2 < ksw) ? cA + (size_t)(t + 2) * kstep : cA2 + (size_t)(t + 2 - ksw) * kstep); const char* b2 = last ? nB : cB + (size_t)(t + 2) * kstep;
            const char* a3 = a2 + kstep; const char* b3 = b2 + kstep;
            if (last && has_next) S.a_ready(nxt);
            if constexpr (Epi::HAS_MID) { if (t == ksw) E.mid(acc, cur, wr, wc, fr, fq); }
            if constexpr (SP2) {
            PG8_LDB(B0, 0, 0); PG8_LDB(B1, 0, 1); PG8_SCHED; PG8_LDA(At, 0, 0); PG8_STAGE(PG8_SA(1, 1), a1 + hstepA, voffA);
            PG8_WAIT_V(8); PG8_WAIT_L(0); PG8_BAR; PG8_MMA(0, 0, At, B0); PG8_MMA(0, 1, At, B1); PG8_BAR; PG8_SCHED;
            PG8_LDA(At, 0, 1); PG8_STAGE(PG8_SB(0, 0), b2, voffB); PG8_STAGE(PG8_SB(0, 1), b2 + hstep, voffB); PG8_STAGE(PG8_SA(0, 0), a2, voffA);
            PG8_WAIT_V(8); PG8_WAIT_L(0); PG8_BAR; PG8_MMA(1, 0, At, B0); PG8_MMA(1, 1, At, B1); PG8_BAR; PG8_SCHED;
            PG8_LDB(B0, 1, 0); PG8_LDB(B1, 1, 1); PG8_SCHED; PG8_LDA(At, 1, 0); PG8_STAGE(PG8_SA(0, 1), a2 + hstepA, voffA);
            PG8_WAIT_V(8); PG8_WAIT_L(0); PG8_BAR; PG8_MMA(0, 0, At, B0); PG8_MMA(0, 1, At, B1); PG8_BAR; PG8_SCHED;
            PG8_LDA(At, 1, 1); PG8_STAGE(PG8_SB(1, 0), b3, voffB); PG8_STAGE(PG8_SB(1, 1), b3 + hstep, voffB); PG8_STAGE(PG8_SA(1, 0), a3, voffA);
            PG8_WAIT_V(8); PG8_WAIT_L(0); PG8_BAR; PG8_MMA(1, 0, At, B0); PG8_MMA(1, 1, At, B1); PG8_BAR; PG8_SCHED;
            } else {
            PG8_LDB(B0, 0, 0); PG8_SCHED; PG8_LDA(At, 0, 0); PG8_STAGE(PG8_SA(1, 1), a1 + hstepA, voffA);
            PG8_WAIT_L(8); PG8_BAR; PG8_WAIT_L(0); PG8_MMA(0, 0, At, B0); PG8_BAR; PG8_SCHED;
            PG8_LDB(B1, 0, 1); PG8_STAGE(PG8_SB(0, 0), b2, voffB);
            PG8_BAR; PG8_WAIT_L(0); PG8_MMA(0, 1, At, B1); PG8_BAR;
            PG8_LDA(At, 0, 1); PG8_STAGE(PG8_SA(0, 0), a2, voffA);
            PG8_BAR; PG8_WAIT_L(0); PG8_MMA(1, 0, At, B0); PG8_BAR; PG8_SCHED;
            PG8_STAGE(PG8_SB(0, 1), b2 + hstep, voffB);
            PG8_WAIT_V(6); PG8_BAR; PG8_MMA(1, 1, At, B1); PG8_BAR;
            PG8_LDB(B0, 1, 0); PG8_SCHED; PG8_LDA(At, 1, 0); PG8_STAGE(PG8_SA(0, 1), a2 + hstepA, voffA);
            PG8_WAIT_L(8); PG8_BAR; PG8_WAIT_L(0); PG8_MMA(0, 0, At, B0); PG8_BAR; PG8_SCHED;
            PG8_LDB(B1, 1, 1); PG8_STAGE(PG8_SB(1, 0), b3, voffB);
            PG8_BAR; PG8_WAIT_L(0); PG8_MMA(0, 1, At, B1); PG8_BAR;
            PG8_LDA(At, 1, 1); PG8_STAGE(PG8_SA(1, 0), a3, voffA);
            PG8_BAR; PG8_WAIT_L(0); PG8_MMA(1, 0, At, B0); PG8_BAR; PG8_SCHED;
            PG8_STAGE(PG8_SB(1, 1), b3 + hstep, voffB);
            PG8_WAIT_V(6); PG8_BAR; PG8_MMA(1, 1, At, B1); PG8_BAR;
            }
        }
        if constexpr (ALIGN_EPI) { if (wr == 0) PG8_BAR; }
        E(acc, cur, wr, wc, fr, fq); S.done(cur);
        if (!has_next) break;
#pragma unroll
        for (int a = 0; a < 2; ++a)
#pragma unroll
            for (int b = 0; b < 2; ++b)
#pragma unroll
                for (int m = 0; m < 4; ++m)
#pragma unroll
                    for (int n = 0; n < 2; ++n) acc[a][b][m][n] = (f32x4){0.f, 0.f, 0.f, 0.f};
        cur = nxt; cA = nA; cA2 = nA2; cB = nB; ++ui;
        if constexpr (ALIGN_EPI) { if (wr == 1) PG8_BAR; }
    }
    PG8_WAIT_V(0);
    if constexpr (!ALIGN_EPI) { if (wr == 0) PG8_BAR; }
    PG8_BAR;
#undef PG8_SA
#undef PG8_SB
#undef PG8_STAGE
#undef PG8_LDA
#undef PG8_LDB
#undef PG8_MMA
#undef PG8_WAIT_V
#undef PG8_WAIT_L
#undef PG8_BAR
#undef PG8_SCHED
}
}

#define XB_TMO      128
#define XB_XCNT(j)  (256  + 64 * (j))
#define XB_XSUB(j)  (1280 + 64 * (j))
#define XB_XGEN(j)  (2304 + 64 * (j))
#define XB_TOP      3328
#define XB_TOPGEN   3392
#define XCD_BAR_WORDS 3456
#define XB_SPIN_CAP (1u << 18)
__device__ __forceinline__ unsigned xb_ld(unsigned* p)              { return __hip_atomic_load(p, __ATOMIC_RELAXED, __HIP_MEMORY_SCOPE_AGENT); }
__device__ __forceinline__ unsigned xb_add(unsigned* p, unsigned v) { return __hip_atomic_fetch_add(p, v, __ATOMIC_RELAXED, __HIP_MEMORY_SCOPE_AGENT); }
__device__ __forceinline__ unsigned xb_xcc_id() { return (unsigned)__builtin_amdgcn_s_getreg((3 << 11) | 20) & 0xFu; }
#define XB_SPIN(cond, bar) do { unsigned _sp = 0; while (cond) { __builtin_amdgcn_s_sleep(1); \
    if ((++_sp & 255u) == 0u) { if (xb_ld(&(bar)[XB_TMO])) break; if (_sp > XB_SPIN_CAP) { atomicAdd(&(bar)[XB_TMO], 1u); break; } } } } while (0)
struct XcdBarrier { unsigned* bar; unsigned x; volatile LAS unsigned* st; };
__device__ __forceinline__ XcdBarrier xcd_barrier_post(unsigned* bar, volatile LAS unsigned* st, const bool leader) {
    XcdBarrier b; b.bar = bar; b.x = xb_xcc_id(); b.st = st;
    if (leader) (void)xb_add(&bar[XB_XCNT(b.x)], 1u);
    return b;
}
__device__ __forceinline__ void xcd_barrier_complete(unsigned* bar, unsigned x, unsigned& nloc, unsigned& nx) {
    const unsigned G = gridDim.x * gridDim.y * gridDim.z;
    unsigned sum, cnt, mine, sp = 0u;
    for (;;) {
        sum = 0u; cnt = 0u; mine = 0u;
#pragma unroll
        for (unsigned j = 0; j < 16; ++j) { const unsigned c = xb_ld(&bar[XB_XCNT(j)]); sum += c; cnt += (c > 0u) ? 1u : 0u; mine = (j == x) ? c : mine; }
        if (sum == G) break;
        __builtin_amdgcn_s_sleep(1);
        if ((++sp & 255u) == 0u) { if (xb_ld(&bar[XB_TMO])) break; if (sp > XB_SPIN_CAP) { atomicAdd(&bar[XB_TMO], 1u); break; } }
    }
    nloc = mine > 0u ? mine : 1u; nx = cnt > 0u ? cnt : 1u;
}
__device__ __forceinline__ void xcd_barrier(const XcdBarrier& b, const bool leader) {
    asm volatile("s_waitcnt vmcnt(0)" ::: "memory");
    __syncthreads();
    if (leader) {
        unsigned* bar = b.bar;
        __builtin_amdgcn_s_waitcnt(0);
        unsigned nloc = b.st[0], nx = b.st[1];
        if (nloc == 0u) { xcd_barrier_complete(bar, b.x, nloc, nx); b.st[0] = nloc; b.st[1] = nx; }
        const unsigned old = xb_add(&bar[XB_XSUB(b.x)], 1u);
        const unsigned gen = old / nloc;
        if (old + 1u == (gen + 1u) * nloc) {
            __builtin_amdgcn_fence(__ATOMIC_RELEASE, "agent");
            asm volatile("s_waitcnt vmcnt(0)" ::: "memory");
            const unsigned og = xb_add(&bar[XB_TOP], 1u);
            const unsigned tg = og / nx;
            if (og + 1u == (tg + 1u) * nx) xb_add(&bar[XB_TOPGEN], 1u);
            else XB_SPIN(xb_ld(&bar[XB_TOPGEN]) == tg, bar);
            __builtin_amdgcn_fence(__ATOMIC_ACQUIRE, "agent");
            xb_add(&bar[XB_XGEN(b.x)], 1u);
            asm volatile("s_waitcnt vmcnt(0)" ::: "memory");
        } else {
            XB_SPIN(xb_ld(&bar[XB_XGEN(b.x)]) == gen, bar);
            __builtin_amdgcn_fence(__ATOMIC_ACQUIRE, "agent");
            asm volatile("s_waitcnt vmcnt(0)" ::: "memory");
        }
    }
    __syncthreads();
}

constexpr int NB = 4, SEQ = 8192, DM = 1024, NT = NB * SEQ;
constexpr int NINP = 5632;
constexpr int FF0 = 2752, FF0P = 2816, FFE = 3584, NEXP = 8;
constexpr int NWAVES = 8, NTHR = 512;
constexpr int LDS_BYTES = 155648;
constexpr int MISC_OFF = LDS_BYTES - 64;
constexpr float DN_ALPHA = 1.41421356237309515f;
constexpr int MAXPANELS = 272;
constexpr int MAXCHUNK = 5;

constexpr size_t al256(size_t x) { return (x + 255) & ~(size_t)255; }
constexpr size_t WS_CTL = 0;
constexpr size_t CTL_BYTES = 65536;
constexpr size_t CW_BAR = 0;
constexpr size_t CW_BLKCNT = 16384;
constexpr size_t CW_META = 16384 + 8192;
constexpr size_t CW_PANELE = 16384 + 8192 + 256;
constexpr size_t CW_PE32 = 16384 + 8192 + 2048;
constexpr size_t CW_PROBE = 16384 + 8192 + 4096;
constexpr size_t WS_LBS = WS_CTL + CTL_BYTES;
constexpr size_t WS_KC = WS_LBS + 4096;
constexpr size_t WS_VC = WS_KC + 1048576;
constexpr size_t WS_DEC = WS_VC + 1048576;
constexpr size_t WS_TOPI = WS_DEC + 1048576;
constexpr size_t WS_TOPG = WS_TOPI + (size_t)NT * 4;
constexpr size_t WS_ROWINFO = WS_TOPG + (size_t)NT * 8;
constexpr size_t WS_HID = al256(WS_ROWINFO + (size_t)MAXPANELS * 256 * 4);
constexpr size_t WS_B1 = WS_HID + (size_t)8192 * 128 * 2;
constexpr size_t WS_BIG = al256(WS_B1 + 4096);
constexpr size_t SZ_WIN = (size_t)NINP * DM * 2, SZ_WBR = (size_t)DM * 512 * 2, SZ_WOUT = (size_t)DM * DM * 2;
constexpr size_t WS_WIN0 = WS_BIG, WS_WIN1 = WS_WIN0 + SZ_WIN;
constexpr size_t WS_WBA0 = WS_WIN1 + SZ_WIN, WS_WBA1 = WS_WBA0 + SZ_WBR, WS_WBB0 = WS_WBA1 + SZ_WBR, WS_WBB1 = WS_WBB0 + SZ_WBR;
constexpr size_t WS_WOUT0 = WS_WBB1 + SZ_WBR, WS_WOUT1 = WS_WOUT0 + SZ_WOUT;
constexpr size_t WS_WGU0 = WS_WOUT1 + SZ_WOUT;
constexpr size_t WS_WDN0 = WS_WGU0 + (size_t)NINP * DM * 2;
constexpr size_t WS_W1T = WS_WDN0 + (size_t)DM * FF0P * 2;
constexpr size_t WS_XB = WS_W1T + (size_t)2 * 2 * 256 * 2048 * 2;
constexpr size_t WS_US = WS_XB;
constexpr size_t WS_PROJ = WS_XB + (size_t)NT * DM * 2;
constexpr size_t WS_QHG = WS_PROJ;
constexpr size_t WS_HF = WS_QHG + (size_t)NT * 512 * 2;
constexpr size_t WS_HI = WS_HF + (size_t)NT * 512 * 4;
constexpr size_t WS_HG = WS_HI + (size_t)NT * 512 * 2;
constexpr size_t WS_NQ = WS_HG + (size_t)NT * 512 * 2;
constexpr size_t WS_KV6 = WS_NQ + (size_t)NT * 512 * 2;
constexpr size_t WS_GA = WS_KV6 + (size_t)NT * 768 * 2;
constexpr size_t WS_GB = WS_GA + (size_t)NT * DM * 2;
constexpr size_t WS_NG = WS_GB + (size_t)NT * DM * 2;
constexpr size_t WS_MIX_END = WS_NG + (size_t)NT * 32 * 4;
constexpr size_t WS_H0 = WS_PROJ;
constexpr size_t WS_MGU = WS_BIG;
constexpr size_t WS_MDN = WS_MGU + (size_t)NEXP * 2 * FFE * DM * 2;
constexpr size_t WS_XS = WS_MDN + (size_t)NEXP * DM * FFE * 2;
constexpr size_t WS_HM = WS_XS + (size_t)MAXPANELS * 256 * DM * 2;
constexpr size_t WS_YM = WS_HM + (size_t)64 * 256 * FFE * 2;
constexpr size_t WS_MOE_END = WS_YM + (size_t)NT * 2 * DM * 2;
constexpr size_t WS_END = WS_MOE_END > WS_MIX_END ? WS_MOE_END : WS_MIX_END;

struct Args {
    const float* in[22]; float* out; unsigned char* ws; int ph_lo, ph_hi;
};
typedef const __attribute__((address_space(4))) Args* KArgsP;

struct EpiInProj {
    static constexpr bool PERM = false, HAS_MID = false;
    unsigned char* ws;
    __device__ __forceinline__ void operator()(const f32x4 (&acc)[2][2][4][2], const pg8::Unit& u, int wr, int wc, int fr, int fq) const {
        const int row0 = u.pm * 256 + wr * 64 + fr;
#pragma unroll
        for (int bj = 0; bj < 2; ++bj)
#pragma unroll
            for (int n = 0; n < 2; ++n) {
                const int cb = u.pn * 256 + bj * 128 + wc * 32 + n * 16;
                const int c = cb + 4 * fq;
                int kind = 0, ld = 512, co = 0; size_t base = 0; float sc = 1.f;
                if (cb < 512) { base = WS_QHG; co = c; }
                else if (cb < 1024) { kind = 1; base = WS_HF; co = c - 512; }
                else if (cb < 1536) { base = WS_HI; co = c - 1024; }
                else if (cb < 2048) { base = WS_HG; co = c - 1536; }
                else if (cb < 2560) { base = WS_NQ; co = c - 2048; sc = 0.125f * 1.4426950408889634f; }
                else if (cb < 3328) { kind = 3; base = WS_KV6; const int idx = cb - 2560; co = ((idx >> 7) * 8 + ((idx >> 6) & 1)) * SEQ * 64 + (idx & 63) + 4 * fq; }
                else if (cb < 4352) { base = WS_GA; co = c - 3328; ld = 1024; }
                else if (cb < 5376) { base = WS_GB; co = c - 4352; ld = 1024; }
                else if (cb < 5408) { kind = 1; base = WS_NG; co = c - 5376; ld = 32; }
                else kind = 2;
                if (kind == 2) continue;
#pragma unroll
                for (int ai = 0; ai < 2; ++ai)
#pragma unroll
                    for (int m = 0; m < 4; ++m) {
                        const int row = row0 + ai * 128 + m * 16;
                        const f32x4 v = acc[ai][bj][m][n];
                        if (kind == 0) { u32x2 w; w.x = cvt_pk_bf16(v[0] * sc, v[1] * sc); w.y = cvt_pk_bf16(v[2] * sc, v[3] * sc); *(u32x2*)((bf16*)(ws + base) + (size_t)row * ld + co) = w; }
                        else if (kind == 3) { u32x2 w; w.x = cvt_pk_bf16(v[0], v[1]); w.y = cvt_pk_bf16(v[2], v[3]); *(u32x2*)((bf16*)(ws + base) + (size_t)co + ((size_t)(row >> 13) * 2 * SEQ + (row & (SEQ - 1))) * 64) = w; }
                        else *(f32x4*)((float*)(ws + base) + (size_t)row * ld + co) = v;
                    }
            }
    }
};
struct EpiCmpHid {
    static constexpr bool PERM = false, HAS_MID = false;
    bf16* HID; const float* B1;
    __device__ __forceinline__ void operator()(const f32x4 (&acc)[2][2][4][2], const pg8::Unit& u, int wr, int wc, int fr, int fq) const {
        const int row0 = u.pm * 256 + wr * 64 + fr, col0 = wc * 32 + 4 * fq;
#pragma unroll
        for (int n = 0; n < 2; ++n) { const f32x4 bq = *(const f32x4*)(B1 + u.e * 128 + col0 + n * 16);
#pragma unroll
            for (int ai = 0; ai < 2; ++ai)
#pragma unroll
                for (int m = 0; m < 4; ++m) { const f32x4 v = acc[ai][0][m][n] + bq; float o[4];
#pragma unroll
                    for (int q = 0; q < 4; ++q) { const float x = v[q]; o[q] = 0.5f * x * (1.f + tanhf(0.7978845608028654f * (x + 0.044715f * x * x * x))); }
                    u32x2 w; w.x = cvt_pk_bf16(o[0], o[1]); w.y = cvt_pk_bf16(o[2], o[3]);
                    *(u32x2*)(HID + (size_t)(row0 + ai * 128 + m * 16) * 128 + col0 + n * 16) = w; } }
    }
};
template <bool FIRST> struct EpiGate {
    static constexpr bool PERM = false, HAS_MID = false;
    bf16* Y; const bf16* G;
    __device__ __forceinline__ void operator()(const f32x4 (&acc)[2][2][4][2], const pg8::Unit& u, int wr, int wc, int fr, int fq) const {
        const int row0 = u.pm * 256 + wr * 64 + fr, col0 = u.pn * 256 + wc * 32 + 4 * fq;
#pragma unroll
        for (int ai = 0; ai < 2; ++ai)
#pragma unroll
            for (int m = 0; m < 4; ++m)
#pragma unroll
                for (int bj = 0; bj < 2; ++bj)
#pragma unroll
                    for (int n = 0; n < 2; ++n) {
                        const size_t off = (size_t)(row0 + ai * 128 + m * 16) * DM + col0 + bj * 128 + n * 16;
                        const u32x2 gq = *(const u32x2*)(G + off);
                        const f32x4 v = acc[ai][bj][m][n];
                        float o0 = sigmoidf_(bflo(gq.x)) * v[0], o1 = sigmoidf_(bfhi(gq.x)) * v[1], o2 = sigmoidf_(bflo(gq.y)) * v[2], o3 = sigmoidf_(bfhi(gq.y)) * v[3];
                        if (!FIRST) { const u32x2 yq = *(const u32x2*)(Y + off); o0 += bflo(yq.x); o1 += bfhi(yq.x); o2 += bflo(yq.y); o3 += bfhi(yq.y); }
                        u32x2 w; w.x = cvt_pk_bf16(o0, o1); w.y = cvt_pk_bf16(o2, o3); *(u32x2*)(Y + off) = w;
                    }
    }
};
struct EpiGate2 {
    static constexpr bool PERM = false, HAS_MID = true;
    bf16* Y; const bf16* GA; const bf16* GB;
    static __device__ __forceinline__ float cl(float x) { return fminf(fmaxf(x, -30.f), 30.f); }
    __device__ __forceinline__ void mid(f32x4 (&acc)[2][2][4][2], const pg8::Unit& u, int wr, int wc, int fr, int fq) const {
        int row0 = u.pm * 256 + wr * 64 + fr; const int col0 = u.pn * 256 + wc * 32 + 4 * fq;
        asm volatile("" : "+v"(row0));
#pragma unroll
        for (int ai = 0; ai < 2; ++ai)
#pragma unroll
            for (int m = 0; m < 4; ++m) {
#pragma unroll
                for (int bj = 0; bj < 2; ++bj)
#pragma unroll
                    for (int n = 0; n < 2; ++n) {
                        const size_t off = (size_t)(row0 + ai * 128 + m * 16) * DM + col0 + bj * 128 + n * 16;
                        const u32x2 ga = *(const u32x2*)(GA + off), gb = *(const u32x2*)(GB + off);
                        f32x4 r;
                        r[0] = (1.f + __expf(-cl(bflo(gb.x)))) * __builtin_amdgcn_rcpf(1.f + __expf(-cl(bflo(ga.x))));
                        r[1] = (1.f + __expf(-cl(bfhi(gb.x)))) * __builtin_amdgcn_rcpf(1.f + __expf(-cl(bfhi(ga.x))));
                        r[2] = (1.f + __expf(-cl(bflo(gb.y)))) * __builtin_amdgcn_rcpf(1.f + __expf(-cl(bflo(ga.y))));
                        r[3] = (1.f + __expf(-cl(bfhi(gb.y)))) * __builtin_amdgcn_rcpf(1.f + __expf(-cl(bfhi(ga.y))));
                        acc[ai][bj][m][n] = acc[ai][bj][m][n] * r;
                    }
                asm volatile("" : "+v"(acc[ai][0][m][0]), "+v"(acc[ai][0][m][1]), "+v"(acc[ai][1][m][0]), "+v"(acc[ai][1][m][1]) :: "memory");
            }
    }
    __device__ __forceinline__ void operator()(const f32x4 (&acc)[2][2][4][2], const pg8::Unit& u, int wr, int wc, int fr, int fq) const {
        const int row0 = u.pm * 256 + wr * 64 + fr, col0 = u.pn * 256 + wc * 32 + 4 * fq;
#pragma unroll
        for (int ai = 0; ai < 2; ++ai)
#pragma unroll
            for (int m = 0; m < 4; ++m)
#pragma unroll
                for (int bj = 0; bj < 2; ++bj)
#pragma unroll
                    for (int n = 0; n < 2; ++n) {
                        const size_t off = (size_t)(row0 + ai * 128 + m * 16) * DM + col0 + bj * 128 + n * 16;
                        const u32x2 gb = *(const u32x2*)(GB + off);
                        const f32x4 v = acc[ai][bj][m][n];
                        u32x2 w; w.x = cvt_pk_bf16(v[0] * sigmoidf_(cl(bflo(gb.x))), v[1] * sigmoidf_(cl(bfhi(gb.x)))); w.y = cvt_pk_bf16(v[2] * sigmoidf_(cl(bflo(gb.y))), v[3] * sigmoidf_(cl(bfhi(gb.y))));
                        *(u32x2*)(Y + off) = w;
                    }
    }
};
struct EpiResid {
    static constexpr bool PERM = false, HAS_MID = false;
    const float* XI; float* XO;
    __device__ __forceinline__ void operator()(const f32x4 (&acc)[2][2][4][2], const pg8::Unit& u, int wr, int wc, int fr, int fq) const {
        const int row0 = u.pm * 256 + wr * 64 + fr, col0 = u.pn * 256 + wc * 32 + 4 * fq;
#pragma unroll
        for (int ai = 0; ai < 2; ++ai)
#pragma unroll
            for (int m = 0; m < 4; ++m)
#pragma unroll
                for (int bj = 0; bj < 2; ++bj)
#pragma unroll
                    for (int n = 0; n < 2; ++n) {
                        const size_t off = (size_t)(row0 + ai * 128 + m * 16) * DM + col0 + bj * 128 + n * 16;
                        const f32x4 xi = *(const f32x4*)(XI + off);
                        *(f32x4*)(XO + off) = xi * DN_ALPHA + acc[ai][bj][m][n];
                    }
    }
};
struct EpiSwiglu {
    static constexpr bool PERM = false, HAS_MID = false;
    bf16* H; int ldh;
    __device__ __forceinline__ void operator()(const f32x4 (&acc)[2][2][4][2], const pg8::Unit& u, int wr, int wc, int fr, int fq) const {
        const int row0 = u.pm * 256 + wr * 64 + fr, col0 = u.pn * 128 + wc * 32 + 4 * fq;
#pragma unroll
        for (int ai = 0; ai < 2; ++ai)
#pragma unroll
            for (int m = 0; m < 4; ++m)
#pragma unroll
                for (int n = 0; n < 2; ++n) {
                    const f32x4 gq = acc[ai][0][m][n], uq = acc[ai][1][m][n];
                    u32x2 w; w.x = cvt_pk_bf16(siluf_(gq[0]) * uq[0], siluf_(gq[1]) * uq[1]); w.y = cvt_pk_bf16(siluf_(gq[2]) * uq[2], siluf_(gq[3]) * uq[3]);
                    *(u32x2*)(H + (size_t)(row0 + ai * 128 + m * 16) * ldh + col0 + n * 16) = w;
                }
    }
};
struct EpiScatter {
    static constexpr bool PERM = false, HAS_MID = false;
    bf16* Y; const int* rowinfo;
    __device__ __forceinline__ void operator()(const f32x4 (&acc)[2][2][4][2], const pg8::Unit& u, int wr, int wc, int fr, int fq) const {
        const int row0 = u.pm * 256 + wr * 64 + fr, col0 = u.pn * 256 + wc * 32 + 4 * fq;
#pragma unroll
        for (int ai = 0; ai < 2; ++ai)
#pragma unroll
            for (int m = 0; m < 4; ++m) {
                const int info = rowinfo[row0 + ai * 128 + m * 16];
                if (info < 0) continue;
#pragma unroll
                for (int bj = 0; bj < 2; ++bj)
#pragma unroll
                    for (int n = 0; n < 2; ++n) {
                        const f32x4 v = acc[ai][bj][m][n];
                        u32x2 w; w.x = cvt_pk_bf16(v[0], v[1]); w.y = cvt_pk_bf16(v[2], v[3]);
                        *(u32x2*)(Y + (size_t)info * DM + col0 + bj * 128 + n * 16) = w;
                    }
            }
    }
};

__device__ __forceinline__ int rel_bucket(int n) {
    if (n < 16) return n;
    return 16 + (n >= 22) + (n >= 30) + (n >= 40) + (n >= 54) + (n >= 73) + (n >= 99) + (n >= 134) + (n >= 182) + (n >= 246) + (n >= 332) + (n >= 450) + (n >= 609) + (n >= 825) + (n >= 1117) + (n >= 1513);
}
template <class F>
__device__ __forceinline__ void tr_item(F colptr, int ld, int Kvalid, bf16* dst, int dstld, int n0, int k0, LAS float* scr, int lane) {
    const float* cp = colptr(n0 + 4 * (lane & 7));
#pragma unroll
    for (int i = 0; i < 8; ++i) { const int kk = 8 * i + (lane >> 3), k = k0 + kk; f32x4 v = (f32x4){0.f, 0.f, 0.f, 0.f}; if (cp && k < Kvalid) v = *(const f32x4*)(cp + (size_t)k * ld);
        LAS float* s = scr + kk * 33 + 4 * (lane & 7); s[0] = v[0]; s[1] = v[1]; s[2] = v[2]; s[3] = v[3]; }
    WAVE_SYNC();
    const int c = lane & 7;
#pragma unroll
    for (int j = 0; j < 4; ++j) { const int n = (lane >> 3) + 8 * j; const LAS float* s = scr + (8 * c) * 33 + n;
        u32x4 o; o.x = cvt_pk_bf16(s[0 * 33], s[1 * 33]); o.y = cvt_pk_bf16(s[2 * 33], s[3 * 33]); o.z = cvt_pk_bf16(s[4 * 33], s[5 * 33]); o.w = cvt_pk_bf16(s[6 * 33], s[7 * 33]);
        *(u32x4*)(dst + (size_t)(n0 + n) * dstld + k0 + 8 * c) = o; }
    WAVE_SYNC();
}

__global__ void __launch_bounds__(NTHR, 2) mega_fwd(Args args) {
    extern __shared__ __attribute__((aligned(16))) unsigned char lds_raw[];
    LAS unsigned char* lds = (LAS unsigned char*)lds_raw;
    const int G = gridDim.x, bid = blockIdx.x;
    const int nwaves = G * NWAVES;
    KArgsP kap = (KArgsP)__builtin_amdgcn_kernarg_segment_ptr();
    unsigned char* ws0 = kap->ws;
#if ONE_LAUNCH
    constexpr int lo = 0, hi = 64;
#else
    const int lo = kap->ph_lo, hi = kap->ph_hi;
#endif

    volatile LAS unsigned* misc = (volatile LAS unsigned*)(lds + MISC_OFF);
    const int wave_s = __builtin_amdgcn_readfirstlane((int)threadIdx.x >> 6);
    if (wave_s == 0 && lane_id() < 16) misc[lane_id()] = 0u;
    __syncthreads();
    XcdBarrier bar; bar.bar = (unsigned*)(ws0 + WS_CTL + CW_BAR); bar.x = 0; bar.st = misc;
    const bool multi = (hi - lo) > 1;
    if (multi) bar = xcd_barrier_post((unsigned*)(ws0 + WS_CTL + CW_BAR), misc, wave_s == 0 && lane_id() == 0);
#ifndef EN_MASK
#define EN_MASK 0xFFFFFFFFu
#endif
#define EN(b) (((EN_MASK) >> (b)) & 1u)
#define IN(k) (lo <= (k) && (k) < hi)
#ifndef PROBE_GRP
#define PROBE_GRP -1
#endif
#define PROBE_K 4
#ifndef SELREP
#define SELREP 1
#endif
#define WINREP 1
#define NSA_SGB 1
#define NSA_DUP_A 0
#define NSA_DUP_B 0
#define NSA_DUP_C 0
#ifndef PROBE_SCALE
#define PROBE_SCALE 1e-6f
#endif
#if PROBE_GRP >= 0
    unsigned long long pr_last = __builtin_amdgcn_s_memrealtime(), pr_acc = 0ull;
#define PMARK(g) do { const unsigned long long _n = __builtin_amdgcn_s_memrealtime(); if ((g) == PROBE_GRP) pr_acc += _n - pr_last; pr_last = _n; } while (0)
#else
    const unsigned long long pr_acc = 0ull; (void)pr_acc;
#define PMARK(g) do { } while (0)
#endif
#define SEAM(k, g) do { if (IN(k) && IN((k) + 1)) { XcdBarrier b_ = bar; asm volatile("" : "+s"(b_.bar)); unsigned bx_ = b_.x; asm volatile("" : "+s"(bx_)); b_.x = bx_; \
        xcd_barrier(b_, wave_s == 0 && lane_id() == 0); } PMARK(g); } while (0)


    if (EN(0) && IN(0)) { PHASE_IDS();
        LAS float* scr = (LAS float*)(lds + wave * 16384);
        constexpr int I_WIN = 16 * (NINP / 32), I_BR = 8 * 32, I_OUT = 16 * 32, I_GU = 16 * (NINP / 32), I_DN = (FF0P / 64) * 32;
        constexpr int I_W1 = 32 * 8;
        constexpr int NITEMS = 2 * (I_WIN + 2 * I_BR + I_OUT) + I_GU + I_DN + 4 * I_W1;
        for (int it = gwave; it < NITEMS; it += nwaves) {
            int r = it;
            if (r < 2 * I_WIN) { const int l = r / I_WIN; r %= I_WIN; const int nb = r % (NINP / 32), kb = r / (NINP / 32);
                const float* W = ap->in[1] + (size_t)l * DM * 5400;
                auto cp = [=](int n) -> const float* { int c; if (n < 3328) c = n; else if (n < 5376) c = n + 24; else if (n < 5400) c = n - 5376 + 3328; else return nullptr; return W + c; };
                tr_item(cp, 5400, DM, (bf16*)(ws + (l ? WS_WIN1 : WS_WIN0)), DM, nb * 32, kb * 64, scr, lane); continue; }
            r -= 2 * I_WIN;
            if (r < 4 * I_BR) { const int which = r / I_BR; r %= I_BR; const int l = which & 1, ab = which >> 1; const int nb = r % 32, kb = r / 32;
                const float* W = ap->in[ab ? 9 : 8] + (size_t)l * 512 * DM;
                auto cp = [=](int n) -> const float* { return W + n; };
                tr_item(cp, DM, 512, (bf16*)(ws + WS_WBA0 + (size_t)l * 2 * SZ_WBR) + ab * 512, DM, nb * 32, kb * 64, scr, lane); continue; }
            r -= 4 * I_BR;
            if (r < 2 * I_OUT) { const int l = r / I_OUT; r %= I_OUT; const int nb = r % 32, kb = r / 32;
                const float* W = ap->in[10] + (size_t)l * DM * DM;
                auto cp = [=](int n) -> const float* { return W + n; };
                tr_item(cp, DM, DM, (bf16*)(ws + (l ? WS_WOUT1 : WS_WOUT0)), DM, nb * 32, kb * 64, scr, lane); continue; }
            r -= 2 * I_OUT;
            if (r < I_GU) { const int nb = r % (NINP / 32), kb = r / (NINP / 32);
                const float* Wg = ap->in[15]; const float* Wu = ap->in[16];
                auto cp = [=](int n) -> const float* { const int pn = n >> 8, hf = (n >> 7) & 1, c = pn * 128 + (n & 127); if (c >= FF0) return nullptr; return (hf ? Wu : Wg) + c; };
                tr_item(cp, FF0, DM, (bf16*)(ws + WS_WGU0), DM, nb * 32, kb * 64, scr, lane); continue; }
            r -= I_GU;
            if (r >= I_DN) { r -= I_DN; const int lk = r / I_W1; r %= I_W1; const int nb = r % 8, kb = r / 8;
                const float* W = ap->in[5] + (size_t)lk * 2048 * 128;
                auto cp = [=](int n) -> const float* { return n < 128 ? W + n : nullptr; };
                tr_item(cp, 128, 2048, (bf16*)(ws + WS_W1T) + (size_t)lk * 256 * 2048, 2048, nb * 32, kb * 64, scr, lane); continue; }
            { const int nb = r % 32, kb = r / 32;
                const float* W = ap->in[17];
                auto cp = [=](int n) -> const float* { return W + n; };
                tr_item(cp, DM, FF0, (bf16*)(ws + WS_WDN0), FF0P, nb * 32, kb * 64, scr, lane); }
        }
        for (int row = gwave; row < NT; row += nwaves) {
            const f32x4* xr = (const f32x4*)(x_in + (size_t)row * DM);
            u32x2* o = (u32x2*)(XB + (size_t)row * DM);
#pragma unroll
            for (int j = 0; j < 4; ++j) { const f32x4 v = xr[64 * j + lane]; u32x2 w; w.x = cvt_pk_bf16(v[0], v[1]); w.y = cvt_pk_bf16(v[2], v[3]); o[64 * j + lane] = w; }
        }
        for (int o = gwave; o < 4 * 128; o += nwaves) { const int lk = o >> 7, j = o & 127; const float* PS = ap->in[4] + (size_t)lk * 2048; const float* W = ap->in[5] + (size_t)lk * 2048 * 128;
            float s = 0.f; for (int k = lane; k < 2048; k += 64) s += PS[k] * W[(size_t)k * 128 + j];
            s = wave_sum(s); if (lane == 0) ((float*)(ws + WS_B1))[o] = s; }
        if (bid == 0 && tid < 32) ((int*)(ws + WS_CTL + CW_PE32))[tid] = tid >> 4;
        if (bid == 0) {
            const float* lg = ap->in[2];
            const float a = lg[tid], b = lg[512 + tid], m = fmaxf(a, b), ea = expf(a - m), eb = expf(b - m), s = ea + eb, p0 = ea / s, p1 = eb / s;
            LBS[tid] = p0 - p0; LBS[512 + tid] = (p0 + p1) - p0;
        }
    }
    SEAM(0, 0);

    for (int l = 0; l < 2; ++l) {
        const int pb = 1 + l * 10;

        if (EN(1) && IN(pb + 0)) { PHASE_IDS();
            pg8::Gemm g{XB, (const bf16*)(ws + (l ? WS_WIN1 : WS_WIN0)), NT, NINP, DM, 0, 0, nullptr, 0};
            pg8::StaticOrder S; S.init(NT, NINP, G, bid);
            EpiInProj E{ws};
            pg8::gemm_phase<EpiInProj, pg8::StaticOrder>(lds, g, S, E, wave_s);
        }
        SEAM(pb + 0, 1);

        if (EN(2) && IN(pb + 1)) { PHASE_IDS();
            {
                constexpr int RS = 272;
                LAS float* bsf = (LAS float*)lds;
                LAS unsigned char* kd = lds + 32768;
                LAS unsigned char* vt = lds + 32768 + 64 * RS;
                const bf16* HI = (const bf16*)(ws + WS_HI); const float* HF = (const float*)(ws + WS_HF);
                bf16* US = (bf16*)(ws + WS_US); float* DEC = (float*)(ws + WS_DEC);
                const int d = tid & 127, tp = tid >> 7;
                const int d0 = 4 * (tid & 31), tg = tid >> 5;
                f32x4 zr[4];
                auto ld_z = [&](int it) { const int h = it & 3, ci = (it >> 2) & 127, b = it >> 9; const size_t tok0 = (size_t)b * SEQ + ci * 64;
#pragma unroll
                    for (int i = 0; i < 4; ++i) zr[i] = *(const f32x4*)(HF + (tok0 + tg + 16 * i) * 512 + h * 128 + d0); };
                ld_z(bid);
                for (int item = bid; item < NB * 128 * 4; item += G) {
                    const int h = item & 3, ci = (item >> 2) & 127, b = item >> 9, bh = b * 4 + h;
                    const size_t tok0 = (size_t)b * SEQ + ci * 64;
                    const f32x4 lb4 = *(const f32x4*)(LBS + l * 512 + h * 128 + d0);
                    f32x4 kk[4];
#pragma unroll
                    for (int i = 0; i < 4; ++i) { const int t = tg + 16 * i; f32x4 lg;
#pragma unroll
                        for (int c = 0; c < 4; ++c) { kk[i][c] = (1.f - lb4[c]) * __builtin_amdgcn_rcpf(1.f + __expf(zr[i][c])); lg[c] = __logf(1.f - kk[i][c]); }
                        *(LAS f32x4*)(bsf + t * 128 + d0) = lg; }
                    { const int t = tid >> 3, c8 = tid & 7;
                        const u32x4* src = (const u32x4*)(HI + (tok0 + t) * 512 + h * 128) + c8 * 2;
                        const u32x4 a0 = src[0], a1 = src[1]; *(LAS u32x4*)(vt + t * RS + c8 * 32) = a0; *(LAS u32x4*)(vt + t * RS + c8 * 32 + 16) = a1; }
                    __syncthreads();
                    { float run = 0.f;
#pragma unroll
                        for (int i = 0; i < 16; ++i) { run += bsf[(16 * tp + i) * 128 + d]; bsf[(16 * tp + i) * 128 + d] = run; } }
                    __syncthreads();
                    float off = 0.f;
                    for (int p = 0; p < tp; ++p) off += bsf[(16 * p + 15) * 128 + d];
                    __syncthreads();
#pragma unroll
                    for (int i = 0; i < 16; ++i) bsf[(16 * tp + i) * 128 + d] += off;
                    __syncthreads();
                    { const f32x4 bl = *(const LAS f32x4*)(bsf + 63 * 128 + d0);
                        if (tg == 0) { f32x4 e; e[0] = __expf(bl[0]); e[1] = __expf(bl[1]); e[2] = __expf(bl[2]); e[3] = __expf(bl[3]); *(f32x4*)(DEC + ((size_t)bh * 128 + ci) * 128 + d0) = e; }
#pragma unroll
                        for (int i = 0; i < 4; ++i) { const int t = tg + 16 * i; const f32x4 bt = *(const LAS f32x4*)(bsf + t * 128 + d0);
                            u32x2 w; w.x = cvt_pk_bf16(kk[i][0] * __expf(bl[0] - bt[0]), kk[i][1] * __expf(bl[1] - bt[1])); w.y = cvt_pk_bf16(kk[i][2] * __expf(bl[2] - bt[2]), kk[i][3] * __expf(bl[3] - bt[3]));
                            *(LAS u32x2*)(kd + t * RS + d0 * 2) = w; } }
                    __syncthreads();
                    if (item + G < NB * 128 * 4) ld_z(item + G);
                    {
                        const int mi = wave >> 1, r31 = lane & 31, hh = lane >> 5, i16 = lane & 15, sub = (lane >> 4) & 1;
                        f32x16 acc[2];
#pragma unroll
                        for (int q = 0; q < 2; ++q)
#pragma unroll
                            for (int r = 0; r < 16; ++r) acc[q][r] = 0.f;
#pragma unroll
                        for (int st = 0; st < 4; ++st) {
                            const LAS unsigned char* ka = kd + (16 * st + 8 * hh + (i16 >> 2)) * RS + (32 * mi + 16 * sub + 4 * (i16 & 3)) * 2;
                            const s16x4 k0 = __builtin_amdgcn_ds_read_tr16_b64_v4i16((LAS s16x4*)ka), k1 = __builtin_amdgcn_ds_read_tr16_b64_v4i16((LAS s16x4*)(ka + 4 * RS));
                            const bf16x8 af = __builtin_shufflevector(k0, k1, 0, 1, 2, 3, 4, 5, 6, 7);
#pragma unroll
                            for (int q = 0; q < 2; ++q) { const int ni = 2 * (wave & 1) + q;
                                const LAS unsigned char* va = vt + (16 * st + 8 * hh + (i16 >> 2)) * RS + (32 * ni + 16 * sub + 4 * (i16 & 3)) * 2;
                                const s16x4 v0 = __builtin_amdgcn_ds_read_tr16_b64_v4i16((LAS s16x4*)va), v1 = __builtin_amdgcn_ds_read_tr16_b64_v4i16((LAS s16x4*)(va + 4 * RS));
                                const bf16x8 bf = __builtin_shufflevector(v0, v1, 0, 1, 2, 3, 4, 5, 6, 7);
                                acc[q] = __builtin_amdgcn_mfma_f32_32x32x16_bf16(af, bf, acc[q], 0, 0, 0); } }
                        bf16* u = US + ((size_t)bh * 128 + ci) * 16384;
#pragma unroll
                        for (int q = 0; q < 2; ++q) { const int dv = 32 * (2 * (wave & 1) + q) + r31;
#pragma unroll
                            for (int rq = 0; rq < 4; ++rq) { u32x2 w; w.x = cvt_pk_bf16(acc[q][4 * rq], acc[q][4 * rq + 1]); w.y = cvt_pk_bf16(acc[q][4 * rq + 2], acc[q][4 * rq + 3]);
                                *(u32x2*)(u + dv * 128 + 32 * mi + 8 * rq + 4 * hh) = w; } }
                    }
                    __syncthreads();
                }
            }
            {
                pg8::Gemm g{(const bf16*)(ws + WS_KV6), (const bf16*)(ws + WS_W1T) + (size_t)l * 2 * 256 * 2048, 8192, 256, 2048, (size_t)256 * 2048, 1024, nullptr, 0};
                pg8::StaticOrder S; S.init(8192, 256, G, bid, (const int*)(ws + WS_CTL + CW_PE32));
                EpiCmpHid E{(bf16*)(ws + WS_HID), (const float*)(ws + WS_B1) + l * 256};
                pg8::gemm_phase<EpiCmpHid, pg8::StaticOrder>(lds, g, S, E, wave_s);
            }
        }
        SEAM(pb + 1, 2);

        if (EN(3) && IN(pb + 2)) { PHASE_IDS();
            {
                unsigned* US32 = (unsigned*)(ws + WS_US); const float* DEC = (const float*)(ws + WS_DEC);
                for (int e2 = bid * NTHR + tid; e2 < 16 * 8192; e2 += G * NTHR) {
                    const int bh = e2 >> 13, dv2 = e2 & 8191, d = (2 * dv2) & 127;
                    float s0 = 0.f, s1 = 0.f;
#pragma unroll 1
                    for (int c0 = 0; c0 < 128; c0 += 16) {
                        unsigned u[16]; f32x2 dec[16];
#pragma unroll
                        for (int i = 0; i < 16; ++i) { u[i] = US32[((size_t)bh * 128 + c0 + i) * 8192 + dv2]; dec[i] = *(const f32x2*)(DEC + ((size_t)bh * 128 + c0 + i) * 128 + d); }
#pragma unroll
                        for (int i = 0; i < 16; ++i) { US32[((size_t)bh * 128 + c0 + i) * 8192 + dv2] = cvt_pk_bf16(s0, s1); s0 = dec[i][0] * s0 + bflo(u[i]); s1 = dec[i][1] * s1 + bfhi(u[i]); }
                    }
                }
            }
            {
                const bf16* HID = (const bf16*)(ws + WS_HID); bf16* KCb = (bf16*)(ws + WS_KC);
                for (int row = gwave; row < 8192; row += nwaves) { const int kind = row >> 12;
                    const float* W2 = ap->in[6] + ((size_t)l * 2 + kind) * 128 * 64;
                    const unsigned hv = ((const unsigned*)(HID + (size_t)row * 128))[lane];
                    float o = 0.f;
#pragma unroll 8
                    for (int j = 0; j < 64; ++j) { const unsigned hj = (unsigned)__builtin_amdgcn_readlane((int)hv, j); o += bflo(hj) * W2[(2 * j) * 64 + lane] + bfhi(hj) * W2[(2 * j + 1) * 64 + lane]; }
                    KCb[(size_t)row * 64 + lane] = f2bf(o); }
            }
        }
        SEAM(pb + 2, 3);

        if (EN(4) && IN(pb + 3)) {
          if (EN(16)) { PHASE_IDS();
            {
                constexpr int RS = 272;
                LAS float* bsf = (LAS float*)lds;
                LAS unsigned char* qh = lds + 32768;
                LAS unsigned char* q1 = qh + 64 * RS;
                LAS unsigned char* k0 = q1 + 32 * RS;
                LAS unsigned char* k1 = k0 + 32 * RS;
                LAS unsigned char* vt = k1 + 64 * RS;
                LAS float* ssq = (LAS float*)(vt + 64 * RS);
                bf16* QHG = (bf16*)(ws + WS_QHG); const bf16* HI = (const bf16*)(ws + WS_HI); const bf16* HG = (const bf16*)(ws + WS_HG); const float* HF = (const float*)(ws + WS_HF);
                const bf16* US = (const bf16*)(ws + WS_US);
                const float* NW = ap->in[3] + l * 512;
                const int d = tid & 127, tp = tid >> 7;
                const int d0 = 4 * (tid & 31), tg = tid >> 5;
                for (int item = bid; item < NB * 128 * 4; item += G) {
                    const int h = item & 3, ci = (item >> 2) & 127, b = item >> 9, bh = b * 4 + h;
                    const size_t tok0 = (size_t)b * SEQ + ci * 64;
                    const f32x4 lb4 = *(const f32x4*)(LBS + l * 512 + h * 128 + d0);
                    bf16x8 sf[8];
                    { const bf16* Sg = US + ((size_t)bh * 128 + ci) * 16384 + (size_t)(32 * (wave & 3) + (lane & 31)) * 128 + 8 * (lane >> 5);
#pragma unroll
                        for (int st = 0; st < 8; ++st) sf[st] = *(const bf16x8*)(Sg + 16 * st); }
                    f32x4 kk[4]; u32x2 qp[4];
                    { f32x4 z4[4];
#pragma unroll
                        for (int i = 0; i < 4; ++i) { const size_t go = (tok0 + tg + 16 * i) * 512 + h * 128 + d0; z4[i] = *(const f32x4*)(HF + go); qp[i] = *(const u32x2*)(QHG + go); }
#pragma unroll
                        for (int i = 0; i < 4; ++i) { const int t = tg + 16 * i; f32x4 lg;
#pragma unroll
                            for (int c = 0; c < 4; ++c) { kk[i][c] = (1.f - lb4[c]) * __builtin_amdgcn_rcpf(1.f + __expf(z4[i][c])); lg[c] = __logf(1.f - kk[i][c]); }
                            *(LAS f32x4*)(bsf + t * 128 + d0) = lg; } }
                    { const int t = tid >> 3, c8 = tid & 7;
                        const u32x4* src = (const u32x4*)(HI + (tok0 + t) * 512 + h * 128) + c8 * 2;
                        const u32x4 a0 = src[0], a1 = src[1]; *(LAS u32x4*)(vt + t * RS + c8 * 32) = a0; *(LAS u32x4*)(vt + t * RS + c8 * 32 + 16) = a1; }
                    __syncthreads();
                    { float run = 0.f;
#pragma unroll
                        for (int i = 0; i < 16; ++i) { run += bsf[(16 * tp + i) * 128 + d]; bsf[(16 * tp + i) * 128 + d] = run; } }
                    __syncthreads();
                    float off = 0.f;
                    for (int p = 0; p < tp; ++p) off += bsf[(16 * p + 15) * 128 + d];
                    __syncthreads();
#pragma unroll
                    for (int i = 0; i < 16; ++i) bsf[(16 * tp + i) * 128 + d] += off;
                    __syncthreads();
                    { const f32x4 b31 = *(const LAS f32x4*)(bsf + 31 * 128 + d0);
#pragma unroll
                        for (int i = 0; i < 4; ++i) { const int t = tg + 16 * i; const f32x4 bt = *(const LAS f32x4*)(bsf + t * 128 + d0);
                            const float q0 = bflo(qp[i].x), q1v = bfhi(qp[i].x), q2 = bflo(qp[i].y), q3 = bfhi(qp[i].y);
                            u32x2 w;
                            w.x = cvt_pk_bf16(q0 * __expf(bt[0]), q1v * __expf(bt[1])); w.y = cvt_pk_bf16(q2 * __expf(bt[2]), q3 * __expf(bt[3]));
                            *(LAS u32x2*)(qh + t * RS + d0 * 2) = w;
                            w.x = cvt_pk_bf16(kk[i][0] * __expf(fminf(b31[0] - bt[0], 80.f)), kk[i][1] * __expf(fminf(b31[1] - bt[1], 80.f)));
                            w.y = cvt_pk_bf16(kk[i][2] * __expf(fminf(b31[2] - bt[2], 80.f)), kk[i][3] * __expf(fminf(b31[3] - bt[3], 80.f)));
                            *(LAS u32x2*)(k1 + t * RS + d0 * 2) = w;
                            if (i < 2) {
                                w.x = cvt_pk_bf16(kk[i][0] * __expf(fminf(-bt[0], 80.f)), kk[i][1] * __expf(fminf(-bt[1], 80.f)));
                                w.y = cvt_pk_bf16(kk[i][2] * __expf(fminf(-bt[2], 80.f)), kk[i][3] * __expf(fminf(-bt[3], 80.f)));
                                *(LAS u32x2*)(k0 + t * RS + d0 * 2) = w;
                            } else {
                                w.x = cvt_pk_bf16(q0 * __expf(bt[0] - b31[0]), q1v * __expf(bt[1] - b31[1])); w.y = cvt_pk_bf16(q2 * __expf(bt[2] - b31[2]), q3 * __expf(bt[3] - b31[3]));
                                *(LAS u32x2*)(q1 + (t - 32) * RS + d0 * 2) = w; } } }
                    __syncthreads();
                    {
                        const int ni = wave & 3, mi = wave >> 2, r31 = lane & 31, hh = lane >> 5, i16 = lane & 15, sub = (lane >> 4) & 1;
                        f32x16 acc;
#pragma unroll
                        for (int r = 0; r < 16; ++r) acc[r] = 0.f;
#pragma unroll
                        for (int st = 0; st < 8; ++st) { const bf16x8 bq = *(const LAS bf16x8*)(qh + (32 * mi + r31) * RS + (16 * st + 8 * hh) * 2);
                            acc = __builtin_amdgcn_mfma_f32_32x32x16_bf16(sf[st], bq, acc, 0, 0, 0); }
#pragma unroll
                        for (int jb = 0; jb < 2; ++jb) { if (jb > mi) continue;
                            f32x16 x;
#pragma unroll
                            for (int r = 0; r < 16; ++r) x[r] = 0.f;
                            const LAS unsigned char* kb = (mi == 0) ? k0 : (k1 + 32 * jb * RS);
                            const LAS unsigned char* qb = (mi == 0) ? qh : q1;
#pragma unroll
                            for (int st = 0; st < 8; ++st) { const bf16x8 ka = *(const LAS bf16x8*)(kb + r31 * RS + (16 * st + 8 * hh) * 2), qq = *(const LAS bf16x8*)(qb + r31 * RS + (16 * st + 8 * hh) * 2);
                                x = __builtin_amdgcn_mfma_f32_32x32x16_bf16(ka, qq, x, 0, 0, 0); }
                            if (jb == mi) {
#pragma unroll
                                for (int r = 0; r < 16; ++r) { const int key = (r & 3) + 8 * (r >> 2) + 4 * hh; if (key > r31) x[r] = 0.f; } }
#pragma unroll
                            for (int s2 = 0; s2 < 2; ++s2) { u32x4 w; w.x = cvt_pk_bf16(x[8 * s2], x[8 * s2 + 1]); w.y = cvt_pk_bf16(x[8 * s2 + 2], x[8 * s2 + 3]); w.z = cvt_pk_bf16(x[8 * s2 + 4], x[8 * s2 + 5]); w.w = cvt_pk_bf16(x[8 * s2 + 6], x[8 * s2 + 7]);
                                const bf16x8 xb = __builtin_bit_cast(bf16x8, w);
                                const LAS unsigned char* va = vt + (32 * jb + 16 * s2 + 4 * hh + (i16 >> 2)) * RS + (32 * ni + 16 * sub + 4 * (i16 & 3)) * 2;
                                const s16x4 v0 = __builtin_amdgcn_ds_read_tr16_b64_v4i16((LAS s16x4*)va), v1 = __builtin_amdgcn_ds_read_tr16_b64_v4i16((LAS s16x4*)(va + 8 * RS));
                                const bf16x8 vf = __builtin_shufflevector(v0, v1, 0, 1, 2, 3, 4, 5, 6, 7);
                                acc = __builtin_amdgcn_mfma_f32_32x32x16_bf16(vf, xb, acc, 0, 0, 0); } }
                        u32x2 gq4[4];
                        { const size_t gg = (tok0 + 32 * mi + r31) * 512 + h * 128 + 32 * ni + 4 * hh;
#pragma unroll
                          for (int rq = 0; rq < 4; ++rq) gq4[rq] = *(const u32x2*)(HG + gg + 8 * rq); }
                        float ss = 0.f;
#pragma unroll
                        for (int r = 0; r < 16; ++r) ss += acc[r] * acc[r];
                        ss += __shfl_xor(ss, 32);
                        if (hh == 0) ssq[ni * 64 + 32 * mi + r31] = ss;
                        __syncthreads();
                        const int tl = 32 * mi + r31;
                        const float tot = ssq[tl] + ssq[64 + tl] + ssq[128 + tl] + ssq[192 + tl];
                        const float rn = rsqrtf(tot * (1.f / 128.f) + 1e-6f);
                        const size_t go = (tok0 + tl) * 512 + h * 128 + 32 * ni + 4 * hh;
#pragma unroll
                        for (int rq = 0; rq < 4; ++rq) { const u32x2 gq = gq4[rq]; const f32x4 nw = *(const f32x4*)(NW + h * 128 + 32 * ni + 4 * hh + 8 * rq);
                            u32x2 w; w.x = cvt_pk_bf16(acc[4 * rq] * rn * nw[0] * siluf_(bflo(gq.x)), acc[4 * rq + 1] * rn * nw[1] * siluf_(bfhi(gq.x)));
                            w.y = cvt_pk_bf16(acc[4 * rq + 2] * rn * nw[2] * siluf_(bflo(gq.y)), acc[4 * rq + 3] * rn * nw[3] * siluf_(bfhi(gq.y)));
                            *(u32x2*)(QHG + go + 8 * rq) = w; }
                    }
                    __syncthreads();
                }
            }
          }
          PMARK(15);
          if (EN(17)) { PHASE_IDS();
            {
                constexpr int KST = 144, TB = 9216;
                constexpr float LOG2E = 1.4426950408889634f;
                LAS unsigned char* kvb = lds;
                LAS float* lut = (LAS float*)(lds + 4 * TB);
                LAS float* impW = (LAS float*)(lds + 4 * TB + 32768 + wave * 8192);
                LAS float* ocl = impW + lane;
                LAS unsigned* selm = (LAS unsigned*)(lds + 4 * TB + 32768 + 65536);
                const bf16* NQ = (const bf16*)(ws + WS_NQ); const bf16* KVT = (const bf16*)(ws + WS_KV6); const bf16* KCb = (const bf16*)(ws + WS_KC);
                const float* NG = (const float*)(ws + WS_NG); const float* RB = ap->in[7];
                bf16* OB = (bf16*)(ws + WS_NQ);
                const int col = lane & 15, q4 = lane >> 4, head = col & 3, ti = col >> 2;
                const float NINF = -__builtin_inff();
                const bool lut_once = (G & 7) == 0;
                LAS float* gld = (LAS float*)(lds + 4 * TB + 32768 + 65536 + 1024) + wave * 96;
                if (lut_once) { const int g = bid & 1; __syncthreads();
                    for (int d = tid; d < 2048; d += NTHR) { const int bk = rel_bucket(d); *(LAS f32x4*)(lut + d * 4) = *(const f32x4*)(RB + bk * 8 + g * 4) * LOG2E; } }
                for (int pq = bid; pq < 512; pq += G)
#pragma unroll 1
                for (int odd = 0; odd < 2; ++odd) {
                    const int bg = pq & 7, xx = pq >> 3, tile = odd ? 127 - xx : xx, b = bg >> 1, g = bg & 1, t0 = tile * 64, cur = tile;
                    const size_t tokw = (size_t)b * SEQ + t0 + 8 * wave;
                    int tq[2]; bf16x8 qf[2][2];
                    auto gatev = [&](int gq, int br) -> float { return gld[(gq * 3 + br) * 16 + col]; };
                    float gl[6];
#pragma unroll
                    for (int gq = 0; gq < 2; ++gq)
#pragma unroll
                        for (int br = 0; br < 3; ++br) gl[gq * 3 + br] = NG[(tokw + 4 * gq + ti) * 32 + (g * 4 + head) * 3 + br];
#pragma unroll
                    for (int gq = 0; gq < 2; ++gq) { tq[gq] = t0 + 8 * wave + 4 * gq + ti; const size_t tok = tokw + 4 * gq + ti;
#pragma unroll
                        for (int s = 0; s < 2; ++s) qf[gq][s] = *(const bf16x8*)(NQ + tok * 512 + (g * 4 + head) * 64 + 32 * s + 8 * q4);
                    }
                    const float bfar = RB[31 * 8 + g * 4 + head] * LOG2E;
                    __syncthreads();
                    if (!lut_once) for (int d = tid; d < 2048; d += NTHR) { const int bk = rel_bucket(d); *(LAS f32x4*)(lut + d * 4) = *(const f32x4*)(RB + bk * 8 + g * 4) * LOG2E; }
                    for (int i = lane; i < 8 * 128; i += 64) impW[i] = 0.f;
                    f32x4 O[2][4], Ls[2];
                    float m[2], l[2], m1[2] = {0.f, 0.f}, linv[2] = {0.f, 0.f}, carry[2] = {0.f, 0.f};
                    const bf16x8 ones8 = {0x3F80, 0x3F80, 0x3F80, 0x3F80, 0x3F80, 0x3F80, 0x3F80, 0x3F80};
                    auto soft = [&](const int mode, const int gq, f32x4 (&st)[4], bf16x8 (&pb)[2], const int pos0, const bool far, const bool full, const float cbias, const bool colsel, const int sblk0) {
                        float tmax = NINF;
                        if (far) {
#pragma unroll
                            for (int kt = 0; kt < 4; ++kt)
#pragma unroll
                                for (int r = 0; r < 4; ++r) tmax = fmaxf(tmax, st[kt][r]);
                            tmax += cbias;
                        } else if (mode >= 2) {
                            const int dbase = tq[gq] - (pos0 + 4 * q4);
                            const LAS float* lb = lut + (dbase - 51) * 4 + head;
                            const float cadd = (mode == 2 && !colsel) ? NINF : 0.f;
                            float bv[4][4];
#pragma unroll
                            for (int kt = 0; kt < 4; ++kt)
#pragma unroll
                                for (int r = 0; r < 4; ++r) bv[kt][r] = lb[(51 - 16 * kt - r) * 4];
                            asm volatile("" : "+v"(bv[0][0]), "+v"(bv[0][1]), "+v"(bv[0][2]), "+v"(bv[0][3]), "+v"(bv[1][0]), "+v"(bv[1][1]), "+v"(bv[1][2]), "+v"(bv[1][3]));
                            asm volatile("" : "+v"(bv[2][0]), "+v"(bv[2][1]), "+v"(bv[2][2]), "+v"(bv[2][3]), "+v"(bv[3][0]), "+v"(bv[3][1]), "+v"(bv[3][2]), "+v"(bv[3][3]));
#pragma unroll
                            for (int kt = 0; kt < 4; ++kt)
#pragma unroll
                                for (int r = 0; r < 4; ++r) { float sv = st[kt][r] + bv[kt][r];
                                    if (mode == 2) sv += cadd;
                                    if (!full) { const int dist = dbase - (16 * kt + r); const bool valid = (mode == 3) ? ((unsigned)dist < 512u) : (dist >= 0); sv = valid ? sv : NINF; }
                                    st[kt][r] = sv; tmax = fmaxf(tmax, sv); }
                        } else {
                            const int dbase = tq[gq] - 16 * (pos0 + 4 * q4) - 31;
                            float bv[4][4];
#pragma unroll
                            for (int kt = 0; kt < 4; ++kt)
#pragma unroll
                                for (int r = 0; r < 4; ++r) { const int dist = dbase - 16 * (16 * kt + r); const unsigned di = (unsigned)dist < 2047u ? (unsigned)dist : 2047u; bv[kt][r] = lut[di * 4 + head]; }
#pragma unroll
                            for (int kt = 0; kt < 4; ++kt)
#pragma unroll
                                for (int r = 0; r < 4; ++r) { float sv = st[kt][r] + bv[kt][r];
                                    if (!full) { const int dist = dbase - 16 * (16 * kt + r); sv = (dist >= 0) ? sv : NINF; }
                                    st[kt][r] = sv; tmax = fmaxf(tmax, sv); }
                        }
                        float muse;
                        if (mode == 1) muse = m1[gq];
                        else {
                            tmax = max_x16(tmax); tmax = max_x32(tmax);
                            const float mnew = fmaxf(m[gq], tmax);
                            if (__any(mnew != m[gq])) {
                                const float mu = (mnew == NINF) ? 0.f : mnew;
                                const float alpha = __builtin_amdgcn_exp2f(m[gq] - mu);
                                m[gq] = mnew; l[gq] *= alpha;
                                if (mode >= 2) { Ls[gq] = Ls[gq] * alpha;
#pragma unroll
                                    for (int mt = 0; mt < 4; ++mt) O[gq][mt] = O[gq][mt] * alpha; }
                            }
                            muse = (m[gq] == NINF) ? 0.f : m[gq];
                        }
                        const float esub = far ? muse - cbias : muse;
                        float ls = 0.f;
#pragma unroll
                        for (int kt = 0; kt < 4; ++kt)
#pragma unroll
                            for (int r = 0; r < 4; ++r) { float p = __builtin_amdgcn_exp2f(st[kt][r] - esub); if (mode == 1) p *= linv[gq]; st[kt][r] = p; if (mode <= 1) ls += p; }
#if NSA_DUP_B
                        if (mode == 2) { float acc2 = 0.f;
#pragma unroll
                            for (int kt = 0; kt < 4; ++kt)
#pragma unroll
                                for (int r = 0; r < 4; ++r) { float x = st[kt][r]; asm volatile("" : "+v"(x)); const float p2 = __builtin_amdgcn_exp2f(x * 0.5f - esub); acc2 = fmaxf(acc2, p2 + x); }
                            asm volatile("" :: "v"(acc2)); }
#endif
                        if (mode <= 1) l[gq] += ls;
                        if (mode == 1) {
                            float a[4], h3[4];
#pragma unroll
                            for (int kt = 0; kt < 4; ++kt) { a[kt] = st[kt][0] + st[kt][1] + st[kt][2] + 0.5f * st[kt][3]; h3[kt] = 0.5f * st[kt][3];
                                a[kt] += dpp_x1(a[kt]); a[kt] += dpp_x2(a[kt]); h3[kt] += dpp_x1(h3[kt]); h3[kt] += dpp_x2(h3[kt]); }
#pragma unroll
                            for (int kt = 0; kt < 4; ++kt) { const float give = (q4 == 3) ? (kt > 0 ? h3[kt - 1] : carry[gq]) : h3[kt];
                                const float prev = __shfl(give, (lane - 16) & 63);
                                if (head == 0) impW[(4 * gq + ti) * 128 + sblk0 + 4 * kt + q4] = a[kt] + prev; }
                            carry[gq] = h3[3];
                        }
                        if (mode != 0) {
#pragma unroll
                            for (int s = 0; s < 2; ++s) { u32x4 w; w.x = cvt_pk_bf16(st[2 * s][0], st[2 * s][1]); w.y = cvt_pk_bf16(st[2 * s][2], st[2 * s][3]);
                                w.z = cvt_pk_bf16(st[2 * s + 1][0], st[2 * s + 1][1]); w.w = cvt_pk_bf16(st[2 * s + 1][2], st[2 * s + 1][3]); pb[s] = __builtin_bit_cast(bf16x8, w); } }
                    };
                    auto tile2 = [&](const int mode, const LAS unsigned char* kbuf, const LAS unsigned char* vbuf, const int pos0, const bool far, const bool full, const bool a0, const bool a1,
                                     const float cb0, const float cb1, const bool cs0, const bool cs1, const int sblk0) {
                        f32x4 st0[4], st1[4]; bf16x8 pb0[2], pb1[2];
#pragma unroll
                        for (int kt = 0; kt < 4; ++kt) {
                            const bf16x8 kf0 = *(const LAS bf16x8*)(kbuf + (16 * kt + col) * KST + 16 * q4), kf1 = *(const LAS bf16x8*)(kbuf + (16 * kt + col) * KST + 64 + 16 * q4);
                            if (a0) { st0[kt] = __builtin_amdgcn_mfma_f32_16x16x32_bf16(kf0, qf[0][0], (f32x4){0.f, 0.f, 0.f, 0.f}, 0, 0, 0); st0[kt] = __builtin_amdgcn_mfma_f32_16x16x32_bf16(kf1, qf[0][1], st0[kt], 0, 0, 0); }
                            if (a1) { st1[kt] = __builtin_amdgcn_mfma_f32_16x16x32_bf16(kf0, qf[1][0], (f32x4){0.f, 0.f, 0.f, 0.f}, 0, 0, 0); st1[kt] = __builtin_amdgcn_mfma_f32_16x16x32_bf16(kf1, qf[1][1], st1[kt], 0, 0, 0); } }
#if NSA_DUP_A
                        if (mode == 2) {
#pragma unroll
                            for (int kt = 0; kt < 4; ++kt) {
                                const bf16x8 kf0 = *(const LAS bf16x8*)(kbuf + (16 * kt + col) * KST + 16 * q4 + 32), kf1 = *(const LAS bf16x8*)(kbuf + (16 * kt + col) * KST + 64 + 16 * q4 - 32);
                                f32x4 d0 = __builtin_amdgcn_mfma_f32_16x16x32_bf16(kf0, qf[0][0], (f32x4){0.f, 0.f, 0.f, 0.f}, 0, 0, 0); d0 = __builtin_amdgcn_mfma_f32_16x16x32_bf16(kf1, qf[0][1], d0, 0, 0, 0);
                                f32x4 d1 = __builtin_amdgcn_mfma_f32_16x16x32_bf16(kf0, qf[1][0], (f32x4){0.f, 0.f, 0.f, 0.f}, 0, 0, 0); d1 = __builtin_amdgcn_mfma_f32_16x16x32_bf16(kf1, qf[1][1], d1, 0, 0, 0);
                                asm volatile("" :: "v"(d0), "v"(d1)); } }
#endif
                        if (a0) soft(mode, 0, st0, pb0, pos0, far, full, cb0, cs0, sblk0);
                        if (a1) soft(mode, 1, st1, pb1, pos0, far, full, cb1, cs1, sblk0);
                        if (mode == 0) return;
#pragma unroll
                        for (int mt = 0; mt < 4; ++mt)
#pragma unroll
                            for (int s = 0; s < 2; ++s) { const LAS unsigned char* a = vbuf + (32 * s + 4 * q4 + (col >> 2)) * KST + (16 * mt + 4 * (col & 3)) * 2;
                                const s16x4 lo = __builtin_amdgcn_ds_read_tr16_b64_v4i16((LAS s16x4*)a), hi = __builtin_amdgcn_ds_read_tr16_b64_v4i16((LAS s16x4*)(a + 16 * KST));
                                const bf16x8 vfs = __builtin_shufflevector(lo, hi, 0, 1, 2, 3, 4, 5, 6, 7);
                                if (a0) O[0][mt] = __builtin_amdgcn_mfma_f32_16x16x32_bf16(vfs, pb0[s], O[0][mt], 0, 0, 0);
                                if (a1) O[1][mt] = __builtin_amdgcn_mfma_f32_16x16x32_bf16(vfs, pb1[s], O[1][mt], 0, 0, 0); }
                        if (mode >= 2) {
#pragma unroll
                            for (int s = 0; s < 2; ++s) { if (a0) Ls[0] = __builtin_amdgcn_mfma_f32_16x16x32_bf16(ones8, pb0[s], Ls[0], 0, 0, 0); if (a1) Ls[1] = __builtin_amdgcn_mfma_f32_16x16x32_bf16(ones8, pb1[s], Ls[1], 0, 0, 0); } }
                    };
                    auto soft_far = [&](const int gq, f32x4 (&st)[4], bf16x8 (&pb)[2], const float cbias) {
                        float tmax = fmaxf(fmaxf(fmaxf(st[0][0], st[0][1]), fmaxf(st[0][2], st[0][3])), fmaxf(fmaxf(st[1][0], st[1][1]), fmaxf(st[1][2], st[1][3])));
                        tmax = fmaxf(tmax, fmaxf(fmaxf(fmaxf(st[2][0], st[2][1]), fmaxf(st[2][2], st[2][3])), fmaxf(fmaxf(st[3][0], st[3][1]), fmaxf(st[3][2], st[3][3]))));
                        tmax += cbias; tmax = max_x16(tmax); tmax = max_x32(tmax);
                        const float mnew = fmaxf(m[gq], tmax), mu = (mnew == NINF) ? 0.f : mnew, alpha = __builtin_amdgcn_exp2f(m[gq] - mu);
                        m[gq] = mnew; Ls[gq] = Ls[gq] * alpha;
#pragma unroll
                        for (int mt = 0; mt < 4; ++mt) O[gq][mt] = O[gq][mt] * alpha;
                        const float esub = mu - cbias;
#pragma unroll
                        for (int kt = 0; kt < 4; ++kt)
#pragma unroll
                            for (int r = 0; r < 4; ++r) st[kt][r] = __builtin_amdgcn_exp2f(st[kt][r] - esub);
#pragma unroll
                        for (int s = 0; s < 2; ++s) { u32x4 w; w.x = cvt_pk_bf16(st[2 * s][0], st[2 * s][1]); w.y = cvt_pk_bf16(st[2 * s][2], st[2 * s][3]);
                            w.z = cvt_pk_bf16(st[2 * s + 1][0], st[2 * s + 1][1]); w.w = cvt_pk_bf16(st[2 * s + 1][2], st[2 * s + 1][3]); pb[s] = __builtin_bit_cast(bf16x8, w); }
                    };
                    auto tile_far2 = [&](const LAS unsigned char* kbuf, const LAS unsigned char* vbuf, const float cb0, const float cb1) {
                        f32x4 st0[4], st1[4]; bf16x8 pb0[2], pb1[2];
#pragma unroll
                        for (int kt = 0; kt < 4; ++kt) { const bf16x8 kf0 = *(const LAS bf16x8*)(kbuf + (16 * kt + col) * KST + 16 * q4), kf1 = *(const LAS bf16x8*)(kbuf + (16 * kt + col) * KST + 64 + 16 * q4);
                            st0[kt] = __builtin_amdgcn_mfma_f32_16x16x32_bf16(kf0, qf[0][0], (f32x4){0.f, 0.f, 0.f, 0.f}, 0, 0, 0); st0[kt] = __builtin_amdgcn_mfma_f32_16x16x32_bf16(kf1, qf[0][1], st0[kt], 0, 0, 0);
                            st1[kt] = __builtin_amdgcn_mfma_f32_16x16x32_bf16(kf0, qf[1][0], (f32x4){0.f, 0.f, 0.f, 0.f}, 0, 0, 0); st1[kt] = __builtin_amdgcn_mfma_f32_16x16x32_bf16(kf1, qf[1][1], st1[kt], 0, 0, 0); }
                        soft_far(0, st0, pb0, cb0);
                        soft_far(1, st1, pb1, cb1);
#pragma unroll
                        for (int mt = 0; mt < 4; ++mt)
#pragma unroll
                            for (int s = 0; s < 2; ++s) { const LAS unsigned char* a = vbuf + (32 * s + 4 * q4 + (col >> 2)) * KST + (16 * mt + 4 * (col & 3)) * 2;
                                const s16x4 lo = __builtin_amdgcn_ds_read_tr16_b64_v4i16((LAS s16x4*)a), hi = __builtin_amdgcn_ds_read_tr16_b64_v4i16((LAS s16x4*)(a + 16 * KST));
                                const bf16x8 vfs = __builtin_shufflevector(lo, hi, 0, 1, 2, 3, 4, 5, 6, 7);
                                O[0][mt] = __builtin_amdgcn_mfma_f32_16x16x32_bf16(vfs, pb0[s], O[0][mt], 0, 0, 0);
                                O[1][mt] = __builtin_amdgcn_mfma_f32_16x16x32_bf16(vfs, pb1[s], O[1][mt], 0, 0, 0); }
#pragma unroll
                        for (int s = 0; s < 2; ++s) { Ls[0] = __builtin_amdgcn_mfma_f32_16x16x32_bf16(ones8, pb0[s], Ls[0], 0, 0, 0); Ls[1] = __builtin_amdgcn_mfma_f32_16x16x32_bf16(ones8, pb1[s], Ls[1], 0, 0, 0); }
#if NSA_SGB
                        __builtin_amdgcn_sched_group_barrier(0x100, 8, 0); __builtin_amdgcn_sched_group_barrier(0x008, 16, 0);
                        __builtin_amdgcn_sched_group_barrier(0x002, 64, 0); __builtin_amdgcn_sched_group_barrier(0x400, 17, 0); __builtin_amdgcn_sched_group_barrier(0x002, 40, 0);
                        __builtin_amdgcn_sched_group_barrier(0x100, 16, 0);
#pragma unroll
                        for (int i = 0; i < 10; ++i) { __builtin_amdgcn_sched_group_barrier(0x008, 1, 0); __builtin_amdgcn_sched_group_barrier(0x002, 7, 0); __builtin_amdgcn_sched_group_barrier(0x400, 2, 0); }
                        __builtin_amdgcn_sched_group_barrier(0x002, 40, 0);
                        __builtin_amdgcn_sched_group_barrier(0x008, 10, 0);
#endif
                    };
                    auto ld_tile = [&](const bf16* src) -> u32x4 { return *(const u32x4*)(src + tid * 8); };
                    auto st_tile = [&](LAS unsigned char* buf, const u32x4 v) { *(LAS u32x4*)(buf + (tid >> 3) * KST + (tid & 7) * 16) = v; };
                    auto zeroO = [&]() {
#pragma unroll
                        for (int gq = 0; gq < 2; ++gq) { m[gq] = NINF; l[gq] = 0.f; Ls[gq] = (f32x4){0.f, 0.f, 0.f, 0.f};
#pragma unroll
                            for (int mt = 0; mt < 4; ++mt) O[gq][mt] = (f32x4){0.f, 0.f, 0.f, 0.f}; } };
                    const int ntc = (4 * tile + 3 + 63) >> 6;
                    const bf16* kcb = KCb + (size_t)bg * 512 * 64; const bf16* vcb = KCb + (size_t)(8 + bg) * 512 * 64;
                    {
                        zeroO();
                        u32x4 rk = ld_tile(kcb);
                        st_tile(kvb, rk); if (ntc > 1) rk = ld_tile(kcb + 4096);
                        __syncthreads();
#pragma unroll 1
                        for (int i = 0; i < ntc; ++i) { LAS unsigned char* cb = kvb + (i & 1) * 2 * TB;
                            if (i + 1 < ntc) st_tile(kvb + ((i + 1) & 1) * 2 * TB, rk);
                            if (i + 2 < ntc) rk = ld_tile(kcb + (size_t)(i + 2) * 4096);
                            const bool far = (t0 - (16 * (64 * i + 63) + 31)) >= 1513;
                            tile2(0, cb, cb + TB, 64 * i, far, (16 * (64 * i + 63) + 31) <= t0, true, true, bfar, bfar, true, true, 0);
                            __syncthreads(); }
                    }
#pragma unroll
                    for (int gq = 0; gq < 2; ++gq) { float lt = sum_x32(sum_x16(l[gq])); linv[gq] = 1.f / fmaxf(lt, 1e-30f); m1[gq] = (m[gq] == NINF) ? 0.f : m[gq]; }
                    if (q4 == 0) {
#pragma unroll
                        for (int k6 = 0; k6 < 6; ++k6) gld[k6 * 16 + col] = sigmoidf_(gl[k6]); }
                    {
                        zeroO();
                        u32x4 rk = ld_tile(kcb), rv = ld_tile(vcb);
                        st_tile(kvb, rk); st_tile(kvb + TB, rv); if (ntc > 1) { rk = ld_tile(kcb + 4096); rv = ld_tile(vcb + 4096); }
                        __syncthreads();
#pragma unroll 1
                        for (int i = 0; i < ntc; ++i) { LAS unsigned char* cb = kvb + (i & 1) * 2 * TB;
                            if (i + 1 < ntc) { LAS unsigned char* nb = kvb + ((i + 1) & 1) * 2 * TB; st_tile(nb, rk); st_tile(nb + TB, rv); }
                            if (i + 2 < ntc) { rk = ld_tile(kcb + (size_t)(i + 2) * 4096); rv = ld_tile(vcb + (size_t)(i + 2) * 4096); }
                            const bool far = (t0 - (16 * (64 * i + 63) + 31)) >= 1513;
                            tile2(1, cb, cb + TB, 64 * i, far, (16 * (64 * i + 63) + 31) <= t0, true, true, bfar, bfar, true, true, 16 * i);
                            __syncthreads(); }
                    }
                    WAVE_SYNC();
                    {
                        const int tt = lane >> 3, sub = lane & 7;
                        unsigned key[16];
                        const LAS f32x4* ip = (const LAS f32x4*)(impW + tt * 128 + sub * 16);
#pragma unroll
                        for (int q = 0; q < 4; ++q) { const f32x4 v = ip[q];
#pragma unroll
                            for (int e2 = 0; e2 < 4; ++e2) { const int i = 4 * q + e2, s = sub * 16 + i;
                                const bool forced = (s == 0) || (s == cur) || (s == cur - 1);
                                const unsigned k = forced ? 0x7FFFFF80u : ((__float_as_uint(v[e2]) & 0xFFFFFF80u) + 128u);
                                key[i] = (s <= cur) ? (k | (unsigned)(127 - s)) : 0u; } }
                        unsigned w0 = 0u, w1 = 0u, w2 = 0u, w3 = 0u;
#pragma unroll 1
                        for (int k = 0; k < 16; ++k) {
                            unsigned best = key[0];
#pragma unroll
                            for (int i = 1; i < 16; ++i) best = best > key[i] ? best : key[i];
                            { const unsigned o1 = (unsigned)__builtin_amdgcn_mov_dpp((int)best, 0xB1, 0xF, 0xF, true); best = best > o1 ? best : o1;
                              const unsigned o2 = (unsigned)__builtin_amdgcn_mov_dpp((int)best, 0x4E, 0xF, 0xF, true); best = best > o2 ? best : o2;
                              const unsigned o3 = (unsigned)__builtin_amdgcn_mov_dpp((int)best, 0x141, 0xF, 0xF, true); best = best > o3 ? best : o3; }
#pragma unroll
                            for (int i = 0; i < 16; ++i) key[i] = (key[i] == best) ? 0u : key[i];
                            if (best != 0u) { const int idx = 127 - (int)(best & 127u); const unsigned bit = 1u << (idx & 31); const int wd = idx >> 5;
                                w0 |= wd == 0 ? bit : 0u; w1 |= wd == 1 ? bit : 0u; w2 |= wd == 2 ? bit : 0u; w3 |= wd == 3 ? bit : 0u; }
                        }
                        if (sub == 0) { LAS unsigned* sp = selm + (8 * wave + tt) * 4; sp[0] = w0; sp[1] = w1; sp[2] = w2; sp[3] = w3; }
                    }
                    WAVE_SYNC();
#pragma unroll
                    for (int gq = 0; gq < 2; ++gq) { const float g0 = gatev(gq, 0);
#pragma unroll
                        for (int mt = 0; mt < 4; ++mt)
#pragma unroll
                            for (int r = 0; r < 4; ++r) ocl[((gq * 4 + mt) * 4 + r) * 64] = O[gq][mt][r] * g0; }
                    __syncthreads();
                    unsigned long long Ulo, Uhi;
                    { unsigned u[4];
#pragma unroll
                      for (int k = 0; k < 4; ++k) { unsigned x = selm[lane * 4 + k];
#pragma unroll
                        for (int o = 1; o < 64; o <<= 1) x |= __shfl_xor(x, o);
                        u[k] = __builtin_amdgcn_readfirstlane(x); }
                      Ulo = ((unsigned long long)u[1] << 32) | u[0]; Uhi = ((unsigned long long)u[3] << 32) | u[2]; }
                    auto nextj = [&](int j) -> int {
                        if (j < 64) { const unsigned long long x = Ulo >> j; if (x) return j + __builtin_ctzll(x); j = 64; }
                        if (j < 128) { const unsigned long long x = Uhi >> (j - 64); if (x) return j + __builtin_ctzll(x); }
                        return 128; };
                    {
                        const bf16* ksb = KVT + (size_t)(2 * 8 + bg) * SEQ * 64; const bf16* vsb = KVT + (size_t)(3 * 8 + bg) * SEQ * 64;
#pragma unroll 1
                        for (int rep = 0; rep < SELREP; ++rep) {
                        zeroO();
                        int j = nextj(0), jn = nextj(j + 1), it = 0;
                        u32x4 rk = ld_tile(ksb + (size_t)j * 4096), rv = ld_tile(vsb + (size_t)j * 4096);
                        st_tile(kvb, rk); st_tile(kvb + TB, rv);
                        if (jn <= cur) { rk = ld_tile(ksb + (size_t)jn * 4096); rv = ld_tile(vsb + (size_t)jn * 4096); }
                        __syncthreads();
#pragma unroll 1
                        while (j <= cur) { LAS unsigned char* cb = kvb + (it & 1) * 2 * TB;
                            const int jnn = jn <= cur ? nextj(jn + 1) : 128;
                            if (jn <= cur) { LAS unsigned char* nb = kvb + ((it + 1) & 1) * 2 * TB; st_tile(nb, rk); st_tile(nb + TB, rv); }
                            if (jnn <= cur) { rk = ld_tile(ksb + (size_t)jnn * 4096); rv = ld_tile(vsb + (size_t)jnn * 4096); }
                            const bool cs0 = (selm[(8 * wave + ti) * 4 + (j >> 5)] >> (j & 31)) & 1u, cs1 = (selm[(8 * wave + 4 + ti) * 4 + (j >> 5)] >> (j & 31)) & 1u;
                            const bool act0 = __ballot(cs0) != 0ull, act1 = __ballot(cs1) != 0ull;
                            const bool far = (t0 - (64 * j + 63)) >= 1513;
                            const float cb0 = cs0 ? bfar : NINF, cb1 = cs1 ? bfar : NINF;
                            const bool full = j < cur;
                            if (act0 && act1 && far) tile_far2(cb, cb + TB, cb0, cb1);
                            else if (act0 && act1) tile2(2, cb, cb + TB, 64 * j, far, full, true, true, cb0, cb1, cs0, cs1, 0);
                            else if (act0) tile2(2, cb, cb + TB, 64 * j, far, full, true, false, cb0, cb1, cs0, cs1, 0);
                            else if (act1) tile2(2, cb, cb + TB, 64 * j, far, full, false, true, cb0, cb1, cs0, cs1, 0);
#if NSA_DUP_C
                            __syncthreads();
#endif
                            __syncthreads();
                            j = jn; jn = jnn; ++it;
                        }
                        }
#pragma unroll
                        for (int gq = 0; gq < 2; ++gq) { const float lt = Ls[gq][0]; const float sc = gatev(gq, 1) / fmaxf(lt, 1e-30f);
#pragma unroll
                            for (int mt = 0; mt < 4; ++mt)
#pragma unroll
                                for (int r = 0; r < 4; ++r) ocl[((gq * 4 + mt) * 4 + r) * 64] += O[gq][mt][r] * sc; }
                    }
                    {
                        const bf16* kwb = KVT + (size_t)(4 * 8 + bg) * SEQ * 64; const bf16* vwb = KVT + (size_t)(5 * 8 + bg) * SEQ * 64;
                        const int j0 = cur - 8 < 0 ? 0 : cur - 8, nw = cur - j0 + 1;
#pragma unroll 1
                        for (int wrep = 0; wrep < WINREP; ++wrep) {
                        zeroO();
                        u32x4 rk = ld_tile(kwb + (size_t)j0 * 4096), rv = ld_tile(vwb + (size_t)j0 * 4096);
                        st_tile(kvb, rk); st_tile(kvb + TB, rv);
                        if (nw > 1) { rk = ld_tile(kwb + (size_t)(j0 + 1) * 4096); rv = ld_tile(vwb + (size_t)(j0 + 1) * 4096); }
                        __syncthreads();
#pragma unroll 1
                        for (int i = 0; i < nw; ++i) { LAS unsigned char* cb = kvb + (i & 1) * 2 * TB;
                            if (i + 1 < nw) { LAS unsigned char* nb = kvb + ((i + 1) & 1) * 2 * TB; st_tile(nb, rk); st_tile(nb + TB, rv); }
                            if (i + 2 < nw) { rk = ld_tile(kwb + (size_t)(j0 + i + 2) * 4096); rv = ld_tile(vwb + (size_t)(j0 + i + 2) * 4096); }
                            tile2(3, cb, cb + TB, 64 * (j0 + i), false, (j0 + i > cur - 8) && (j0 + i < cur), true, true, 0.f, 0.f, true, true, 0);
                            __syncthreads(); }
                        }
#pragma unroll
                        for (int gq = 0; gq < 2; ++gq) { const float lt = Ls[gq][0]; const float sc = gatev(gq, 2) / fmaxf(lt, 1e-30f);
#pragma unroll
                            for (int mt = 0; mt < 4; ++mt)
#pragma unroll
                                for (int r = 0; r < 4; ++r) O[gq][mt][r] = ocl[((gq * 4 + mt) * 4 + r) * 64] + O[gq][mt][r] * sc; }
                    }
#pragma unroll
                    for (int gq = 0; gq < 2; ++gq)
#pragma unroll
                        for (int mt = 0; mt < 4; ++mt) { u32x2 w; w.x = cvt_pk_bf16(O[gq][mt][0], O[gq][mt][1]); w.y = cvt_pk_bf16(O[gq][mt][2], O[gq][mt][3]);
                            *(u32x2*)(OB + (tokw + 4 * gq + ti) * 512 + (g * 4 + head) * 64 + 16 * mt + 4 * q4) = w; }
                }
            }
          }
        }
        SEAM(pb + 3, 4);

        if (EN(5) && IN(pb + 4)) { PHASE_IDS();
            pg8::Gemm g{(const bf16*)(ws + WS_QHG), (const bf16*)(ws + WS_WBA0 + (size_t)l * 2 * SZ_WBR), NT, DM, DM, 0, 512, (const bf16*)(ws + WS_NQ), 8};
            pg8::StaticOrder S; S.init(NT, DM, G, bid); EpiGate2 E{(bf16*)(ws + WS_GA), (const bf16*)(ws + WS_GA), (const bf16*)(ws + WS_GB)};
            pg8::gemm_phase<EpiGate2, pg8::StaticOrder>(lds, g, S, E, wave_s);
        }
        SEAM(pb + 4, 5);

        if (EN(6) && IN(pb + 5)) { PHASE_IDS();
            pg8::Gemm g{(const bf16*)(ws + WS_GA), (const bf16*)(ws + (l ? WS_WOUT1 : WS_WOUT0)), NT, DM, DM, 0, 0, nullptr, 0};
            const float* XI = l ? (const float*)X : x_in;
            pg8::StaticOrder S; S.init(NT, DM, G, bid); EpiResid E{XI, X};
            pg8::gemm_phase<EpiResid, pg8::StaticOrder>(lds, g, S, E, wave_s);
        }
        SEAM(pb + 5, 6);

        if (EN(7) && IN(pb + 6)) { PHASE_IDS();
            const float* gam = ap->in[11] + l * DM; const float* bet = ap->in[12] + l * DM;
            LAS int* hist = (LAS int*)(lds + 8 * 16384);
            if (l == 1) { if (tid < 8) hist[tid] = 0; __syncthreads(); }
            const int rpb = (NT + G - 1) / G;
            for (int i = wave; i < rpb; i += NWAVES) {
                const int row = bid * rpb + i; if (row >= NT) break;
                f32x4* xr = (f32x4*)(X + (size_t)row * DM);
                f32x4 v[4]; float s = 0.f;
#pragma unroll
                for (int j = 0; j < 4; ++j) { v[j] = xr[64 * j + lane]; s += (v[j][0] + v[j][1]) + (v[j][2] + v[j][3]); }
                const float mean = wave_sum(s) * (1.f / DM); float s2 = 0.f;
#pragma unroll
                for (int j = 0; j < 4; ++j) { v[j] = v[j] - mean; s2 += (v[j][0] * v[j][0] + v[j][1] * v[j][1]) + (v[j][2] * v[j][2] + v[j][3] * v[j][3]); }
                const float rstd = rsqrtf(wave_sum(s2) * (1.f / DM) + 1e-5f);
#pragma unroll
                for (int j = 0; j < 4; ++j) { const f32x4 gq = ((const f32x4*)gam)[64 * j + lane], bq = ((const f32x4*)bet)[64 * j + lane]; v[j] = v[j] * rstd * gq + bq; xr[64 * j + lane] = v[j]; }
                if (l == 0) { u32x2* o = (u32x2*)(XB + (size_t)row * DM);
#pragma unroll
                    for (int j = 0; j < 4; ++j) { u32x2 w; w.x = cvt_pk_bf16(v[j][0], v[j][1]); w.y = cvt_pk_bf16(v[j][2], v[j][3]); o[64 * j + lane] = w; }
                } else {
                    const float* WR = ap->in[18];
                    float lg[8];
#pragma unroll
                    for (int e = 0; e < 8; ++e) lg[e] = 0.f;
#pragma unroll
                    for (int j = 0; j < 4; ++j)
#pragma unroll
                        for (int q = 0; q < 4; ++q) { const int c = 4 * (64 * j + lane) + q; const f32x4 w0 = *(const f32x4*)(WR + c * 8), w1 = *(const f32x4*)(WR + c * 8 + 4); const float xv = v[j][q];
                            lg[0] += xv * w0[0]; lg[1] += xv * w0[1]; lg[2] += xv * w0[2]; lg[3] += xv * w0[3]; lg[4] += xv * w1[0]; lg[5] += xv * w1[1]; lg[6] += xv * w1[2]; lg[7] += xv * w1[3]; }
#pragma unroll
                    for (int e = 0; e < 8; ++e) lg[e] = wave_sum(lg[e]);
                    int e1 = 0; float v1 = lg[0];
#pragma unroll
                    for (int e = 1; e < 8; ++e) if (lg[e] > v1) { v1 = lg[e]; e1 = e; }
                    int e2 = -1; float v2 = -3e38f;
#pragma unroll
                    for (int e = 0; e < 8; ++e) if (e != e1 && lg[e] > v2) { v2 = lg[e]; e2 = e; }
                    if (lane == 0) { const float g2 = 1.f / (1.f + expf(v1 - v2)), g1 = 1.f - g2;
                        ((int*)(ws + WS_TOPI))[row] = e1 | (e2 << 8); ((float*)(ws + WS_TOPG))[row * 2] = g1; ((float*)(ws + WS_TOPG))[row * 2 + 1] = g2;
                        atomicAdd((int*)&hist[e1], 1); atomicAdd((int*)&hist[e2], 1); }
                }
            }
            if (l == 1) {
                __syncthreads();
                if (tid < 8) ((int*)(ws + WS_CTL + CW_BLKCNT))[bid * 8 + tid] = hist[tid];
                LAS float* scr = (LAS float*)(lds + wave * 16384);
                constexpr int I_GU = 16 * (2 * FFE / 32), I_DN = (FFE / 64) * 32;
                for (int it = gwave; it < NEXP * (I_GU + I_DN); it += nwaves) {
                    const int e = it / (I_GU + I_DN); int r = it % (I_GU + I_DN);
                    if (r < I_GU) { const int nb = r % (2 * FFE / 32), kb = r / (2 * FFE / 32);
                        const float* Wg = ap->in[19] + (size_t)e * DM * FFE; const float* Wu = ap->in[20] + (size_t)e * DM * FFE;
                        auto cp = [=](int n) -> const float* { const int pn = n >> 8, hf = (n >> 7) & 1, c = pn * 128 + (n & 127); return (hf ? Wu : Wg) + c; };
                        tr_item(cp, FFE, DM, (bf16*)(ws + WS_MGU) + (size_t)e * 2 * FFE * DM, DM, nb * 32, kb * 64, scr, lane); }
                    else { r -= I_GU; const int nb = r % 32, kb = r / 32;
                        const float* W = ap->in[21] + (size_t)e * FFE * DM;
                        auto cp = [=](int n) -> const float* { return W + n; };
                        tr_item(cp, DM, FFE, (bf16*)(ws + WS_MDN) + (size_t)e * DM * FFE, FFE, nb * 32, kb * 64, scr, lane); }
                }
            }
        }
        SEAM(pb + 6, 7);

        if (l == 0) {
            if (EN(8) && IN(pb + 7)) { PHASE_IDS();
                pg8::Gemm g{XB, (const bf16*)(ws + WS_WGU0), NT, NINP, DM, 0, 0, nullptr, 0};
                pg8::StaticOrder S; S.init(NT, NINP, G, bid); EpiSwiglu E{(bf16*)(ws + WS_H0), FF0P};
                pg8::gemm_phase<EpiSwiglu, pg8::StaticOrder>(lds, g, S, E, wave_s);
            }
            SEAM(pb + 7, 8);
            if (EN(9) && IN(pb + 8)) { PHASE_IDS();
                pg8::Gemm g{(const bf16*)(ws + WS_H0), (const bf16*)(ws + WS_WDN0), NT, DM, FF0P, 0, 0, nullptr, 0};
                pg8::StaticOrder S; S.init(NT, DM, G, bid); EpiResid E{X, X};
                pg8::gemm_phase<EpiResid, pg8::StaticOrder>(lds, g, S, E, wave_s);
            }
            SEAM(pb + 8, 9);
            if (EN(10) && IN(pb + 9)) { PHASE_IDS();
                const float* gam = ap->in[13]; const float* bet = ap->in[14];
                for (int row = gwave; row < NT; row += nwaves) {
                    f32x4* xr = (f32x4*)(X + (size_t)row * DM);
                    f32x4 v[4]; float s = 0.f;
#pragma unroll
                    for (int j = 0; j < 4; ++j) { v[j] = xr[64 * j + lane]; s += (v[j][0] + v[j][1]) + (v[j][2] + v[j][3]); }
                    const float mean = wave_sum(s) * (1.f / DM); float s2 = 0.f;
#pragma unroll
                    for (int j = 0; j < 4; ++j) { v[j] = v[j] - mean; s2 += (v[j][0] * v[j][0] + v[j][1] * v[j][1]) + (v[j][2] * v[j][2] + v[j][3] * v[j][3]); }
                    const float rstd = rsqrtf(wave_sum(s2) * (1.f / DM) + 1e-5f);
                    u32x2* o = (u32x2*)(XB + (size_t)row * DM);
#pragma unroll
                    for (int j = 0; j < 4; ++j) { const f32x4 gq = ((const f32x4*)gam)[64 * j + lane], bq = ((const f32x4*)bet)[64 * j + lane]; v[j] = v[j] * rstd * gq + bq; xr[64 * j + lane] = v[j];
                        u32x2 w; w.x = cvt_pk_bf16(v[j][0], v[j][1]); w.y = cvt_pk_bf16(v[j][2], v[j][3]); o[64 * j + lane] = w; }
                }
            }
            SEAM(pb + 9, 10);
        } else {
            if (EN(11) && IN(pb + 7)) { PHASE_IDS(); int* META = (int*)(ws + WS_CTL + CW_META); int* PANELE = (int*)(ws + WS_CTL + CW_PANELE); int* ROWINFO = (int*)(ws + WS_ROWINFO); bf16* XS = (bf16*)(ws + WS_XS); (void)META; (void)PANELE; (void)ROWINFO; (void)XS;
                LAS int* sh = (LAS int*)lds;
                const int* BC = (const int*)(ws + WS_CTL + CW_BLKCNT);
                {
                    float tot = 0.f, pre = 0.f;
                    for (int bb = lane; bb < G; bb += 64) { const float c = (float)BC[bb * 8 + wave]; tot += c; pre += (bb < bid) ? c : 0.f; }
                    tot = wave_sum(tot); pre = wave_sum(pre);
                    if (lane == 0) { sh[wave] = (int)tot; sh[8 + wave] = (int)pre; sh[24 + wave] = 0; } }
                __syncthreads();
                if (tid == 0) { int base = 0;
#pragma unroll 1
                    for (int e = 0; e < 8; ++e) { sh[16 + e] = base; base += (sh[e] + 255) & ~255; }
                    sh[32] = base; }
                __syncthreads();
                if (bid == 0) { const int base = sh[32]; if (tid == 0) { META[0] = base / 256; META[1] = (base / 256 + 63) / 64; }
                    if (tid < 8) { META[8 + tid] = sh[16 + tid]; META[16 + tid] = sh[tid]; }
                    for (int p = tid; p < base / 256; p += NTHR) { int e = 0;
#pragma unroll 1
                        for (int q = 1; q < 8; ++q) if (p * 256 >= sh[16 + q]) e = q;
                        PANELE[p] = e; } }
                __syncthreads();
                if (bid < 8) { const int e = bid, r0 = sh[16 + e] + sh[e], r1 = sh[16 + e] + ((sh[e] + 255) & ~255);
                    for (int r = r0 + wave; r < r1; r += NWAVES) { if (lane == 0) ROWINFO[r] = -1;
#pragma unroll
                        for (int j = 0; j < 4; ++j) ((u32x2*)(XS + (size_t)r * DM))[64 * j + lane] = (u32x2){0u, 0u}; } }
                const int rpb = (NT + G - 1) / G;
                for (int i = wave; i < rpb; i += NWAVES) {
                    const int row = bid * rpb + i; if (row >= NT) break;
                    const int ti = ((const int*)(ws + WS_TOPI))[row]; const int e1 = ti & 255, e2 = ti >> 8;
                    int s1 = 0, s2 = 0;
                    if (lane == 0) { s1 = sh[16 + e1] + sh[8 + e1] + atomicAdd((int*)&sh[24 + e1], 1); s2 = sh[16 + e2] + sh[8 + e2] + atomicAdd((int*)&sh[24 + e2], 1); ROWINFO[s1] = row * 2; ROWINFO[s2] = row * 2 + 1; }
                    s1 = __builtin_amdgcn_readfirstlane(s1); s2 = __builtin_amdgcn_readfirstlane(s2);
                    const f32x4* xr = (const f32x4*)(X + (size_t)row * DM);
#pragma unroll
                    for (int j = 0; j < 4; ++j) { const f32x4 v = xr[64 * j + lane]; u32x2 w; w.x = cvt_pk_bf16(v[0], v[1]); w.y = cvt_pk_bf16(v[2], v[3]);
                        ((u32x2*)(XS + (size_t)s1 * DM))[64 * j + lane] = w; ((u32x2*)(XS + (size_t)s2 * DM))[64 * j + lane] = w; }
                }
            }
            SEAM(pb + 7, 11);
            for (int c = 0; c < MAXCHUNK; ++c) {
                if (EN(12) && IN(pb + 8 + 2 * c)) { PHASE_IDS(); int* META = (int*)(ws + WS_CTL + CW_META); int* PANELE = (int*)(ws + WS_CTL + CW_PANELE); int* ROWINFO = (int*)(ws + WS_ROWINFO); bf16* XS = (bf16*)(ws + WS_XS); (void)META; (void)PANELE; (void)ROWINFO; (void)XS;
                    const int P = META[0], nch = META[1];
                    if (c < nch) { const int p0 = (int)((long)c * P / nch), p1 = (int)((long)(c + 1) * P / nch);
                        pg8::Gemm g{XS + (size_t)p0 * 256 * DM, (const bf16*)(ws + WS_MGU), (p1 - p0) * 256, 2 * FFE, DM, (size_t)2 * FFE * DM, 0, nullptr, 0};
                        pg8::StaticOrder S; S.init((p1 - p0) * 256, 2 * FFE, G, bid, PANELE + p0); EpiSwiglu E{(bf16*)(ws + WS_HM), FFE};
                        pg8::gemm_phase<EpiSwiglu, pg8::StaticOrder>(lds, g, S, E, wave_s); }
                }
                SEAM(pb + 8 + 2 * c, 12);
                if (EN(13) && IN(pb + 9 + 2 * c)) { PHASE_IDS(); int* META = (int*)(ws + WS_CTL + CW_META); int* PANELE = (int*)(ws + WS_CTL + CW_PANELE); int* ROWINFO = (int*)(ws + WS_ROWINFO); bf16* XS = (bf16*)(ws + WS_XS); (void)META; (void)PANELE; (void)ROWINFO; (void)XS;
                    const int P = META[0], nch = META[1];
                    if (c < nch) { const int p0 = (int)((long)c * P / nch), p1 = (int)((long)(c + 1) * P / nch);
                        pg8::Gemm g{(const bf16*)(ws + WS_HM), (const bf16*)(ws + WS_MDN), (p1 - p0) * 256, DM, FFE, (size_t)DM * FFE, 0, nullptr, 0};
                        pg8::StaticOrder S; S.init((p1 - p0) * 256, DM, G, bid, PANELE + p0); EpiScatter E{(bf16*)(ws + WS_YM), ROWINFO + p0 * 256};
                        pg8::gemm_phase<EpiScatter, pg8::StaticOrder>(lds, g, S, E, wave_s); }
                }
                if (PROBE_GRP >= 0 && c == MAXCHUNK - 1) { PMARK(13); if (bid == 0 && wave_s == 0 && lane_id() == 0) *(unsigned long long*)(ws0 + WS_CTL + CW_PROBE) = pr_acc; }
                SEAM(pb + 9 + 2 * c, 13);
            }
            if (EN(14) && IN(pb + 8 + 2 * MAXCHUNK)) { PHASE_IDS();
                const float* gam = ap->in[13] + DM; const float* bet = ap->in[14] + DM;
                const bf16* YM = (const bf16*)(ws + WS_YM); const float* TG = (const float*)(ws + WS_TOPG);
                const float pscale = 1.f;
                for (int row = gwave; row < NT; row += nwaves) {
                    f32x4* xr = (f32x4*)(X + (size_t)row * DM);
                    const float g1 = TG[row * 2], g2 = TG[row * 2 + 1];
                    const u32x2* y1 = (const u32x2*)(YM + (size_t)(row * 2) * DM); const u32x2* y2 = (const u32x2*)(YM + (size_t)(row * 2 + 1) * DM);
                    f32x4 v[4]; float s = 0.f;
#pragma unroll
                    for (int j = 0; j < 4; ++j) { const f32x4 xv = xr[64 * j + lane]; const u32x2 a = y1[64 * j + lane], bq = y2[64 * j + lane];
                        v[j][0] = xv[0] * DN_ALPHA + g1 * bflo(a.x) + g2 * bflo(bq.x); v[j][1] = xv[1] * DN_ALPHA + g1 * bfhi(a.x) + g2 * bfhi(bq.x);
                        v[j][2] = xv[2] * DN_ALPHA + g1 * bflo(a.y) + g2 * bflo(bq.y); v[j][3] = xv[3] * DN_ALPHA + g1 * bfhi(a.y) + g2 * bfhi(bq.y);
                        s += (v[j][0] + v[j][1]) + (v[j][2] + v[j][3]); }
                    const float mean = wave_sum(s) * (1.f / DM); float s2 = 0.f;
#pragma unroll
                    for (int j = 0; j < 4; ++j) { v[j] = v[j] - mean; s2 += (v[j][0] * v[j][0] + v[j][1] * v[j][1]) + (v[j][2] * v[j][2] + v[j][3] * v[j][3]); }
                    const float rstd = rsqrtf(wave_sum(s2) * (1.f / DM) + 1e-5f);
#pragma unroll
                    for (int j = 0; j < 4; ++j) { const f32x4 gq = ((const f32x4*)gam)[64 * j + lane], bq = ((const f32x4*)bet)[64 * j + lane]; xr[64 * j + lane] = (v[j] * rstd * gq + bq) * pscale; }
                }
#if PROBE_GRP >= 0
                {
                    const unsigned long long dt = *(const unsigned long long*)(ws + WS_CTL + CW_PROBE) * (unsigned long long)PROBE_K;
                    const unsigned long long t0 = __builtin_amdgcn_s_memrealtime();
                    while (__builtin_amdgcn_s_memrealtime() - t0 < dt) __builtin_amdgcn_s_sleep(8);
                }
#endif
            }
        }
    }
#undef IN
#undef SEAM
}

constexpr int NPHASES = 1 + 10 + 8 + 2 * MAXCHUNK + 1;

extern "C" void kernel_launch(void* const* d_in, const int* in_sizes, int n_in, void* d_out, int out_size, void* d_ws, size_t ws_size, hipStream_t stream) {
    static int grid = 0;
    if (grid == 0) {
        if (n_in != 22 || out_size != NT * DM || ws_size < WS_END) { fprintf(stderr, "kernel_launch: need 22 inputs, %d outputs, >= %zu bytes of workspace; got %d, %d, %zu\n", NT * DM, (size_t)WS_END, n_in, out_size, ws_size); grid = -1; return; }
        int dev = 0, cus = 0, per_cu = 0;
        if (hipGetDevice(&dev) != hipSuccess || hipDeviceGetAttribute(&cus, hipDeviceAttributeMultiprocessorCount, dev) != hipSuccess) { grid = -1; return; }
        if (hipFuncSetAttribute((const void*)mega_fwd, hipFuncAttributeMaxDynamicSharedMemorySize, LDS_BYTES) != hipSuccess) { fprintf(stderr, "kernel_launch: hipFuncSetAttribute failed\n"); grid = -1; return; }
        if (hipOccupancyMaxActiveBlocksPerMultiprocessor(&per_cu, (const void*)mega_fwd, NTHR, LDS_BYTES) != hipSuccess || per_cu < 1) fprintf(stderr, "kernel_launch: occupancy query reports %d\n", per_cu);
        (void)hipGetLastError();
        grid = cus > 256 ? 256 : cus;
    }
    if (grid < 0) return;
    (void)hipMemsetAsync((char*)d_ws + WS_CTL, 0, CTL_BYTES, stream);
    Args a{};
    for (int i = 0; i < 22; ++i) a.in[i] = (const float*)d_in[i];
    a.out = (float*)d_out; a.ws = (unsigned char*)d_ws;
#if ONE_LAUNCH
    a.ph_lo = 0; a.ph_hi = NPHASES;
    hipLaunchKernelGGL(mega_fwd, dim3(grid), dim3(NTHR), LDS_BYTES, stream, a);
#else
    for (int p = 0; p < NPHASES; ++p) { a.ph_lo = p; a.ph_hi = p + 1; hipLaunchKernelGGL(mega_fwd, dim3(grid), dim3(NTHR), LDS_BYTES, stream, a); }
#endif
}
```

```cpp
#include <hip/hip_runtime.h>
#include <cstdio>
#include <cstdint>

#ifndef ONE_LAUNCH
#define ONE_LAUNCH 1
#endif

#define LAS __attribute__((address_space(3)))
typedef unsigned short bf16;
typedef short bf16x8 __attribute__((ext_vector_type(8)));
typedef short s16x4 __attribute__((ext_vector_type(4)));
typedef float f32x4 __attribute__((ext_vector_type(4)));
typedef float f32x16 __attribute__((ext_vector_type(16)));
typedef float f32x2 __attribute__((ext_vector_type(2)));
typedef unsigned u32x4 __attribute__((ext_vector_type(4)));
typedef unsigned u32x2 __attribute__((ext_vector_type(2)));

typedef __bf16 bf16x2_t __attribute__((ext_vector_type(2)));
__device__ __forceinline__ unsigned cvt_pk_bf16(float lo, float hi) { bf16x2_t v; v[0] = (__bf16)lo; v[1] = (__bf16)hi; return __builtin_bit_cast(unsigned, v); }
__device__ __forceinline__ bf16 f2bf(float f) { unsigned u = __float_as_uint(f); u += 0x7FFFu + ((u >> 16) & 1u); return (bf16)(u >> 16); }
__device__ __forceinline__ float bf2f(bf16 b) { return __uint_as_float(((unsigned)b) << 16); }
__device__ __forceinline__ float bflo(unsigned u) { return __uint_as_float(u << 16); }
__device__ __forceinline__ float bfhi(unsigned u) { return __uint_as_float(u & 0xFFFF0000u); }
__device__ __forceinline__ float sigmoidf_(float x) { return 1.0f / (1.0f + __expf(-x)); }
__device__ __forceinline__ float siluf_(float x) { return x / (1.0f + __expf(-x)); }
__device__ __forceinline__ float max_x32(float x) { auto r = __builtin_amdgcn_permlane32_swap(__float_as_uint(x), __float_as_uint(x), false, false); return fmaxf(__uint_as_float(r[0]), __uint_as_float(r[1])); }
__device__ __forceinline__ float max_x16(float x) { auto r = __builtin_amdgcn_permlane16_swap(__float_as_uint(x), __float_as_uint(x), false, false); return fmaxf(__uint_as_float(r[0]), __uint_as_float(r[1])); }
__device__ __forceinline__ float sum_x32(float x) { auto r = __builtin_amdgcn_permlane32_swap(__float_as_uint(x), __float_as_uint(x), false, false); return __uint_as_float(r[0]) + __uint_as_float(r[1]); }
__device__ __forceinline__ float sum_x16(float x) { auto r = __builtin_amdgcn_permlane16_swap(__float_as_uint(x), __float_as_uint(x), false, false); return __uint_as_float(r[0]) + __uint_as_float(r[1]); }
__device__ __forceinline__ float dpp_x1(float x) { return __uint_as_float(__builtin_amdgcn_mov_dpp(__float_as_uint(x), 0xB1, 0xF, 0xF, true)); }
__device__ __forceinline__ float dpp_x2(float x) { return __uint_as_float(__builtin_amdgcn_mov_dpp(__float_as_uint(x), 0x4E, 0xF, 0xF, true)); }
__device__ __forceinline__ float dpp_hm(float x) { return __uint_as_float(__builtin_amdgcn_mov_dpp(__float_as_uint(x), 0x141, 0xF, 0xF, true)); }
__device__ __forceinline__ float dpp_rm(float x) { return __uint_as_float(__builtin_amdgcn_mov_dpp(__float_as_uint(x), 0x140, 0xF, 0xF, true)); }
__device__ __forceinline__ float wave_sum(float v) { v += dpp_x1(v); v += dpp_x2(v); v += dpp_hm(v); v += dpp_rm(v); v = sum_x16(v); return sum_x32(v); }
__device__ __forceinline__ float wave_max(float v) { v = fmaxf(v, dpp_x1(v)); v = fmaxf(v, dpp_x2(v)); v = fmaxf(v, dpp_hm(v)); v = fmaxf(v, dpp_rm(v)); v = max_x16(v); return max_x32(v); }
__device__ __forceinline__ int lane_id() { int l; asm volatile("v_mbcnt_lo_u32_b32 %0, -1, 0\n\tv_mbcnt_hi_u32_b32 %0, -1, %0" : "=v"(l)); return l; }
#define LDS_SYNC() do { asm volatile("s_waitcnt lgkmcnt(0)" ::: "memory"); __builtin_amdgcn_s_barrier(); asm volatile("" ::: "memory"); } while (0)
#define WAVE_SYNC() do { asm volatile("s_waitcnt lgkmcnt(0)" ::: "memory"); __builtin_amdgcn_wave_barrier(); } while (0)

#define PHASE_IDS() int tid_ph = wave_s * 64 + lane_id(); asm volatile("" : "+v"(tid_ph)); int bid_ph = (int)blockIdx.x; asm volatile("" : "+s"(bid_ph)); const int bid = bid_ph; (void)bid; const int tid = tid_ph, lane = tid & 63, wave = __builtin_amdgcn_readfirstlane(tid >> 6), gwave = bid * NWAVES + wave; (void)tid; (void)lane; (void)wave; (void)gwave; \
    KArgsP ap = kap; asm volatile("" : "+s"(ap));     \
    unsigned char* ws = ap->ws; float* X = ap->out; const float* x_in = ap->in[0]; bf16* XB = (bf16*)(ws + WS_XB); float* LBS = (float*)(ws + WS_LBS); (void)X; (void)x_in; (void)XB; (void)LBS
namespace pg8 {
constexpr int BM = 256, BK = 64, HALF = 128, HTB = HALF * BK * 2, STAGE_BYTES = 8 * HTB, NXCD = 8, WGM = 8;
__host__ __device__ __forceinline__ int lds_byte(int r, int c) { const int st = (r >> 4) * 2 + (c >> 5), rr = r & 15, cc = c & 31, ob = rr * 64 + cc * 2; return st * 1024 + (ob ^ (((ob >> 9) & 1) << 5)); }
__host__ __device__ __forceinline__ void stage_rc(int b, int& R, int& C) { const int st = b / 1024, sb = b % 1024, swz = sb ^ (((sb >> 9) & 1) << 5); R = (st >> 1) * 16 + swz / 64; C = (st & 1) * 32 + (swz % 64) / 2; }
__host__ __device__ __forceinline__ int perm32(int rho) { const int n = rho >> 4, i = rho & 15; return 8 * (i >> 2) + 4 * n + (i & 3); }

struct Unit { int pm, pn, e; };
struct Gemm { const bf16* A; const bf16* Bt; int M, N, K; size_t bt_estride; int lda; const bf16* A2; int ksw; };

struct StaticOrder {
    int nM, nN, nwg, G, c; const int* pe;
    __device__ void init(int M, int N, int G_, int c_, const int* pe_ = nullptr) { nM = M / BM; nN = N / BM; nwg = nM * nN; G = G_; c = c_; pe = pe_; }
    __device__ bool next(int i, Unit& u) const {
        const long L = (long)i * G + c; if (L >= nwg) return false;
        int wgid = (int)L; { const int q = nwg / NXCD, r = nwg % NXCD, xcd = wgid % NXCD, off = wgid / NXCD; wgid = (xcd < r ? xcd * (q + 1) : r * (q + 1) + (xcd - r) * q) + off; }
        const int nig = WGM * nN, gid = wgid / nig, fm = gid * WGM, gsz = (nM - fm) < WGM ? (nM - fm) : WGM;
        u.pm = fm + ((wgid % nig) % gsz); u.pn = (wgid % nig) / gsz; u.e = pe ? pe[u.pm] : 0; return true;
    }
    __device__ __forceinline__ void a_ready(const Unit&) const {}
    __device__ __forceinline__ void done(const Unit&) const {}
};

template <class Epi, class Sched, bool ALIGN_EPI = true, bool SP2 = true>
__device__ __forceinline__ void gemm_phase(LAS unsigned char* lds, const Gemm g, const Sched& S, const Epi& E, const int wave_s) {
    int tid_l = wave_s * 64 + lane_id(); asm volatile("" : "+v"(tid_l));
    const int tid = tid_l, wid = __builtin_amdgcn_readfirstlane(tid >> 6), lane = tid & 63, wr = wid >> 2, wc = wid & 3, fr = lane & 15, fq = lane >> 4;
    const int K = g.K, nt = K / BK, LDA = g.lda ? g.lda : g.K;
    unsigned voffA[2], voffB[2];
#pragma unroll
    for (int i = 0; i < 2; ++i) { int R, C; stage_rc(tid * 16 + i * 8192, R, C); const int Rb = Epi::PERM ? ((R & ~31) + perm32(R & 31)) : R;
        voffA[i] = (unsigned)(R * LDA + C) * 2u; voffB[i] = (unsigned)(Rb * K + C) * 2u; }
    const size_t kstep = (size_t)(BK * 2);
    const size_t hstep = (size_t)HALF * K * 2, hstepA = (size_t)HALF * LDA * 2;
    const size_t tstep = 2 * hstep, tstepA = 2 * hstepA;
    const unsigned ldsw = (unsigned)wid * 1024u;
    const int aoff = lds_byte(wr * 64 + fr, fq * 8), boff = lds_byte(wc * 32 + fr, fq * 8);
#define PG8_SA(b, h) (((b) * 2 + (h)) * HTB)
#define PG8_SB(b, h) ((4 + (b) * 2 + (h)) * HTB)
#define PG8_STAGE(bufoff, gbase, voff) do { _Pragma("unroll") for (int _i = 0; _i < 2; ++_i) \
        __builtin_amdgcn_global_load_lds((const unsigned*)((const char*)(gbase) + (voff)[_i]), (LAS unsigned*)(lds + (bufoff) + ldsw + _i * 8192), 16, 0, 0); } while (0)
#define PG8_LDA(dst, b, h) do { _Pragma("unroll") for (int m = 0; m < 4; ++m) _Pragma("unroll") for (int k = 0; k < 2; ++k) dst[m][k] = *(const LAS bf16x8*)(lds + PG8_SA(b, h) + aoff + m * 2048 + k * 1024); } while (0)
#define PG8_LDB(dst, b, h) do { _Pragma("unroll") for (int n = 0; n < 2; ++n) _Pragma("unroll") for (int k = 0; k < 2; ++k) dst[n][k] = *(const LAS bf16x8*)(lds + PG8_SB(b, h) + boff + n * 2048 + k * 1024); } while (0)
#define PG8_MMA(ai, bj, At, Bt) do { __builtin_amdgcn_s_setprio(1); _Pragma("unroll") for (int m = 0; m < 4; ++m) _Pragma("unroll") for (int n = 0; n < 2; ++n) _Pragma("unroll") for (int k = 0; k < 2; ++k) \
        acc[ai][bj][m][n] = __builtin_amdgcn_mfma_f32_16x16x32_bf16(Bt[n][k], At[m][k], acc[ai][bj][m][n], 0, 0, 0); __builtin_amdgcn_s_setprio(0); } while (0)
#define PG8_WAIT_V(n) asm volatile("s_waitcnt vmcnt(" #n ")" ::: "memory")
#define PG8_WAIT_L(n) asm volatile("s_waitcnt lgkmcnt(" #n ")" ::: "memory")
#define PG8_BAR __builtin_amdgcn_s_barrier()
#define PG8_SCHED __builtin_amdgcn_sched_barrier(0)
    Unit cur, nxt; int ui = 0;
    if (!S.next(0, cur)) return;
    f32x4 acc[2][2][4][2];
#pragma unroll
    for (int a = 0; a < 2; ++a)
#pragma unroll
        for (int b = 0; b < 2; ++b)
#pragma unroll
            for (int m = 0; m < 4; ++m)
#pragma unroll
                for (int n = 0; n < 2; ++n) acc[a][b][m][n] = (f32x4){0.f, 0.f, 0.f, 0.f};
    bf16x8 At[4][2], B0[2][2], B1[2][2];
    const int ksw = g.ksw ? g.ksw : nt;
    const char* cA = (const char*)g.A + (size_t)cur.pm * tstepA; const char* cB = (const char*)(g.Bt + (size_t)cur.e * g.bt_estride) + (size_t)cur.pn * tstep;
    const char* cA2 = g.ksw ? (const char*)g.A2 + (size_t)cur.pm * tstepA : cA;
    S.a_ready(cur);
    if constexpr (SP2) {
        PG8_STAGE(PG8_SB(0, 0), cB, voffB); PG8_STAGE(PG8_SB(0, 1), cB + hstep, voffB); PG8_STAGE(PG8_SA(0, 0), cA, voffA); PG8_STAGE(PG8_SA(0, 1), cA + hstepA, voffA);
        if (wr == 1) PG8_BAR;
        PG8_WAIT_V(2); PG8_BAR;
        PG8_STAGE(PG8_SB(1, 0), cB + kstep, voffB); PG8_STAGE(PG8_SA(1, 0), cA + kstep, voffA); PG8_STAGE(PG8_SB(1, 1), cB + hstep + kstep, voffB);
        PG8_WAIT_V(6); PG8_BAR;
    } else {
        PG8_STAGE(PG8_SB(0, 0), cB, voffB); PG8_STAGE(PG8_SA(0, 0), cA, voffA); PG8_STAGE(PG8_SB(0, 1), cB + hstep, voffB); PG8_STAGE(PG8_SA(0, 1), cA + hstepA, voffA);
        if (wr == 1) PG8_BAR;
        PG8_WAIT_V(4); PG8_BAR;
        PG8_STAGE(PG8_SB(1, 0), cB + kstep, voffB); PG8_STAGE(PG8_SA(1, 0), cA + kstep, voffA); PG8_STAGE(PG8_SB(1, 1), cB + hstep + kstep, voffB);
        PG8_WAIT_V(6); PG8_BAR;
    }
    for (;;) {
        const bool has_next = S.next(ui + 1, nxt);
        const char* nA = has_next ? (const char*)g.A + (size_t)nxt.pm * tstepA : cA;
        const char* nA2 = (has_next && g.ksw) ? (const char*)g.A2 + (size_t)nxt.pm * tstepA : cA2;
        const char* nB = has_next ? (const char*)(g.Bt + (size_t)nxt.e * g.bt_estride) + (size_t)nxt.pn * tstep : cB;
        for (int t = 0; t < nt; t += 2) {
            const bool last = (t == nt - 2);
            const char* a1 = (t + 1 < ksw) ? cA + (size_t)(t + 1) * kstep : cA2 + (size_t)(t + 1 - ksw) * kstep;
            const char* a2 = last ? nA : ((t + 2 < ksw) ? cA + (size_t)(t + 2) * kstep : cA2 + (size_t)(t + 2 - ksw) * kstep); const char* b2 = last ? nB : cB + (size_t)(t + 2) * kstep;
            const char* a3 = a2 + kstep; const char* b3 = b2 + kstep;
            if (last && has_next) S.a_ready(nxt);
            if constexpr (Epi::HAS_MID) { if (t == ksw) E.mid(acc, cur, wr, wc, fr, fq); }
            if constexpr (SP2) {
            PG8_LDB(B0, 0, 0); PG8_LDB(B1, 0, 1); PG8_SCHED; PG8_LDA(At, 0, 0); PG8_STAGE(PG8_SA(1, 1), a1 + hstepA, voffA);
            PG8_WAIT_V(8); PG8_WAIT_L(0); PG8_BAR; PG8_MMA(0, 0, At, B0); PG8_MMA(0, 1, At, B1); PG8_BAR; PG8_SCHED;
            PG8_LDA(At, 0, 1); PG8_STAGE(PG8_SB(0, 0), b2, voffB); PG8_STAGE(PG8_SB(0, 1), b2 + hstep, voffB); PG8_STAGE(PG8_SA(0, 0), a2, voffA);
            PG8_WAIT_V(8); PG8_WAIT_L(0); PG8_BAR; PG8_MMA(1, 0, At, B0); PG8_MMA(1, 1, At, B1); PG8_BAR; PG8_SCHED;
            PG8_LDB(B0, 1, 0); PG8_LDB(B1, 1, 1); PG8_SCHED; PG8_LDA(At, 1, 0); PG8_STAGE(PG8_SA(0, 1), a2 + hstepA, voffA);
            PG8_WAIT_V(8); PG8_WAIT_L(0); PG8_BAR; PG8_MMA(0, 0, At, B0); PG8_MMA(0, 1, At, B1); PG8_BAR; PG8_SCHED;
            PG8_LDA(At, 1, 1); PG8_STAGE(PG8_SB(1, 0), b3, voffB); PG8_STAGE(PG8_SB(1, 1), b3 + hstep, voffB); PG8_STAGE(PG8_SA(1, 0), a3, voffA);
            PG8_WAIT_V(8); PG8_WAIT_L(0); PG8_BAR; PG8_MMA(1, 0, At, B0); PG8_MMA(1, 1, At, B1); PG8_BAR; PG8_SCHED;
            } else {
            PG8_LDB(B0, 0, 0); PG8_SCHED; PG8_LDA(At, 0, 0); PG8_STAGE(PG8_SA(1, 1), a1 + hstepA, voffA);
            PG8_WAIT_L(8); PG8_BAR; PG8_WAIT_L(0); PG8_MMA(0, 0, At, B0); PG8_BAR; PG8_SCHED;
            PG8_LDB(B1, 0, 1); PG8_STAGE(PG8_SB(0, 0), b2, voffB);
            PG8_BAR; PG8_WAIT_L(0); PG8_MMA(0, 1, At, B1); PG8_BAR;
            PG8_LDA(At, 0, 1); PG8_STAGE(PG8_SA(0, 0), a2, voffA);
            PG8_BAR; PG8_WAIT_L(0); PG8_MMA(1, 0, At, B0); PG8_BAR; PG8_SCHED;
            PG8_STAGE(PG8_SB(0, 1), b2 + hstep, voffB);
            PG8_WAIT_V(6); PG8_BAR; PG8_MMA(1, 1, At, B1); PG8_BAR;
            PG8_LDB(B0, 1, 0); PG8_SCHED; PG8_LDA(At, 1, 0); PG8_STAGE(PG8_SA(0, 1), a2 + hstepA, voffA);
            PG8_WAIT_L(8); PG8_BAR; PG8_WAIT_L(0); PG8_MMA(0, 0, At, B0); PG8_BAR; PG8_SCHED;
            PG8_LDB(B1, 1, 1); PG8_STAGE(PG8_SB(1, 0), b3, voffB);
            PG8_BAR; PG8_WAIT_L(0); PG8_MMA(0, 1, At, B1); PG8_BAR;
            PG8_LDA(At, 1, 1); PG8_STAGE(PG8_SA(1, 0), a3, voffA);
            PG8_BAR; PG8_WAIT_L(0); PG8_MMA(1, 0, At, B0); PG8_BAR; PG8_SCHED;
            PG8_STAGE(PG8_SB(1, 1), b3 + hstep, voffB);
            PG8_WAIT_V(6); PG8_BAR; PG8_MMA(1, 1, At, B1); PG8_BAR;
            }
        }
        if constexpr (ALIGN_EPI) { if (wr == 0) PG8_BAR; }
        E(acc, cur, wr, wc, fr, fq); S.done(cur);
        if (!has_next) break;
#pragma unroll
        for (int a = 0; a < 2; ++a)
#pragma unroll
            for (int b = 0; b < 2; ++b)
#pragma unroll
                for (int m = 0; m < 4; ++m)
#pragma unroll
                    for (int n = 0; n < 2; ++n) acc[a][b][m][n] = (f32x4){0.f, 0.f, 0.f, 0.f};
        cur = nxt; cA = nA; cA2 = nA2; cB = nB; ++ui;
        if constexpr (ALIGN_EPI) { if (wr == 1) PG8_BAR; }
    }
    PG8_WAIT_V(0);
    if constexpr (!ALIGN_EPI) { if (wr == 0) PG8_BAR; }
    PG8_BAR;
#undef PG8_SA
#undef PG8_SB
#undef PG8_STAGE
#undef PG8_LDA
#undef PG8_LDB
#undef PG8_MMA
#undef PG8_WAIT_V
#undef PG8_WAIT_L
#undef PG8_BAR
#undef PG8_SCHED
}
}

#define XB_TMO      128
#define XB_XCNT(j)  (256  + 64 * (j))
#define XB_XSUB(j)  (1280 + 64 * (j))
#define XB_XGEN(j)  (2304 + 64 * (j))
#define XB_TOP      3328
#define XB_TOPGEN   3392
#define XCD_BAR_WORDS 3456
#define XB_SPIN_CAP (1u << 18)
__device__ __forceinline__ unsigned xb_ld(unsigned* p)              { return __hip_atomic_load(p, __ATOMIC_RELAXED, __HIP_MEMORY_SCOPE_AGENT); }
__device__ __forceinline__ unsigned xb_add(unsigned* p, unsigned v) { return __hip_atomic_fetch_add(p, v, __ATOMIC_RELAXED, __HIP_MEMORY_SCOPE_AGENT); }
__device__ __forceinline__ unsigned xb_xcc_id() { return (unsigned)__builtin_amdgcn_s_getreg((3 << 11) | 20) & 0xFu; }
#define XB_SPIN(cond, bar) do { unsigned _sp = 0; while (cond) { __builtin_amdgcn_s_sleep(1); \
    if ((++_sp & 255u) == 0u) { if (xb_ld(&(bar)[XB_TMO])) break; if (_sp > XB_SPIN_CAP) { atomicAdd(&(bar)[XB_TMO], 1u); break; } } } } while (0)
struct XcdBarrier { unsigned* bar; unsigned x; volatile LAS unsigned* st; };
__device__ __forceinline__ XcdBarrier xcd_barrier_post(unsigned* bar, volatile LAS unsigned* st, const bool leader) {
    XcdBarrier b; b.bar = bar; b.x = xb_xcc_id(); b.st = st;
    if (leader) (void)xb_add(&bar[XB_XCNT(b.x)], 1u);
    return b;
}
__device__ __forceinline__ void xcd_barrier_complete(unsigned* bar, unsigned x, unsigned& nloc, unsigned& nx) {
    const unsigned G = gridDim.x * gridDim.y * gridDim.z;
    unsigned sum, cnt, mine, sp = 0u;
    for (;;) {
        sum = 0u; cnt = 0u; mine = 0u;
#pragma unroll
        for (unsigned j = 0; j < 16; ++j) { const unsigned c = xb_ld(&bar[XB_XCNT(j)]); sum += c; cnt += (c > 0u) ? 1u : 0u; mine = (j == x) ? c : mine; }
        if (sum == G) break;
        __builtin_amdgcn_s_sleep(1);
        if ((++sp & 255u) == 0u) { if (xb_ld(&bar[XB_TMO])) break; if (sp > XB_SPIN_CAP) { atomicAdd(&bar[XB_TMO], 1u); break; } }
    }
    nloc = mine > 0u ? mine : 1u; nx = cnt > 0u ? cnt : 1u;
}
__device__ __forceinline__ void xcd_barrier(const XcdBarrier& b, const bool leader) {
    asm volatile("s_waitcnt vmcnt(0)" ::: "memory");
    __syncthreads();
    if (leader) {
        unsigned* bar = b.bar;
        __builtin_amdgcn_s_waitcnt(0);
        unsigned nloc = b.st[0], nx = b.st[1];
        if (nloc == 0u) { xcd_barrier_complete(bar, b.x, nloc, nx); b.st[0] = nloc; b.st[1] = nx; }
        const unsigned old = xb_add(&bar[XB_XSUB(b.x)], 1u);
        const unsigned gen = old / nloc;
        if (old + 1u == (gen + 1u) * nloc) {
            __builtin_amdgcn_fence(__ATOMIC_RELEASE, "agent");
            asm volatile("s_waitcnt vmcnt(0)" ::: "memory");
            const unsigned og = xb_add(&bar[XB_TOP], 1u);
            const unsigned tg = og / nx;
            if (og + 1u == (tg + 1u) * nx) xb_add(&bar[XB_TOPGEN], 1u);
            else XB_SPIN(xb_ld(&bar[XB_TOPGEN]) == tg, bar);
            __builtin_amdgcn_fence(__ATOMIC_ACQUIRE, "agent");
            xb_add(&bar[XB_XGEN(b.x)], 1u);
            asm volatile("s_waitcnt vmcnt(0)" ::: "memory");
        } else {
            XB_SPIN(xb_ld(&bar[XB_XGEN(b.x)]) == gen, bar);
            __builtin_amdgcn_fence(__ATOMIC_ACQUIRE, "agent");
            asm volatile("s_waitcnt vmcnt(0)" ::: "memory");
        }
    }
    __syncthreads();
}

constexpr int NB = 4, SEQ = 8192, DM = 1024, NT = NB * SEQ;
constexpr int NINP = 5632;
constexpr int FF0 = 2752, FF0P = 2816, FFE = 3584, NEXP = 8;
constexpr int NWAVES = 8, NTHR = 512;
constexpr int LDS_BYTES = 155648;
constexpr int MISC_OFF = LDS_BYTES - 64;
constexpr float DN_ALPHA = 1.41421356237309515f;
constexpr int MAXPANELS = 272;
constexpr int MAXCHUNK = 5;

constexpr size_t al256(size_t x) { return (x + 255) & ~(size_t)255; }
constexpr size_t WS_CTL = 0;
constexpr size_t CTL_BYTES = 65536;
constexpr size_t CW_BAR = 0;
constexpr size_t CW_BLKCNT = 16384;
constexpr size_t CW_META = 16384 + 8192;
constexpr size_t CW_PANELE = 16384 + 8192 + 256;
constexpr size_t CW_PE32 = 16384 + 8192 + 2048;
constexpr size_t CW_PROBE = 16384 + 8192 + 4096;
constexpr size_t WS_LBS = WS_CTL + CTL_BYTES;
constexpr size_t WS_KC = WS_LBS + 4096;
constexpr size_t WS_VC = WS_KC + 1048576;
constexpr size_t WS_DEC = WS_VC + 1048576;
constexpr size_t WS_TOPI = WS_DEC + 1048576;
constexpr size_t WS_TOPG = WS_TOPI + (size_t)NT * 4;
constexpr size_t WS_ROWINFO = WS_TOPG + (size_t)NT * 8;
constexpr size_t WS_HID = al256(WS_ROWINFO + (size_t)MAXPANELS * 256 * 4);
constexpr size_t WS_B1 = WS_HID + (size_t)8192 * 128 * 2;
constexpr size_t WS_BIG = al256(WS_B1 + 4096);
constexpr size_t SZ_WIN = (size_t)NINP * DM * 2, SZ_WBR = (size_t)DM * 512 * 2, SZ_WOUT = (size_t)DM * DM * 2;
constexpr size_t WS_WIN0 = WS_BIG, WS_WIN1 = WS_WIN0 + SZ_WIN;
constexpr size_t WS_WBA0 = WS_WIN1 + SZ_WIN, WS_WBA1 = WS_WBA0 + SZ_WBR, WS_WBB0 = WS_WBA1 + SZ_WBR, WS_WBB1 = WS_WBB0 + SZ_WBR;
constexpr size_t WS_WOUT0 = WS_WBB1 + SZ_WBR, WS_WOUT1 = WS_WOUT0 + SZ_WOUT;
constexpr size_t WS_WGU0 = WS_WOUT1 + SZ_WOUT;
constexpr size_t WS_WDN0 = WS_WGU0 + (size_t)NINP * DM * 2;
constexpr size_t WS_W1T = WS_WDN0 + (size_t)DM * FF0P * 2;
constexpr size_t WS_XB = WS_W1T + (size_t)2 * 2 * 256 * 2048 * 2;
constexpr size_t WS_US = WS_XB;
constexpr size_t WS_PROJ = WS_XB + (size_t)NT * DM * 2;
constexpr size_t WS_QHG = WS_PROJ;
constexpr size_t WS_HF = WS_QHG + (size_t)NT * 512 * 2;
constexpr size_t WS_HI = WS_HF + (size_t)NT * 512 * 4;
constexpr size_t WS_HG = WS_HI + (size_t)NT * 512 * 2;
constexpr size_t WS_NQ = WS_HG + (size_t)NT * 512 * 2;
constexpr size_t WS_KV6 = WS_NQ + (size_t)NT * 512 * 2;
constexpr size_t WS_GA = WS_KV6 + (size_t)NT * 768 * 2;
constexpr size_t WS_GB = WS_GA + (size_t)NT * DM * 2;
constexpr size_t WS_NG = WS_GB + (size_t)NT * DM * 2;
constexpr size_t WS_MIX_END = WS_NG + (size_t)NT * 32 * 4;
constexpr size_t WS_H0 = WS_PROJ;
constexpr size_t WS_MGU = WS_BIG;
constexpr size_t WS_MDN = WS_MGU + (size_t)NEXP * 2 * FFE * DM * 2;
constexpr size_t WS_XS = WS_MDN + (size_t)NEXP * DM * FFE * 2;
constexpr size_t WS_HM = WS_XS + (size_t)MAXPANELS * 256 * DM * 2;
constexpr size_t WS_YM = WS_HM + (size_t)64 * 256 * FFE * 2;
constexpr size_t WS_MOE_END = WS_YM + (size_t)NT * 2 * DM * 2;
constexpr size_t WS_END = WS_MOE_END > WS_MIX_END ? WS_MOE_END : WS_MIX_END;

struct Args {
    const float* in[22]; float* out; unsigned char* ws; int ph_lo, ph_hi;
};
typedef const __attribute__((address_space(4))) Args* KArgsP;

struct EpiInProj {
    static constexpr bool PERM = false, HAS_MID = false;
    unsigned char* ws;
    __device__ __forceinline__ void operator()(const f32x4 (&acc)[2][2][4][2], const pg8::Unit& u, int wr, int wc, int fr, int fq) const {
        const int row0 = u.pm * 256 + wr * 64 + fr;
#pragma unroll
        for (int bj = 0; bj < 2; ++bj)
#pragma unroll
            for (int n = 0; n < 2; ++n) {
                const int cb = u.pn * 256 + bj * 128 + wc * 32 + n * 16;
                const int c = cb + 4 * fq;
                int kind = 0, ld = 512, co = 0; size_t base = 0; float sc = 1.f;
                if (cb < 512) { base = WS_QHG; co = c; }
                else if (cb < 1024) { kind = 1; base = WS_HF; co = c - 512; }
                else if (cb < 1536) { base = WS_HI; co = c - 1024; }
                else if (cb < 2048) { base = WS_HG; co = c - 1536; }
                else if (cb < 2560) { base = WS_NQ; co = c - 2048; sc = 0.125f * 1.4426950408889634f; }
                else if (cb < 3328) { kind = 3; base = WS_KV6; const int idx = cb - 2560; co = ((idx >> 7) * 8 + ((idx >> 6) & 1)) * SEQ * 64 + (idx & 63) + 4 * fq; }
                else if (cb < 4352) { base = WS_GA; co = c - 3328; ld = 1024; }
                else if (cb < 5376) { base = WS_GB; co = c - 4352; ld = 1024; }
                else if (cb < 5408) { kind = 1; base = WS_NG; co = c - 5376; ld = 32; }
                else kind = 2;
                if (kind == 2) continue;
#pragma unroll
                for (int ai = 0; ai < 2; ++ai)
#pragma unroll
                    for (int m = 0; m < 4; ++m) {
                        const int row = row0 + ai * 128 + m * 16;
                        const f32x4 v = acc[ai][bj][m][n];
                        if (kind == 0) { u32x2 w; w.x = cvt_pk_bf16(v[0] * sc, v[1] * sc); w.y = cvt_pk_bf16(v[2] * sc, v[3] * sc); *(u32x2*)((bf16*)(ws + base) + (size_t)row * ld + co) = w; }
                        else if (kind == 3) { u32x2 w; w.x = cvt_pk_bf16(v[0], v[1]); w.y = cvt_pk_bf16(v[2], v[3]); *(u32x2*)((bf16*)(ws + base) + (size_t)co + ((size_t)(row >> 13) * 2 * SEQ + (row & (SEQ - 1))) * 64) = w; }
                        else *(f32x4*)((float*)(ws + base) + (size_t)row * ld + co) = v;
                    }
            }
    }
};
struct EpiCmpHid {
    static constexpr bool PERM = false, HAS_MID = false;
    bf16* HID; const float* B1;
    __device__ __forceinline__ void operator()(const f32x4 (&acc)[2][2][4][2], const pg8::Unit& u, int wr, int wc, int fr, int fq) const {
        const int row0 = u.pm * 256 + wr * 64 + fr, col0 = wc * 32 + 4 * fq;
#pragma unroll
        for (int n = 0; n < 2; ++n) { const f32x4 bq = *(const f32x4*)(B1 + u.e * 128 + col0 + n * 16);
#pragma unroll
            for (int ai = 0; ai < 2; ++ai)
#pragma unroll
                for (int m = 0; m < 4; ++m) { const f32x4 v = acc[ai][0][m][n] + bq; float o[4];
#pragma unroll
                    for (int q = 0; q < 4; ++q) { const float x = v[q]; o[q] = 0.5f * x * (1.f + tanhf(0.7978845608028654f * (x + 0.044715f * x * x * x))); }
                    u32x2 w; w.x = cvt_pk_bf16(o[0], o[1]); w.y = cvt_pk_bf16(o[2], o[3]);
                    *(u32x2*)(HID + (size_t)(row0 + ai * 128 + m * 16) * 128 + col0 + n * 16) = w; } }
    }
};
template <bool FIRST> struct EpiGate {
    static constexpr bool PERM = false, HAS_MID = false;
    bf16* Y; const bf16* G;
    __device__ __forceinline__ void operator()(const f32x4 (&acc)[2][2][4][2], const pg8::Unit& u, int wr, int wc, int fr, int fq) const {
        const int row0 = u.pm * 256 + wr * 64 + fr, col0 = u.pn * 256 + wc * 32 + 4 * fq;
#pragma unroll
        for (int ai = 0; ai < 2; ++ai)
#pragma unroll
            for (int m = 0; m < 4; ++m)
#pragma unroll
                for (int bj = 0; bj < 2; ++bj)
#pragma unroll
                    for (int n = 0; n < 2; ++n) {
                        const size_t off = (size_t)(row0 + ai * 128 + m * 16) * DM + col0 + bj * 128 + n * 16;
                        const u32x2 gq = *(const u32x2*)(G + off);
                        const f32x4 v = acc[ai][bj][m][n];
                        float o0 = sigmoidf_(bflo(gq.x)) * v[0], o1 = sigmoidf_(bfhi(gq.x)) * v[1], o2 = sigmoidf_(bflo(gq.y)) * v[2], o3 = sigmoidf_(bfhi(gq.y)) * v[3];
                        if (!FIRST) { const u32x2 yq = *(const u32x2*)(Y + off); o0 += bflo(yq.x); o1 += bfhi(yq.x); o2 += bflo(yq.y); o3 += bfhi(yq.y); }
                        u32x2 w; w.x = cvt_pk_bf16(o0, o1); w.y = cvt_pk_bf16(o2, o3); *(u32x2*)(Y + off) = w;
                    }
    }
};
struct EpiGate2 {
    static constexpr bool PERM = false, HAS_MID = true;
    bf16* Y; const bf16* GA; const bf16* GB;
    static __device__ __forceinline__ float cl(float x) { return fminf(fmaxf(x, -30.f), 30.f); }
    __device__ __forceinline__ void mid(f32x4 (&acc)[2][2][4][2], const pg8::Unit& u, int wr, int wc, int fr, int fq) const {
        int row0 = u.pm * 256 + wr * 64 + fr; const int col0 = u.pn * 256 + wc * 32 + 4 * fq;
        asm volatile("" : "+v"(row0));
#pragma unroll
        for (int ai = 0; ai < 2; ++ai)
#pragma unroll
            for (int m = 0; m < 4; ++m) {
#pragma unroll
                for (int bj = 0; bj < 2; ++bj)
#pragma unroll
                    for (int n = 0; n < 2; ++n) {
                        const size_t off = (size_t)(row0 + ai * 128 + m * 16) * DM + col0 + bj * 128 + n * 16;
                        const u32x2 ga = *(const u32x2*)(GA + off), gb = *(const u32x2*)(GB + off);
                        f32x4 r;
                        r[0] = (1.f + __expf(-cl(bflo(gb.x)))) * __builtin_amdgcn_rcpf(1.f + __expf(-cl(bflo(ga.x))));
                        r[1] = (1.f + __expf(-cl(bfhi(gb.x)))) * __builtin_amdgcn_rcpf(1.f + __expf(-cl(bfhi(ga.x))));
                        r[2] = (1.f + __expf(-cl(bflo(gb.y)))) * __builtin_amdgcn_rcpf(1.f + __expf(-cl(bflo(ga.y))));
                        r[3] = (1.f + __expf(-cl(bfhi(gb.y)))) * __builtin_amdgcn_rcpf(1.f + __expf(-cl(bfhi(ga.y))));
                        acc[ai][bj][m][n] = acc[ai][bj][m][n] * r;
                    }
                asm volatile("" : "+v"(acc[ai][0][m][0]), "+v"(acc[ai][0][m][1]), "+v"(acc[ai][1][m][0]), "+v"(acc[ai][1][m][1]) :: "memory");
            }
    }
    __device__ __forceinline__ void operator()(const f32x4 (&acc)[2][2][4][2], const pg8::Unit& u, int wr, int wc, int fr, int fq) const {
        const int row0 = u.pm * 256 + wr * 64 + fr, col0 = u.pn * 256 + wc * 32 + 4 * fq;
#pragma unroll
        for (int ai = 0; ai < 2; ++ai)
#pragma unroll
            for (int m = 0; m < 4; ++m)
#pragma unroll
                for (int bj = 0; bj < 2; ++bj)
#pragma unroll
                    for (int n = 0; n < 2; ++n) {
                        const size_t off = (size_t)(row0 + ai * 128 + m * 16) * DM + col0 + bj * 128 + n * 16;
                        const u32x2 gb = *(const u32x2*)(GB + off);
                        const f32x4 v = acc[ai][bj][m][n];
                        u32x2 w; w.x = cvt_pk_bf16(v[0] * sigmoidf_(cl(bflo(gb.x))), v[1] * sigmoidf_(cl(bfhi(gb.x)))); w.y = cvt_pk_bf16(v[2] * sigmoidf_(cl(bflo(gb.y))), v[3] * sigmoidf_(cl(bfhi(gb.y))));
                        *(u32x2*)(Y + off) = w;
                    }
    }
};
struct EpiResid {
    static constexpr bool PERM = false, HAS_MID = false;
    const float* XI; float* XO;
    __device__ __forceinline__ void operator()(const f32x4 (&acc)[2][2][4][2], const pg8::Unit& u, int wr, int wc, int fr, int fq) const {
        const int row0 = u.pm * 256 + wr * 64 + fr, col0 = u.pn * 256 + wc * 32 + 4 * fq;
#pragma unroll
        for (int ai = 0; ai < 2; ++ai)
#pragma unroll
            for (int m = 0; m < 4; ++m)
#pragma unroll
                for (int bj = 0; bj < 2; ++bj)
#pragma unroll
                    for (int n = 0; n < 2; ++n) {
                        const size_t off = (size_t)(row0 + ai * 128 + m * 16) * DM + col0 + bj * 128 + n * 16;
                        const f32x4 xi = *(const f32x4*)(XI + off);
                        *(f32x4*)(XO + off) = xi * DN_ALPHA + acc[ai][bj][m][n];
                    }
    }
};
struct EpiSwiglu {
    static constexpr bool PERM = false, HAS_MID = false;
    bf16* H; int ldh;
    __device__ __forceinline__ void operator()(const f32x4 (&acc)[2][2][4][2], const pg8::Unit& u, int wr, int wc, int fr, int fq) const {
        const int row0 = u.pm * 256 + wr * 64 + fr, col0 = u.pn * 128 + wc * 32 + 4 * fq;
#pragma unroll
        for (int ai = 0; ai < 2; ++ai)
#pragma unroll
            for (int m = 0; m < 4; ++m)
#pragma unroll
                for (int n = 0; n < 2; ++n) {
                    const f32x4 gq = acc[ai][0][m][n], uq = acc[ai][1][m][n];
                    u32x2 w; w.x = cvt_pk_bf16(siluf_(gq[0]) * uq[0], siluf_(gq[1]) * uq[1]); w.y = cvt_pk_bf16(siluf_(gq[2]) * uq[2], siluf_(gq[3]) * uq[3]);
                    *(u32x2*)(H + (size_t)(row0 + ai * 128 + m * 16) * ldh + col0 + n * 16) = w;
                }
    }
};
struct EpiScatter {
    static constexpr bool PERM = false, HAS_MID = false;
    bf16* Y; const int* rowinfo;
    __device__ __forceinline__ void operator()(const f32x4 (&acc)[2][2][4][2], const pg8::Unit& u, int wr, int wc, int fr, int fq) const {
        const int row0 = u.pm * 256 + wr * 64 + fr, col0 = u.pn * 256 + wc * 32 + 4 * fq;
#pragma unroll
        for (int ai = 0; ai < 2; ++ai)
#pragma unroll
            for (int m = 0; m < 4; ++m) {
                const int info = rowinfo[row0 + ai * 128 + m * 16];
                if (info < 0) continue;
#pragma unroll
                for (int bj = 0; bj < 2; ++bj)
#pragma unroll
                    for (int n = 0; n < 2; ++n) {
                        const f32x4 v = acc[ai][bj][m][n];
                        u32x2 w; w.x = cvt_pk_bf16(v[0], v[1]); w.y = cvt_pk_bf16(v[2], v[3]);
                        *(u32x2*)(Y + (size_t)info * DM + col0 + bj * 128 + n * 16) = w;
                    }
            }
    }
};

template <int N> struct IConst { static constexpr int value = N; };
__device__ __forceinline__ int rel_bucket(int n) {
    if (n < 16) return n;
    return 16 + (n >= 22) + (n >= 30) + (n >= 40) + (n >= 54) + (n >= 73) + (n >= 99) + (n >= 134) + (n >= 182) + (n >= 246) + (n >= 332) + (n >= 450) + (n >= 609) + (n >= 825) + (n >= 1117) + (n >= 1513);
}
template <class F>
__device__ __forceinline__ void tr_item(F colptr, int ld, int Kvalid, bf16* dst, int dstld, int n0, int k0, LAS float* scr, int lane) {
    const float* cp = colptr(n0 + 4 * (lane & 7));
#pragma unroll
    for (int i = 0; i < 8; ++i) { const int kk = 8 * i + (lane >> 3), k = k0 + kk; f32x4 v = (f32x4){0.f, 0.f, 0.f, 0.f}; if (cp && k < Kvalid) v = *(const f32x4*)(cp + (size_t)k * ld);
        LAS float* s = scr + kk * 33 + 4 * (lane & 7); s[0] = v[0]; s[1] = v[1]; s[2] = v[2]; s[3] = v[3]; }
    WAVE_SYNC();
    const int c = lane & 7;
#pragma unroll
    for (int j = 0; j < 4; ++j) { const int n = (lane >> 3) + 8 * j; const LAS float* s = scr + (8 * c) * 33 + n;
        u32x4 o; o.x = cvt_pk_bf16(s[0 * 33], s[1 * 33]); o.y = cvt_pk_bf16(s[2 * 33], s[3 * 33]); o.z = cvt_pk_bf16(s[4 * 33], s[5 * 33]); o.w = cvt_pk_bf16(s[6 * 33], s[7 * 33]);
        *(u32x4*)(dst + (size_t)(n0 + n) * dstld + k0 + 8 * c) = o; }
    WAVE_SYNC();
}

__global__ void __launch_bounds__(NTHR, 2) mega_fwd(Args args) {
    extern __shared__ __attribute__((aligned(16))) unsigned char lds_raw[];
    LAS unsigned char* lds = (LAS unsigned char*)lds_raw;
    const int G = gridDim.x, bid = blockIdx.x;
    const int nwaves = G * NWAVES;
    KArgsP kap = (KArgsP)__builtin_amdgcn_kernarg_segment_ptr();
    unsigned char* ws0 = kap->ws;
#if ONE_LAUNCH
    constexpr int lo = 0, hi = 64;
#else
    const int lo = kap->ph_lo, hi = kap->ph_hi;
#endif

    volatile LAS unsigned* misc = (volatile LAS unsigned*)(lds + MISC_OFF);
    const int wave_s = __builtin_amdgcn_readfirstlane((int)threadIdx.x >> 6);
    if (wave_s == 0 && lane_id() < 16) misc[lane_id()] = 0u;
    __syncthreads();
    XcdBarrier bar; bar.bar = (unsigned*)(ws0 + WS_CTL + CW_BAR); bar.x = 0; bar.st = misc;
    const bool multi = (hi - lo) > 1;
    if (multi) bar = xcd_barrier_post((unsigned*)(ws0 + WS_CTL + CW_BAR), misc, wave_s == 0 && lane_id() == 0);
#ifndef EN_MASK
#define EN_MASK 0xFFFFFFFFu
#endif
#define EN(b) (((EN_MASK) >> (b)) & 1u)
#define IN(k) (lo <= (k) && (k) < hi)
#ifndef PROBE_GRP
#define PROBE_GRP -1
#endif
#define PROBE_K 4
#ifndef STAGGER_TICKS
#define STAGGER_TICKS 0
#endif
#ifndef SELREP
#define SELREP 1
#endif
#define WINREP 1
#define NSA_SGB 1
#define NSA_DUP_A 0
#define NSA_DUP_B 0
#define NSA_DUP_C 0
#ifndef PROBE_SCALE
#define PROBE_SCALE 1e-6f
#endif
#if PROBE_GRP >= 0
    unsigned long long pr_last = __builtin_amdgcn_s_memrealtime(), pr_acc = 0ull;
#define PMARK(g) do { const unsigned long long _n = __builtin_amdgcn_s_memrealtime(); if ((g) == PROBE_GRP) pr_acc += _n - pr_last; pr_last = _n; } while (0)
#else
    const unsigned long long pr_acc = 0ull; (void)pr_acc;
#define PMARK(g) do { } while (0)
#endif
#define SEAM(k, g) do { if (IN(k) && IN((k) + 1)) { XcdBarrier b_ = bar; asm volatile("" : "+s"(b_.bar)); unsigned bx_ = b_.x; asm volatile("" : "+s"(bx_)); b_.x = bx_; \
        xcd_barrier(b_, wave_s == 0 && lane_id() == 0); } PMARK(g); } while (0)


    if (EN(0) && IN(0)) { PHASE_IDS();
        LAS float* scr = (LAS float*)(lds + wave * 16384);
        constexpr int I_WIN = 16 * (NINP / 32), I_BR = 8 * 32, I_OUT = 16 * 32, I_GU = 16 * (NINP / 32), I_DN = (FF0P / 64) * 32;
        constexpr int I_W1 = 32 * 8;
        constexpr int NITEMS = 2 * (I_WIN + 2 * I_BR + I_OUT) + I_GU + I_DN + 4 * I_W1;
        for (int it = gwave; it < NITEMS; it += nwaves) {
            int r = it;
            if (r < 2 * I_WIN) { const int l = r / I_WIN; r %= I_WIN; const int nb = r % (NINP / 32), kb = r / (NINP / 32);
                const float* W = ap->in[1] + (size_t)l * DM * 5400;
                auto cp = [=](int n) -> const float* { int c; if (n < 3328) c = n; else if (n < 5376) c = n + 24; else if (n < 5400) c = n - 5376 + 3328; else return nullptr; return W + c; };
                tr_item(cp, 5400, DM, (bf16*)(ws + (l ? WS_WIN1 : WS_WIN0)), DM, nb * 32, kb * 64, scr, lane); continue; }
            r -= 2 * I_WIN;
            if (r < 4 * I_BR) { const int which = r / I_BR; r %= I_BR; const int l = which & 1, ab = which >> 1; const int nb = r % 32, kb = r / 32;
                const float* W = ap->in[ab ? 9 : 8] + (size_t)l * 512 * DM;
                auto cp = [=](int n) -> const float* { return W + n; };
                tr_item(cp, DM, 512, (bf16*)(ws + WS_WBA0 + (size_t)l * 2 * SZ_WBR) + ab * 512, DM, nb * 32, kb * 64, scr, lane); continue; }
            r -= 4 * I_BR;
            if (r < 2 * I_OUT) { const int l = r / I_OUT; r %= I_OUT; const int nb = r % 32, kb = r / 32;
                const float* W = ap->in[10] + (size_t)l * DM * DM;
                auto cp = [=](int n) -> const float* { return W + n; };
                tr_item(cp, DM, DM, (bf16*)(ws + (l ? WS_WOUT1 : WS_WOUT0)), DM, nb * 32, kb * 64, scr, lane); continue; }
            r -= 2 * I_OUT;
            if (r < I_GU) { const int nb = r % (NINP / 32), kb = r / (NINP / 32);
                const float* Wg = ap->in[15]; const float* Wu = ap->in[16];
                auto cp = [=](int n) -> const float* { const int pn = n >> 8, hf = (n >> 7) & 1, c = pn * 128 + (n & 127); if (c >= FF0) return nullptr; return (hf ? Wu : Wg) + c; };
                tr_item(cp, FF0, DM, (bf16*)(ws + WS_WGU0), DM, nb * 32, kb * 64, scr, lane); continue; }
            r -= I_GU;
            if (r >= I_DN) { r -= I_DN; const int lk = r / I_W1; r %= I_W1; const int nb = r % 8, kb = r / 8;
                const float* W = ap->in[5] + (size_t)lk * 2048 * 128;
                auto cp = [=](int n) -> const float* { return n < 128 ? W + n : nullptr; };
                tr_item(cp, 128, 2048, (bf16*)(ws + WS_W1T) + (size_t)lk * 256 * 2048, 2048, nb * 32, kb * 64, scr, lane); continue; }
            { const int nb = r % 32, kb = r / 32;
                const float* W = ap->in[17];
                auto cp = [=](int n) -> const float* { return W + n; };
                tr_item(cp, DM, FF0, (bf16*)(ws + WS_WDN0), FF0P, nb * 32, kb * 64, scr, lane); }
        }
        for (int row = gwave; row < NT; row += nwaves) {
            const f32x4* xr = (const f32x4*)(x_in + (size_t)row * DM);
            u32x2* o = (u32x2*)(XB + (size_t)row * DM);
#pragma unroll
            for (int j = 0; j < 4; ++j) { const f32x4 v = xr[64 * j + lane]; u32x2 w; w.x = cvt_pk_bf16(v[0], v[1]); w.y = cvt_pk_bf16(v[2], v[3]); o[64 * j + lane] = w; }
        }
        for (int o = gwave; o < 4 * 128; o += nwaves) { const int lk = o >> 7, j = o & 127; const float* PS = ap->in[4] + (size_t)lk * 2048; const float* W = ap->in[5] + (size_t)lk * 2048 * 128;
            float s = 0.f; for (int k = lane; k < 2048; k += 64) s += PS[k] * W[(size_t)k * 128 + j];
            s = wave_sum(s); if (lane == 0) ((float*)(ws + WS_B1))[o] = s; }
        if (bid == 0 && tid < 32) ((int*)(ws + WS_CTL + CW_PE32))[tid] = tid >> 4;
        if (bid == 0) {
            const float* lg = ap->in[2];
            const float a = lg[tid], b = lg[512 + tid], m = fmaxf(a, b), ea = expf(a - m), eb = expf(b - m), s = ea + eb, p0 = ea / s, p1 = eb / s;
            LBS[tid] = p0 - p0; LBS[512 + tid] = (p0 + p1) - p0;
        }
    }
    SEAM(0, 0);

    for (int l = 0; l < 2; ++l) {
        const int pb = 1 + l * 10;

        if (EN(1) && IN(pb + 0)) { PHASE_IDS();
            if (STAGGER_TICKS > 0 && ((bid >> 3) & 1)) { const unsigned long long t0 = __builtin_amdgcn_s_memrealtime(); while (__builtin_amdgcn_s_memrealtime() - t0 < (unsigned long long)STAGGER_TICKS) __builtin_amdgcn_s_sleep(8); }
            pg8::Gemm g{XB, (const bf16*)(ws + (l ? WS_WIN1 : WS_WIN0)), NT, NINP, DM, 0, 0, nullptr, 0};
            pg8::StaticOrder S; S.init(NT, NINP, G, bid);
            EpiInProj E{ws};
            pg8::gemm_phase<EpiInProj, pg8::StaticOrder>(lds, g, S, E, wave_s);
        }
        SEAM(pb + 0, 1);

        if (EN(2) && IN(pb + 1)) { PHASE_IDS();
            {
                constexpr int RS = 272;
                LAS float* bsf = (LAS float*)lds;
                LAS unsigned char* kd = lds + 32768;
                LAS unsigned char* vt = lds + 32768 + 64 * RS;
                const bf16* HI = (const bf16*)(ws + WS_HI); const float* HF = (const float*)(ws + WS_HF);
                bf16* US = (bf16*)(ws + WS_US); float* DEC = (float*)(ws + WS_DEC);
                const int d = tid & 127, tp = tid >> 7;
                const int d0 = 4 * (tid & 31), tg = tid >> 5;
                f32x4 zr[4];
                auto ld_z = [&](int it) { const int h = it & 3, ci = (it >> 2) & 127, b = it >> 9; const size_t tok0 = (size_t)b * SEQ + ci * 64;
#pragma unroll
                    for (int i = 0; i < 4; ++i) zr[i] = *(const f32x4*)(HF + (tok0 + tg + 16 * i) * 512 + h * 128 + d0); };
                ld_z(bid);
                for (int item = bid; item < NB * 128 * 4; item += G) {
                    const int h = item & 3, ci = (item >> 2) & 127, b = item >> 9, bh = b * 4 + h;
                    const size_t tok0 = (size_t)b * SEQ + ci * 64;
                    const f32x4 lb4 = *(const f32x4*)(LBS + l * 512 + h * 128 + d0);
                    f32x4 kk[4];
#pragma unroll
                    for (int i = 0; i < 4; ++i) { const int t = tg + 16 * i; f32x4 lg;
#pragma unroll
                        for (int c = 0; c < 4; ++c) { kk[i][c] = (1.f - lb4[c]) * __builtin_amdgcn_rcpf(1.f + __expf(zr[i][c])); lg[c] = __logf(1.f - kk[i][c]); }
                        *(LAS f32x4*)(bsf + t * 128 + d0) = lg; }
                    { const int t = tid >> 3, c8 = tid & 7;
                        const u32x4* src = (const u32x4*)(HI + (tok0 + t) * 512 + h * 128) + c8 * 2;
                        const u32x4 a0 = src[0], a1 = src[1]; *(LAS u32x4*)(vt + t * RS + c8 * 32) = a0; *(LAS u32x4*)(vt + t * RS + c8 * 32 + 16) = a1; }
                    LDS_SYNC();
                    { float run = 0.f;
#pragma unroll
                        for (int i = 0; i < 16; ++i) { run += bsf[(16 * tp + i) * 128 + d]; bsf[(16 * tp + i) * 128 + d] = run; } }
                    LDS_SYNC();
                    float off = 0.f;
                    for (int p = 0; p < tp; ++p) off += bsf[(16 * p + 15) * 128 + d];
                    LDS_SYNC();
#pragma unroll
                    for (int i = 0; i < 16; ++i) bsf[(16 * tp + i) * 128 + d] += off;
                    LDS_SYNC();
                    { const f32x4 bl = *(const LAS f32x4*)(bsf + 63 * 128 + d0);
                        if (tg == 0) { f32x4 e; e[0] = __expf(bl[0]); e[1] = __expf(bl[1]); e[2] = __expf(bl[2]); e[3] = __expf(bl[3]); *(f32x4*)(DEC + ((size_t)bh * 128 + ci) * 128 + d0) = e; }
#pragma unroll
                        for (int i = 0; i < 4; ++i) { const int t = tg + 16 * i; const f32x4 bt = *(const LAS f32x4*)(bsf + t * 128 + d0);
                            u32x2 w; w.x = cvt_pk_bf16(kk[i][0] * __expf(bl[0] - bt[0]), kk[i][1] * __expf(bl[1] - bt[1])); w.y = cvt_pk_bf16(kk[i][2] * __expf(bl[2] - bt[2]), kk[i][3] * __expf(bl[3] - bt[3]));
                            *(LAS u32x2*)(kd + t * RS + d0 * 2) = w; } }
                    LDS_SYNC();
                    if (item + G < NB * 128 * 4) ld_z(item + G);
                    {
                        const int mi = wave >> 1, r31 = lane & 31, hh = lane >> 5, i16 = lane & 15, sub = (lane >> 4) & 1;
                        f32x16 acc[2];
#pragma unroll
                        for (int q = 0; q < 2; ++q)
#pragma unroll
                            for (int r = 0; r < 16; ++r) acc[q][r] = 0.f;
#pragma unroll
                        for (int st = 0; st < 4; ++st) {
                            const LAS unsigned char* ka = kd + (16 * st + 8 * hh + (i16 >> 2)) * RS + (32 * mi + 16 * sub + 4 * (i16 & 3)) * 2;
                            const s16x4 k0 = __builtin_amdgcn_ds_read_tr16_b64_v4i16((LAS s16x4*)ka), k1 = __builtin_amdgcn_ds_read_tr16_b64_v4i16((LAS s16x4*)(ka + 4 * RS));
                            const bf16x8 af = __builtin_shufflevector(k0, k1, 0, 1, 2, 3, 4, 5, 6, 7);
#pragma unroll
                            for (int q = 0; q < 2; ++q) { const int ni = 2 * (wave & 1) + q;
                                const LAS unsigned char* va = vt + (16 * st + 8 * hh + (i16 >> 2)) * RS + (32 * ni + 16 * sub + 4 * (i16 & 3)) * 2;
                                const s16x4 v0 = __builtin_amdgcn_ds_read_tr16_b64_v4i16((LAS s16x4*)va), v1 = __builtin_amdgcn_ds_read_tr16_b64_v4i16((LAS s16x4*)(va + 4 * RS));
                                const bf16x8 bf = __builtin_shufflevector(v0, v1, 0, 1, 2, 3, 4, 5, 6, 7);
                                acc[q] = __builtin_amdgcn_mfma_f32_32x32x16_bf16(af, bf, acc[q], 0, 0, 0); } }
                        bf16* u = US + ((size_t)bh * 128 + ci) * 16384;
#pragma unroll
                        for (int q = 0; q < 2; ++q) { const int dv = 32 * (2 * (wave & 1) + q) + r31;
#pragma unroll
                            for (int rq = 0; rq < 4; ++rq) { u32x2 w; w.x = cvt_pk_bf16(acc[q][4 * rq], acc[q][4 * rq + 1]); w.y = cvt_pk_bf16(acc[q][4 * rq + 2], acc[q][4 * rq + 3]);
                                *(u32x2*)(u + dv * 128 + 32 * mi + 8 * rq + 4 * hh) = w; } }
                    }
                    LDS_SYNC();
                }
            }
            {
                pg8::Gemm g{(const bf16*)(ws + WS_KV6), (const bf16*)(ws + WS_W1T) + (size_t)l * 2 * 256 * 2048, 8192, 256, 2048, (size_t)256 * 2048, 1024, nullptr, 0};
                pg8::StaticOrder S; S.init(8192, 256, G, bid, (const int*)(ws + WS_CTL + CW_PE32));
                EpiCmpHid E{(bf16*)(ws + WS_HID), (const float*)(ws + WS_B1) + l * 256};
                pg8::gemm_phase<EpiCmpHid, pg8::StaticOrder>(lds, g, S, E, wave_s);
            }
        }
        SEAM(pb + 1, 2);

        if (EN(3) && IN(pb + 2)) { PHASE_IDS();
            {
                unsigned* US32 = (unsigned*)(ws + WS_US); const float* DEC = (const float*)(ws + WS_DEC);
                for (int e2 = bid * NTHR + tid; e2 < 16 * 8192; e2 += G * NTHR) {
                    const int bh = e2 >> 13, dv2 = e2 & 8191, d = (2 * dv2) & 127;
                    float s0 = 0.f, s1 = 0.f;
#pragma unroll 1
                    for (int c0 = 0; c0 < 128; c0 += 16) {
                        unsigned u[16]; f32x2 dec[16];
#pragma unroll
                        for (int i = 0; i < 16; ++i) { u[i] = US32[((size_t)bh * 128 + c0 + i) * 8192 + dv2]; dec[i] = *(const f32x2*)(DEC + ((size_t)bh * 128 + c0 + i) * 128 + d); }
#pragma unroll
                        for (int i = 0; i < 16; ++i) { US32[((size_t)bh * 128 + c0 + i) * 8192 + dv2] = cvt_pk_bf16(s0, s1); s0 = dec[i][0] * s0 + bflo(u[i]); s1 = dec[i][1] * s1 + bfhi(u[i]); }
                    }
                }
            }
            {
                const bf16* HID = (const bf16*)(ws + WS_HID); bf16* KCb = (bf16*)(ws + WS_KC);
                for (int row = gwave; row < 8192; row += nwaves) { const int kind = row >> 12;
                    const float* W2 = ap->in[6] + ((size_t)l * 2 + kind) * 128 * 64;
                    const unsigned hv = ((const unsigned*)(HID + (size_t)row * 128))[lane];
                    float o = 0.f;
#pragma unroll 8
                    for (int j = 0; j < 64; ++j) { const unsigned hj = (unsigned)__builtin_amdgcn_readlane((int)hv, j); o += bflo(hj) * W2[(2 * j) * 64 + lane] + bfhi(hj) * W2[(2 * j + 1) * 64 + lane]; }
                    KCb[(size_t)row * 64 + lane] = f2bf(o); }
            }
        }
        SEAM(pb + 2, 3);

        if (EN(4) && IN(pb + 3)) {
          if (EN(16)) { PHASE_IDS();
            {
                constexpr int RS = 272;
                LAS float* bsf = (LAS float*)lds;
                LAS unsigned char* qh = lds + 32768;
                LAS unsigned char* q1 = qh + 64 * RS;
                LAS unsigned char* k0 = q1 + 32 * RS;
                LAS unsigned char* k1 = k0 + 32 * RS;
                LAS unsigned char* vt = k1 + 64 * RS;
                LAS float* ssq = (LAS float*)(vt + 64 * RS);
                LAS float* nwl = ssq + 256;
                LAS float* lbl = nwl + 512;
                bf16* QHG = (bf16*)(ws + WS_QHG); const bf16* HI = (const bf16*)(ws + WS_HI); const bf16* HG = (const bf16*)(ws + WS_HG); const float* HF = (const float*)(ws + WS_HF);
                const bf16* US = (const bf16*)(ws + WS_US);
                const float* NW = ap->in[3] + l * 512;
                const int d = tid & 127, tp = tid >> 7;
                const int d0 = 4 * (tid & 31), tg = tid >> 5;
                f32x4 z4[4]; u32x2 qp[4];
                auto ld_zq = [&](int it) { const int h = it & 3, ci = (it >> 2) & 127, b = it >> 9; const size_t tok0 = (size_t)b * SEQ + ci * 64;
#pragma unroll
                    for (int i = 0; i < 4; ++i) { const size_t go = (tok0 + tg + 16 * i) * 512 + h * 128 + d0; z4[i] = *(const f32x4*)(HF + go); qp[i] = *(const u32x2*)(QHG + go); } };
                ld_zq(bid);
                nwl[tid] = NW[tid]; lbl[tid] = LBS[l * 512 + tid];
                __syncthreads();
                int item = bid;
                do {
                    const int h = item & 3, ci = (item >> 2) & 127, b = item >> 9, bh = b * 4 + h;
                    const size_t tok0 = (size_t)b * SEQ + ci * 64;
                    const f32x4 lb4 = *(const LAS f32x4*)(lbl + h * 128 + d0);
                    f32x4 kk[4];
                    {
#pragma unroll
                        for (int i = 0; i < 4; ++i) { const int t = tg + 16 * i; f32x4 lg;
#pragma unroll
                            for (int c = 0; c < 4; ++c) { kk[i][c] = (1.f - lb4[c]) * __builtin_amdgcn_rcpf(1.f + __expf(z4[i][c])); lg[c] = __logf(1.f - kk[i][c]); }
                            *(LAS f32x4*)(bsf + t * 128 + d0) = lg; } }
                    { const int t = tid >> 3, c8 = tid & 7;
                        const u32x4* src = (const u32x4*)(HI + (tok0 + t) * 512 + h * 128) + c8 * 2;
                        const u32x4 a0 = src[0], a1 = src[1]; *(LAS u32x4*)(vt + t * RS + c8 * 32) = a0; *(LAS u32x4*)(vt + t * RS + c8 * 32 + 16) = a1; }
                    bf16x8 sf[8];
                    { const bf16* Sg = US + ((size_t)bh * 128 + ci) * 16384 + (size_t)(32 * (wave & 3) + (lane & 31)) * 128 + 8 * (lane >> 5);
#pragma unroll
                        for (int st = 0; st < 8; ++st) sf[st] = *(const bf16x8*)(Sg + 16 * st); }
                    LDS_SYNC();
                    { float run = 0.f;
#pragma unroll
                        for (int i = 0; i < 16; ++i) { run += bsf[(16 * tp + i) * 128 + d]; bsf[(16 * tp + i) * 128 + d] = run; } }
                    LDS_SYNC();
                    float off = 0.f;
                    for (int p = 0; p < tp; ++p) off += bsf[(16 * p + 15) * 128 + d];
                    LDS_SYNC();
#pragma unroll
                    for (int i = 0; i < 16; ++i) bsf[(16 * tp + i) * 128 + d] += off;
                    LDS_SYNC();
                    { const f32x4 b31 = *(const LAS f32x4*)(bsf + 31 * 128 + d0);
#pragma unroll
                        for (int i = 0; i < 4; ++i) { const int t = tg + 16 * i; const f32x4 bt = *(const LAS f32x4*)(bsf + t * 128 + d0);
                            const float q0 = bflo(qp[i].x), q1v = bfhi(qp[i].x), q2 = bflo(qp[i].y), q3 = bfhi(qp[i].y);
                            u32x2 w;
                            w.x = cvt_pk_bf16(q0 * __expf(bt[0]), q1v * __expf(bt[1])); w.y = cvt_pk_bf16(q2 * __expf(bt[2]), q3 * __expf(bt[3]));
                            *(LAS u32x2*)(qh + t * RS + d0 * 2) = w;
                            w.x = cvt_pk_bf16(kk[i][0] * __expf(fminf(b31[0] - bt[0], 80.f)), kk[i][1] * __expf(fminf(b31[1] - bt[1], 80.f)));
                            w.y = cvt_pk_bf16(kk[i][2] * __expf(fminf(b31[2] - bt[2], 80.f)), kk[i][3] * __expf(fminf(b31[3] - bt[3], 80.f)));
                            *(LAS u32x2*)(k1 + t * RS + d0 * 2) = w;
                            if (i < 2) {
                                w.x = cvt_pk_bf16(kk[i][0] * __expf(fminf(-bt[0], 80.f)), kk[i][1] * __expf(fminf(-bt[1], 80.f)));
                                w.y = cvt_pk_bf16(kk[i][2] * __expf(fminf(-bt[2], 80.f)), kk[i][3] * __expf(fminf(-bt[3], 80.f)));
                                *(LAS u32x2*)(k0 + t * RS + d0 * 2) = w;
                            } else {
                                w.x = cvt_pk_bf16(q0 * __expf(bt[0] - b31[0]), q1v * __expf(bt[1] - b31[1])); w.y = cvt_pk_bf16(q2 * __expf(bt[2] - b31[2]), q3 * __expf(bt[3] - b31[3]));
                                *(LAS u32x2*)(q1 + (t - 32) * RS + d0 * 2) = w; } } }
                    LDS_SYNC();
                    {
                        const int ni = wave & 3, mi = wave >> 2, r31 = lane & 31, hh = lane >> 5, i16 = lane & 15, sub = (lane >> 4) & 1;
                        f32x16 acc;
#pragma unroll
                        for (int r = 0; r < 16; ++r) acc[r] = 0.f;
#pragma unroll
                        for (int st = 0; st < 8; ++st) { const bf16x8 bq = *(const LAS bf16x8*)(qh + (32 * mi + r31) * RS + (16 * st + 8 * hh) * 2);
                            acc = __builtin_amdgcn_mfma_f32_32x32x16_bf16(sf[st], bq, acc, 0, 0, 0); }
#pragma unroll
                        for (int jb = 0; jb < 2; ++jb) { if (jb > mi) continue;
                            f32x16 x;
#pragma unroll
                            for (int r = 0; r < 16; ++r) x[r] = 0.f;
                            const LAS unsigned char* kb = (mi == 0) ? k0 : (k1 + 32 * jb * RS);
                            const LAS unsigned char* qb = (mi == 0) ? qh : q1;
#pragma unroll
                            for (int st = 0; st < 8; ++st) { const bf16x8 ka = *(const LAS bf16x8*)(kb + r31 * RS + (16 * st + 8 * hh) * 2), qq = *(const LAS bf16x8*)(qb + r31 * RS + (16 * st + 8 * hh) * 2);
                                x = __builtin_amdgcn_mfma_f32_32x32x16_bf16(ka, qq, x, 0, 0, 0); }
                            if (jb == mi) {
#pragma unroll
                                for (int r = 0; r < 16; ++r) { const int key = (r & 3) + 8 * (r >> 2) + 4 * hh; if (key > r31) x[r] = 0.f; } }
#pragma unroll
                            for (int s2 = 0; s2 < 2; ++s2) { u32x4 w; w.x = cvt_pk_bf16(x[8 * s2], x[8 * s2 + 1]); w.y = cvt_pk_bf16(x[8 * s2 + 2], x[8 * s2 + 3]); w.z = cvt_pk_bf16(x[8 * s2 + 4], x[8 * s2 + 5]); w.w = cvt_pk_bf16(x[8 * s2 + 6], x[8 * s2 + 7]);
                                const bf16x8 xb = __builtin_bit_cast(bf16x8, w);
                                const LAS unsigned char* va = vt + (32 * jb + 16 * s2 + 4 * hh + (i16 >> 2)) * RS + (32 * ni + 16 * sub + 4 * (i16 & 3)) * 2;
                                const s16x4 v0 = __builtin_amdgcn_ds_read_tr16_b64_v4i16((LAS s16x4*)va), v1 = __builtin_amdgcn_ds_read_tr16_b64_v4i16((LAS s16x4*)(va + 8 * RS));
                                const bf16x8 vf = __builtin_shufflevector(v0, v1, 0, 1, 2, 3, 4, 5, 6, 7);
                                acc = __builtin_amdgcn_mfma_f32_32x32x16_bf16(vf, xb, acc, 0, 0, 0); } }
                        u32x2 gq4[4];
                        { const size_t gg = (tok0 + 32 * mi + r31) * 512 + h * 128 + 32 * ni + 4 * hh;
#pragma unroll
                          for (int rq = 0; rq < 4; ++rq) gq4[rq] = *(const u32x2*)(HG + gg + 8 * rq); }
                        ld_zq(min(item + G, NB * 128 * 4 - 1));
                        float ss = 0.f;
#pragma unroll
                        for (int r = 0; r < 16; ++r) ss += acc[r] * acc[r];
                        ss += __shfl_xor(ss, 32);
                        if (hh == 0) ssq[ni * 64 + 32 * mi + r31] = ss;
                        LDS_SYNC();
                        const int tl = 32 * mi + r31;
                        const float tot = ssq[tl] + ssq[64 + tl] + ssq[128 + tl] + ssq[192 + tl];
                        const float rn = rsqrtf(tot * (1.f / 128.f) + 1e-6f);
                        const size_t go = (tok0 + tl) * 512 + h * 128 + 32 * ni + 4 * hh;
#pragma unroll
                        for (int rq = 0; rq < 4; ++rq) { const u32x2 gq = gq4[rq]; const f32x4 nw = *(const LAS f32x4*)(nwl + h * 128 + 32 * ni + 4 * hh + 8 * rq);
                            u32x2 w; w.x = cvt_pk_bf16(acc[4 * rq] * rn * nw[0] * siluf_(bflo(gq.x)), acc[4 * rq + 1] * rn * nw[1] * siluf_(bfhi(gq.x)));
                            w.y = cvt_pk_bf16(acc[4 * rq + 2] * rn * nw[2] * siluf_(bflo(gq.y)), acc[4 * rq + 3] * rn * nw[3] * siluf_(bfhi(gq.y)));
                            *(u32x2*)(QHG + go + 8 * rq) = w; }
                    }
                    LDS_SYNC();
                    item += G;
                } while (item < NB * 128 * 4);
            }
          }
          PMARK(15);
          if (EN(17)) { PHASE_IDS();
            {
                constexpr int KST = 144, TB = 9216;
                constexpr float LOG2E = 1.4426950408889634f;
                LAS unsigned char* kvb = lds;
                LAS float* lut = (LAS float*)(lds + 4 * TB);
                LAS float* impW = (LAS float*)(lds + 4 * TB + 32768 + wave * 8192);
                LAS float* ocl = impW + lane;
                LAS unsigned* selm = (LAS unsigned*)(lds + 4 * TB + 32768 + 65536);
                const bf16* NQ = (const bf16*)(ws + WS_NQ); const bf16* KVT = (const bf16*)(ws + WS_KV6); const bf16* KCb = (const bf16*)(ws + WS_KC);
                const float* NG = (const float*)(ws + WS_NG); const float* RB = ap->in[7];
                bf16* OB = (bf16*)(ws + WS_NQ);
                const int col = lane & 15, q4 = lane >> 4, head = col & 3, ti = col >> 2;
                const float NINF = -__builtin_inff();
                const bool lut_once = (G & 7) == 0;
                LAS float* gld = (LAS float*)(lds + 4 * TB + 32768 + 65536 + 1024) + wave * 96;
                if (lut_once) { const int g = bid & 1; __syncthreads();
                    for (int d = tid; d < 2048; d += NTHR) { const int bk = rel_bucket(d); *(LAS f32x4*)(lut + d * 4) = *(const f32x4*)(RB + bk * 8 + g * 4) * LOG2E; } }
                for (int pq = bid; pq < 512; pq += G)
#pragma unroll 1
                for (int odd = 0; odd < 2; ++odd) {
                    const int bg = pq & 7, xx = pq >> 3, tile = odd ? 127 - xx : xx, b = bg >> 1, g = bg & 1, t0 = tile * 64, cur = tile;
                    const size_t tokw = (size_t)b * SEQ + t0 + 8 * wave;
                    int tq[2]; bf16x8 qf[2][2];
                    auto gatev = [&](int gq, int br) -> float { return gld[(gq * 3 + br) * 16 + col]; };
                    float gl[6];
#pragma unroll
                    for (int gq = 0; gq < 2; ++gq)
#pragma unroll
                        for (int br = 0; br < 3; ++br) gl[gq * 3 + br] = NG[(tokw + 4 * gq + ti) * 32 + (g * 4 + head) * 3 + br];
#pragma unroll
                    for (int gq = 0; gq < 2; ++gq) { tq[gq] = t0 + 8 * wave + 4 * gq + ti; const size_t tok = tokw + 4 * gq + ti;
#pragma unroll
                        for (int s = 0; s < 2; ++s) qf[gq][s] = *(const bf16x8*)(NQ + tok * 512 + (g * 4 + head) * 64 + 32 * s + 8 * q4);
                    }
                    const float bfar = RB[31 * 8 + g * 4 + head] * LOG2E;
                    __syncthreads();
                    if (!lut_once) for (int d = tid; d < 2048; d += NTHR) { const int bk = rel_bucket(d); *(LAS f32x4*)(lut + d * 4) = *(const f32x4*)(RB + bk * 8 + g * 4) * LOG2E; }
                    for (int i = lane; i < 8 * 128; i += 64) impW[i] = 0.f;
                    f32x4 O[2][4], Ls[2];
                    float m[2], l[2], m1[2] = {0.f, 0.f}, linv[2] = {0.f, 0.f}, carry[2] = {0.f, 0.f};
                    const bf16x8 ones8 = {0x3F80, 0x3F80, 0x3F80, 0x3F80, 0x3F80, 0x3F80, 0x3F80, 0x3F80};
                    auto soft = [&](const int mode, const int gq, f32x4 (&st)[4], bf16x8 (&pb)[2], const int pos0, const bool far, const bool full, const float cbias, const bool colsel, const int sblk0) {
                        float tmax = NINF;
                        if (far) {
#pragma unroll
                            for (int kt = 0; kt < 4; ++kt)
#pragma unroll
                                for (int r = 0; r < 4; ++r) tmax = fmaxf(tmax, st[kt][r]);
                            tmax += cbias;
                        } else if (mode >= 2) {
                            const int dbase = tq[gq] - (pos0 + 4 * q4);
                            const LAS float* lb = lut + (dbase - 51) * 4 + head;
                            const float cadd = (mode == 2 && !colsel) ? NINF : 0.f;
                            float bv[4][4];
#pragma unroll
                            for (int kt = 0; kt < 4; ++kt)
#pragma unroll
                                for (int r = 0; r < 4; ++r) bv[kt][r] = lb[(51 - 16 * kt - r) * 4];
                            asm volatile("" : "+v"(bv[0][0]), "+v"(bv[0][1]), "+v"(bv[0][2]), "+v"(bv[0][3]), "+v"(bv[1][0]), "+v"(bv[1][1]), "+v"(bv[1][2]), "+v"(bv[1][3]));
                            asm volatile("" : "+v"(bv[2][0]), "+v"(bv[2][1]), "+v"(bv[2][2]), "+v"(bv[2][3]), "+v"(bv[3][0]), "+v"(bv[3][1]), "+v"(bv[3][2]), "+v"(bv[3][3]));
#pragma unroll
                            for (int kt = 0; kt < 4; ++kt)
#pragma unroll
                                for (int r = 0; r < 4; ++r) { float sv = st[kt][r] + bv[kt][r];
                                    if (mode == 2) sv += cadd;
                                    if (!full) { const int dist = dbase - (16 * kt + r); const bool valid = (mode == 3) ? ((unsigned)dist < 512u) : (dist >= 0); sv = valid ? sv : NINF; }
                                    st[kt][r] = sv; tmax = fmaxf(tmax, sv); }
                        } else {
                            const int dbase = tq[gq] - 16 * (pos0 + 4 * q4) - 31;
                            float bv[4][4];
#pragma unroll
                            for (int kt = 0; kt < 4; ++kt)
#pragma unroll
                                for (int r = 0; r < 4; ++r) { const int dist = dbase - 16 * (16 * kt + r); const unsigned di = (unsigned)dist < 2047u ? (unsigned)dist : 2047u; bv[kt][r] = lut[di * 4 + head]; }
#pragma unroll
                            for (int kt = 0; kt < 4; ++kt)
#pragma unroll
                                for (int r = 0; r < 4; ++r) { float sv = st[kt][r] + bv[kt][r];
                                    if (!full) { const int dist = dbase - 16 * (16 * kt + r); sv = (dist >= 0) ? sv : NINF; }
                                    st[kt][r] = sv; tmax = fmaxf(tmax, sv); }
                        }
                        float muse;
                        if (mode == 1) muse = m1[gq];
                        else {
                            tmax = max_x16(tmax); tmax = max_x32(tmax);
                            const float mnew = fmaxf(m[gq], tmax);
                            if (__any(mnew != m[gq])) {
                                const float mu = (mnew == NINF) ? 0.f : mnew;
                                const float alpha = __builtin_amdgcn_exp2f(m[gq] - mu);
                                m[gq] = mnew; l[gq] *= alpha;
                                if (mode >= 2) { Ls[gq] = Ls[gq] * alpha;
#pragma unroll
                                    for (int mt = 0; mt < 4; ++mt) O[gq][mt] = O[gq][mt] * alpha; }
                            }
                            muse = (m[gq] == NINF) ? 0.f : m[gq];
                        }
                        const float esub = far ? muse - cbias : muse;
                        float ls = 0.f;
#pragma unroll
                        for (int kt = 0; kt < 4; ++kt)
#pragma unroll
                            for (int r = 0; r < 4; ++r) { float p = __builtin_amdgcn_exp2f(st[kt][r] - esub); if (mode == 1) p *= linv[gq]; st[kt][r] = p; if (mode <= 1) ls += p; }
#if NSA_DUP_B
                        if (mode == 2) { float acc2 = 0.f;
#pragma unroll
                            for (int kt = 0; kt < 4; ++kt)
#pragma unroll
                                for (int r = 0; r < 4; ++r) { float x = st[kt][r]; asm volatile("" : "+v"(x)); const float p2 = __builtin_amdgcn_exp2f(x * 0.5f - esub); acc2 = fmaxf(acc2, p2 + x); }
                            asm volatile("" :: "v"(acc2)); }
#endif
                        if (mode <= 1) l[gq] += ls;
                        if (mode == 1) {
                            float a[4], h3[4];
#pragma unroll
                            for (int kt = 0; kt < 4; ++kt) { a[kt] = st[kt][0] + st[kt][1] + st[kt][2] + 0.5f * st[kt][3]; h3[kt] = 0.5f * st[kt][3];
                                a[kt] += dpp_x1(a[kt]); a[kt] += dpp_x2(a[kt]); h3[kt] += dpp_x1(h3[kt]); h3[kt] += dpp_x2(h3[kt]); }
#pragma unroll
                            for (int kt = 0; kt < 4; ++kt) { const float give = (q4 == 3) ? (kt > 0 ? h3[kt - 1] : carry[gq]) : h3[kt];
                                const float prev = __shfl(give, (lane - 16) & 63);
                                if (head == 0) impW[(4 * gq + ti) * 128 + sblk0 + 4 * kt + q4] = a[kt] + prev; }
                            carry[gq] = h3[3];
                        }
                        if (mode != 0) {
#pragma unroll
                            for (int s = 0; s < 2; ++s) { u32x4 w; w.x = cvt_pk_bf16(st[2 * s][0], st[2 * s][1]); w.y = cvt_pk_bf16(st[2 * s][2], st[2 * s][3]);
                                w.z = cvt_pk_bf16(st[2 * s + 1][0], st[2 * s + 1][1]); w.w = cvt_pk_bf16(st[2 * s + 1][2], st[2 * s + 1][3]); pb[s] = __builtin_bit_cast(bf16x8, w); } }
                    };
                    auto tile2 = [&](const int mode, const LAS unsigned char* kbuf, const LAS unsigned char* vbuf, const int pos0, const bool far, const bool full, const bool a0, const bool a1,
                                     const float cb0, const float cb1, const bool cs0, const bool cs1, const int sblk0) {
                        f32x4 st0[4], st1[4]; bf16x8 pb0[2], pb1[2];
#pragma unroll
                        for (int kt = 0; kt < 4; ++kt) {
                            const bf16x8 kf0 = *(const LAS bf16x8*)(kbuf + (16 * kt + col) * KST + 16 * q4), kf1 = *(const LAS bf16x8*)(kbuf + (16 * kt + col) * KST + 64 + 16 * q4);
                            if (a0) { st0[kt] = __builtin_amdgcn_mfma_f32_16x16x32_bf16(kf0, qf[0][0], (f32x4){0.f, 0.f, 0.f, 0.f}, 0, 0, 0); st0[kt] = __builtin_amdgcn_mfma_f32_16x16x32_bf16(kf1, qf[0][1], st0[kt], 0, 0, 0); }
                            if (a1) { st1[kt] = __builtin_amdgcn_mfma_f32_16x16x32_bf16(kf0, qf[1][0], (f32x4){0.f, 0.f, 0.f, 0.f}, 0, 0, 0); st1[kt] = __builtin_amdgcn_mfma_f32_16x16x32_bf16(kf1, qf[1][1], st1[kt], 0, 0, 0); } }
#if NSA_DUP_A
                        if (mode == 2) {
#pragma unroll
                            for (int kt = 0; kt < 4; ++kt) {
                                const bf16x8 kf0 = *(const LAS bf16x8*)(kbuf + (16 * kt + col) * KST + 16 * q4 + 32), kf1 = *(const LAS bf16x8*)(kbuf + (16 * kt + col) * KST + 64 + 16 * q4 - 32);
                                f32x4 d0 = __builtin_amdgcn_mfma_f32_16x16x32_bf16(kf0, qf[0][0], (f32x4){0.f, 0.f, 0.f, 0.f}, 0, 0, 0); d0 = __builtin_amdgcn_mfma_f32_16x16x32_bf16(kf1, qf[0][1], d0, 0, 0, 0);
                                f32x4 d1 = __builtin_amdgcn_mfma_f32_16x16x32_bf16(kf0, qf[1][0], (f32x4){0.f, 0.f, 0.f, 0.f}, 0, 0, 0); d1 = __builtin_amdgcn_mfma_f32_16x16x32_bf16(kf1, qf[1][1], d1, 0, 0, 0);
                                asm volatile("" :: "v"(d0), "v"(d1)); } }
#endif
                        if (a0) soft(mode, 0, st0, pb0, pos0, far, full, cb0, cs0, sblk0);
                        if (a1) soft(mode, 1, st1, pb1, pos0, far, full, cb1, cs1, sblk0);
                        if (mode == 0) return;
#pragma unroll
                        for (int mt = 0; mt < 4; ++mt)
#pragma unroll
                            for (int s = 0; s < 2; ++s) { const LAS unsigned char* a = vbuf + (32 * s + 4 * q4 + (col >> 2)) * KST + (16 * mt + 4 * (col & 3)) * 2;
                                const s16x4 lo = __builtin_amdgcn_ds_read_tr16_b64_v4i16((LAS s16x4*)a), hi = __builtin_amdgcn_ds_read_tr16_b64_v4i16((LAS s16x4*)(a + 16 * KST));
                                const bf16x8 vfs = __builtin_shufflevector(lo, hi, 0, 1, 2, 3, 4, 5, 6, 7);
                                if (a0) O[0][mt] = __builtin_amdgcn_mfma_f32_16x16x32_bf16(vfs, pb0[s], O[0][mt], 0, 0, 0);
                                if (a1) O[1][mt] = __builtin_amdgcn_mfma_f32_16x16x32_bf16(vfs, pb1[s], O[1][mt], 0, 0, 0); }
                        if (mode >= 2) {
#pragma unroll
                            for (int s = 0; s < 2; ++s) { if (a0) Ls[0] = __builtin_amdgcn_mfma_f32_16x16x32_bf16(ones8, pb0[s], Ls[0], 0, 0, 0); if (a1) Ls[1] = __builtin_amdgcn_mfma_f32_16x16x32_bf16(ones8, pb1[s], Ls[1], 0, 0, 0); } }
                    };
                    auto soft_far = [&](const int gq, f32x4 (&st)[4], bf16x8 (&pb)[2], const float mu_old) {
                        float tmax = fmaxf(fmaxf(fmaxf(st[0][0], st[0][1]), fmaxf(st[0][2], st[0][3])), fmaxf(fmaxf(st[1][0], st[1][1]), fmaxf(st[1][2], st[1][3])));
                        tmax = fmaxf(tmax, fmaxf(fmaxf(fmaxf(st[2][0], st[2][1]), fmaxf(st[2][2], st[2][3])), fmaxf(fmaxf(st[3][0], st[3][1]), fmaxf(st[3][2], st[3][3]))));
                        tmax = max_x16(tmax); tmax = max_x32(tmax);
                        if (__any(tmax > 8.f || (m[gq] == NINF && tmax != NINF))) {
                            const float mnew = fmaxf(m[gq], mu_old + tmax), mu = (mnew == NINF) ? 0.f : mnew, alpha = __builtin_amdgcn_exp2f(m[gq] - mu), delta = mu - mu_old;
                            m[gq] = mnew; Ls[gq] = Ls[gq] * alpha;
#pragma unroll
                            for (int mt = 0; mt < 4; ++mt) O[gq][mt] = O[gq][mt] * alpha;
#pragma unroll
                            for (int kt = 0; kt < 4; ++kt)
#pragma unroll
                                for (int r = 0; r < 4; ++r) st[kt][r] -= delta;
                        }
#pragma unroll
                        for (int kt = 0; kt < 4; ++kt)
#pragma unroll
                            for (int r = 0; r < 4; ++r) st[kt][r] = __builtin_amdgcn_exp2f(st[kt][r]);
#pragma unroll
                        for (int s = 0; s < 2; ++s) { u32x4 w; w.x = cvt_pk_bf16(st[2 * s][0], st[2 * s][1]); w.y = cvt_pk_bf16(st[2 * s][2], st[2 * s][3]);
                            w.z = cvt_pk_bf16(st[2 * s + 1][0], st[2 * s + 1][1]); w.w = cvt_pk_bf16(st[2 * s + 1][2], st[2 * s + 1][3]); pb[s] = __builtin_bit_cast(bf16x8, w); }
                    };
                    auto tile_far2 = [&](const LAS unsigned char* kbuf, const LAS unsigned char* vbuf, const float cb0, const float cb1) {
                        f32x4 st0[4], st1[4]; bf16x8 pb0[2], pb1[2];
                        const float mu0 = (m[0] == NINF) ? 0.f : m[0], mu1 = (m[1] == NINF) ? 0.f : m[1];
                        const float c0 = cb0 - mu0, c1 = cb1 - mu1;
                        const f32x4 ci0 = {c0, c0, c0, c0}, ci1 = {c1, c1, c1, c1};
#pragma unroll
                        for (int kt = 0; kt < 4; ++kt) { const bf16x8 kf0 = *(const LAS bf16x8*)(kbuf + (16 * kt + col) * KST + 16 * q4), kf1 = *(const LAS bf16x8*)(kbuf + (16 * kt + col) * KST + 64 + 16 * q4);
                            st0[kt] = __builtin_amdgcn_mfma_f32_16x16x32_bf16(kf0, qf[0][0], ci0, 0, 0, 0); st0[kt] = __builtin_amdgcn_mfma_f32_16x16x32_bf16(kf1, qf[0][1], st0[kt], 0, 0, 0);
                            st1[kt] = __builtin_amdgcn_mfma_f32_16x16x32_bf16(kf0, qf[1][0], ci1, 0, 0, 0); st1[kt] = __builtin_amdgcn_mfma_f32_16x16x32_bf16(kf1, qf[1][1], st1[kt], 0, 0, 0); }
                        soft_far(0, st0, pb0, mu0);
                        soft_far(1, st1, pb1, mu1);
#pragma unroll
                        for (int mt = 0; mt < 4; ++mt)
#pragma unroll
                            for (int s = 0; s < 2; ++s) { const LAS unsigned char* a = vbuf + (32 * s + 4 * q4 + (col >> 2)) * KST + (16 * mt + 4 * (col & 3)) * 2;
                                const s16x4 lo = __builtin_amdgcn_ds_read_tr16_b64_v4i16((LAS s16x4*)a), hi = __builtin_amdgcn_ds_read_tr16_b64_v4i16((LAS s16x4*)(a + 16 * KST));
                                const bf16x8 vfs = __builtin_shufflevector(lo, hi, 0, 1, 2, 3, 4, 5, 6, 7);
                                O[0][mt] = __builtin_amdgcn_mfma_f32_16x16x32_bf16(vfs, pb0[s], O[0][mt], 0, 0, 0);
                                O[1][mt] = __builtin_amdgcn_mfma_f32_16x16x32_bf16(vfs, pb1[s], O[1][mt], 0, 0, 0); }
#pragma unroll
                        for (int s = 0; s < 2; ++s) { Ls[0] = __builtin_amdgcn_mfma_f32_16x16x32_bf16(ones8, pb0[s], Ls[0], 0, 0, 0); Ls[1] = __builtin_amdgcn_mfma_f32_16x16x32_bf16(ones8, pb1[s], Ls[1], 0, 0, 0); }
                    };
                    auto tile_far1 = [&](auto gqc, const LAS unsigned char* kbuf, const LAS unsigned char* vbuf, const float cbx) {
                        constexpr int gq = decltype(gqc)::value;
                        f32x4 st[4]; bf16x8 pb[2];
                        const float mu = (m[gq] == NINF) ? 0.f : m[gq], c = cbx - mu;
                        const f32x4 ci = {c, c, c, c};
#pragma unroll
                        for (int kt = 0; kt < 4; ++kt) { const bf16x8 kf0 = *(const LAS bf16x8*)(kbuf + (16 * kt + col) * KST + 16 * q4), kf1 = *(const LAS bf16x8*)(kbuf + (16 * kt + col) * KST + 64 + 16 * q4);
                            st[kt] = __builtin_amdgcn_mfma_f32_16x16x32_bf16(kf0, qf[gq][0], ci, 0, 0, 0); st[kt] = __builtin_amdgcn_mfma_f32_16x16x32_bf16(kf1, qf[gq][1], st[kt], 0, 0, 0); }
                        soft_far(gq, st, pb, mu);
#pragma unroll
                        for (int mt = 0; mt < 4; ++mt)
#pragma unroll
                            for (int s = 0; s < 2; ++s) { const LAS unsigned char* a = vbuf + (32 * s + 4 * q4 + (col >> 2)) * KST + (16 * mt + 4 * (col & 3)) * 2;
                                const s16x4 lo = __builtin_amdgcn_ds_read_tr16_b64_v4i16((LAS s16x4*)a), hi = __builtin_amdgcn_ds_read_tr16_b64_v4i16((LAS s16x4*)(a + 16 * KST));
                                const bf16x8 vfs = __builtin_shufflevector(lo, hi, 0, 1, 2, 3, 4, 5, 6, 7);
                                O[gq][mt] = __builtin_amdgcn_mfma_f32_16x16x32_bf16(vfs, pb[s], O[gq][mt], 0, 0, 0); }
#pragma unroll
                        for (int s = 0; s < 2; ++s) Ls[gq] = __builtin_amdgcn_mfma_f32_16x16x32_bf16(ones8, pb[s], Ls[gq], 0, 0, 0);
                    };
                    auto ld_tile = [&](const bf16* src) -> u32x4 { return *(const u32x4*)(src + tid * 8); };
                    auto st_tile = [&](LAS unsigned char* buf, const u32x4 v) { *(LAS u32x4*)(buf + (tid >> 3) * KST + (tid & 7) * 16) = v; };
                    auto zeroO = [&]() {
#pragma unroll
                        for (int gq = 0; gq < 2; ++gq) { m[gq] = NINF; l[gq] = 0.f; Ls[gq] = (f32x4){0.f, 0.f, 0.f, 0.f};
#pragma unroll
                            for (int mt = 0; mt < 4; ++mt) O[gq][mt] = (f32x4){0.f, 0.f, 0.f, 0.f}; } };
                    const int ntc = (4 * tile + 3 + 63) >> 6;
                    const bf16* kcb = KCb + (size_t)bg * 512 * 64; const bf16* vcb = KCb + (size_t)(8 + bg) * 512 * 64;
                    {
                        zeroO();
                        u32x4 rk = ld_tile(kcb);
                        st_tile(kvb, rk); if (ntc > 1) rk = ld_tile(kcb + 4096);
                        __syncthreads();
#pragma unroll 1
                        for (int i = 0; i < ntc; ++i) { LAS unsigned char* cb = kvb + (i & 1) * 2 * TB;
                            if (i + 1 < ntc) st_tile(kvb + ((i + 1) & 1) * 2 * TB, rk);
                            if (i + 2 < ntc) rk = ld_tile(kcb + (size_t)(i + 2) * 4096);
                            const bool far = (t0 - (16 * (64 * i + 63) + 31)) >= 1513;
                            tile2(0, cb, cb + TB, 64 * i, far, (16 * (64 * i + 63) + 31) <= t0, true, true, bfar, bfar, true, true, 0);
                            __syncthreads(); }
                    }
#pragma unroll
                    for (int gq = 0; gq < 2; ++gq) { float lt = sum_x32(sum_x16(l[gq])); linv[gq] = 1.f / fmaxf(lt, 1e-30f); m1[gq] = (m[gq] == NINF) ? 0.f : m[gq]; }
                    if (q4 == 0) {
#pragma unroll
                        for (int k6 = 0; k6 < 6; ++k6) gld[k6 * 16 + col] = sigmoidf_(gl[k6]); }
                    {
                        zeroO();
                        u32x4 rk = ld_tile(kcb), rv = ld_tile(vcb);
                        st_tile(kvb, rk); st_tile(kvb + TB, rv); if (ntc > 1) { rk = ld_tile(kcb + 4096); rv = ld_tile(vcb + 4096); }
                        __syncthreads();
#pragma unroll 1
                        for (int i = 0; i < ntc; ++i) { LAS unsigned char* cb = kvb + (i & 1) * 2 * TB;
                            if (i + 1 < ntc) { LAS unsigned char* nb = kvb + ((i + 1) & 1) * 2 * TB; st_tile(nb, rk); st_tile(nb + TB, rv); }
                            if (i + 2 < ntc) { rk = ld_tile(kcb + (size_t)(i + 2) * 4096); rv = ld_tile(vcb + (size_t)(i + 2) * 4096); }
                            const bool far = (t0 - (16 * (64 * i + 63) + 31)) >= 1513;
                            tile2(1, cb, cb + TB, 64 * i, far, (16 * (64 * i + 63) + 31) <= t0, true, true, bfar, bfar, true, true, 16 * i);
                            __syncthreads(); }
                    }
                    WAVE_SYNC();
                    {
                        const int tt = lane >> 3, sub = lane & 7;
                        unsigned key[16];
                        const LAS f32x4* ip = (const LAS f32x4*)(impW + tt * 128 + sub * 16);
#pragma unroll
                        for (int q = 0; q < 4; ++q) { const f32x4 v = ip[q];
#pragma unroll
                            for (int e2 = 0; e2 < 4; ++e2) { const int i = 4 * q + e2, s = sub * 16 + i;
                                const bool forced = (s == 0) || (s == cur) || (s == cur - 1);
                                const unsigned k = forced ? 0x7FFFFF80u : ((__float_as_uint(v[e2]) & 0xFFFFFF80u) + 128u);
                                key[i] = (s <= cur) ? (k | (unsigned)(127 - s)) : 0u; } }
                        unsigned w0 = 0u, w1 = 0u, w2 = 0u, w3 = 0u;
#pragma unroll 1
                        for (int k = 0; k < 16; ++k) {
                            unsigned best = key[0];
#pragma unroll
                            for (int i = 1; i < 16; ++i) best = best > key[i] ? best : key[i];
                            { const unsigned o1 = (unsigned)__builtin_amdgcn_mov_dpp((int)best, 0xB1, 0xF, 0xF, true); best = best > o1 ? best : o1;
                              const unsigned o2 = (unsigned)__builtin_amdgcn_mov_dpp((int)best, 0x4E, 0xF, 0xF, true); best = best > o2 ? best : o2;
                              const unsigned o3 = (unsigned)__builtin_amdgcn_mov_dpp((int)best, 0x141, 0xF, 0xF, true); best = best > o3 ? best : o3; }
#pragma unroll
                            for (int i = 0; i < 16; ++i) key[i] = (key[i] == best) ? 0u : key[i];
                            if (best != 0u) { const int idx = 127 - (int)(best & 127u); const unsigned bit = 1u << (idx & 31); const int wd = idx >> 5;
                                w0 |= wd == 0 ? bit : 0u; w1 |= wd == 1 ? bit : 0u; w2 |= wd == 2 ? bit : 0u; w3 |= wd == 3 ? bit : 0u; }
                        }
                        if (sub == 0) { LAS unsigned* sp = selm + (8 * wave + tt) * 4; sp[0] = w0; sp[1] = w1; sp[2] = w2; sp[3] = w3; }
                    }
                    WAVE_SYNC();
#pragma unroll
                    for (int gq = 0; gq < 2; ++gq) { const float g0 = gatev(gq, 0);
#pragma unroll
                        for (int mt = 0; mt < 4; ++mt)
#pragma unroll
                            for (int r = 0; r < 4; ++r) ocl[((gq * 4 + mt) * 4 + r) * 64] = O[gq][mt][r] * g0; }
                    __syncthreads();
                    unsigned long long Ulo, Uhi;
                    { unsigned u[4];
#pragma unroll
                      for (int k = 0; k < 4; ++k) { unsigned x = selm[lane * 4 + k];
#pragma unroll
                        for (int o = 1; o < 64; o <<= 1) x |= __shfl_xor(x, o);
                        u[k] = __builtin_amdgcn_readfirstlane(x); }
                      Ulo = ((unsigned long long)u[1] << 32) | u[0]; Uhi = ((unsigned long long)u[3] << 32) | u[2]; }
                    auto nextj = [&](int j) -> int {
                        if (j < 64) { const unsigned long long x = Ulo >> j; if (x) return j + __builtin_ctzll(x); j = 64; }
                        if (j < 128) { const unsigned long long x = Uhi >> (j - 64); if (x) return j + __builtin_ctzll(x); }
                        return 128; };
                    unsigned long long F0lo, F0hi, F1lo, F1hi;
                    {
                        const int dA = t0 + 8 * wave - (64 * lane + 63), dB = dA - 64 * 64;
                        const bool a0 = lane < cur && rel_bucket(min(dA, 2047)) == rel_bucket(min(dA + 66, 2047)), a1 = lane < cur && rel_bucket(min(dA + 4, 2047)) == rel_bucket(min(dA + 70, 2047));
                        const bool b0 = 64 + lane < cur && rel_bucket(min(dB, 2047)) == rel_bucket(min(dB + 66, 2047)), b1 = 64 + lane < cur && rel_bucket(min(dB + 4, 2047)) == rel_bucket(min(dB + 70, 2047));
                        F0lo = __ballot(a0); F1lo = __ballot(a1); F0hi = __ballot(b0); F1hi = __ballot(b1);
                    }
                    {
                        const bf16* ksb = KVT + (size_t)(2 * 8 + bg) * SEQ * 64; const bf16* vsb = KVT + (size_t)(3 * 8 + bg) * SEQ * 64;
#pragma unroll 1
                        for (int rep = 0; rep < SELREP; ++rep) {
                        zeroO();
                        int j = nextj(0), jn = nextj(j + 1), it = 0;
                        u32x4 rk = ld_tile(ksb + (size_t)j * 4096), rv = ld_tile(vsb + (size_t)j * 4096);
                        st_tile(kvb, rk); st_tile(kvb + TB, rv);
                        if (jn <= cur) { rk = ld_tile(ksb + (size_t)jn * 4096); rv = ld_tile(vsb + (size_t)jn * 4096); }
                        __syncthreads();
#pragma unroll 1
                        while (j <= cur) { LAS unsigned char* cb = kvb + (it & 1) * 2 * TB;
                            const int jnn = jn <= cur ? nextj(jn + 1) : 128;
                            if (jn <= cur) { LAS unsigned char* nb = kvb + ((it + 1) & 1) * 2 * TB; st_tile(nb, rk); st_tile(nb + TB, rv); }
                            if (jnn <= cur) { rk = ld_tile(ksb + (size_t)jnn * 4096); rv = ld_tile(vsb + (size_t)jnn * 4096); }
                            const bool cs0 = (selm[(8 * wave + ti) * 4 + (j >> 5)] >> (j & 31)) & 1u, cs1 = (selm[(8 * wave + 4 + ti) * 4 + (j >> 5)] >> (j & 31)) & 1u;
                            const bool act0 = __ballot(cs0) != 0ull, act1 = __ballot(cs1) != 0ull;
                            const bool far = (t0 - (64 * j + 63)) >= 1513;
                            const bool full = j < cur;
                            const int dlo = t0 + 8 * wave - (64 * j + 63), dl0 = min(dlo, 2047), dl1 = min(dlo + 4, 2047);
                            const bool flat0 = ((j < 64 ? F0lo >> j : F0hi >> (j - 64)) & 1ull) != 0ull, flat1 = ((j < 64 ? F1lo >> j : F1hi >> (j - 64)) & 1ull) != 0ull;
                            const float cb0 = cs0 ? (flat0 ? lut[dl0 * 4 + head] : bfar) : NINF, cb1 = cs1 ? (flat1 ? lut[dl1 * 4 + head] : bfar) : NINF;
                            if (act0 && act1 && flat0 && flat1) tile_far2(cb, cb + TB, cb0, cb1);
                            else if (act0 && !act1 && flat0) tile_far1(IConst<0>{}, cb, cb + TB, cb0);
                            else if (act1 && !act0 && flat1) tile_far1(IConst<1>{}, cb, cb + TB, cb1);
                            else if (act0 && act1) tile2(2, cb, cb + TB, 64 * j, far, full, true, true, cb0, cb1, cs0, cs1, 0);
                            else if (act0) tile2(2, cb, cb + TB, 64 * j, far, full, true, false, cb0, cb1, cs0, cs1, 0);
                            else if (act1) tile2(2, cb, cb + TB, 64 * j, far, full, false, true, cb0, cb1, cs0, cs1, 0);
#if NSA_DUP_C
                            __syncthreads();
#endif
                            __syncthreads();
                            j = jn; jn = jnn; ++it;
                        }
                        }
#pragma unroll
                        for (int gq = 0; gq < 2; ++gq) { const float lt = Ls[gq][0]; const float sc = gatev(gq, 1) / fmaxf(lt, 1e-30f);
#pragma unroll
                            for (int mt = 0; mt < 4; ++mt)
#pragma unroll
                                for (int r = 0; r < 4; ++r) ocl[((gq * 4 + mt) * 4 + r) * 64] += O[gq][mt][r] * sc; }
                    }
                    {
                        const bf16* kwb = KVT + (size_t)(4 * 8 + bg) * SEQ * 64; const bf16* vwb = KVT + (size_t)(5 * 8 + bg) * SEQ * 64;
                        const int j0 = cur - 8 < 0 ? 0 : cur - 8, nw = cur - j0 + 1;
#pragma unroll 1
                        for (int wrep = 0; wrep < WINREP; ++wrep) {
                        zeroO();
                        u32x4 rk = ld_tile(kwb + (size_t)j0 * 4096), rv = ld_tile(vwb + (size_t)j0 * 4096);
                        st_tile(kvb, rk); st_tile(kvb + TB, rv);
                        if (nw > 1) { rk = ld_tile(kwb + (size_t)(j0 + 1) * 4096); rv = ld_tile(vwb + (size_t)(j0 + 1) * 4096); }
                        __syncthreads();
#pragma unroll 1
                        for (int i = 0; i < nw; ++i) { LAS unsigned char* cb = kvb + (i & 1) * 2 * TB;
                            if (i + 1 < nw) { LAS unsigned char* nb = kvb + ((i + 1) & 1) * 2 * TB; st_tile(nb, rk); st_tile(nb + TB, rv); }
                            if (i + 2 < nw) { rk = ld_tile(kwb + (size_t)(j0 + i + 2) * 4096); rv = ld_tile(vwb + (size_t)(j0 + i + 2) * 4096); }
                            tile2(3, cb, cb + TB, 64 * (j0 + i), false, (j0 + i > cur - 8) && (j0 + i < cur), true, true, 0.f, 0.f, true, true, 0);
                            __syncthreads(); }
                        }
#pragma unroll
                        for (int gq = 0; gq < 2; ++gq) { const float lt = Ls[gq][0]; const float sc = gatev(gq, 2) / fmaxf(lt, 1e-30f);
#pragma unroll
                            for (int mt = 0; mt < 4; ++mt)
#pragma unroll
                                for (int r = 0; r < 4; ++r) O[gq][mt][r] = ocl[((gq * 4 + mt) * 4 + r) * 64] + O[gq][mt][r] * sc; }
                    }
#pragma unroll
                    for (int gq = 0; gq < 2; ++gq)
#pragma unroll
                        for (int mt = 0; mt < 4; ++mt) { u32x2 w; w.x = cvt_pk_bf16(O[gq][mt][0], O[gq][mt][1]); w.y = cvt_pk_bf16(O[gq][mt][2], O[gq][mt][3]);
                            *(u32x2*)(OB + (tokw + 4 * gq + ti) * 512 + (g * 4 + head) * 64 + 16 * mt + 4 * q4) = w; }
                }
            }
          }
        }
        SEAM(pb + 3, 4);

        if (EN(5) && IN(pb + 4)) { PHASE_IDS();
            pg8::Gemm g{(const bf16*)(ws + WS_QHG), (const bf16*)(ws + WS_WBA0 + (size_t)l * 2 * SZ_WBR), NT, DM, DM, 0, 512, (const bf16*)(ws + WS_NQ), 8};
            pg8::StaticOrder S; S.init(NT, DM, G, bid); EpiGate2 E{(bf16*)(ws + WS_GA), (const bf16*)(ws + WS_GA), (const bf16*)(ws + WS_GB)};
            pg8::gemm_phase<EpiGate2, pg8::StaticOrder>(lds, g, S, E, wave_s);
        }
        SEAM(pb + 4, 5);

        if (EN(6) && IN(pb + 5)) { PHASE_IDS();
            pg8::Gemm g{(const bf16*)(ws + WS_GA), (const bf16*)(ws + (l ? WS_WOUT1 : WS_WOUT0)), NT, DM, DM, 0, 0, nullptr, 0};
            const float* XI = l ? (const float*)X : x_in;
            pg8::StaticOrder S; S.init(NT, DM, G, bid); EpiResid E{XI, X};
            pg8::gemm_phase<EpiResid, pg8::StaticOrder>(lds, g, S, E, wave_s);
        }
        SEAM(pb + 5, 6);

        if (EN(7) && IN(pb + 6)) { PHASE_IDS();
            const float* gam = ap->in[11] + l * DM; const float* bet = ap->in[12] + l * DM;
            LAS int* hist = (LAS int*)(lds + 8 * 16384);
            if (l == 1) { if (tid < 8) hist[tid] = 0; __syncthreads(); }
            const int rpb = (NT + G - 1) / G;
            for (int i = wave; i < rpb; i += NWAVES) {
                const int row = bid * rpb + i; if (row >= NT) break;
                f32x4* xr = (f32x4*)(X + (size_t)row * DM);
                f32x4 v[4]; float s = 0.f;
#pragma unroll
                for (int j = 0; j < 4; ++j) { v[j] = xr[64 * j + lane]; s += (v[j][0] + v[j][1]) + (v[j][2] + v[j][3]); }
                const float mean = wave_sum(s) * (1.f / DM); float s2 = 0.f;
#pragma unroll
                for (int j = 0; j < 4; ++j) { v[j] = v[j] - mean; s2 += (v[j][0] * v[j][0] + v[j][1] * v[j][1]) + (v[j][2] * v[j][2] + v[j][3] * v[j][3]); }
                const float rstd = rsqrtf(wave_sum(s2) * (1.f / DM) + 1e-5f);
#pragma unroll
                for (int j = 0; j < 4; ++j) { const f32x4 gq = ((const f32x4*)gam)[64 * j + lane], bq = ((const f32x4*)bet)[64 * j + lane]; v[j] = v[j] * rstd * gq + bq; xr[64 * j + lane] = v[j]; }
                if (l == 0) { u32x2* o = (u32x2*)(XB + (size_t)row * DM);
#pragma unroll
                    for (int j = 0; j < 4; ++j) { u32x2 w; w.x = cvt_pk_bf16(v[j][0], v[j][1]); w.y = cvt_pk_bf16(v[j][2], v[j][3]); o[64 * j + lane] = w; }
                } else {
                    const float* WR = ap->in[18];
                    float lg[8];
#pragma unroll
                    for (int e = 0; e < 8; ++e) lg[e] = 0.f;
#pragma unroll
                    for (int j = 0; j < 4; ++j)
#pragma unroll
                        for (int q = 0; q < 4; ++q) { const int c = 4 * (64 * j + lane) + q; const f32x4 w0 = *(const f32x4*)(WR + c * 8), w1 = *(const f32x4*)(WR + c * 8 + 4); const float xv = v[j][q];
                            lg[0] += xv * w0[0]; lg[1] += xv * w0[1]; lg[2] += xv * w0[2]; lg[3] += xv * w0[3]; lg[4] += xv * w1[0]; lg[5] += xv * w1[1]; lg[6] += xv * w1[2]; lg[7] += xv * w1[3]; }
#pragma unroll
                    for (int e = 0; e < 8; ++e) lg[e] = wave_sum(lg[e]);
                    int e1 = 0; float v1 = lg[0];
#pragma unroll
                    for (int e = 1; e < 8; ++e) if (lg[e] > v1) { v1 = lg[e]; e1 = e; }
                    int e2 = -1; float v2 = -3e38f;
#pragma unroll
                    for (int e = 0; e < 8; ++e) if (e != e1 && lg[e] > v2) { v2 = lg[e]; e2 = e; }
                    if (lane == 0) { const float g2 = 1.f / (1.f + expf(v1 - v2)), g1 = 1.f - g2;
                        ((int*)(ws + WS_TOPI))[row] = e1 | (e2 << 8); ((float*)(ws + WS_TOPG))[row * 2] = g1; ((float*)(ws + WS_TOPG))[row * 2 + 1] = g2;
                        atomicAdd((int*)&hist[e1], 1); atomicAdd((int*)&hist[e2], 1); }
                }
            }
            if (l == 1) {
                __syncthreads();
                if (tid < 8) ((int*)(ws + WS_CTL + CW_BLKCNT))[bid * 8 + tid] = hist[tid];
                LAS float* scr = (LAS float*)(lds + wave * 16384);
                constexpr int I_GU = 16 * (2 * FFE / 32), I_DN = (FFE / 64) * 32;
                for (int it = gwave; it < NEXP * (I_GU + I_DN); it += nwaves) {
                    const int e = it / (I_GU + I_DN); int r = it % (I_GU + I_DN);
                    if (r < I_GU) { const int nb = r % (2 * FFE / 32), kb = r / (2 * FFE / 32);
                        const float* Wg = ap->in[19] + (size_t)e * DM * FFE; const float* Wu = ap->in[20] + (size_t)e * DM * FFE;
                        auto cp = [=](int n) -> const float* { const int pn = n >> 8, hf = (n >> 7) & 1, c = pn * 128 + (n & 127); return (hf ? Wu : Wg) + c; };
                        tr_item(cp, FFE, DM, (bf16*)(ws + WS_MGU) + (size_t)e * 2 * FFE * DM, DM, nb * 32, kb * 64, scr, lane); }
                    else { r -= I_GU; const int nb = r % 32, kb = r / 32;
                        const float* W = ap->in[21] + (size_t)e * FFE * DM;
                        auto cp = [=](int n) -> const float* { return W + n; };
                        tr_item(cp, DM, FFE, (bf16*)(ws + WS_MDN) + (size_t)e * DM * FFE, FFE, nb * 32, kb * 64, scr, lane); }
                }
            }
        }
        SEAM(pb + 6, 7);

        if (l == 0) {
            if (EN(8) && IN(pb + 7)) { PHASE_IDS();
                pg8::Gemm g{XB, (const bf16*)(ws + WS_WGU0), NT, NINP, DM, 0, 0, nullptr, 0};
                pg8::StaticOrder S; S.init(NT, NINP, G, bid); EpiSwiglu E{(bf16*)(ws + WS_H0), FF0P};
                pg8::gemm_phase<EpiSwiglu, pg8::StaticOrder>(lds, g, S, E, wave_s);
            }
            SEAM(pb + 7, 8);
            if (EN(9) && IN(pb + 8)) { PHASE_IDS();
                pg8::Gemm g{(const bf16*)(ws + WS_H0), (const bf16*)(ws + WS_WDN0), NT, DM, FF0P, 0, 0, nullptr, 0};
                pg8::StaticOrder S; S.init(NT, DM, G, bid); EpiResid E{X, X};
                pg8::gemm_phase<EpiResid, pg8::StaticOrder>(lds, g, S, E, wave_s);
            }
            SEAM(pb + 8, 9);
            if (EN(10) && IN(pb + 9)) { PHASE_IDS();
                const float* gam = ap->in[13]; const float* bet = ap->in[14];
                for (int row = gwave; row < NT; row += nwaves) {
                    f32x4* xr = (f32x4*)(X + (size_t)row * DM);
                    f32x4 v[4]; float s = 0.f;
#pragma unroll
                    for (int j = 0; j < 4; ++j) { v[j] = xr[64 * j + lane]; s += (v[j][0] + v[j][1]) + (v[j][2] + v[j][3]); }
                    const float mean = wave_sum(s) * (1.f / DM); float s2 = 0.f;
#pragma unroll
                    for (int j = 0; j < 4; ++j) { v[j] = v[j] - mean; s2 += (v[j][0] * v[j][0] + v[j][1] * v[j][1]) + (v[j][2] * v[j][2] + v[j][3] * v[j][3]); }
                    const float rstd = rsqrtf(wave_sum(s2) * (1.f / DM) + 1e-5f);
                    u32x2* o = (u32x2*)(XB + (size_t)row * DM);
#pragma unroll
                    for (int j = 0; j < 4; ++j) { const f32x4 gq = ((const f32x4*)gam)[64 * j + lane], bq = ((const f32x4*)bet)[64 * j + lane]; v[j] = v[j] * rstd * gq + bq; xr[64 * j + lane] = v[j];
                        u32x2 w; w.x = cvt_pk_bf16(v[j][0], v[j][1]); w.y = cvt_pk_bf16(v[j][2], v[j][3]); o[64 * j + lane] = w; }
                }
            }
            SEAM(pb + 9, 10);
        } else {
            if (EN(11) && IN(pb + 7)) { PHASE_IDS(); int* META = (int*)(ws + WS_CTL + CW_META); int* PANELE = (int*)(ws + WS_CTL + CW_PANELE); int* ROWINFO = (int*)(ws + WS_ROWINFO); bf16* XS = (bf16*)(ws + WS_XS); (void)META; (void)PANELE; (void)ROWINFO; (void)XS;
                LAS int* sh = (LAS int*)lds;
                const int* BC = (const int*)(ws + WS_CTL + CW_BLKCNT);
                {
                    float tot = 0.f, pre = 0.f;
                    for (int bb = lane; bb < G; bb += 64) { const float c = (float)BC[bb * 8 + wave]; tot += c; pre += (bb < bid) ? c : 0.f; }
                    tot = wave_sum(tot); pre = wave_sum(pre);
                    if (lane == 0) { sh[wave] = (int)tot; sh[8 + wave] = (int)pre; sh[24 + wave] = 0; } }
                __syncthreads();
                if (tid == 0) { int base = 0;
#pragma unroll 1
                    for (int e = 0; e < 8; ++e) { sh[16 + e] = base; base += (sh[e] + 255) & ~255; }
                    sh[32] = base; }
                __syncthreads();
                if (bid == 0) { const int base = sh[32]; if (tid == 0) { META[0] = base / 256; META[1] = (base / 256 + 63) / 64; }
                    if (tid < 8) { META[8 + tid] = sh[16 + tid]; META[16 + tid] = sh[tid]; }
                    for (int p = tid; p < base / 256; p += NTHR) { int e = 0;
#pragma unroll 1
                        for (int q = 1; q < 8; ++q) if (p * 256 >= sh[16 + q]) e = q;
                        PANELE[p] = e; } }
                __syncthreads();
                if (bid < 8) { const int e = bid, r0 = sh[16 + e] + sh[e], r1 = sh[16 + e] + ((sh[e] + 255) & ~255);
                    for (int r = r0 + wave; r < r1; r += NWAVES) { if (lane == 0) ROWINFO[r] = -1;
#pragma unroll
                        for (int j = 0; j < 4; ++j) ((u32x2*)(XS + (size_t)r * DM))[64 * j + lane] = (u32x2){0u, 0u}; } }
                const int rpb = (NT + G - 1) / G;
                for (int i = wave; i < rpb; i += NWAVES) {
                    const int row = bid * rpb + i; if (row >= NT) break;
                    const int ti = ((const int*)(ws + WS_TOPI))[row]; const int e1 = ti & 255, e2 = ti >> 8;
                    int s1 = 0, s2 = 0;
                    if (lane == 0) { s1 = sh[16 + e1] + sh[8 + e1] + atomicAdd((int*)&sh[24 + e1], 1); s2 = sh[16 + e2] + sh[8 + e2] + atomicAdd((int*)&sh[24 + e2], 1); ROWINFO[s1] = row * 2; ROWINFO[s2] = row * 2 + 1; }
                    s1 = __builtin_amdgcn_readfirstlane(s1); s2 = __builtin_amdgcn_readfirstlane(s2);
                    const f32x4* xr = (const f32x4*)(X + (size_t)row * DM);
#pragma unroll
                    for (int j = 0; j < 4; ++j) { const f32x4 v = xr[64 * j + lane]; u32x2 w; w.x = cvt_pk_bf16(v[0], v[1]); w.y = cvt_pk_bf16(v[2], v[3]);
                        ((u32x2*)(XS + (size_t)s1 * DM))[64 * j + lane] = w; ((u32x2*)(XS + (size_t)s2 * DM))[64 * j + lane] = w; }
                }
            }
            SEAM(pb + 7, 11);
            for (int c = 0; c < MAXCHUNK; ++c) {
                if (EN(12) && IN(pb + 8 + 2 * c)) { PHASE_IDS(); int* META = (int*)(ws + WS_CTL + CW_META); int* PANELE = (int*)(ws + WS_CTL + CW_PANELE); int* ROWINFO = (int*)(ws + WS_ROWINFO); bf16* XS = (bf16*)(ws + WS_XS); (void)META; (void)PANELE; (void)ROWINFO; (void)XS;
                    const int P = META[0], nch = META[1];
                    if (c < nch) { const int p0 = (int)((long)c * P / nch), p1 = (int)((long)(c + 1) * P / nch);
                        pg8::Gemm g{XS + (size_t)p0 * 256 * DM, (const bf16*)(ws + WS_MGU), (p1 - p0) * 256, 2 * FFE, DM, (size_t)2 * FFE * DM, 0, nullptr, 0};
                        pg8::StaticOrder S; S.init((p1 - p0) * 256, 2 * FFE, G, bid, PANELE + p0); EpiSwiglu E{(bf16*)(ws + WS_HM), FFE};
                        pg8::gemm_phase<EpiSwiglu, pg8::StaticOrder>(lds, g, S, E, wave_s); }
                }
                SEAM(pb + 8 + 2 * c, 12);
                if (EN(13) && IN(pb + 9 + 2 * c)) { PHASE_IDS(); int* META = (int*)(ws + WS_CTL + CW_META); int* PANELE = (int*)(ws + WS_CTL + CW_PANELE); int* ROWINFO = (int*)(ws + WS_ROWINFO); bf16* XS = (bf16*)(ws + WS_XS); (void)META; (void)PANELE; (void)ROWINFO; (void)XS;
                    const int P = META[0], nch = META[1];
                    if (c < nch) { const int p0 = (int)((long)c * P / nch), p1 = (int)((long)(c + 1) * P / nch);
                        pg8::Gemm g{(const bf16*)(ws + WS_HM), (const bf16*)(ws + WS_MDN), (p1 - p0) * 256, DM, FFE, (size_t)DM * FFE, 0, nullptr, 0};
                        pg8::StaticOrder S; S.init((p1 - p0) * 256, DM, G, bid, PANELE + p0); EpiScatter E{(bf16*)(ws + WS_YM), ROWINFO + p0 * 256};
                        pg8::gemm_phase<EpiScatter, pg8::StaticOrder>(lds, g, S, E, wave_s); }
                }
                if (PROBE_GRP >= 0 && c == MAXCHUNK - 1) { PMARK(13); if (bid == 0 && wave_s == 0 && lane_id() == 0) *(unsigned long long*)(ws0 + WS_CTL + CW_PROBE) = pr_acc; }
                SEAM(pb + 9 + 2 * c, 13);
            }
            if (EN(14) && IN(pb + 8 + 2 * MAXCHUNK)) { PHASE_IDS();
                const float* gam = ap->in[13] + DM; const float* bet = ap->in[14] + DM;
                const bf16* YM = (const bf16*)(ws + WS_YM); const float* TG = (const float*)(ws + WS_TOPG);
                const float pscale = 1.f;
                for (int row = gwave; row < NT; row += nwaves) {
                    f32x4* xr = (f32x4*)(X + (size_t)row * DM);
                    const float g1 = TG[row * 2], g2 = TG[row * 2 + 1];
                    const u32x2* y1 = (const u32x2*)(YM + (size_t)(row * 2) * DM); const u32x2* y2 = (const u32x2*)(YM + (size_t)(row * 2 + 1) * DM);
                    f32x4 v[4]; float s = 0.f;
#pragma unroll
                    for (int j = 0; j < 4; ++j) { const f32x4 xv = xr[64 * j + lane]; const u32x2 a = y1[64 * j + lane], bq = y2[64 * j + lane];
                        v[j][0] = xv[0] * DN_ALPHA + g1 * bflo(a.x) + g2 * bflo(bq.x); v[j][1] = xv[1] * DN_ALPHA + g1 * bfhi(a.x) + g2 * bfhi(bq.x);
                        v[j][2] = xv[2] * DN_ALPHA + g1 * bflo(a.y) + g2 * bflo(bq.y); v[j][3] = xv[3] * DN_ALPHA + g1 * bfhi(a.y) + g2 * bfhi(bq.y);
                        s += (v[j][0] + v[j][1]) + (v[j][2] + v[j][3]); }
                    const float mean = wave_sum(s) * (1.f / DM); float s2 = 0.f;
#pragma unroll
                    for (int j = 0; j < 4; ++j) { v[j] = v[j] - mean; s2 += (v[j][0] * v[j][0] + v[j][1] * v[j][1]) + (v[j][2] * v[j][2] + v[j][3] * v[j][3]); }
                    const float rstd = rsqrtf(wave_sum(s2) * (1.f / DM) + 1e-5f);
#pragma unroll
                    for (int j = 0; j < 4; ++j) { const f32x4 gq = ((const f32x4*)gam)[64 * j + lane], bq = ((const f32x4*)bet)[64 * j + lane]; xr[64 * j + lane] = (v[j] * rstd * gq + bq) * pscale; }
                }
#if PROBE_GRP >= 0
                {
                    const unsigned long long dt = *(const unsigned long long*)(ws + WS_CTL + CW_PROBE) * (unsigned long long)PROBE_K;
                    const unsigned long long t0 = __builtin_amdgcn_s_memrealtime();
                    while (__builtin_amdgcn_s_memrealtime() - t0 < dt) __builtin_amdgcn_s_sleep(8);
                }
#endif
            }
        }
    }
#undef IN
#undef SEAM
}

constexpr int NPHASES = 1 + 10 + 8 + 2 * MAXCHUNK + 1;

extern "C" void kernel_launch(void* const* d_in, const int* in_sizes, int n_in, void* d_out, int out_size, void* d_ws, size_t ws_size, hipStream_t stream) {
    static int grid = 0;
    if (grid == 0) {
        if (n_in != 22 || out_size != NT * DM || ws_size < WS_END) { fprintf(stderr, "kernel_launch: need 22 inputs, %d outputs, >= %zu bytes of workspace; got %d, %d, %zu\n", NT * DM, (size_t)WS_END, n_in, out_size, ws_size); grid = -1; return; }
        int dev = 0, cus = 0, per_cu = 0;
        if (hipGetDevice(&dev) != hipSuccess || hipDeviceGetAttribute(&cus, hipDeviceAttributeMultiprocessorCount, dev) != hipSuccess) { grid = -1; return; }
        if (hipFuncSetAttribute((const void*)mega_fwd, hipFuncAttributeMaxDynamicSharedMemorySize, LDS_BYTES) != hipSuccess) { fprintf(stderr, "kernel_launch: hipFuncSetAttribute failed\n"); grid = -1; return; }
        if (hipOccupancyMaxActiveBlocksPerMultiprocessor(&per_cu, (const void*)mega_fwd, NTHR, LDS_BYTES) != hipSuccess || per_cu < 1) fprintf(stderr, "kernel_launch: occupancy query reports %d\n", per_cu);
        (void)hipGetLastError();
        grid = cus > 256 ? 256 : cus;
    }
    if (grid < 0) return;
    (void)hipMemsetAsync((char*)d_ws + WS_CTL, 0, CTL_BYTES, stream);
    Args a{};
    for (int i = 0; i < 22; ++i) a.in[i] = (const float*)d_in[i];
    a.out = (float*)d_out; a.ws = (unsigned char*)d_ws;
#if ONE_LAUNCH
    a.ph_lo = 0; a.ph_hi = NPHASES;
    hipLaunchKernelGGL(mega_fwd, dim3(grid), dim3(NTHR), LDS_BYTES, stream, a);
#else
    for (int p = 0; p < NPHASES; ++p) { a.ph_lo = p; a.ph_hi = p + 1; hipLaunchKernelGGL(mega_fwd, dim3(grid), dim3(NTHR), LDS_BYTES, stream, a); }
#endif
}
```

```cpp
#include <hip/hip_runtime.h>
#include <cstdio>
#include <cstdint>

#ifndef ONE_LAUNCH
#define ONE_LAUNCH 1
#endif

#define LAS __attribute__((address_space(3)))
typedef unsigned short bf16;
typedef short bf16x8 __attribute__((ext_vector_type(8)));
typedef short s16x4 __attribute__((ext_vector_type(4)));
typedef float f32x4 __attribute__((ext_vector_type(4)));
typedef float f32x16 __attribute__((ext_vector_type(16)));
typedef float f32x2 __attribute__((ext_vector_type(2)));
typedef unsigned u32x4 __attribute__((ext_vector_type(4)));
typedef unsigned u32x2 __attribute__((ext_vector_type(2)));

typedef __bf16 bf16x2_t __attribute__((ext_vector_type(2)));
__device__ __forceinline__ unsigned cvt_pk_bf16(float lo, float hi) { bf16x2_t v; v[0] = (__bf16)lo; v[1] = (__bf16)hi; return __builtin_bit_cast(unsigned, v); }
__device__ __forceinline__ bf16 f2bf(float f) { unsigned u = __float_as_uint(f); u += 0x7FFFu + ((u >> 16) & 1u); return (bf16)(u >> 16); }
__device__ __forceinline__ float bf2f(bf16 b) { return __uint_as_float(((unsigned)b) << 16); }
__device__ __forceinline__ float bflo(unsigned u) { return __uint_as_float(u << 16); }
__device__ __forceinline__ float bfhi(unsigned u) { return __uint_as_float(u & 0xFFFF0000u); }
__device__ __forceinline__ float sigmoidf_(float x) { return 1.0f / (1.0f + __expf(-x)); }
__device__ __forceinline__ float siluf_(float x) { return x / (1.0f + __expf(-x)); }
__device__ __forceinline__ float max_x32(float x) { auto r = __builtin_amdgcn_permlane32_swap(__float_as_uint(x), __float_as_uint(x), false, false); return fmaxf(__uint_as_float(r[0]), __uint_as_float(r[1])); }
__device__ __forceinline__ float max_x16(float x) { auto r = __builtin_amdgcn_permlane16_swap(__float_as_uint(x), __float_as_uint(x), false, false); return fmaxf(__uint_as_float(r[0]), __uint_as_float(r[1])); }
__device__ __forceinline__ float sum_x32(float x) { auto r = __builtin_amdgcn_permlane32_swap(__float_as_uint(x), __float_as_uint(x), false, false); return __uint_as_float(r[0]) + __uint_as_float(r[1]); }
__device__ __forceinline__ float sum_x16(float x) { auto r = __builtin_amdgcn_permlane16_swap(__float_as_uint(x), __float_as_uint(x), false, false); return __uint_as_float(r[0]) + __uint_as_float(r[1]); }
__device__ __forceinline__ float dpp_x1(float x) { return __uint_as_float(__builtin_amdgcn_mov_dpp(__float_as_uint(x), 0xB1, 0xF, 0xF, true)); }
__device__ __forceinline__ float dpp_x2(float x) { return __uint_as_float(__builtin_amdgcn_mov_dpp(__float_as_uint(x), 0x4E, 0xF, 0xF, true)); }
__device__ __forceinline__ float dpp_hm(float x) { return __uint_as_float(__builtin_amdgcn_mov_dpp(__float_as_uint(x), 0x141, 0xF, 0xF, true)); }
__device__ __forceinline__ float dpp_rm(float x) { return __uint_as_float(__builtin_amdgcn_mov_dpp(__float_as_uint(x), 0x140, 0xF, 0xF, true)); }
__device__ __forceinline__ float wave_sum(float v) { v += dpp_x1(v); v += dpp_x2(v); v += dpp_hm(v); v += dpp_rm(v); v = sum_x16(v); return sum_x32(v); }
__device__ __forceinline__ float wave_max(float v) { v = fmaxf(v, dpp_x1(v)); v = fmaxf(v, dpp_x2(v)); v = fmaxf(v, dpp_hm(v)); v = fmaxf(v, dpp_rm(v)); v = max_x16(v); return max_x32(v); }
__device__ __forceinline__ int lane_id() { int l; asm volatile("v_mbcnt_lo_u32_b32 %0, -1, 0\n\tv_mbcnt_hi_u32_b32 %0, -1, %0" : "=v"(l)); return l; }
#define LDS_SYNC() do { asm volatile("s_waitcnt lgkmcnt(0)" ::: "memory"); __builtin_amdgcn_s_barrier(); asm volatile("" ::: "memory"); } while (0)
#define WAVE_SYNC() do { asm volatile("s_waitcnt lgkmcnt(0)" ::: "memory"); __builtin_amdgcn_wave_barrier(); } while (0)

#define PHASE_IDS() int tid_ph = wave_s * 64 + lane_id(); asm volatile("" : "+v"(tid_ph)); int bid_ph = (int)blockIdx.x; asm volatile("" : "+s"(bid_ph)); const int bid = bid_ph; (void)bid; const int tid = tid_ph, lane = tid & 63, wave = __builtin_amdgcn_readfirstlane(tid >> 6), gwave = bid * NWAVES + wave; (void)tid; (void)lane; (void)wave; (void)gwave; \
    KArgsP ap = kap; asm volatile("" : "+s"(ap));     \
    unsigned char* ws = ap->ws; float* X = ap->out; const float* x_in = ap->in[0]; bf16* XB = (bf16*)(ws + WS_XB); float* LBS = (float*)(ws + WS_LBS); (void)X; (void)x_in; (void)XB; (void)LBS
namespace pg8 {
constexpr int BM = 256, BK = 64, HALF = 128, HTB = HALF * BK * 2, STAGE_BYTES = 8 * HTB, NXCD = 8, WGM = 8;
__host__ __device__ __forceinline__ int lds_byte(int r, int c) { const int st = (r >> 4) * 2 + (c >> 5), rr = r & 15, cc = c & 31, ob = rr * 64 + cc * 2; return st * 1024 + (ob ^ (((ob >> 9) & 1) << 5)); }
__host__ __device__ __forceinline__ void stage_rc(int b, int& R, int& C) { const int st = b / 1024, sb = b % 1024, swz = sb ^ (((sb >> 9) & 1) << 5); R = (st >> 1) * 16 + swz / 64; C = (st & 1) * 32 + (swz % 64) / 2; }
__host__ __device__ __forceinline__ int perm32(int rho) { const int n = rho >> 4, i = rho & 15; return 8 * (i >> 2) + 4 * n + (i & 3); }

struct Unit { int pm, pn, e; };
struct Gemm { const bf16* A; const bf16* Bt; int M, N, K; size_t bt_estride; int lda; const bf16* A2; int ksw; };

struct StaticOrder {
    int nM, nN, nwg, G, c; const int* pe;
    __device__ void init(int M, int N, int G_, int c_, const int* pe_ = nullptr) { nM = M / BM; nN = N / BM; nwg = nM * nN; G = G_; c = c_; pe = pe_; }
    __device__ bool next(int i, Unit& u) const {
        const long L = (long)i * G + c; if (L >= nwg) return false;
        int wgid = (int)L; { const int q = nwg / NXCD, r = nwg % NXCD, xcd = wgid % NXCD, off = wgid / NXCD; wgid = (xcd < r ? xcd * (q + 1) : r * (q + 1) + (xcd - r) * q) + off; }
        const int nig = WGM * nN, gid = wgid / nig, fm = gid * WGM, gsz = (nM - fm) < WGM ? (nM - fm) : WGM;
        u.pm = fm + ((wgid % nig) % gsz); u.pn = (wgid % nig) / gsz; u.e = pe ? pe[u.pm] : 0; return true;
    }
    __device__ __forceinline__ void a_ready(const Unit&) const {}
    __device__ __forceinline__ void done(const Unit&) const {}
};

template <class Epi, class Sched, bool ALIGN_EPI = true, bool SP2 = true>
__device__ __forceinline__ void gemm_phase(LAS unsigned char* lds, const Gemm g, const Sched& S, const Epi& E, const int wave_s) {
    int tid_l = wave_s * 64 + lane_id(); asm volatile("" : "+v"(tid_l));
    const int tid = tid_l, wid = __builtin_amdgcn_readfirstlane(tid >> 6), lane = tid & 63, wr = wid >> 2, wc = wid & 3, fr = lane & 15, fq = lane >> 4;
    const int K = g.K, nt = K / BK, LDA = g.lda ? g.lda : g.K;
    unsigned voffA[2], voffB[2];
#pragma unroll
    for (int i = 0; i < 2; ++i) { int R, C; stage_rc(tid * 16 + i * 8192, R, C); const int Rb = Epi::PERM ? ((R & ~31) + perm32(R & 31)) : R;
        voffA[i] = (unsigned)(R * LDA + C) * 2u; voffB[i] = (unsigned)(Rb * K + C) * 2u; }
    const size_t kstep = (size_t)(BK * 2);
    const size_t hstep = (size_t)HALF * K * 2, hstepA = (size_t)HALF * LDA * 2;
    const size_t tstep = 2 * hstep, tstepA = 2 * hstepA;
    const unsigned ldsw = (unsigned)wid * 1024u;
    const int aoff = lds_byte(wr * 64 + fr, fq * 8), boff = lds_byte(wc * 32 + fr, fq * 8);
#define PG8_SA(b, h) (((b) * 2 + (h)) * HTB)
#define PG8_SB(b, h) ((4 + (b) * 2 + (h)) * HTB)
#define PG8_STAGE(bufoff, gbase, voff) do { _Pragma("unroll") for (int _i = 0; _i < 2; ++_i) \
        __builtin_amdgcn_global_load_lds((const unsigned*)((const char*)(gbase) + (voff)[_i]), (LAS unsigned*)(lds + (bufoff) + ldsw + _i * 8192), 16, 0, 0); } while (0)
#define PG8_LDA(dst, b, h) do { _Pragma("unroll") for (int m = 0; m < 4; ++m) _Pragma("unroll") for (int k = 0; k < 2; ++k) dst[m][k] = *(const LAS bf16x8*)(lds + PG8_SA(b, h) + aoff + m * 2048 + k * 1024); } while (0)
#define PG8_LDB(dst, b, h) do { _Pragma("unroll") for (int n = 0; n < 2; ++n) _Pragma("unroll") for (int k = 0; k < 2; ++k) dst[n][k] = *(const LAS bf16x8*)(lds + PG8_SB(b, h) + boff + n * 2048 + k * 1024); } while (0)
#define PG8_MMA(ai, bj, At, Bt) do { __builtin_amdgcn_s_setprio(1); _Pragma("unroll") for (int m = 0; m < 4; ++m) _Pragma("unroll") for (int n = 0; n < 2; ++n) _Pragma("unroll") for (int k = 0; k < 2; ++k) \
        acc[ai][bj][m][n] = __builtin_amdgcn_mfma_f32_16x16x32_bf16(Bt[n][k], At[m][k], acc[ai][bj][m][n], 0, 0, 0); __builtin_amdgcn_s_setprio(0); } while (0)
#define PG8_WAIT_V(n) asm volatile("s_waitcnt vmcnt(" #n ")" ::: "memory")
#define PG8_WAIT_L(n) asm volatile("s_waitcnt lgkmcnt(" #n ")" ::: "memory")
#define PG8_BAR __builtin_amdgcn_s_barrier()
#define PG8_SCHED __builtin_amdgcn_sched_barrier(0)
    Unit cur, nxt; int ui = 0;
    if (!S.next(0, cur)) return;
    f32x4 acc[2][2][4][2];
#pragma unroll
    for (int a = 0; a < 2; ++a)
#pragma unroll
        for (int b = 0; b < 2; ++b)
#pragma unroll
            for (int m = 0; m < 4; ++m)
#pragma unroll
                for (int n = 0; n < 2; ++n) acc[a][b][m][n] = (f32x4){0.f, 0.f, 0.f, 0.f};
    bf16x8 At[4][2], B0[2][2], B1[2][2];
    const int ksw = g.ksw ? g.ksw : nt;
    const char* cA = (const char*)g.A + (size_t)cur.pm * tstepA; const char* cB = (const char*)(g.Bt + (size_t)cur.e * g.bt_estride) + (size_t)cur.pn * tstep;
    const char* cA2 = g.ksw ? (const char*)g.A2 + (size_t)cur.pm * tstepA : cA;
    S.a_ready(cur);
    if constexpr (SP2) {
        PG8_STAGE(PG8_SB(0, 0), cB, voffB); PG8_STAGE(PG8_SB(0, 1), cB + hstep, voffB); PG8_STAGE(PG8_SA(0, 0), cA, voffA); PG8_STAGE(PG8_SA(0, 1), cA + hstepA, voffA);
        if (wr == 1) PG8_BAR;
        PG8_WAIT_V(2); PG8_BAR;
        PG8_STAGE(PG8_SB(1, 0), cB + kstep, voffB); PG8_STAGE(PG8_SA(1, 0), cA + kstep, voffA); PG8_STAGE(PG8_SB(1, 1), cB + hstep + kstep, voffB);
        PG8_WAIT_V(6); PG8_BAR;
    } else {
        PG8_STAGE(PG8_SB(0, 0), cB, voffB); PG8_STAGE(PG8_SA(0, 0), cA, voffA); PG8_STAGE(PG8_SB(0, 1), cB + hstep, voffB); PG8_STAGE(PG8_SA(0, 1), cA + hstepA, voffA);
        if (wr == 1) PG8_BAR;
        PG8_WAIT_V(4); PG8_BAR;
        PG8_STAGE(PG8_SB(1, 0), cB + kstep, voffB); PG8_STAGE(PG8_SA(1, 0), cA + kstep, voffA); PG8_STAGE(PG8_SB(1, 1), cB + hstep + kstep, voffB);
        PG8_WAIT_V(6); PG8_BAR;
    }
    for (;;) {
        const bool has_next = S.next(ui + 1, nxt);
        const char* nA = has_next ? (const char*)g.A + (size_t)nxt.pm * tstepA : cA;
        const char* nA2 = (has_next && g.ksw) ? (const char*)g.A2 + (size_t)nxt.pm * tstepA : cA2;
        const char* nB = has_next ? (const char*)(g.Bt + (size_t)nxt.e * g.bt_estride) + (size_t)nxt.pn * tstep : cB;
        for (int t = 0; t < nt; t += 2) {
            const bool last = (t == nt - 2);
            const char* a1 = (t + 1 < ksw) ? cA + (size_t)(t + 1) * kstep : cA2 + (size_t)(t + 1 - ksw) * kstep;
            const char* a2 = last ? nA : ((t + 2 < ksw) ? cA + (size_t)(t + 2) * kstep : cA2 + (size_t)(t + 2 - ksw) * kstep); const char* b2 = last ? nB : cB + (size_t)(t + 2) * kstep;
            const char* a3 = a2 + kstep; const char* b3 = b2 + kstep;
            if (last && has_next) S.a_ready(nxt);
            if constexpr (Epi::HAS_MID) { if (t == ksw) E.mid(acc, cur, wr, wc, fr, fq); }
            if constexpr (SP2) {
            PG8_LDB(B0, 0, 0); PG8_LDB(B1, 0, 1); PG8_SCHED; PG8_LDA(At, 0, 0); PG8_STAGE(PG8_SA(1, 1), a1 + hstepA, voffA);
            PG8_WAIT_V(8); PG8_WAIT_L(0); PG8_BAR; PG8_MMA(0, 0, At, B0); PG8_MMA(0, 1, At, B1); PG8_BAR; PG8_SCHED;
            PG8_LDA(At, 0, 1); PG8_STAGE(PG8_SB(0, 0), b2, voffB); PG8_STAGE(PG8_SB(0, 1), b2 + hstep, voffB); PG8_STAGE(PG8_SA(0, 0), a2, voffA);
            PG8_WAIT_V(8); PG8_WAIT_L(0); PG8_BAR; PG8_MMA(1, 0, At, B0); PG8_MMA(1, 1, At, B1); PG8_BAR; PG8_SCHED;
            PG8_LDB(B0, 1, 0); PG8_LDB(B1, 1, 1); PG8_SCHED; PG8_LDA(At, 1, 0); PG8_STAGE(PG8_SA(0, 1), a2 + hstepA, voffA);
            PG8_WAIT_V(8); PG8_WAIT_L(0); PG8_BAR; PG8_MMA(0, 0, At, B0); PG8_MMA(0, 1, At, B1); PG8_BAR; PG8_SCHED;
            PG8_LDA(At, 1, 1); PG8_STAGE(PG8_SB(1, 0), b3, voffB); PG8_STAGE(PG8_SB(1, 1), b3 + hstep, voffB); PG8_STAGE(PG8_SA(1, 0), a3, voffA);
            PG8_WAIT_V(8); PG8_WAIT_L(0); PG8_BAR; PG8_MMA(1, 0, At, B0); PG8_MMA(1, 1, At, B1); PG8_BAR; PG8_SCHED;
            } else {
            PG8_LDB(B0, 0, 0); PG8_SCHED; PG8_LDA(At, 0, 0); PG8_STAGE(PG8_SA(1, 1), a1 + hstepA, voffA);
            PG8_WAIT_L(8); PG8_BAR; PG8_WAIT_L(0); PG8_MMA(0, 0, At, B0); PG8_BAR; PG8_SCHED;
            PG8_LDB(B1, 0, 1); PG8_STAGE(PG8_SB(0, 0), b2, voffB);
            PG8_BAR; PG8_WAIT_L(0); PG8_MMA(0, 1, At, B1); PG8_BAR;
            PG8_LDA(At, 0, 1); PG8_STAGE(PG8_SA(0, 0), a2, voffA);
            PG8_BAR; PG8_WAIT_L(0); PG8_MMA(1, 0, At, B0); PG8_BAR; PG8_SCHED;
            PG8_STAGE(PG8_SB(0, 1), b2 + hstep, voffB);
            PG8_WAIT_V(6); PG8_BAR; PG8_MMA(1, 1, At, B1); PG8_BAR;
            PG8_LDB(B0, 1, 0); PG8_SCHED; PG8_LDA(At, 1, 0); PG8_STAGE(PG8_SA(0, 1), a2 + hstepA, voffA);
            PG8_WAIT_L(8); PG8_BAR; PG8_WAIT_L(0); PG8_MMA(0, 0, At, B0); PG8_BAR; PG8_SCHED;
            PG8_LDB(B1, 1, 1); PG8_STAGE(PG8_SB(1, 0), b3, voffB);
            PG8_BAR; PG8_WAIT_L(0); PG8_MMA(0, 1, At, B1); PG8_BAR;
            PG8_LDA(At, 1, 1); PG8_STAGE(PG8_SA(1, 0), a3, voffA);
            PG8_BAR; PG8_WAIT_L(0); PG8_MMA(1, 0, At, B0); PG8_BAR; PG8_SCHED;
            PG8_STAGE(PG8_SB(1, 1), b3 + hstep, voffB);
            PG8_WAIT_V(6); PG8_BAR; PG8_MMA(1, 1, At, B1); PG8_BAR;
            }
        }
        if constexpr (ALIGN_EPI) { if (wr == 0) PG8_BAR; }
        E(acc, cur, wr, wc, fr, fq); S.done(cur);
        if (!has_next) break;
#pragma unroll
        for (int a = 0; a < 2; ++a)
#pragma unroll
            for (int b = 0; b < 2; ++b)
#pragma unroll
                for (int m = 0; m < 4; ++m)
#pragma unroll
                    for (int n = 0; n < 2; ++n) acc[a][b][m][n] = (f32x4){0.f, 0.f, 0.f, 0.f};
        cur = nxt; cA = nA; cA2 = nA2; cB = nB; ++ui;
        if constexpr (ALIGN_EPI) { if (wr == 1) PG8_BAR; }
    }
    PG8_WAIT_V(0);
    if constexpr (!ALIGN_EPI) { if (wr == 0) PG8_BAR; }
    PG8_BAR;
#undef PG8_SA
#undef PG8_SB
#undef PG8_STAGE
#undef PG8_LDA
#undef PG8_LDB
#undef PG8_MMA
#undef PG8_WAIT_V
#undef PG8_WAIT_L
#undef PG8_BAR
#undef PG8_SCHED
}
}

#define XB_TMO      128
#define XB_XCNT(j)  (256  + 64 * (j))
#define XB_XSUB(j)  (1280 + 64 * (j))
#define XB_XGEN(j)  (2304 + 64 * (j))
#define XB_TOP      3328
#define XB_TOPGEN   3392
#define XCD_BAR_WORDS 3456
#define XB_SPIN_CAP (1u << 18)
__device__ __forceinline__ unsigned xb_ld(unsigned* p)              { return __hip_atomic_load(p, __ATOMIC_RELAXED, __HIP_MEMORY_SCOPE_AGENT); }
__device__ __forceinline__ unsigned xb_add(unsigned* p, unsigned v) { return __hip_atomic_fetch_add(p, v, __ATOMIC_RELAXED, __HIP_MEMORY_SCOPE_AGENT); }
__device__ __forceinline__ unsigned xb_xcc_id() { return (unsigned)__builtin_amdgcn_s_getreg((3 << 11) | 20) & 0xFu; }
#define XB_SPIN(cond, bar) do { unsigned _sp = 0; while (cond) { __builtin_amdgcn_s_sleep(1); \
    if ((++_sp & 255u) == 0u) { if (xb_ld(&(bar)[XB_TMO])) break; if (_sp > XB_SPIN_CAP) { atomicAdd(&(bar)[XB_TMO], 1u); break; } } } } while (0)
struct XcdBarrier { unsigned* bar; unsigned x; volatile LAS unsigned* st; };
__device__ __forceinline__ XcdBarrier xcd_barrier_post(unsigned* bar, volatile LAS unsigned* st, const bool leader) {
    XcdBarrier b; b.bar = bar; b.x = xb_xcc_id(); b.st = st;
    if (leader) (void)xb_add(&bar[XB_XCNT(b.x)], 1u);
    return b;
}
__device__ __forceinline__ void xcd_barrier_complete(unsigned* bar, unsigned x, unsigned& nloc, unsigned& nx) {
    const unsigned G = gridDim.x * gridDim.y * gridDim.z;
    unsigned sum, cnt, mine, sp = 0u;
    for (;;) {
        sum = 0u; cnt = 0u; mine = 0u;
#pragma unroll
        for (unsigned j = 0; j < 16; ++j) { const unsigned c = xb_ld(&bar[XB_XCNT(j)]); sum += c; cnt += (c > 0u) ? 1u : 0u; mine = (j == x) ? c : mine; }
        if (sum == G) break;
        __builtin_amdgcn_s_sleep(1);
        if ((++sp & 255u) == 0u) { if (xb_ld(&bar[XB_TMO])) break; if (sp > XB_SPIN_CAP) { atomicAdd(&bar[XB_TMO], 1u); break; } }
    }
    nloc = mine > 0u ? mine : 1u; nx = cnt > 0u ? cnt : 1u;
}
__device__ __forceinline__ void xcd_barrier(const XcdBarrier& b, const bool leader) {
    asm volatile("s_waitcnt vmcnt(0)" ::: "memory");
    __syncthreads();
    if (leader) {
        unsigned* bar = b.bar;
        __builtin_amdgcn_s_waitcnt(0);
        unsigned nloc = b.st[0], nx = b.st[1];
        if (nloc == 0u) { xcd_barrier_complete(bar, b.x, nloc, nx); b.st[0] = nloc; b.st[1] = nx; }
        const unsigned old = xb_add(&bar[XB_XSUB(b.x)], 1u);
        const unsigned gen = old / nloc;
        if (old + 1u == (gen + 1u) * nloc) {
            __builtin_amdgcn_fence(__ATOMIC_RELEASE, "agent");
            asm volatile("s_waitcnt vmcnt(0)" ::: "memory");
            const unsigned og = xb_add(&bar[XB_TOP], 1u);
            const unsigned tg = og / nx;
            if (og + 1u == (tg + 1u) * nx) xb_add(&bar[XB_TOPGEN], 1u);
            else XB_SPIN(xb_ld(&bar[XB_TOPGEN]) == tg, bar);
            __builtin_amdgcn_fence(__ATOMIC_ACQUIRE, "agent");
            xb_add(&bar[XB_XGEN(b.x)], 1u);
            asm volatile("s_waitcnt vmcnt(0)" ::: "memory");
        } else {
            XB_SPIN(xb_ld(&bar[XB_XGEN(b.x)]) == gen, bar);
            __builtin_amdgcn_fence(__ATOMIC_ACQUIRE, "agent");
            asm volatile("s_waitcnt vmcnt(0)" ::: "memory");
        }
    }
    __syncthreads();
}

constexpr int NB = 4, SEQ = 8192, DM = 1024, NT = NB * SEQ;
constexpr int NINP = 5632;
constexpr int FF0 = 2752, FF0P = 2816, FFE = 3584, NEXP = 8;
constexpr int NWAVES = 8, NTHR = 512;
constexpr int LDS_BYTES = 155648;
constexpr int MISC_OFF = LDS_BYTES - 64;
constexpr float DN_ALPHA = 1.41421356237309515f;
constexpr int MAXPANELS = 272;
constexpr int MAXCHUNK = 5;

constexpr size_t al256(size_t x) { return (x + 255) & ~(size_t)255; }
constexpr size_t WS_CTL = 0;
constexpr size_t CTL_BYTES = 65536;
constexpr size_t CW_BAR = 0;
constexpr size_t CW_BLKCNT = 16384;
constexpr size_t CW_META = 16384 + 8192;
constexpr size_t CW_PANELE = 16384 + 8192 + 256;
constexpr size_t CW_PE32 = 16384 + 8192 + 2048;
constexpr size_t CW_PROBE = 16384 + 8192 + 4096;
constexpr size_t WS_LBS = WS_CTL + CTL_BYTES;
constexpr size_t WS_KC = WS_LBS + 4096;
constexpr size_t WS_VC = WS_KC + 1048576;
constexpr size_t WS_DEC = WS_VC + 1048576;
constexpr size_t WS_TOPI = WS_DEC + 1048576;
constexpr size_t WS_TOPG = WS_TOPI + (size_t)NT * 4;
constexpr size_t WS_ROWINFO = WS_TOPG + (size_t)NT * 8;
constexpr size_t WS_HID = al256(WS_ROWINFO + (size_t)MAXPANELS * 256 * 4);
constexpr size_t WS_B1 = WS_HID + (size_t)8192 * 128 * 2;
constexpr size_t WS_BIG = al256(WS_B1 + 4096);
constexpr size_t SZ_WIN = (size_t)NINP * DM * 2, SZ_WBR = (size_t)DM * 512 * 2, SZ_WOUT = (size_t)DM * DM * 2;
constexpr size_t WS_WIN0 = WS_BIG, WS_WIN1 = WS_WIN0 + SZ_WIN;
constexpr size_t WS_WBA0 = WS_WIN1 + SZ_WIN, WS_WBA1 = WS_WBA0 + SZ_WBR, WS_WBB0 = WS_WBA1 + SZ_WBR, WS_WBB1 = WS_WBB0 + SZ_WBR;
constexpr size_t WS_WOUT0 = WS_WBB1 + SZ_WBR, WS_WOUT1 = WS_WOUT0 + SZ_WOUT;
constexpr size_t WS_WGU0 = WS_WOUT1 + SZ_WOUT;
constexpr size_t WS_WDN0 = WS_WGU0 + (size_t)NINP * DM * 2;
constexpr size_t WS_W1T = WS_WDN0 + (size_t)DM * FF0P * 2;
constexpr size_t WS_XB = WS_W1T + (size_t)2 * 2 * 256 * 2048 * 2;
constexpr size_t WS_US = WS_XB;
constexpr size_t WS_PROJ = WS_XB + (size_t)NT * DM * 2;
constexpr size_t WS_QHG = WS_PROJ;
constexpr size_t WS_HF = WS_QHG + (size_t)NT * 512 * 2;
constexpr size_t WS_HI = WS_HF + (size_t)NT * 512 * 4;
constexpr size_t WS_HG = WS_HI + (size_t)NT * 512 * 2;
constexpr size_t WS_NQ = WS_HG + (size_t)NT * 512 * 2;
constexpr size_t WS_KV6 = WS_NQ + (size_t)NT * 512 * 2;
constexpr size_t WS_GA = WS_KV6 + (size_t)NT * 768 * 2;
constexpr size_t WS_GB = WS_GA + (size_t)NT * DM * 2;
constexpr size_t WS_NG = WS_GB + (size_t)NT * DM * 2;
constexpr size_t WS_MIX_END = WS_NG + (size_t)NT * 32 * 4;
constexpr size_t WS_H0 = WS_PROJ;
constexpr size_t WS_MGU = WS_BIG;
constexpr size_t WS_MDN = WS_MGU + (size_t)NEXP * 2 * FFE * DM * 2;
constexpr size_t WS_XS = WS_MDN + (size_t)NEXP * DM * FFE * 2;
constexpr size_t WS_HM = WS_XS + (size_t)MAXPANELS * 256 * DM * 2;
constexpr size_t WS_YM = WS_HM + (size_t)64 * 256 * FFE * 2;
constexpr size_t WS_MOE_END = WS_YM + (size_t)NT * 2 * DM * 2;
constexpr size_t WS_END = WS_MOE_END > WS_MIX_END ? WS_MOE_END : WS_MIX_END;

struct Args {
    const float* in[22]; float* out; unsigned char* ws; int ph_lo, ph_hi;
};
typedef const __attribute__((address_space(4))) Args* KArgsP;

struct EpiInProj {
    static constexpr bool PERM = false, HAS_MID = false;
    unsigned char* ws;
    __device__ __forceinline__ void operator()(const f32x4 (&acc)[2][2][4][2], const pg8::Unit& u, int wr, int wc, int fr, int fq) const {
        const int row0 = u.pm * 256 + wr * 64 + fr;
#pragma unroll
        for (int bj = 0; bj < 2; ++bj)
#pragma unroll
            for (int n = 0; n < 2; ++n) {
                const int cb = u.pn * 256 + bj * 128 + wc * 32 + n * 16;
                const int c = cb + 4 * fq;
                int kind = 0, ld = 512, co = 0; size_t base = 0; float sc = 1.f;
                if (cb < 512) { base = WS_QHG; co = c; }
                else if (cb < 1024) { kind = 1; base = WS_HF; co = c - 512; }
                else if (cb < 1536) { base = WS_HI; co = c - 1024; }
                else if (cb < 2048) { base = WS_HG; co = c - 1536; }
                else if (cb < 2560) { base = WS_NQ; co = c - 2048; sc = 0.125f * 1.4426950408889634f; }
                else if (cb < 3328) { kind = 3; base = WS_KV6; const int idx = cb - 2560; co = ((idx >> 7) * 8 + ((idx >> 6) & 1)) * SEQ * 64 + (idx & 63) + 4 * fq; }
                else if (cb < 4352) { base = WS_GA; co = c - 3328; ld = 1024; }
                else if (cb < 5376) { base = WS_GB; co = c - 4352; ld = 1024; }
                else if (cb < 5408) { kind = 1; base = WS_NG; co = c - 5376; ld = 32; }
                else kind = 2;
                if (kind == 2) continue;
#pragma unroll
                for (int ai = 0; ai < 2; ++ai)
#pragma unroll
                    for (int m = 0; m < 4; ++m) {
                        const int row = row0 + ai * 128 + m * 16;
                        const f32x4 v = acc[ai][bj][m][n];
                        if (kind == 0) { u32x2 w; w.x = cvt_pk_bf16(v[0] * sc, v[1] * sc); w.y = cvt_pk_bf16(v[2] * sc, v[3] * sc); *(u32x2*)((bf16*)(ws + base) + (size_t)row * ld + co) = w; }
                        else if (kind == 3) { u32x2 w; w.x = cvt_pk_bf16(v[0], v[1]); w.y = cvt_pk_bf16(v[2], v[3]); *(u32x2*)((bf16*)(ws + base) + (size_t)co + ((size_t)(row >> 13) * 2 * SEQ + (row & (SEQ - 1))) * 64) = w; }
                        else *(f32x4*)((float*)(ws + base) + (size_t)row * ld + co) = v;
                    }
            }
    }
};
struct EpiCmpHid {
    static constexpr bool PERM = false, HAS_MID = false;
    bf16* HID; const float* B1;
    __device__ __forceinline__ void operator()(const f32x4 (&acc)[2][2][4][2], const pg8::Unit& u, int wr, int wc, int fr, int fq) const {
        const int row0 = u.pm * 256 + wr * 64 + fr, col0 = wc * 32 + 4 * fq;
#pragma unroll
        for (int n = 0; n < 2; ++n) { const f32x4 bq = *(const f32x4*)(B1 + u.e * 128 + col0 + n * 16);
#pragma unroll
            for (int ai = 0; ai < 2; ++ai)
#pragma unroll
                for (int m = 0; m < 4; ++m) { const f32x4 v = acc[ai][0][m][n] + bq; float o[4];
#pragma unroll
                    for (int q = 0; q < 4; ++q) { const float x = v[q]; o[q] = 0.5f * x * (1.f + tanhf(0.7978845608028654f * (x + 0.044715f * x * x * x))); }
                    u32x2 w; w.x = cvt_pk_bf16(o[0], o[1]); w.y = cvt_pk_bf16(o[2], o[3]);
                    *(u32x2*)(HID + (size_t)(row0 + ai * 128 + m * 16) * 128 + col0 + n * 16) = w; } }
    }
};
template <bool FIRST> struct EpiGate {
    static constexpr bool PERM = false, HAS_MID = false;
    bf16* Y; const bf16* G;
    __device__ __forceinline__ void operator()(const f32x4 (&acc)[2][2][4][2], const pg8::Unit& u, int wr, int wc, int fr, int fq) const {
        const int row0 = u.pm * 256 + wr * 64 + fr, col0 = u.pn * 256 + wc * 32 + 4 * fq;
#pragma unroll
        for (int ai = 0; ai < 2; ++ai)
#pragma unroll
            for (int m = 0; m < 4; ++m)
#pragma unroll
                for (int bj = 0; bj < 2; ++bj)
#pragma unroll
                    for (int n = 0; n < 2; ++n) {
                        const size_t off = (size_t)(row0 + ai * 128 + m * 16) * DM + col0 + bj * 128 + n * 16;
                        const u32x2 gq = *(const u32x2*)(G + off);
                        const f32x4 v = acc[ai][bj][m][n];
                        float o0 = sigmoidf_(bflo(gq.x)) * v[0], o1 = sigmoidf_(bfhi(gq.x)) * v[1], o2 = sigmoidf_(bflo(gq.y)) * v[2], o3 = sigmoidf_(bfhi(gq.y)) * v[3];
                        if (!FIRST) { const u32x2 yq = *(const u32x2*)(Y + off); o0 += bflo(yq.x); o1 += bfhi(yq.x); o2 += bflo(yq.y); o3 += bfhi(yq.y); }
                        u32x2 w; w.x = cvt_pk_bf16(o0, o1); w.y = cvt_pk_bf16(o2, o3); *(u32x2*)(Y + off) = w;
                    }
    }
};
struct EpiGate2 {
    static constexpr bool PERM = false, HAS_MID = true;
    bf16* Y; const bf16* GA; const bf16* GB;
    static __device__ __forceinline__ float cl(float x) { return fminf(fmaxf(x, -30.f), 30.f); }
    __device__ __forceinline__ void mid(f32x4 (&acc)[2][2][4][2], const pg8::Unit& u, int wr, int wc, int fr, int fq) const {
        int row0 = u.pm * 256 + wr * 64 + fr; const int col0 = u.pn * 256 + wc * 32 + 4 * fq;
        asm volatile("" : "+v"(row0));
#pragma unroll
        for (int ai = 0; ai < 2; ++ai)
#pragma unroll
            for (int m = 0; m < 4; ++m) {
#pragma unroll
                for (int bj = 0; bj < 2; ++bj)
#pragma unroll
                    for (int n = 0; n < 2; ++n) {
                        const size_t off = (size_t)(row0 + ai * 128 + m * 16) * DM + col0 + bj * 128 + n * 16;
                        const u32x2 ga = *(const u32x2*)(GA + off), gb = *(const u32x2*)(GB + off);
                        f32x4 r;
                        r[0] = (1.f + __expf(-cl(bflo(gb.x)))) * __builtin_amdgcn_rcpf(1.f + __expf(-cl(bflo(ga.x))));
                        r[1] = (1.f + __expf(-cl(bfhi(gb.x)))) * __builtin_amdgcn_rcpf(1.f + __expf(-cl(bfhi(ga.x))));
                        r[2] = (1.f + __expf(-cl(bflo(gb.y)))) * __builtin_amdgcn_rcpf(1.f + __expf(-cl(bflo(ga.y))));
                        r[3] = (1.f + __expf(-cl(bfhi(gb.y)))) * __builtin_amdgcn_rcpf(1.f + __expf(-cl(bfhi(ga.y))));
                        acc[ai][bj][m][n] = acc[ai][bj][m][n] * r;
                    }
                asm volatile("" : "+v"(acc[ai][0][m][0]), "+v"(acc[ai][0][m][1]), "+v"(acc[ai][1][m][0]), "+v"(acc[ai][1][m][1]) :: "memory");
            }
    }
    __device__ __forceinline__ void operator()(const f32x4 (&acc)[2][2][4][2], const pg8::Unit& u, int wr, int wc, int fr, int fq) const {
        const int row0 = u.pm * 256 + wr * 64 + fr, col0 = u.pn * 256 + wc * 32 + 4 * fq;
#pragma unroll
        for (int ai = 0; ai < 2; ++ai)
#pragma unroll
            for (int m = 0; m < 4; ++m)
#pragma unroll
                for (int bj = 0; bj < 2; ++bj)
#pragma unroll
                    for (int n = 0; n < 2; ++n) {
                        const size_t off = (size_t)(row0 + ai * 128 + m * 16) * DM + col0 + bj * 128 + n * 16;
                        const u32x2 gb = *(const u32x2*)(GB + off);
                        const f32x4 v = acc[ai][bj][m][n];
                        u32x2 w; w.x = cvt_pk_bf16(v[0] * sigmoidf_(cl(bflo(gb.x))), v[1] * sigmoidf_(cl(bfhi(gb.x)))); w.y = cvt_pk_bf16(v[2] * sigmoidf_(cl(bflo(gb.y))), v[3] * sigmoidf_(cl(bfhi(gb.y))));
                        *(u32x2*)(Y + off) = w;
                    }
    }
};
struct EpiResid {
    static constexpr bool PERM = false, HAS_MID = false;
    const float* XI; float* XO;
    __device__ __forceinline__ void operator()(const f32x4 (&acc)[2][2][4][2], const pg8::Unit& u, int wr, int wc, int fr, int fq) const {
        const int row0 = u.pm * 256 + wr * 64 + fr, col0 = u.pn * 256 + wc * 32 + 4 * fq;
#pragma unroll
        for (int ai = 0; ai < 2; ++ai)
#pragma unroll
            for (int m = 0; m < 4; ++m)
#pragma unroll
                for (int bj = 0; bj < 2; ++bj)
#pragma unroll
                    for (int n = 0; n < 2; ++n) {
                        const size_t off = (size_t)(row0 + ai * 128 + m * 16) * DM + col0 + bj * 128 + n * 16;
                        const f32x4 xi = *(const f32x4*)(XI + off);
                        *(f32x4*)(XO + off) = xi * DN_ALPHA + acc[ai][bj][m][n];
                    }
    }
};
struct EpiSwiglu {
    static constexpr bool PERM = false, HAS_MID = false;
    bf16* H; int ldh;
    __device__ __forceinline__ void operator()(const f32x4 (&acc)[2][2][4][2], const pg8::Unit& u, int wr, int wc, int fr, int fq) const {
        const int row0 = u.pm * 256 + wr * 64 + fr, col0 = u.pn * 128 + wc * 32 + 4 * fq;
#pragma unroll
        for (int ai = 0; ai < 2; ++ai)
#pragma unroll
            for (int m = 0; m < 4; ++m)
#pragma unroll
                for (int n = 0; n < 2; ++n) {
                    const f32x4 gq = acc[ai][0][m][n], uq = acc[ai][1][m][n];
                    u32x2 w; w.x = cvt_pk_bf16(siluf_(gq[0]) * uq[0], siluf_(gq[1]) * uq[1]); w.y = cvt_pk_bf16(siluf_(gq[2]) * uq[2], siluf_(gq[3]) * uq[3]);
                    *(u32x2*)(H + (size_t)(row0 + ai * 128 + m * 16) * ldh + col0 + n * 16) = w;
                }
    }
};
struct EpiScatter {
    static constexpr bool PERM = false, HAS_MID = false;
    bf16* Y; const int* rowinfo;
    __device__ __forceinline__ void operator()(const f32x4 (&acc)[2][2][4][2], const pg8::Unit& u, int wr, int wc, int fr, int fq) const {
        const int row0 = u.pm * 256 + wr * 64 + fr, col0 = u.pn * 256 + wc * 32 + 4 * fq;
#pragma unroll
        for (int ai = 0; ai < 2; ++ai)
#pragma unroll
            for (int m = 0; m < 4; ++m) {
                const int info = rowinfo[row0 + ai * 128 + m * 16];
                if (info < 0) continue;
#pragma unroll
                for (int bj = 0; bj < 2; ++bj)
#pragma unroll
                    for (int n = 0; n < 2; ++n) {
                        const f32x4 v = acc[ai][bj][m][n];
                        u32x2 w; w.x = cvt_pk_bf16(v[0], v[1]); w.y = cvt_pk_bf16(v[2], v[3]);
                        *(u32x2*)(Y + (size_t)info * DM + col0 + bj * 128 + n * 16) = w;
                    }
            }
    }
};

template <int N> struct IConst { static constexpr int value = N; };
__device__ __forceinline__ int rel_bucket(int n) {
    if (n < 16) return n;
    return 16 + (n >= 22) + (n >= 30) + (n >= 40) + (n >= 54) + (n >= 73) + (n >= 99) + (n >= 134) + (n >= 182) + (n >= 246) + (n >= 332) + (n >= 450) + (n >= 609) + (n >= 825) + (n >= 1117) + (n >= 1513);
}
template <class F>
__device__ __forceinline__ void tr_item(F colptr, int ld, int Kvalid, bf16* dst, int dstld, int n0, int k0, LAS float* scr, int lane) {
    const float* cp = colptr(n0 + 4 * (lane & 7));
#pragma unroll
    for (int i = 0; i < 8; ++i) { const int kk = 8 * i + (lane >> 3), k = k0 + kk; f32x4 v = (f32x4){0.f, 0.f, 0.f, 0.f}; if (cp && k < Kvalid) v = *(const f32x4*)(cp + (size_t)k * ld);
        LAS float* s = scr + kk * 33 + 4 * (lane & 7); s[0] = v[0]; s[1] = v[1]; s[2] = v[2]; s[3] = v[3]; }
    WAVE_SYNC();
    const int c = lane & 7;
#pragma unroll
    for (int j = 0; j < 4; ++j) { const int n = (lane >> 3) + 8 * j; const LAS float* s = scr + (8 * c) * 33 + n;
        u32x4 o; o.x = cvt_pk_bf16(s[0 * 33], s[1 * 33]); o.y = cvt_pk_bf16(s[2 * 33], s[3 * 33]); o.z = cvt_pk_bf16(s[4 * 33], s[5 * 33]); o.w = cvt_pk_bf16(s[6 * 33], s[7 * 33]);
        *(u32x4*)(dst + (size_t)(n0 + n) * dstld + k0 + 8 * c) = o; }
    WAVE_SYNC();
}

__global__ void __launch_bounds__(NTHR, 2) mega_fwd(Args args) {
    extern __shared__ __attribute__((aligned(16))) unsigned char lds_raw[];
    LAS unsigned char* lds = (LAS unsigned char*)lds_raw;
    const int G = gridDim.x, bid = blockIdx.x;
    const int nwaves = G * NWAVES;
    KArgsP kap = (KArgsP)__builtin_amdgcn_kernarg_segment_ptr();
    unsigned char* ws0 = kap->ws;
#if ONE_LAUNCH
    constexpr int lo = 0, hi = 64;
#else
    const int lo = kap->ph_lo, hi = kap->ph_hi;
#endif

    volatile LAS unsigned* misc = (volatile LAS unsigned*)(lds + MISC_OFF);
    const int wave_s = __builtin_amdgcn_readfirstlane((int)threadIdx.x >> 6);
    if (wave_s == 0 && lane_id() < 16) misc[lane_id()] = 0u;
    __syncthreads();
    XcdBarrier bar; bar.bar = (unsigned*)(ws0 + WS_CTL + CW_BAR); bar.x = 0; bar.st = misc;
    const bool multi = (hi - lo) > 1;
    if (multi) bar = xcd_barrier_post((unsigned*)(ws0 + WS_CTL + CW_BAR), misc, wave_s == 0 && lane_id() == 0);
#ifndef EN_MASK
#define EN_MASK 0xFFFFFFFFu
#endif
#define EN(b) (((EN_MASK) >> (b)) & 1u)
#define IN(k) (lo <= (k) && (k) < hi)
#ifndef PROBE_GRP
#define PROBE_GRP -1
#endif
#define PROBE_K 4
#ifndef STAGGER_TICKS
#define STAGGER_TICKS 0
#endif
#ifndef SELREP
#define SELREP 1
#endif
#define WINREP 1
#define NSA_SGB 1
#define NSA_DUP_A 0
#define NSA_DUP_B 0
#define NSA_DUP_C 0
#ifndef PROBE_SCALE
#define PROBE_SCALE 1e-6f
#endif
#if PROBE_GRP >= 0
    unsigned long long pr_last = __builtin_amdgcn_s_memrealtime(), pr_acc = 0ull;
#define PMARK(g) do { const unsigned long long _n = __builtin_amdgcn_s_memrealtime(); if ((g) == PROBE_GRP) pr_acc += _n - pr_last; pr_last = _n; } while (0)
#else
    const unsigned long long pr_acc = 0ull; (void)pr_acc;
#define PMARK(g) do { } while (0)
#endif
#define SEAM(k, g) do { if (IN(k) && IN((k) + 1)) { XcdBarrier b_ = bar; asm volatile("" : "+s"(b_.bar)); unsigned bx_ = b_.x; asm volatile("" : "+s"(bx_)); b_.x = bx_; \
        xcd_barrier(b_, wave_s == 0 && lane_id() == 0); } PMARK(g); } while (0)


    if (EN(0) && IN(0)) { PHASE_IDS();
        LAS float* scr = (LAS float*)(lds + wave * 16384);
        constexpr int I_WIN = 16 * (NINP / 32), I_BR = 8 * 32, I_OUT = 16 * 32, I_GU = 16 * (NINP / 32), I_DN = (FF0P / 64) * 32;
        constexpr int I_W1 = 32 * 8;
        constexpr int NITEMS = 2 * (I_WIN + 2 * I_BR + I_OUT) + I_GU + I_DN + 4 * I_W1;
        for (int it = gwave; it < NITEMS; it += nwaves) {
            int r = it;
            if (r < 2 * I_WIN) { const int l = r / I_WIN; r %= I_WIN; const int nb = r % (NINP / 32), kb = r / (NINP / 32);
                const float* W = ap->in[1] + (size_t)l * DM * 5400;
                auto cp = [=](int n) -> const float* { int c; if (n < 3328) c = n; else if (n < 5376) c = n + 24; else if (n < 5400) c = n - 5376 + 3328; else return nullptr; return W + c; };
                tr_item(cp, 5400, DM, (bf16*)(ws + (l ? WS_WIN1 : WS_WIN0)), DM, nb * 32, kb * 64, scr, lane); continue; }
            r -= 2 * I_WIN;
            if (r < 4 * I_BR) { const int which = r / I_BR; r %= I_BR; const int l = which & 1, ab = which >> 1; const int nb = r % 32, kb = r / 32;
                const float* W = ap->in[ab ? 9 : 8] + (size_t)l * 512 * DM;
                auto cp = [=](int n) -> const float* { return W + n; };
                tr_item(cp, DM, 512, (bf16*)(ws + WS_WBA0 + (size_t)l * 2 * SZ_WBR) + ab * 512, DM, nb * 32, kb * 64, scr, lane); continue; }
            r -= 4 * I_BR;
            if (r < 2 * I_OUT) { const int l = r / I_OUT; r %= I_OUT; const int nb = r % 32, kb = r / 32;
                const float* W = ap->in[10] + (size_t)l * DM * DM;
                auto cp = [=](int n) -> const float* { return W + n; };
                tr_item(cp, DM, DM, (bf16*)(ws + (l ? WS_WOUT1 : WS_WOUT0)), DM, nb * 32, kb * 64, scr, lane); continue; }
            r -= 2 * I_OUT;
            if (r < I_GU) { const int nb = r % (NINP / 32), kb = r / (NINP / 32);
                const float* Wg = ap->in[15]; const float* Wu = ap->in[16];
                auto cp = [=](int n) -> const float* { const int pn = n >> 8, hf = (n >> 7) & 1, c = pn * 128 + (n & 127); if (c >= FF0) return nullptr; return (hf ? Wu : Wg) + c; };
                tr_item(cp, FF0, DM, (bf16*)(ws + WS_WGU0), DM, nb * 32, kb * 64, scr, lane); continue; }
            r -= I_GU;
            if (r >= I_DN) { r -= I_DN; const int lk = r / I_W1; r %= I_W1; const int nb = r % 8, kb = r / 8;
                const float* W = ap->in[5] + (size_t)lk * 2048 * 128;
                auto cp = [=](int n) -> const float* { return n < 128 ? W + n : nullptr; };
                tr_item(cp, 128, 2048, (bf16*)(ws + WS_W1T) + (size_t)lk * 256 * 2048, 2048, nb * 32, kb * 64, scr, lane); continue; }
            { const int nb = r % 32, kb = r / 32;
                const float* W = ap->in[17];
                auto cp = [=](int n) -> const float* { return W + n; };
                tr_item(cp, DM, FF0, (bf16*)(ws + WS_WDN0), FF0P, nb * 32, kb * 64, scr, lane); }
        }
        for (int row = gwave; row < NT; row += nwaves) {
            const f32x4* xr = (const f32x4*)(x_in + (size_t)row * DM);
            u32x2* o = (u32x2*)(XB + (size_t)row * DM);
#pragma unroll
            for (int j = 0; j < 4; ++j) { const f32x4 v = xr[64 * j + lane]; u32x2 w; w.x = cvt_pk_bf16(v[0], v[1]); w.y = cvt_pk_bf16(v[2], v[3]); o[64 * j + lane] = w; }
        }
        for (int o = gwave; o < 4 * 128; o += nwaves) { const int lk = o >> 7, j = o & 127; const float* PS = ap->in[4] + (size_t)lk * 2048; const float* W = ap->in[5] + (size_t)lk * 2048 * 128;
            float s = 0.f; for (int k = lane; k < 2048; k += 64) s += PS[k] * W[(size_t)k * 128 + j];
            s = wave_sum(s); if (lane == 0) ((float*)(ws + WS_B1))[o] = s; }
        if (bid == 0 && tid < 32) ((int*)(ws + WS_CTL + CW_PE32))[tid] = tid >> 4;
        if (bid == 0) {
            const float* lg = ap->in[2];
            const float a = lg[tid], b = lg[512 + tid], m = fmaxf(a, b), ea = expf(a - m), eb = expf(b - m), s = ea + eb, p0 = ea / s, p1 = eb / s;
            LBS[tid] = p0 - p0; LBS[512 + tid] = (p0 + p1) - p0;
        }
    }
    SEAM(0, 0);

    for (int l = 0; l < 2; ++l) {
        const int pb = 1 + l * 10;

        if (EN(1) && IN(pb + 0)) { PHASE_IDS();
            if (STAGGER_TICKS > 0 && ((bid >> 3) & 1)) { const unsigned long long t0 = __builtin_amdgcn_s_memrealtime(); while (__builtin_amdgcn_s_memrealtime() - t0 < (unsigned long long)STAGGER_TICKS) __builtin_amdgcn_s_sleep(8); }
            pg8::Gemm g{XB, (const bf16*)(ws + (l ? WS_WIN1 : WS_WIN0)), NT, NINP, DM, 0, 0, nullptr, 0};
            pg8::StaticOrder S; S.init(NT, NINP, G, bid);
            EpiInProj E{ws};
            pg8::gemm_phase<EpiInProj, pg8::StaticOrder>(lds, g, S, E, wave_s);
        }
        SEAM(pb + 0, 1);

        if (EN(2) && IN(pb + 1)) { PHASE_IDS();
            {
                constexpr int RS = 272;
                LAS float* bsf = (LAS float*)lds;
                LAS unsigned char* kd = lds + 32768;
                LAS unsigned char* vt = lds + 32768 + 64 * RS;
                const bf16* HI = (const bf16*)(ws + WS_HI); const float* HF = (const float*)(ws + WS_HF);
                bf16* US = (bf16*)(ws + WS_US); float* DEC = (float*)(ws + WS_DEC);
                const int d = tid & 127, tp = tid >> 7;
                const int d0 = 4 * (tid & 31), tg = tid >> 5;
                f32x4 zr[4]; u32x4 vp0, vp1;
                auto ld_z = [&](int it) { const int h = it & 3, ci = (it >> 2) & 127, b = it >> 9; const size_t tok0 = (size_t)b * SEQ + ci * 64;
#pragma unroll
                    for (int i = 0; i < 4; ++i) zr[i] = *(const f32x4*)(HF + (tok0 + tg + 16 * i) * 512 + h * 128 + d0);
                    const u32x4* src = (const u32x4*)(HI + (tok0 + (tid >> 3)) * 512 + h * 128) + (tid & 7) * 2; vp0 = src[0]; vp1 = src[1]; };
                ld_z(bid);
                LAS float* lbl = (LAS float*)(vt + 64 * RS);
                lbl[tid] = LBS[l * 512 + tid];
                __syncthreads();
                for (int item = bid; item < NB * 128 * 4; item += G) {
                    const int h = item & 3, ci = (item >> 2) & 127, b = item >> 9, bh = b * 4 + h;
                    const size_t tok0 = (size_t)b * SEQ + ci * 64;
                    const f32x4 lb4 = *(const LAS f32x4*)(lbl + h * 128 + d0);
                    f32x4 kk[4];
#pragma unroll
                    for (int i = 0; i < 4; ++i) { const int t = tg + 16 * i; f32x4 lg;
#pragma unroll
                        for (int c = 0; c < 4; ++c) { kk[i][c] = (1.f - lb4[c]) * __builtin_amdgcn_rcpf(1.f + __expf(zr[i][c])); lg[c] = __logf(1.f - kk[i][c]); }
                        *(LAS f32x4*)(bsf + t * 128 + d0) = lg; }
                    { const int t = tid >> 3, c8 = tid & 7; *(LAS u32x4*)(vt + t * RS + c8 * 32) = vp0; *(LAS u32x4*)(vt + t * RS + c8 * 32 + 16) = vp1; }
                    LDS_SYNC();
                    { float run = 0.f;
#pragma unroll
                        for (int i = 0; i < 16; ++i) { run += bsf[(16 * tp + i) * 128 + d]; bsf[(16 * tp + i) * 128 + d] = run; } }
                    LDS_SYNC();
                    float off = 0.f;
                    for (int p = 0; p < tp; ++p) off += bsf[(16 * p + 15) * 128 + d];
                    LDS_SYNC();
#pragma unroll
                    for (int i = 0; i < 16; ++i) bsf[(16 * tp + i) * 128 + d] += off;
                    LDS_SYNC();
                    { const f32x4 bl = *(const LAS f32x4*)(bsf + 63 * 128 + d0);
                        if (tg == 0) { f32x4 e; e[0] = __expf(bl[0]); e[1] = __expf(bl[1]); e[2] = __expf(bl[2]); e[3] = __expf(bl[3]); *(f32x4*)(DEC + ((size_t)bh * 128 + ci) * 128 + d0) = e; }
#pragma unroll
                        for (int i = 0; i < 4; ++i) { const int t = tg + 16 * i; const f32x4 bt = *(const LAS f32x4*)(bsf + t * 128 + d0);
                            u32x2 w; w.x = cvt_pk_bf16(kk[i][0] * __expf(bl[0] - bt[0]), kk[i][1] * __expf(bl[1] - bt[1])); w.y = cvt_pk_bf16(kk[i][2] * __expf(bl[2] - bt[2]), kk[i][3] * __expf(bl[3] - bt[3]));
                            *(LAS u32x2*)(kd + t * RS + d0 * 2) = w; } }
                    LDS_SYNC();
                    ld_z(min(item + G, NB * 128 * 4 - 1));
                    {
                        const int mi = wave >> 1, r31 = lane & 31, hh = lane >> 5, i16 = lane & 15, sub = (lane >> 4) & 1;
                        f32x16 acc[2];
#pragma unroll
                        for (int q = 0; q < 2; ++q)
#pragma unroll
                            for (int r = 0; r < 16; ++r) acc[q][r] = 0.f;
#pragma unroll
                        for (int st = 0; st < 4; ++st) {
                            const LAS unsigned char* ka = kd + (16 * st + 8 * hh + (i16 >> 2)) * RS + (32 * mi + 16 * sub + 4 * (i16 & 3)) * 2;
                            const s16x4 k0 = __builtin_amdgcn_ds_read_tr16_b64_v4i16((LAS s16x4*)ka), k1 = __builtin_amdgcn_ds_read_tr16_b64_v4i16((LAS s16x4*)(ka + 4 * RS));
                            const bf16x8 af = __builtin_shufflevector(k0, k1, 0, 1, 2, 3, 4, 5, 6, 7);
#pragma unroll
                            for (int q = 0; q < 2; ++q) { const int ni = 2 * (wave & 1) + q;
                                const LAS unsigned char* va = vt + (16 * st + 8 * hh + (i16 >> 2)) * RS + (32 * ni + 16 * sub + 4 * (i16 & 3)) * 2;
                                const s16x4 v0 = __builtin_amdgcn_ds_read_tr16_b64_v4i16((LAS s16x4*)va), v1 = __builtin_amdgcn_ds_read_tr16_b64_v4i16((LAS s16x4*)(va + 4 * RS));
                                const bf16x8 bf = __builtin_shufflevector(v0, v1, 0, 1, 2, 3, 4, 5, 6, 7);
                                acc[q] = __builtin_amdgcn_mfma_f32_32x32x16_bf16(af, bf, acc[q], 0, 0, 0); } }
                        bf16* u = US + ((size_t)bh * 128 + ci) * 16384;
#pragma unroll
                        for (int q = 0; q < 2; ++q) { const int dv = 32 * (2 * (wave & 1) + q) + r31;
#pragma unroll
                            for (int rq = 0; rq < 4; ++rq) { u32x2 w; w.x = cvt_pk_bf16(acc[q][4 * rq], acc[q][4 * rq + 1]); w.y = cvt_pk_bf16(acc[q][4 * rq + 2], acc[q][4 * rq + 3]);
                                *(u32x2*)(u + dv * 128 + 32 * mi + 8 * rq + 4 * hh) = w; } }
                    }
                    LDS_SYNC();
                }
            }
            {
                pg8::Gemm g{(const bf16*)(ws + WS_KV6), (const bf16*)(ws + WS_W1T) + (size_t)l * 2 * 256 * 2048, 8192, 256, 2048, (size_t)256 * 2048, 1024, nullptr, 0};
                pg8::StaticOrder S; S.init(8192, 256, G, bid, (const int*)(ws + WS_CTL + CW_PE32));
                EpiCmpHid E{(bf16*)(ws + WS_HID), (const float*)(ws + WS_B1) + l * 256};
                pg8::gemm_phase<EpiCmpHid, pg8::StaticOrder>(lds, g, S, E, wave_s);
            }
        }
        SEAM(pb + 1, 2);

        if (EN(3) && IN(pb + 2)) { PHASE_IDS();
            {
                unsigned* US32 = (unsigned*)(ws + WS_US); const float* DEC = (const float*)(ws + WS_DEC);
                for (int e2 = bid * NTHR + tid; e2 < 16 * 8192; e2 += G * NTHR) {
                    const int bh = e2 >> 13, dv2 = e2 & 8191, d = (2 * dv2) & 127;
                    float s0 = 0.f, s1 = 0.f;
#pragma unroll 1
                    for (int c0 = 0; c0 < 128; c0 += 16) {
                        unsigned u[16]; f32x2 dec[16];
#pragma unroll
                        for (int i = 0; i < 16; ++i) { u[i] = US32[((size_t)bh * 128 + c0 + i) * 8192 + dv2]; dec[i] = *(const f32x2*)(DEC + ((size_t)bh * 128 + c0 + i) * 128 + d); }
#pragma unroll
                        for (int i = 0; i < 16; ++i) { US32[((size_t)bh * 128 + c0 + i) * 8192 + dv2] = cvt_pk_bf16(s0, s1); s0 = dec[i][0] * s0 + bflo(u[i]); s1 = dec[i][1] * s1 + bfhi(u[i]); }
                    }
                }
            }
            {
                const bf16* HID = (const bf16*)(ws + WS_HID); bf16* KCb = (bf16*)(ws + WS_KC);
                for (int row = gwave; row < 8192; row += nwaves) { const int kind = row >> 12;
                    const float* W2 = ap->in[6] + ((size_t)l * 2 + kind) * 128 * 64;
                    const unsigned hv = ((const unsigned*)(HID + (size_t)row * 128))[lane];
                    float o = 0.f;
#pragma unroll 8
                    for (int j = 0; j < 64; ++j) { const unsigned hj = (unsigned)__builtin_amdgcn_readlane((int)hv, j); o += bflo(hj) * W2[(2 * j) * 64 + lane] + bfhi(hj) * W2[(2 * j + 1) * 64 + lane]; }
                    KCb[(size_t)row * 64 + lane] = f2bf(o); }
            }
        }
        SEAM(pb + 2, 3);

        if (EN(4) && IN(pb + 3)) {
          if (EN(16)) { PHASE_IDS();
            {
                constexpr int RS = 272;
                LAS float* bsf = (LAS float*)lds;
                LAS unsigned char* qh = lds + 32768;
                LAS unsigned char* q1 = qh + 64 * RS;
                LAS unsigned char* k0 = q1 + 32 * RS;
                LAS unsigned char* k1 = k0 + 32 * RS;
                LAS unsigned char* vt = k1 + 64 * RS;
                LAS float* ssq = (LAS float*)(vt + 64 * RS);
                LAS float* nwl = ssq + 256;
                LAS float* lbl = nwl + 512;
                bf16* QHG = (bf16*)(ws + WS_QHG); const bf16* HI = (const bf16*)(ws + WS_HI); const bf16* HG = (const bf16*)(ws + WS_HG); const float* HF = (const float*)(ws + WS_HF);
                const bf16* US = (const bf16*)(ws + WS_US);
                const float* NW = ap->in[3] + l * 512;
                const int d = tid & 127, tp = tid >> 7;
                const int d0 = 4 * (tid & 31), tg = tid >> 5;
                f32x4 z4[4]; u32x2 qp[4];
                auto ld_zq = [&](int it) { const int h = it & 3, ci = (it >> 2) & 127, b = it >> 9; const size_t tok0 = (size_t)b * SEQ + ci * 64;
#pragma unroll
                    for (int i = 0; i < 4; ++i) { const size_t go = (tok0 + tg + 16 * i) * 512 + h * 128 + d0; z4[i] = *(const f32x4*)(HF + go); qp[i] = *(const u32x2*)(QHG + go); } };
                ld_zq(bid);
                nwl[tid] = NW[tid]; lbl[tid] = LBS[l * 512 + tid];
                __syncthreads();
                int item = bid;
                do {
                    const int h = item & 3, ci = (item >> 2) & 127, b = item >> 9, bh = b * 4 + h;
                    const size_t tok0 = (size_t)b * SEQ + ci * 64;
                    const f32x4 lb4 = *(const LAS f32x4*)(lbl + h * 128 + d0);
                    f32x4 kk[4];
                    {
#pragma unroll
                        for (int i = 0; i < 4; ++i) { const int t = tg + 16 * i; f32x4 lg;
#pragma unroll
                            for (int c = 0; c < 4; ++c) { kk[i][c] = (1.f - lb4[c]) * __builtin_amdgcn_rcpf(1.f + __expf(z4[i][c])); lg[c] = __logf(1.f - kk[i][c]); }
                            *(LAS f32x4*)(bsf + t * 128 + d0) = lg; } }
                    { const int t = tid >> 3, c8 = tid & 7;
                        const u32x4* src = (const u32x4*)(HI + (tok0 + t) * 512 + h * 128) + c8 * 2;
                        const u32x4 a0 = src[0], a1 = src[1]; *(LAS u32x4*)(vt + t * RS + c8 * 32) = a0; *(LAS u32x4*)(vt + t * RS + c8 * 32 + 16) = a1; }
                    bf16x8 sf[8];
                    { const bf16* Sg = US + ((size_t)bh * 128 + ci) * 16384 + (size_t)(32 * (wave & 3) + (lane & 31)) * 128 + 8 * (lane >> 5);
#pragma unroll
                        for (int st = 0; st < 8; ++st) sf[st] = *(const bf16x8*)(Sg + 16 * st); }
                    LDS_SYNC();
                    { float run = 0.f;
#pragma unroll
                        for (int i = 0; i < 16; ++i) { run += bsf[(16 * tp + i) * 128 + d]; bsf[(16 * tp + i) * 128 + d] = run; } }
                    LDS_SYNC();
                    float off = 0.f;
                    for (int p = 0; p < tp; ++p) off += bsf[(16 * p + 15) * 128 + d];
                    LDS_SYNC();
#pragma unroll
                    for (int i = 0; i < 16; ++i) bsf[(16 * tp + i) * 128 + d] += off;
                    LDS_SYNC();
                    { const f32x4 b31 = *(const LAS f32x4*)(bsf + 31 * 128 + d0);
#pragma unroll
                        for (int i = 0; i < 4; ++i) { const int t = tg + 16 * i; const f32x4 bt = *(const LAS f32x4*)(bsf + t * 128 + d0);
                            const float q0 = bflo(qp[i].x), q1v = bfhi(qp[i].x), q2 = bflo(qp[i].y), q3 = bfhi(qp[i].y);
                            u32x2 w;
                            w.x = cvt_pk_bf16(q0 * __expf(bt[0]), q1v * __expf(bt[1])); w.y = cvt_pk_bf16(q2 * __expf(bt[2]), q3 * __expf(bt[3]));
                            *(LAS u32x2*)(qh + t * RS + d0 * 2) = w;
                            w.x = cvt_pk_bf16(kk[i][0] * __expf(fminf(b31[0] - bt[0], 80.f)), kk[i][1] * __expf(fminf(b31[1] - bt[1], 80.f)));
                            w.y = cvt_pk_bf16(kk[i][2] * __expf(fminf(b31[2] - bt[2], 80.f)), kk[i][3] * __expf(fminf(b31[3] - bt[3], 80.f)));
                            *(LAS u32x2*)(k1 + t * RS + d0 * 2) = w;
                            if (i < 2) {
                                w.x = cvt_pk_bf16(kk[i][0] * __expf(fminf(-bt[0], 80.f)), kk[i][1] * __expf(fminf(-bt[1], 80.f)));
                                w.y = cvt_pk_bf16(kk[i][2] * __expf(fminf(-bt[2], 80.f)), kk[i][3] * __expf(fminf(-bt[3], 80.f)));
                                *(LAS u32x2*)(k0 + t * RS + d0 * 2) = w;
                            } else {
                                w.x = cvt_pk_bf16(q0 * __expf(bt[0] - b31[0]), q1v * __expf(bt[1] - b31[1])); w.y = cvt_pk_bf16(q2 * __expf(bt[2] - b31[2]), q3 * __expf(bt[3] - b31[3]));
                                *(LAS u32x2*)(q1 + (t - 32) * RS + d0 * 2) = w; } } }
                    LDS_SYNC();
                    {
                        const int ni = wave & 3, mi = wave >> 2, r31 = lane & 31, hh = lane >> 5, i16 = lane & 15, sub = (lane >> 4) & 1;
                        f32x16 acc;
#pragma unroll
                        for (int r = 0; r < 16; ++r) acc[r] = 0.f;
#pragma unroll
                        for (int st = 0; st < 8; ++st) { const bf16x8 bq = *(const LAS bf16x8*)(qh + (32 * mi + r31) * RS + (16 * st + 8 * hh) * 2);
                            acc = __builtin_amdgcn_mfma_f32_32x32x16_bf16(sf[st], bq, acc, 0, 0, 0); }
#pragma unroll
                        for (int jb = 0; jb < 2; ++jb) { if (jb > mi) continue;
                            f32x16 x;
#pragma unroll
                            for (int r = 0; r < 16; ++r) x[r] = 0.f;
                            const LAS unsigned char* kb = (mi == 0) ? k0 : (k1 + 32 * jb * RS);
                            const LAS unsigned char* qb = (mi == 0) ? qh : q1;
#pragma unroll
                            for (int st = 0; st < 8; ++st) { const bf16x8 ka = *(const LAS bf16x8*)(kb + r31 * RS + (16 * st + 8 * hh) * 2), qq = *(const LAS bf16x8*)(qb + r31 * RS + (16 * st + 8 * hh) * 2);
                                x = __builtin_amdgcn_mfma_f32_32x32x16_bf16(ka, qq, x, 0, 0, 0); }
                            if (jb == mi) {
#pragma unroll
                                for (int r = 0; r < 16; ++r) { const int key = (r & 3) + 8 * (r >> 2) + 4 * hh; if (key > r31) x[r] = 0.f; } }
#pragma unroll
                            for (int s2 = 0; s2 < 2; ++s2) { u32x4 w; w.x = cvt_pk_bf16(x[8 * s2], x[8 * s2 + 1]); w.y = cvt_pk_bf16(x[8 * s2 + 2], x[8 * s2 + 3]); w.z = cvt_pk_bf16(x[8 * s2 + 4], x[8 * s2 + 5]); w.w = cvt_pk_bf16(x[8 * s2 + 6], x[8 * s2 + 7]);
                                const bf16x8 xb = __builtin_bit_cast(bf16x8, w);
                                const LAS unsigned char* va = vt + (32 * jb + 16 * s2 + 4 * hh + (i16 >> 2)) * RS + (32 * ni + 16 * sub + 4 * (i16 & 3)) * 2;
                                const s16x4 v0 = __builtin_amdgcn_ds_read_tr16_b64_v4i16((LAS s16x4*)va), v1 = __builtin_amdgcn_ds_read_tr16_b64_v4i16((LAS s16x4*)(va + 8 * RS));
                                const bf16x8 vf = __builtin_shufflevector(v0, v1, 0, 1, 2, 3, 4, 5, 6, 7);
                                acc = __builtin_amdgcn_mfma_f32_32x32x16_bf16(vf, xb, acc, 0, 0, 0); } }
                        u32x2 gq4[4];
                        { const size_t gg = (tok0 + 32 * mi + r31) * 512 + h * 128 + 32 * ni + 4 * hh;
#pragma unroll
                          for (int rq = 0; rq < 4; ++rq) gq4[rq] = *(const u32x2*)(HG + gg + 8 * rq); }
                        ld_zq(min(item + G, NB * 128 * 4 - 1));
                        float ss = 0.f;
#pragma unroll
                        for (int r = 0; r < 16; ++r) ss += acc[r] * acc[r];
                        ss += __shfl_xor(ss, 32);
                        if (hh == 0) ssq[ni * 64 + 32 * mi + r31] = ss;
                        LDS_SYNC();
                        const int tl = 32 * mi + r31;
                        const float tot = ssq[tl] + ssq[64 + tl] + ssq[128 + tl] + ssq[192 + tl];
                        const float rn = rsqrtf(tot * (1.f / 128.f) + 1e-6f);
                        const size_t go = (tok0 + tl) * 512 + h * 128 + 32 * ni + 4 * hh;
#pragma unroll
                        for (int rq = 0; rq < 4; ++rq) { const u32x2 gq = gq4[rq]; const f32x4 nw = *(const LAS f32x4*)(nwl + h * 128 + 32 * ni + 4 * hh + 8 * rq);
                            u32x2 w; w.x = cvt_pk_bf16(acc[4 * rq] * rn * nw[0] * siluf_(bflo(gq.x)), acc[4 * rq + 1] * rn * nw[1] * siluf_(bfhi(gq.x)));
                            w.y = cvt_pk_bf16(acc[4 * rq + 2] * rn * nw[2] * siluf_(bflo(gq.y)), acc[4 * rq + 3] * rn * nw[3] * siluf_(bfhi(gq.y)));
                            *(u32x2*)(QHG + go + 8 * rq) = w; }
                    }
                    LDS_SYNC();
                    item += G;
                } while (item < NB * 128 * 4);
            }
          }
          PMARK(15);
          if (EN(17)) { PHASE_IDS();
            {
                constexpr int KST = 144, TB = 9216;
                constexpr float LOG2E = 1.4426950408889634f;
                LAS unsigned char* kvb = lds;
                LAS float* lut = (LAS float*)(lds + 4 * TB);
                LAS float* impW = (LAS float*)(lds + 4 * TB + 32768 + wave * 8192);
                LAS unsigned* selm = (LAS unsigned*)(lds + 4 * TB + 32768 + 65536);
                const bf16* NQ = (const bf16*)(ws + WS_NQ); const bf16* KVT = (const bf16*)(ws + WS_KV6); const bf16* KCb = (const bf16*)(ws + WS_KC);
                const float* NG = (const float*)(ws + WS_NG); const float* RB = ap->in[7];
                bf16* OB = (bf16*)(ws + WS_NQ);
                const float NINF = -__builtin_inff();
                const bool lut_once = (G & 7) == 0;
                LAS float* gld = (LAS float*)(lds + 4 * TB + 32768 + 65536 + 1024) + wave * 96;
                if (lut_once) { const int g = bid & 1; __syncthreads();
                    for (int d = tid; d < 2048; d += NTHR) { const int bk = rel_bucket(d); *(LAS f32x4*)(lut + d * 4) = *(const f32x4*)(RB + bk * 8 + g * 4) * LOG2E; } }
                for (int pq = bid; pq < 512; pq += G)
#pragma unroll 1
                for (int odd = 0; odd < 2; ++odd) {
                    const int bg = pq & 7, xx = pq >> 3, tile = odd ? 127 - xx : xx, b = bg >> 1, g = bg & 1, t0 = tile * 64, cur = tile;
                    int lane_u = lane; asm volatile("" : "+v"(lane_u));
                    const int col = lane_u & 15, q4 = lane_u >> 4, head = col & 3, ti = col >> 2;
                    LAS float* ocl = impW + lane_u;
                    const size_t tokw = (size_t)b * SEQ + t0 + 8 * wave;
                    int tq[2]; bf16x8 qf[2][2];
                    auto gatev = [&](int gq, int br) -> float { return gld[(gq * 3 + br) * 16 + col]; };
                    float gl[6];
#pragma unroll
                    for (int gq = 0; gq < 2; ++gq)
#pragma unroll
                        for (int br = 0; br < 3; ++br) gl[gq * 3 + br] = NG[(tokw + 4 * gq + ti) * 32 + (g * 4 + head) * 3 + br];
#pragma unroll
                    for (int gq = 0; gq < 2; ++gq) { tq[gq] = t0 + 8 * wave + 4 * gq + ti; const size_t tok = tokw + 4 * gq + ti;
#pragma unroll
                        for (int s = 0; s < 2; ++s) qf[gq][s] = *(const bf16x8*)(NQ + tok * 512 + (g * 4 + head) * 64 + 32 * s + 8 * q4);
                    }
                    const float bfar = RB[31 * 8 + g * 4 + head] * LOG2E;
                    __syncthreads();
                    if (!lut_once) for (int d = tid; d < 2048; d += NTHR) { const int bk = rel_bucket(d); *(LAS f32x4*)(lut + d * 4) = *(const f32x4*)(RB + bk * 8 + g * 4) * LOG2E; }
                    for (int i = lane; i < 8 * 128; i += 64) impW[i] = 0.f;
                    f32x4 O[2][4], Ls[2];
                    float m[2], l[2], m1[2] = {0.f, 0.f}, linv[2] = {0.f, 0.f}, carry[2] = {0.f, 0.f};
                    const bf16x8 ones8 = {0x3F80, 0x3F80, 0x3F80, 0x3F80, 0x3F80, 0x3F80, 0x3F80, 0x3F80};
                    auto soft = [&](const int mode, const int gq, f32x4 (&st)[4], bf16x8 (&pb)[2], const int pos0, const bool far, const bool full, const float cbias, const bool colsel, const int sblk0) {
                        float tmax = NINF;
                        if (far) {
#pragma unroll
                            for (int kt = 0; kt < 4; ++kt)
#pragma unroll
                                for (int r = 0; r < 4; ++r) tmax = fmaxf(tmax, st[kt][r]);
                            tmax += cbias;
                        } else if (mode >= 2) {
                            const int dbase = tq[gq] - (pos0 + 4 * q4);
                            const LAS float* lb = lut + (dbase - 51) * 4 + head;
                            const float cadd = (mode == 2 && !colsel) ? NINF : 0.f;
                            float bv[4][4];
#pragma unroll
                            for (int kt = 0; kt < 4; ++kt)
#pragma unroll
                                for (int r = 0; r < 4; ++r) bv[kt][r] = lb[(51 - 16 * kt - r) * 4];
                            asm volatile("" : "+v"(bv[0][0]), "+v"(bv[0][1]), "+v"(bv[0][2]), "+v"(bv[0][3]), "+v"(bv[1][0]), "+v"(bv[1][1]), "+v"(bv[1][2]), "+v"(bv[1][3]));
                            asm volatile("" : "+v"(bv[2][0]), "+v"(bv[2][1]), "+v"(bv[2][2]), "+v"(bv[2][3]), "+v"(bv[3][0]), "+v"(bv[3][1]), "+v"(bv[3][2]), "+v"(bv[3][3]));
#pragma unroll
                            for (int kt = 0; kt < 4; ++kt)
#pragma unroll
                                for (int r = 0; r < 4; ++r) { float sv = st[kt][r] + bv[kt][r];
                                    if (mode == 2) sv += cadd;
                                    if (!full) { const int dist = dbase - (16 * kt + r); const bool valid = (mode == 3) ? ((unsigned)dist < 512u) : (dist >= 0); sv = valid ? sv : NINF; }
                                    st[kt][r] = sv; tmax = fmaxf(tmax, sv); }
                        } else {
                            const int dbase = tq[gq] - 16 * (pos0 + 4 * q4) - 31;
                            float bv[4][4];
#pragma unroll
                            for (int kt = 0; kt < 4; ++kt)
#pragma unroll
                                for (int r = 0; r < 4; ++r) { const int dist = dbase - 16 * (16 * kt + r); const unsigned di = (unsigned)dist < 2047u ? (unsigned)dist : 2047u; bv[kt][r] = lut[di * 4 + head]; }
#pragma unroll
                            for (int kt = 0; kt < 4; ++kt)
#pragma unroll
                                for (int r = 0; r < 4; ++r) { float sv = st[kt][r] + bv[kt][r];
                                    if (!full) { const int dist = dbase - 16 * (16 * kt + r); sv = (dist >= 0) ? sv : NINF; }
                                    st[kt][r] = sv; tmax = fmaxf(tmax, sv); }
                        }
                        float muse;
                        if (mode == 1) muse = m1[gq];
                        else {
                            tmax = max_x16(tmax); tmax = max_x32(tmax);
                            const float mnew = fmaxf(m[gq], tmax);
                            if (__any(mnew != m[gq])) {
                                const float mu = (mnew == NINF) ? 0.f : mnew;
                                const float alpha = __builtin_amdgcn_exp2f(m[gq] - mu);
                                m[gq] = mnew; l[gq] *= alpha;
                                if (mode >= 2) { Ls[gq] = Ls[gq] * alpha;
#pragma unroll
                                    for (int mt = 0; mt < 4; ++mt) O[gq][mt] = O[gq][mt] * alpha; }
                            }
                            muse = (m[gq] == NINF) ? 0.f : m[gq];
                        }
                        const float esub = far ? muse - cbias : muse;
                        float ls = 0.f;
#pragma unroll
                        for (int kt = 0; kt < 4; ++kt)
#pragma unroll
                            for (int r = 0; r < 4; ++r) { float p = __builtin_amdgcn_exp2f(st[kt][r] - esub); if (mode == 1) p *= linv[gq]; st[kt][r] = p; if (mode <= 1) ls += p; }
#if NSA_DUP_B
                        if (mode == 2) { float acc2 = 0.f;
#pragma unroll
                            for (int kt = 0; kt < 4; ++kt)
#pragma unroll
                                for (int r = 0; r < 4; ++r) { float x = st[kt][r]; asm volatile("" : "+v"(x)); const float p2 = __builtin_amdgcn_exp2f(x * 0.5f - esub); acc2 = fmaxf(acc2, p2 + x); }
                            asm volatile("" :: "v"(acc2)); }
#endif
                        if (mode <= 1) l[gq] += ls;
                        if (mode == 1) {
                            float a[4], h3[4];
#pragma unroll
                            for (int kt = 0; kt < 4; ++kt) { a[kt] = st[kt][0] + st[kt][1] + st[kt][2] + 0.5f * st[kt][3]; h3[kt] = 0.5f * st[kt][3];
                                a[kt] += dpp_x1(a[kt]); a[kt] += dpp_x2(a[kt]); h3[kt] += dpp_x1(h3[kt]); h3[kt] += dpp_x2(h3[kt]); }
#pragma unroll
                            for (int kt = 0; kt < 4; ++kt) { const float give = (q4 == 3) ? (kt > 0 ? h3[kt - 1] : carry[gq]) : h3[kt];
                                const float prev = __shfl(give, (lane - 16) & 63);
                                if (head == 0) impW[(4 * gq + ti) * 128 + sblk0 + 4 * kt + q4] = a[kt] + prev; }
                            carry[gq] = h3[3];
                        }
                        if (mode != 0) {
#pragma unroll
                            for (int s = 0; s < 2; ++s) { u32x4 w; w.x = cvt_pk_bf16(st[2 * s][0], st[2 * s][1]); w.y = cvt_pk_bf16(st[2 * s][2], st[2 * s][3]);
                                w.z = cvt_pk_bf16(st[2 * s + 1][0], st[2 * s + 1][1]); w.w = cvt_pk_bf16(st[2 * s + 1][2], st[2 * s + 1][3]); pb[s] = __builtin_bit_cast(bf16x8, w); } }
                    };
                    auto tile2 = [&](const int mode, const LAS unsigned char* kbuf, const LAS unsigned char* vbuf, const int pos0, const bool far, const bool full, const bool a0, const bool a1,
                                     const float cb0, const float cb1, const bool cs0, const bool cs1, const int sblk0) {
                        f32x4 st0[4], st1[4]; bf16x8 pb0[2], pb1[2];
#pragma unroll
                        for (int kt = 0; kt < 4; ++kt) {
                            const bf16x8 kf0 = *(const LAS bf16x8*)(kbuf + (16 * kt + col) * KST + 16 * q4), kf1 = *(const LAS bf16x8*)(kbuf + (16 * kt + col) * KST + 64 + 16 * q4);
                            if (a0) { st0[kt] = __builtin_amdgcn_mfma_f32_16x16x32_bf16(kf0, qf[0][0], (f32x4){0.f, 0.f, 0.f, 0.f}, 0, 0, 0); st0[kt] = __builtin_amdgcn_mfma_f32_16x16x32_bf16(kf1, qf[0][1], st0[kt], 0, 0, 0); }
                            if (a1) { st1[kt] = __builtin_amdgcn_mfma_f32_16x16x32_bf16(kf0, qf[1][0], (f32x4){0.f, 0.f, 0.f, 0.f}, 0, 0, 0); st1[kt] = __builtin_amdgcn_mfma_f32_16x16x32_bf16(kf1, qf[1][1], st1[kt], 0, 0, 0); } }
#if NSA_DUP_A
                        if (mode == 2) {
#pragma unroll
                            for (int kt = 0; kt < 4; ++kt) {
                                const bf16x8 kf0 = *(const LAS bf16x8*)(kbuf + (16 * kt + col) * KST + 16 * q4 + 32), kf1 = *(const LAS bf16x8*)(kbuf + (16 * kt + col) * KST + 64 + 16 * q4 - 32);
                                f32x4 d0 = __builtin_amdgcn_mfma_f32_16x16x32_bf16(kf0, qf[0][0], (f32x4){0.f, 0.f, 0.f, 0.f}, 0, 0, 0); d0 = __builtin_amdgcn_mfma_f32_16x16x32_bf16(kf1, qf[0][1], d0, 0, 0, 0);
                                f32x4 d1 = __builtin_amdgcn_mfma_f32_16x16x32_bf16(kf0, qf[1][0], (f32x4){0.f, 0.f, 0.f, 0.f}, 0, 0, 0); d1 = __builtin_amdgcn_mfma_f32_16x16x32_bf16(kf1, qf[1][1], d1, 0, 0, 0);
                                asm volatile("" :: "v"(d0), "v"(d1)); } }
#endif
                        if (a0) soft(mode, 0, st0, pb0, pos0, far, full, cb0, cs0, sblk0);
                        if (a1) soft(mode, 1, st1, pb1, pos0, far, full, cb1, cs1, sblk0);
                        if (mode == 0) return;
#pragma unroll
                        for (int mt = 0; mt < 4; ++mt)
#pragma unroll
                            for (int s = 0; s < 2; ++s) { const LAS unsigned char* a = vbuf + (32 * s + 4 * q4 + (col >> 2)) * KST + (16 * mt + 4 * (col & 3)) * 2;
                                const s16x4 lo = __builtin_amdgcn_ds_read_tr16_b64_v4i16((LAS s16x4*)a), hi = __builtin_amdgcn_ds_read_tr16_b64_v4i16((LAS s16x4*)(a + 16 * KST));
                                const bf16x8 vfs = __builtin_shufflevector(lo, hi, 0, 1, 2, 3, 4, 5, 6, 7);
                                if (a0) O[0][mt] = __builtin_amdgcn_mfma_f32_16x16x32_bf16(vfs, pb0[s], O[0][mt], 0, 0, 0);
                                if (a1) O[1][mt] = __builtin_amdgcn_mfma_f32_16x16x32_bf16(vfs, pb1[s], O[1][mt], 0, 0, 0); }
                        if (mode >= 2) {
#pragma unroll
                            for (int s = 0; s < 2; ++s) { if (a0) Ls[0] = __builtin_amdgcn_mfma_f32_16x16x32_bf16(ones8, pb0[s], Ls[0], 0, 0, 0); if (a1) Ls[1] = __builtin_amdgcn_mfma_f32_16x16x32_bf16(ones8, pb1[s], Ls[1], 0, 0, 0); } }
                    };
                    auto soft_far = [&](const int gq, f32x4 (&st)[4], bf16x8 (&pb)[2], const float mu_old) {
                        float tmax = fmaxf(fmaxf(fmaxf(st[0][0], st[0][1]), fmaxf(st[0][2], st[0][3])), fmaxf(fmaxf(st[1][0], st[1][1]), fmaxf(st[1][2], st[1][3])));
                        tmax = fmaxf(tmax, fmaxf(fmaxf(fmaxf(st[2][0], st[2][1]), fmaxf(st[2][2], st[2][3])), fmaxf(fmaxf(st[3][0], st[3][1]), fmaxf(st[3][2], st[3][3]))));
                        tmax = max_x16(tmax); tmax = max_x32(tmax);
                        if (__any(tmax > 8.f || (m[gq] == NINF && tmax != NINF))) {
                            const float mnew = fmaxf(m[gq], mu_old + tmax), mu = (mnew == NINF) ? 0.f : mnew, alpha = __builtin_amdgcn_exp2f(m[gq] - mu), delta = mu - mu_old;
                            m[gq] = mnew; Ls[gq] = Ls[gq] * alpha;
#pragma unroll
                            for (int mt = 0; mt < 4; ++mt) O[gq][mt] = O[gq][mt] * alpha;
#pragma unroll
                            for (int kt = 0; kt < 4; ++kt)
#pragma unroll
                                for (int r = 0; r < 4; ++r) st[kt][r] -= delta;
                        }
#pragma unroll
                        for (int kt = 0; kt < 4; ++kt)
#pragma unroll
                            for (int r = 0; r < 4; ++r) st[kt][r] = __builtin_amdgcn_exp2f(st[kt][r]);
#pragma unroll
                        for (int s = 0; s < 2; ++s) { u32x4 w; w.x = cvt_pk_bf16(st[2 * s][0], st[2 * s][1]); w.y = cvt_pk_bf16(st[2 * s][2], st[2 * s][3]);
                            w.z = cvt_pk_bf16(st[2 * s + 1][0], st[2 * s + 1][1]); w.w = cvt_pk_bf16(st[2 * s + 1][2], st[2 * s + 1][3]); pb[s] = __builtin_bit_cast(bf16x8, w); }
                    };
                    auto tile_far2 = [&](const LAS unsigned char* kbuf, const LAS unsigned char* vbuf, const float cb0, const float cb1) {
                        f32x4 st0[4], st1[4]; bf16x8 pb0[2], pb1[2];
                        const float mu0 = (m[0] == NINF) ? 0.f : m[0], mu1 = (m[1] == NINF) ? 0.f : m[1];
                        const float c0 = cb0 - mu0, c1 = cb1 - mu1;
                        const f32x4 ci0 = {c0, c0, c0, c0}, ci1 = {c1, c1, c1, c1};
#pragma unroll
                        for (int kt = 0; kt < 4; ++kt) { const bf16x8 kf0 = *(const LAS bf16x8*)(kbuf + (16 * kt + col) * KST + 16 * q4), kf1 = *(const LAS bf16x8*)(kbuf + (16 * kt + col) * KST + 64 + 16 * q4);
                            st0[kt] = __builtin_amdgcn_mfma_f32_16x16x32_bf16(kf0, qf[0][0], ci0, 0, 0, 0); st0[kt] = __builtin_amdgcn_mfma_f32_16x16x32_bf16(kf1, qf[0][1], st0[kt], 0, 0, 0);
                            st1[kt] = __builtin_amdgcn_mfma_f32_16x16x32_bf16(kf0, qf[1][0], ci1, 0, 0, 0); st1[kt] = __builtin_amdgcn_mfma_f32_16x16x32_bf16(kf1, qf[1][1], st1[kt], 0, 0, 0); }
                        soft_far(0, st0, pb0, mu0);
                        soft_far(1, st1, pb1, mu1);
#pragma unroll
                        for (int mt = 0; mt < 4; ++mt)
#pragma unroll
                            for (int s = 0; s < 2; ++s) { const LAS unsigned char* a = vbuf + (32 * s + 4 * q4 + (col >> 2)) * KST + (16 * mt + 4 * (col & 3)) * 2;
                                const s16x4 lo = __builtin_amdgcn_ds_read_tr16_b64_v4i16((LAS s16x4*)a), hi = __builtin_amdgcn_ds_read_tr16_b64_v4i16((LAS s16x4*)(a + 16 * KST));
                                const bf16x8 vfs = __builtin_shufflevector(lo, hi, 0, 1, 2, 3, 4, 5, 6, 7);
                                O[0][mt] = __builtin_amdgcn_mfma_f32_16x16x32_bf16(vfs, pb0[s], O[0][mt], 0, 0, 0);
                                O[1][mt] = __builtin_amdgcn_mfma_f32_16x16x32_bf16(vfs, pb1[s], O[1][mt], 0, 0, 0); }
#pragma unroll
                        for (int s = 0; s < 2; ++s) { Ls[0] = __builtin_amdgcn_mfma_f32_16x16x32_bf16(ones8, pb0[s], Ls[0], 0, 0, 0); Ls[1] = __builtin_amdgcn_mfma_f32_16x16x32_bf16(ones8, pb1[s], Ls[1], 0, 0, 0); }
                    };
                    auto tile_far1 = [&](auto gqc, const LAS unsigned char* kbuf, const LAS unsigned char* vbuf, const float cbx) {
                        constexpr int gq = decltype(gqc)::value;
                        f32x4 st[4]; bf16x8 pb[2];
                        const float mu = (m[gq] == NINF) ? 0.f : m[gq], c = cbx - mu;
                        const f32x4 ci = {c, c, c, c};
#pragma unroll
                        for (int kt = 0; kt < 4; ++kt) { const bf16x8 kf0 = *(const LAS bf16x8*)(kbuf + (16 * kt + col) * KST + 16 * q4), kf1 = *(const LAS bf16x8*)(kbuf + (16 * kt + col) * KST + 64 + 16 * q4);
                            st[kt] = __builtin_amdgcn_mfma_f32_16x16x32_bf16(kf0, qf[gq][0], ci, 0, 0, 0); st[kt] = __builtin_amdgcn_mfma_f32_16x16x32_bf16(kf1, qf[gq][1], st[kt], 0, 0, 0); }
                        soft_far(gq, st, pb, mu);
#pragma unroll
                        for (int mt = 0; mt < 4; ++mt)
#pragma unroll
                            for (int s = 0; s < 2; ++s) { const LAS unsigned char* a = vbuf + (32 * s + 4 * q4 + (col >> 2)) * KST + (16 * mt + 4 * (col & 3)) * 2;
                                const s16x4 lo = __builtin_amdgcn_ds_read_tr16_b64_v4i16((LAS s16x4*)a), hi = __builtin_amdgcn_ds_read_tr16_b64_v4i16((LAS s16x4*)(a + 16 * KST));
                                const bf16x8 vfs = __builtin_shufflevector(lo, hi, 0, 1, 2, 3, 4, 5, 6, 7);
                                O[gq][mt] = __builtin_amdgcn_mfma_f32_16x16x32_bf16(vfs, pb[s], O[gq][mt], 0, 0, 0); }
#pragma unroll
                        for (int s = 0; s < 2; ++s) Ls[gq] = __builtin_amdgcn_mfma_f32_16x16x32_bf16(ones8, pb[s], Ls[gq], 0, 0, 0);
                    };
                    auto lut_c = [&](const int gq, const int pos0, const float sh, f32x4 (&ci)[4]) {
                        const LAS float* lb = lut + (tq[gq] - (pos0 + 4 * q4) - 51) * 4 + head;
#pragma unroll
                        for (int kt = 0; kt < 4; ++kt)
#pragma unroll
                            for (int r = 0; r < 4; ++r) ci[kt][r] = lb[(51 - 16 * kt - r) * 4];
#pragma unroll
                        for (int kt = 0; kt < 4; ++kt)
#pragma unroll
                            for (int r = 0; r < 4; ++r) ci[kt][r] += sh;
                    };
                    auto tile_lut1 = [&](auto gqc, const LAS unsigned char* kbuf, const LAS unsigned char* vbuf, const int pos0, const bool colsel) {
                        constexpr int gq = decltype(gqc)::value;
                        f32x4 st[4]; bf16x8 pb[2];
                        const float mu = (m[gq] == NINF) ? 0.f : m[gq];
                        lut_c(gq, pos0, colsel ? -mu : NINF, st);
#pragma unroll
                        for (int kt = 0; kt < 4; ++kt) { const bf16x8 kf0 = *(const LAS bf16x8*)(kbuf + (16 * kt + col) * KST + 16 * q4), kf1 = *(const LAS bf16x8*)(kbuf + (16 * kt + col) * KST + 64 + 16 * q4);
                            st[kt] = __builtin_amdgcn_mfma_f32_16x16x32_bf16(kf0, qf[gq][0], st[kt], 0, 0, 0); st[kt] = __builtin_amdgcn_mfma_f32_16x16x32_bf16(kf1, qf[gq][1], st[kt], 0, 0, 0); }
                        soft_far(gq, st, pb, mu);
#pragma unroll
                        for (int mt = 0; mt < 4; ++mt)
#pragma unroll
                            for (int s = 0; s < 2; ++s) { const LAS unsigned char* a = vbuf + (32 * s + 4 * q4 + (col >> 2)) * KST + (16 * mt + 4 * (col & 3)) * 2;
                                const s16x4 lo = __builtin_amdgcn_ds_read_tr16_b64_v4i16((LAS s16x4*)a), hi = __builtin_amdgcn_ds_read_tr16_b64_v4i16((LAS s16x4*)(a + 16 * KST));
                                const bf16x8 vfs = __builtin_shufflevector(lo, hi, 0, 1, 2, 3, 4, 5, 6, 7);
                                O[gq][mt] = __builtin_amdgcn_mfma_f32_16x16x32_bf16(vfs, pb[s], O[gq][mt], 0, 0, 0); }
#pragma unroll
                        for (int s = 0; s < 2; ++s) Ls[gq] = __builtin_amdgcn_mfma_f32_16x16x32_bf16(ones8, pb[s], Ls[gq], 0, 0, 0);
                    };
                    auto ld_tile = [&](const bf16* src) -> u32x4 { return *(const u32x4*)(src + tid * 8); };
                    auto st_tile = [&](LAS unsigned char* buf, const u32x4 v) { *(LAS u32x4*)(buf + (tid >> 3) * KST + (tid & 7) * 16) = v; };
                    auto zeroO = [&]() {
#pragma unroll
                        for (int gq = 0; gq < 2; ++gq) { m[gq] = NINF; l[gq] = 0.f; Ls[gq] = (f32x4){0.f, 0.f, 0.f, 0.f};
#pragma unroll
                            for (int mt = 0; mt < 4; ++mt) O[gq][mt] = (f32x4){0.f, 0.f, 0.f, 0.f}; } };
                    const int ntc = (4 * tile + 3 + 63) >> 6;
                    const bf16* kcb = KCb + (size_t)bg * 512 * 64; const bf16* vcb = KCb + (size_t)(8 + bg) * 512 * 64;
                    {
                        zeroO();
                        u32x4 rk = ld_tile(kcb);
                        st_tile(kvb, rk); if (ntc > 1) rk = ld_tile(kcb + 4096);
                        __syncthreads();
#pragma unroll 1
                        for (int i = 0; i < ntc; ++i) { LAS unsigned char* cb = kvb + (i & 1) * 2 * TB;
                            if (i + 1 < ntc) st_tile(kvb + ((i + 1) & 1) * 2 * TB, rk);
                            if (i + 2 < ntc) rk = ld_tile(kcb + (size_t)(i + 2) * 4096);
                            const bool far = (t0 - (16 * (64 * i + 63) + 31)) >= 1513;
                            tile2(0, cb, cb + TB, 64 * i, far, (16 * (64 * i + 63) + 31) <= t0, true, true, bfar, bfar, true, true, 0);
                            __syncthreads(); }
                    }
#pragma unroll
                    for (int gq = 0; gq < 2; ++gq) { float lt = sum_x32(sum_x16(l[gq])); linv[gq] = 1.f / fmaxf(lt, 1e-30f); m1[gq] = (m[gq] == NINF) ? 0.f : m[gq]; }
                    if (q4 == 0) {
#pragma unroll
                        for (int k6 = 0; k6 < 6; ++k6) gld[k6 * 16 + col] = sigmoidf_(gl[k6]); }
                    {
                        zeroO();
                        u32x4 rk = ld_tile(kcb), rv = ld_tile(vcb);
                        st_tile(kvb, rk); st_tile(kvb + TB, rv); if (ntc > 1) { rk = ld_tile(kcb + 4096); rv = ld_tile(vcb + 4096); }
                        __syncthreads();
#pragma unroll 1
                        for (int i = 0; i < ntc; ++i) { LAS unsigned char* cb = kvb + (i & 1) * 2 * TB;
                            if (i + 1 < ntc) { LAS unsigned char* nb = kvb + ((i + 1) & 1) * 2 * TB; st_tile(nb, rk); st_tile(nb + TB, rv); }
                            if (i + 2 < ntc) { rk = ld_tile(kcb + (size_t)(i + 2) * 4096); rv = ld_tile(vcb + (size_t)(i + 2) * 4096); }
                            const bool far = (t0 - (16 * (64 * i + 63) + 31)) >= 1513;
                            tile2(1, cb, cb + TB, 64 * i, far, (16 * (64 * i + 63) + 31) <= t0, true, true, bfar, bfar, true, true, 16 * i);
                            __syncthreads(); }
                    }
                    WAVE_SYNC();
                    {
                        const int tt = lane >> 3, sub = lane & 7;
                        unsigned key[16];
                        const LAS f32x4* ip = (const LAS f32x4*)(impW + tt * 128 + sub * 16);
#pragma unroll
                        for (int q = 0; q < 4; ++q) { const f32x4 v = ip[q];
#pragma unroll
                            for (int e2 = 0; e2 < 4; ++e2) { const int i = 4 * q + e2, s = sub * 16 + i;
                                const bool forced = (s == 0) || (s == cur) || (s == cur - 1);
                                const unsigned k = forced ? 0x7FFFFF80u : ((__float_as_uint(v[e2]) & 0xFFFFFF80u) + 128u);
                                key[i] = (s <= cur) ? (k | (unsigned)(127 - s)) : 0u; } }
                        unsigned w0 = 0u, w1 = 0u, w2 = 0u, w3 = 0u;
#pragma unroll 1
                        for (int k = 0; k < 16; ++k) {
                            unsigned best = key[0];
#pragma unroll
                            for (int i = 1; i < 16; ++i) best = best > key[i] ? best : key[i];
                            { const unsigned o1 = (unsigned)__builtin_amdgcn_mov_dpp((int)best, 0xB1, 0xF, 0xF, true); best = best > o1 ? best : o1;
                              const unsigned o2 = (unsigned)__builtin_amdgcn_mov_dpp((int)best, 0x4E, 0xF, 0xF, true); best = best > o2 ? best : o2;
                              const unsigned o3 = (unsigned)__builtin_amdgcn_mov_dpp((int)best, 0x141, 0xF, 0xF, true); best = best > o3 ? best : o3; }
#pragma unroll
                            for (int i = 0; i < 16; ++i) key[i] = (key[i] == best) ? 0u : key[i];
                            if (best != 0u) { const int idx = 127 - (int)(best & 127u); const unsigned bit = 1u << (idx & 31); const int wd = idx >> 5;
                                w0 |= wd == 0 ? bit : 0u; w1 |= wd == 1 ? bit : 0u; w2 |= wd == 2 ? bit : 0u; w3 |= wd == 3 ? bit : 0u; }
                        }
                        if (sub == 0) { LAS unsigned* sp = selm + (8 * wave + tt) * 4; sp[0] = w0; sp[1] = w1; sp[2] = w2; sp[3] = w3; }
                    }
                    WAVE_SYNC();
#pragma unroll
                    for (int gq = 0; gq < 2; ++gq) { const float g0 = gatev(gq, 0);
#pragma unroll
                        for (int mt = 0; mt < 4; ++mt)
#pragma unroll
                            for (int r = 0; r < 4; ++r) ocl[((gq * 4 + mt) * 4 + r) * 64] = O[gq][mt][r] * g0; }
                    __syncthreads();
                    unsigned long long Ulo, Uhi;
                    { unsigned u[4];
#pragma unroll
                      for (int k = 0; k < 4; ++k) { unsigned x = selm[lane * 4 + k];
#pragma unroll
                        for (int o = 1; o < 64; o <<= 1) x |= __shfl_xor(x, o);
                        u[k] = __builtin_amdgcn_readfirstlane(x); }
                      Ulo = ((unsigned long long)u[1] << 32) | u[0]; Uhi = ((unsigned long long)u[3] << 32) | u[2]; }
                    auto nextj = [&](int j) -> int {
                        if (j < 64) { const unsigned long long x = Ulo >> j; if (x) return j + __builtin_ctzll(x); j = 64; }
                        if (j < 128) { const unsigned long long x = Uhi >> (j - 64); if (x) return j + __builtin_ctzll(x); }
                        return 128; };
                    unsigned long long F0lo, F0hi, F1lo, F1hi;
                    {
                        const int dA = t0 + 8 * wave - (64 * lane + 63), dB = dA - 64 * 64;
                        const bool a0 = lane < cur && rel_bucket(min(dA, 2047)) == rel_bucket(min(dA + 66, 2047)), a1 = lane < cur && rel_bucket(min(dA + 4, 2047)) == rel_bucket(min(dA + 70, 2047));
                        const bool b0 = 64 + lane < cur && rel_bucket(min(dB, 2047)) == rel_bucket(min(dB + 66, 2047)), b1 = 64 + lane < cur && rel_bucket(min(dB + 4, 2047)) == rel_bucket(min(dB + 70, 2047));
                        F0lo = __ballot(a0); F1lo = __ballot(a1); F0hi = __ballot(b0); F1hi = __ballot(b1);
                    }
                    {
                        const bf16* ksb = KVT + (size_t)(2 * 8 + bg) * SEQ * 64; const bf16* vsb = KVT + (size_t)(3 * 8 + bg) * SEQ * 64;
#pragma unroll 1
                        for (int rep = 0; rep < SELREP; ++rep) {
                        zeroO();
                        int j = nextj(0), jn = nextj(j + 1), it = 0;
                        u32x4 rk = ld_tile(ksb + (size_t)j * 4096), rv = ld_tile(vsb + (size_t)j * 4096);
                        st_tile(kvb, rk); st_tile(kvb + TB, rv);
                        if (jn <= cur) { rk = ld_tile(ksb + (size_t)jn * 4096); rv = ld_tile(vsb + (size_t)jn * 4096); }
                        __syncthreads();
#pragma unroll 1
                        while (j <= cur) { LAS unsigned char* cb = kvb + (it & 1) * 2 * TB;
                            const int jnn = jn <= cur ? nextj(jn + 1) : 128;
                            if (jn <= cur) { LAS unsigned char* nb = kvb + ((it + 1) & 1) * 2 * TB; st_tile(nb, rk); st_tile(nb + TB, rv); }
                            if (jnn <= cur) { rk = ld_tile(ksb + (size_t)jnn * 4096); rv = ld_tile(vsb + (size_t)jnn * 4096); }
                            const bool cs0 = (selm[(8 * wave + ti) * 4 + (j >> 5)] >> (j & 31)) & 1u, cs1 = (selm[(8 * wave + 4 + ti) * 4 + (j >> 5)] >> (j & 31)) & 1u;
                            const bool act0 = __ballot(cs0) != 0ull, act1 = __ballot(cs1) != 0ull;
                            const bool far = (t0 - (64 * j + 63)) >= 1513;
                            const bool full = j < cur;
                            const int dlo = t0 + 8 * wave - (64 * j + 63), dl0 = min(dlo, 2047), dl1 = min(dlo + 4, 2047);
                            const bool flat0 = ((j < 64 ? F0lo >> j : F0hi >> (j - 64)) & 1ull) != 0ull, flat1 = ((j < 64 ? F1lo >> j : F1hi >> (j - 64)) & 1ull) != 0ull;
                            const float cb0 = cs0 ? (flat0 ? lut[dl0 * 4 + head] : bfar) : NINF, cb1 = cs1 ? (flat1 ? lut[dl1 * 4 + head] : bfar) : NINF;
                            if (!full) tile2(2, cb, cb + TB, 64 * j, far, full, true, true, cb0, cb1, cs0, cs1, 0);
                            else if (act0 && act1) { if (flat0 && flat1) tile_far2(cb, cb + TB, cb0, cb1); else { tile_lut1(IConst<0>{}, cb, cb + TB, 64 * j, cs0); tile_lut1(IConst<1>{}, cb, cb + TB, 64 * j, cs1); } }
                            else if (act0) { if (flat0) tile_far1(IConst<0>{}, cb, cb + TB, cb0); else tile_lut1(IConst<0>{}, cb, cb + TB, 64 * j, cs0); }
                            else if (act1) { if (flat1) tile_far1(IConst<1>{}, cb, cb + TB, cb1); else tile_lut1(IConst<1>{}, cb, cb + TB, 64 * j, cs1); }
#if NSA_DUP_C
                            __syncthreads();
#endif
                            __syncthreads();
                            j = jn; jn = jnn; ++it;
                        }
                        }
#pragma unroll
                        for (int gq = 0; gq < 2; ++gq) { const float lt = Ls[gq][0]; const float sc = gatev(gq, 1) / fmaxf(lt, 1e-30f);
#pragma unroll
                            for (int mt = 0; mt < 4; ++mt)
#pragma unroll
                                for (int r = 0; r < 4; ++r) ocl[((gq * 4 + mt) * 4 + r) * 64] += O[gq][mt][r] * sc; }
                    }
                    {
                        const bf16* kwb = KVT + (size_t)(4 * 8 + bg) * SEQ * 64; const bf16* vwb = KVT + (size_t)(5 * 8 + bg) * SEQ * 64;
                        const int j0 = cur - 8 < 0 ? 0 : cur - 8, nw = cur - j0 + 1;
#pragma unroll 1
                        for (int wrep = 0; wrep < WINREP; ++wrep) {
                        zeroO();
                        u32x4 rk = ld_tile(kwb + (size_t)j0 * 4096), rv = ld_tile(vwb + (size_t)j0 * 4096);
                        st_tile(kvb, rk); st_tile(kvb + TB, rv);
                        if (nw > 1) { rk = ld_tile(kwb + (size_t)(j0 + 1) * 4096); rv = ld_tile(vwb + (size_t)(j0 + 1) * 4096); }
                        __syncthreads();
#pragma unroll 1
                        for (int i = 0; i < nw; ++i) { LAS unsigned char* cb = kvb + (i & 1) * 2 * TB;
                            if (i + 1 < nw) { LAS unsigned char* nb = kvb + ((i + 1) & 1) * 2 * TB; st_tile(nb, rk); st_tile(nb + TB, rv); }
                            if (i + 2 < nw) { rk = ld_tile(kwb + (size_t)(j0 + i + 2) * 4096); rv = ld_tile(vwb + (size_t)(j0 + i + 2) * 4096); }
                            tile2(3, cb, cb + TB, 64 * (j0 + i), false, (j0 + i > cur - 8) && (j0 + i < cur), true, true, 0.f, 0.f, true, true, 0);
                            __syncthreads(); }
                        }
#pragma unroll
                        for (int gq = 0; gq < 2; ++gq) { const float lt = Ls[gq][0]; const float sc = gatev(gq, 2) / fmaxf(lt, 1e-30f);
#pragma unroll
                            for (int mt = 0; mt < 4; ++mt)
#pragma unroll
                                for (int r = 0; r < 4; ++r) O[gq][mt][r] = ocl[((gq * 4 + mt) * 4 + r) * 64] + O[gq][mt][r] * sc; }
                    }
#pragma unroll
                    for (int gq = 0; gq < 2; ++gq)
#pragma unroll
                        for (int mt = 0; mt < 4; ++mt) { u32x2 w; w.x = cvt_pk_bf16(O[gq][mt][0], O[gq][mt][1]); w.y = cvt_pk_bf16(O[gq][mt][2], O[gq][mt][3]);
                            *(u32x2*)(OB + (tokw + 4 * gq + ti) * 512 + (g * 4 + head) * 64 + 16 * mt + 4 * q4) = w; }
                }
            }
          }
        }
        SEAM(pb + 3, 4);

        if (EN(5) && IN(pb + 4)) { PHASE_IDS();
            pg8::Gemm g{(const bf16*)(ws + WS_QHG), (const bf16*)(ws + WS_WBA0 + (size_t)l * 2 * SZ_WBR), NT, DM, DM, 0, 512, (const bf16*)(ws + WS_NQ), 8};
            pg8::StaticOrder S; S.init(NT, DM, G, bid); EpiGate2 E{(bf16*)(ws + WS_GA), (const bf16*)(ws + WS_GA), (const bf16*)(ws + WS_GB)};
            pg8::gemm_phase<EpiGate2, pg8::StaticOrder>(lds, g, S, E, wave_s);
        }
        SEAM(pb + 4, 5);

        if (EN(6) && IN(pb + 5)) { PHASE_IDS();
            pg8::Gemm g{(const bf16*)(ws + WS_GA), (const bf16*)(ws + (l ? WS_WOUT1 : WS_WOUT0)), NT, DM, DM, 0, 0, nullptr, 0};
            const float* XI = l ? (const float*)X : x_in;
            pg8::StaticOrder S; S.init(NT, DM, G, bid); EpiResid E{XI, X};
            pg8::gemm_phase<EpiResid, pg8::StaticOrder>(lds, g, S, E, wave_s);
        }
        SEAM(pb + 5, 6);

        if (EN(7) && IN(pb + 6)) { PHASE_IDS();
            const float* gam = ap->in[11] + l * DM; const float* bet = ap->in[12] + l * DM;
            LAS int* hist = (LAS int*)(lds + 8 * 16384);
            if (l == 1) { if (tid < 8) hist[tid] = 0; __syncthreads(); }
            const int rpb = (NT + G - 1) / G;
            for (int i = wave; i < rpb; i += NWAVES) {
                const int row = bid * rpb + i; if (row >= NT) break;
                f32x4* xr = (f32x4*)(X + (size_t)row * DM);
                f32x4 v[4]; float s = 0.f;
#pragma unroll
                for (int j = 0; j < 4; ++j) { v[j] = xr[64 * j + lane]; s += (v[j][0] + v[j][1]) + (v[j][2] + v[j][3]); }
                const float mean = wave_sum(s) * (1.f / DM); float s2 = 0.f;
#pragma unroll
                for (int j = 0; j < 4; ++j) { v[j] = v[j] - mean; s2 += (v[j][0] * v[j][0] + v[j][1] * v[j][1]) + (v[j][2] * v[j][2] + v[j][3] * v[j][3]); }
                const float rstd = rsqrtf(wave_sum(s2) * (1.f / DM) + 1e-5f);
#pragma unroll
                for (int j = 0; j < 4; ++j) { const f32x4 gq = ((const f32x4*)gam)[64 * j + lane], bq = ((const f32x4*)bet)[64 * j + lane]; v[j] = v[j] * rstd * gq + bq; xr[64 * j + lane] = v[j]; }
                if (l == 0) { u32x2* o = (u32x2*)(XB + (size_t)row * DM);
#pragma unroll
                    for (int j = 0; j < 4; ++j) { u32x2 w; w.x = cvt_pk_bf16(v[j][0], v[j][1]); w.y = cvt_pk_bf16(v[j][2], v[j][3]); o[64 * j + lane] = w; }
                } else {
                    const float* WR = ap->in[18];
                    float lg[8];
#pragma unroll
                    for (int e = 0; e < 8; ++e) lg[e] = 0.f;
#pragma unroll
                    for (int j = 0; j < 4; ++j)
#pragma unroll
                        for (int q = 0; q < 4; ++q) { const int c = 4 * (64 * j + lane) + q; const f32x4 w0 = *(const f32x4*)(WR + c * 8), w1 = *(const f32x4*)(WR + c * 8 + 4); const float xv = v[j][q];
                            lg[0] += xv * w0[0]; lg[1] += xv * w0[1]; lg[2] += xv * w0[2]; lg[3] += xv * w0[3]; lg[4] += xv * w1[0]; lg[5] += xv * w1[1]; lg[6] += xv * w1[2]; lg[7] += xv * w1[3]; }
#pragma unroll
                    for (int e = 0; e < 8; ++e) lg[e] = wave_sum(lg[e]);
                    int e1 = 0; float v1 = lg[0];
#pragma unroll
                    for (int e = 1; e < 8; ++e) if (lg[e] > v1) { v1 = lg[e]; e1 = e; }
                    int e2 = -1; float v2 = -3e38f;
#pragma unroll
                    for (int e = 0; e < 8; ++e) if (e != e1 && lg[e] > v2) { v2 = lg[e]; e2 = e; }
                    if (lane == 0) { const float g2 = 1.f / (1.f + expf(v1 - v2)), g1 = 1.f - g2;
                        ((int*)(ws + WS_TOPI))[row] = e1 | (e2 << 8); ((float*)(ws + WS_TOPG))[row * 2] = g1; ((float*)(ws + WS_TOPG))[row * 2 + 1] = g2;
                        atomicAdd((int*)&hist[e1], 1); atomicAdd((int*)&hist[e2], 1); }
                }
            }
            if (l == 1) {
                __syncthreads();
                if (tid < 8) ((int*)(ws + WS_CTL + CW_BLKCNT))[bid * 8 + tid] = hist[tid];
                LAS float* scr = (LAS float*)(lds + wave * 16384);
                constexpr int I_GU = 16 * (2 * FFE / 32), I_DN = (FFE / 64) * 32;
                for (int it = gwave; it < NEXP * (I_GU + I_DN); it += nwaves) {
                    const int e = it / (I_GU + I_DN); int r = it % (I_GU + I_DN);
                    if (r < I_GU) { const int nb = r % (2 * FFE / 32), kb = r / (2 * FFE / 32);
                        const float* Wg = ap->in[19] + (size_t)e * DM * FFE; const float* Wu = ap->in[20] + (size_t)e * DM * FFE;
                        auto cp = [=](int n) -> const float* { const int pn = n >> 8, hf = (n >> 7) & 1, c = pn * 128 + (n & 127); return (hf ? Wu : Wg) + c; };
                        tr_item(cp, FFE, DM, (bf16*)(ws + WS_MGU) + (size_t)e * 2 * FFE * DM, DM, nb * 32, kb * 64, scr, lane); }
                    else { r -= I_GU; const int nb = r % 32, kb = r / 32;
                        const float* W = ap->in[21] + (size_t)e * FFE * DM;
                        auto cp = [=](int n) -> const float* { return W + n; };
                        tr_item(cp, DM, FFE, (bf16*)(ws + WS_MDN) + (size_t)e * DM * FFE, FFE, nb * 32, kb * 64, scr, lane); }
                }
            }
        }
        SEAM(pb + 6, 7);

        if (l == 0) {
            if (EN(8) && IN(pb + 7)) { PHASE_IDS();
                pg8::Gemm g{XB, (const bf16*)(ws + WS_WGU0), NT, NINP, DM, 0, 0, nullptr, 0};
                pg8::StaticOrder S; S.init(NT, NINP, G, bid); EpiSwiglu E{(bf16*)(ws + WS_H0), FF0P};
                pg8::gemm_phase<EpiSwiglu, pg8::StaticOrder>(lds, g, S, E, wave_s);
            }
            SEAM(pb + 7, 8);
            if (EN(9) && IN(pb + 8)) { PHASE_IDS();
                pg8::Gemm g{(const bf16*)(ws + WS_H0), (const bf16*)(ws + WS_WDN0), NT, DM, FF0P, 0, 0, nullptr, 0};
                pg8::StaticOrder S; S.init(NT, DM, G, bid); EpiResid E{X, X};
                pg8::gemm_phase<EpiResid, pg8::StaticOrder>(lds, g, S, E, wave_s);
            }
            SEAM(pb + 8, 9);
            if (EN(10) && IN(pb + 9)) { PHASE_IDS();
                const float* gam = ap->in[13]; const float* bet = ap->in[14];
                for (int row = gwave; row < NT; row += nwaves) {
                    f32x4* xr = (f32x4*)(X + (size_t)row * DM);
                    f32x4 v[4]; float s = 0.f;
#pragma unroll
                    for (int j = 0; j < 4; ++j) { v[j] = xr[64 * j + lane]; s += (v[j][0] + v[j][1]) + (v[j][2] + v[j][3]); }
                    const float mean = wave_sum(s) * (1.f / DM); float s2 = 0.f;
#pragma unroll
                    for (int j = 0; j < 4; ++j) { v[j] = v[j] - mean; s2 += (v[j][0] * v[j][0] + v[j][1] * v[j][1]) + (v[j][2] * v[j][2] + v[j][3] * v[j][3]); }
                    const float rstd = rsqrtf(wave_sum(s2) * (1.f / DM) + 1e-5f);
                    u32x2* o = (u32x2*)(XB + (size_t)row * DM);
#pragma unroll
                    for (int j = 0; j < 4; ++j) { const f32x4 gq = ((const f32x4*)gam)[64 * j + lane], bq = ((const f32x4*)bet)[64 * j + lane]; v[j] = v[j] * rstd * gq + bq; xr[64 * j + lane] = v[j];
                        u32x2 w; w.x = cvt_pk_bf16(v[j][0], v[j][1]); w.y = cvt_pk_bf16(v[j][2], v[j][3]); o[64 * j + lane] = w; }
                }
            }
            SEAM(pb + 9, 10);
        } else {
            if (EN(11) && IN(pb + 7)) { PHASE_IDS(); int* META = (int*)(ws + WS_CTL + CW_META); int* PANELE = (int*)(ws + WS_CTL + CW_PANELE); int* ROWINFO = (int*)(ws + WS_ROWINFO); bf16* XS = (bf16*)(ws + WS_XS); (void)META; (void)PANELE; (void)ROWINFO; (void)XS;
                LAS int* sh = (LAS int*)lds;
                const int* BC = (const int*)(ws + WS_CTL + CW_BLKCNT);
                {
                    float tot = 0.f, pre = 0.f;
                    for (int bb = lane; bb < G; bb += 64) { const float c = (float)BC[bb * 8 + wave]; tot += c; pre += (bb < bid) ? c : 0.f; }
                    tot = wave_sum(tot); pre = wave_sum(pre);
                    if (lane == 0) { sh[wave] = (int)tot; sh[8 + wave] = (int)pre; sh[24 + wave] = 0; } }
                __syncthreads();
                if (tid == 0) { int base = 0;
#pragma unroll 1
                    for (int e = 0; e < 8; ++e) { sh[16 + e] = base; base += (sh[e] + 255) & ~255; }
                    sh[32] = base; }
                __syncthreads();
                if (bid == 0) { const int base = sh[32]; if (tid == 0) { META[0] = base / 256; META[1] = (base / 256 + 63) / 64; }
                    if (tid < 8) { META[8 + tid] = sh[16 + tid]; META[16 + tid] = sh[tid]; }
                    for (int p = tid; p < base / 256; p += NTHR) { int e = 0;
#pragma unroll 1
                        for (int q = 1; q < 8; ++q) if (p * 256 >= sh[16 + q]) e = q;
                        PANELE[p] = e; } }
                __syncthreads();
                if (bid < 8) { const int e = bid, r0 = sh[16 + e] + sh[e], r1 = sh[16 + e] + ((sh[e] + 255) & ~255);
                    for (int r = r0 + wave; r < r1; r += NWAVES) { if (lane == 0) ROWINFO[r] = -1;
#pragma unroll
                        for (int j = 0; j < 4; ++j) ((u32x2*)(XS + (size_t)r * DM))[64 * j + lane] = (u32x2){0u, 0u}; } }
                const int rpb = (NT + G - 1) / G;
                for (int i = wave; i < rpb; i += NWAVES) {
                    const int row = bid * rpb + i; if (row >= NT) break;
                    const int ti = ((const int*)(ws + WS_TOPI))[row]; const int e1 = ti & 255, e2 = ti >> 8;
                    int s1 = 0, s2 = 0;
                    if (lane == 0) { s1 = sh[16 + e1] + sh[8 + e1] + atomicAdd((int*)&sh[24 + e1], 1); s2 = sh[16 + e2] + sh[8 + e2] + atomicAdd((int*)&sh[24 + e2], 1); ROWINFO[s1] = row * 2; ROWINFO[s2] = row * 2 + 1; }
                    s1 = __builtin_amdgcn_readfirstlane(s1); s2 = __builtin_amdgcn_readfirstlane(s2);
                    const f32x4* xr = (const f32x4*)(X + (size_t)row * DM);
#pragma unroll
                    for (int j = 0; j < 4; ++j) { const f32x4 v = xr[64 * j + lane]; u32x2 w; w.x = cvt_pk_bf16(v[0], v[1]); w.y = cvt_pk_bf16(v[2], v[3]);
                        ((u32x2*)(XS + (size_t)s1 * DM))[64 * j + lane] = w; ((u32x2*)(XS + (size_t)s2 * DM))[64 * j + lane] = w; }
                }
            }
            SEAM(pb + 7, 11);
            for (int c = 0; c < MAXCHUNK; ++c) {
                if (EN(12) && IN(pb + 8 + 2 * c)) { PHASE_IDS(); int* META = (int*)(ws + WS_CTL + CW_META); int* PANELE = (int*)(ws + WS_CTL + CW_PANELE); int* ROWINFO = (int*)(ws + WS_ROWINFO); bf16* XS = (bf16*)(ws + WS_XS); (void)META; (void)PANELE; (void)ROWINFO; (void)XS;
                    const int P = META[0], nch = META[1];
                    if (c < nch) { const int p0 = (int)((long)c * P / nch), p1 = (int)((long)(c + 1) * P / nch);
                        pg8::Gemm g{XS + (size_t)p0 * 256 * DM, (const bf16*)(ws + WS_MGU), (p1 - p0) * 256, 2 * FFE, DM, (size_t)2 * FFE * DM, 0, nullptr, 0};
                        pg8::StaticOrder S; S.init((p1 - p0) * 256, 2 * FFE, G, bid, PANELE + p0); EpiSwiglu E{(bf16*)(ws + WS_HM), FFE};
                        pg8::gemm_phase<EpiSwiglu, pg8::StaticOrder>(lds, g, S, E, wave_s); }
                }
                SEAM(pb + 8 + 2 * c, 12);
                if (EN(13) && IN(pb + 9 + 2 * c)) { PHASE_IDS(); int* META = (int*)(ws + WS_CTL + CW_META); int* PANELE = (int*)(ws + WS_CTL + CW_PANELE); int* ROWINFO = (int*)(ws + WS_ROWINFO); bf16* XS = (bf16*)(ws + WS_XS); (void)META; (void)PANELE; (void)ROWINFO; (void)XS;
                    const int P = META[0], nch = META[1];
                    if (c < nch) { const int p0 = (int)((long)c * P / nch), p1 = (int)((long)(c + 1) * P / nch);
                        pg8::Gemm g{(const bf16*)(ws + WS_HM), (const bf16*)(ws + WS_MDN), (p1 - p0) * 256, DM, FFE, (size_t)DM * FFE, 0, nullptr, 0};
                        pg8::StaticOrder S; S.init((p1 - p0) * 256, DM, G, bid, PANELE + p0); EpiScatter E{(bf16*)(ws + WS_YM), ROWINFO + p0 * 256};
                        pg8::gemm_phase<EpiScatter, pg8::StaticOrder>(lds, g, S, E, wave_s); }
                }
                if (PROBE_GRP >= 0 && c == MAXCHUNK - 1) { PMARK(13); if (bid == 0 && wave_s == 0 && lane_id() == 0) *(unsigned long long*)(ws0 + WS_CTL + CW_PROBE) = pr_acc; }
                SEAM(pb + 9 + 2 * c, 13);
            }
            if (EN(14) && IN(pb + 8 + 2 * MAXCHUNK)) { PHASE_IDS();
                const float* gam = ap->in[13] + DM; const float* bet = ap->in[14] + DM;
                const bf16* YM = (const bf16*)(ws + WS_YM); const float* TG = (const float*)(ws + WS_TOPG);
                const float pscale = 1.f;
                for (int row = gwave; row < NT; row += nwaves) {
                    f32x4* xr = (f32x4*)(X + (size_t)row * DM);
                    const float g1 = TG[row * 2], g2 = TG[row * 2 + 1];
                    const u32x2* y1 = (const u32x2*)(YM + (size_t)(row * 2) * DM); const u32x2* y2 = (const u32x2*)(YM + (size_t)(row * 2 + 1) * DM);
                    f32x4 v[4]; float s = 0.f;
#pragma unroll
                    for (int j = 0; j < 4; ++j) { const f32x4 xv = xr[64 * j + lane]; const u32x2 a = y1[64 * j + lane], bq = y2[64 * j + lane];
                        v[j][0] = xv[0] * DN_ALPHA + g1 * bflo(a.x) + g2 * bflo(bq.x); v[j][1] = xv[1] * DN_ALPHA + g1 * bfhi(a.x) + g2 * bfhi(bq.x);
                        v[j][2] = xv[2] * DN_ALPHA + g1 * bflo(a.y) + g2 * bflo(bq.y); v[j][3] = xv[3] * DN_ALPHA + g1 * bfhi(a.y) + g2 * bfhi(bq.y);
                        s += (v[j][0] + v[j][1]) + (v[j][2] + v[j][3]); }
                    const float mean = wave_sum(s) * (1.f / DM); float s2 = 0.f;
#pragma unroll
                    for (int j = 0; j < 4; ++j) { v[j] = v[j] - mean; s2 += (v[j][0] * v[j][0] + v[j][1] * v[j][1]) + (v[j][2] * v[j][2] + v[j][3] * v[j][3]); }
                    const float rstd = rsqrtf(wave_sum(s2) * (1.f / DM) + 1e-5f);
#pragma unroll
                    for (int j = 0; j < 4; ++j) { const f32x4 gq = ((const f32x4*)gam)[64 * j + lane], bq = ((const f32x4*)bet)[64 * j + lane]; xr[64 * j + lane] = (v[j] * rstd * gq + bq) * pscale; }
                }
#if PROBE_GRP >= 0
                {
                    const unsigned long long dt = *(const unsigned long long*)(ws + WS_CTL + CW_PROBE) * (unsigned long long)PROBE_K;
                    const unsigned long long t0 = __builtin_amdgcn_s_memrealtime();
                    while (__builtin_amdgcn_s_memrealtime() - t0 < dt) __builtin_amdgcn_s_sleep(8);
                }
#endif
            }
        }
    }
#undef IN
#undef SEAM
}

constexpr int NPHASES = 1 + 10 + 8 + 2 * MAXCHUNK + 1;

extern "C" void kernel_launch(void* const* d_in, const int* in_sizes, int n_in, void* d_out, int out_size, void* d_ws, size_t ws_size, hipStream_t stream) {
    static int grid = 0;
    if (grid == 0) {
        if (n_in != 22 || out_size != NT * DM || ws_size < WS_END) { fprintf(stderr, "kernel_launch: need 22 inputs, %d outputs, >= %zu bytes of workspace; got %d, %d, %zu\n", NT * DM, (size_t)WS_END, n_in, out_size, ws_size); grid = -1; return; }
        int dev = 0, cus = 0, per_cu = 0;
        if (hipGetDevice(&dev) != hipSuccess || hipDeviceGetAttribute(&cus, hipDeviceAttributeMultiprocessorCount, dev) != hipSuccess) { grid = -1; return; }
        if (hipFuncSetAttribute((const void*)mega_fwd, hipFuncAttributeMaxDynamicSharedMemorySize, LDS_BYTES) != hipSuccess) { fprintf(stderr, "kernel_launch: hipFuncSetAttribute failed\n"); grid = -1; return; }
        if (hipOccupancyMaxActiveBlocksPerMultiprocessor(&per_cu, (const void*)mega_fwd, NTHR, LDS_BYTES) != hipSuccess || per_cu < 1) fprintf(stderr, "kernel_launch: occupancy query reports %d\n", per_cu);
        (void)hipGetLastError();
        grid = cus > 256 ? 256 : cus;
    }
    if (grid < 0) return;
    (void)hipMemsetAsync((char*)d_ws + WS_CTL, 0, CTL_BYTES, stream);
    Args a{};
    for (int i = 0; i < 22; ++i) a.in[i] = (const float*)d_in[i];
    a.out = (float*)d_out; a.ws = (unsigned char*)d_ws;
#if ONE_LAUNCH
    a.ph_lo = 0; a.ph_hi = NPHASES;
    hipLaunchKernelGGL(mega_fwd, dim3(grid), dim3(NTHR), LDS_BYTES, stream, a);
#else
    for (int p = 0; p < NPHASES; ++p) { a.ph_lo = p; a.ph_hi = p + 1; hipLaunchKernelGGL(mega_fwd, dim3(grid), dim3(NTHR), LDS_BYTES, stream, a); }
#endif
}
```

```cpp
#include <hip/hip_runtime.h>
#include <cstdio>
#include <cstdint>

#ifndef ONE_LAUNCH
#define ONE_LAUNCH 1
#endif

#define LAS __attribute__((address_space(3)))
typedef unsigned short bf16;
typedef short bf16x8 __attribute__((ext_vector_type(8)));
typedef short s16x4 __attribute__((ext_vector_type(4)));
typedef float f32x4 __attribute__((ext_vector_type(4)));
typedef float f32x16 __attribute__((ext_vector_type(16)));
typedef float f32x2 __attribute__((ext_vector_type(2)));
typedef unsigned u32x4 __attribute__((ext_vector_type(4)));
typedef unsigned u32x2 __attribute__((ext_vector_type(2)));

typedef __bf16 bf16x2_t __attribute__((ext_vector_type(2)));
__device__ __forceinline__ unsigned cvt_pk_bf16(float lo, float hi) { bf16x2_t v; v[0] = (__bf16)lo; v[1] = (__bf16)hi; return __builtin_bit_cast(unsigned, v); }
__device__ __forceinline__ bf16 f2bf(float f) { unsigned u = __float_as_uint(f); u += 0x7FFFu + ((u >> 16) & 1u); return (bf16)(u >> 16); }
__device__ __forceinline__ float bf2f(bf16 b) { return __uint_as_float(((unsigned)b) << 16); }
__device__ __forceinline__ float bflo(unsigned u) { return __uint_as_float(u << 16); }
__device__ __forceinline__ float bfhi(unsigned u) { return __uint_as_float(u & 0xFFFF0000u); }
__device__ __forceinline__ float sigmoidf_(float x) { return 1.0f / (1.0f + __expf(-x)); }
__device__ __forceinline__ float siluf_(float x) { return x / (1.0f + __expf(-x)); }
__device__ __forceinline__ float max_x32(float x) { auto r = __builtin_amdgcn_permlane32_swap(__float_as_uint(x), __float_as_uint(x), false, false); return fmaxf(__uint_as_float(r[0]), __uint_as_float(r[1])); }
__device__ __forceinline__ float max_x16(float x) { auto r = __builtin_amdgcn_permlane16_swap(__float_as_uint(x), __float_as_uint(x), false, false); return fmaxf(__uint_as_float(r[0]), __uint_as_float(r[1])); }
__device__ __forceinline__ float sum_x32(float x) { auto r = __builtin_amdgcn_permlane32_swap(__float_as_uint(x), __float_as_uint(x), false, false); return __uint_as_float(r[0]) + __uint_as_float(r[1]); }
__device__ __forceinline__ float sum_x16(float x) { auto r = __builtin_amdgcn_permlane16_swap(__float_as_uint(x), __float_as_uint(x), false, false); return __uint_as_float(r[0]) + __uint_as_float(r[1]); }
__device__ __forceinline__ float dpp_x1(float x) { return __uint_as_float(__builtin_amdgcn_mov_dpp(__float_as_uint(x), 0xB1, 0xF, 0xF, true)); }
__device__ __forceinline__ float dpp_x2(float x) { return __uint_as_float(__builtin_amdgcn_mov_dpp(__float_as_uint(x), 0x4E, 0xF, 0xF, true)); }
__device__ __forceinline__ float dpp_hm(float x) { return __uint_as_float(__builtin_amdgcn_mov_dpp(__float_as_uint(x), 0x141, 0xF, 0xF, true)); }
__device__ __forceinline__ float dpp_rm(float x) { return __uint_as_float(__builtin_amdgcn_mov_dpp(__float_as_uint(x), 0x140, 0xF, 0xF, true)); }
__device__ __forceinline__ float wave_sum(float v) { v += dpp_x1(v); v += dpp_x2(v); v += dpp_hm(v); v += dpp_rm(v); v = sum_x16(v); return sum_x32(v); }
__device__ __forceinline__ float wave_max(float v) { v = fmaxf(v, dpp_x1(v)); v = fmaxf(v, dpp_x2(v)); v = fmaxf(v, dpp_hm(v)); v = fmaxf(v, dpp_rm(v)); v = max_x16(v); return max_x32(v); }
__device__ __forceinline__ int lane_id() { int l; asm volatile("v_mbcnt_lo_u32_b32 %0, -1, 0\n\tv_mbcnt_hi_u32_b32 %0, -1, %0" : "=v"(l)); return l; }
#define LDS_SYNC() do { asm volatile("s_waitcnt lgkmcnt(0)" ::: "memory"); __builtin_amdgcn_s_barrier(); asm volatile("" ::: "memory"); } while (0)
#define WAVE_SYNC() do { asm volatile("s_waitcnt lgkmcnt(0)" ::: "memory"); __builtin_amdgcn_wave_barrier(); } while (0)

#define PHASE_IDS() int tid_ph = wave_s * 64 + lane_id(); asm volatile("" : "+v"(tid_ph)); int bid_ph = (int)blockIdx.x; asm volatile("" : "+s"(bid_ph)); const int bid = bid_ph; (void)bid; const int tid = tid_ph, lane = tid & 63, wave = __builtin_amdgcn_readfirstlane(tid >> 6), gwave = bid * NWAVES + wave; (void)tid; (void)lane; (void)wave; (void)gwave; \
    KArgsP ap = kap; asm volatile("" : "+s"(ap));     \
    unsigned char* ws = ap->ws; float* X = ap->out; const float* x_in = ap->in[0]; bf16* XB = (bf16*)(ws + WS_XB); float* LBS = (float*)(ws + WS_LBS); (void)X; (void)x_in; (void)XB; (void)LBS
namespace pg8 {
constexpr int BM = 256, BK = 64, HALF = 128, HTB = HALF * BK * 2, STAGE_BYTES = 8 * HTB, NXCD = 8, WGM = 8;
__host__ __device__ __forceinline__ int lds_byte(int r, int c) { const int st = (r >> 4) * 2 + (c >> 5), rr = r & 15, cc = c & 31, ob = rr * 64 + cc * 2; return st * 1024 + (ob ^ (((ob >> 9) & 1) << 5)); }
__host__ __device__ __forceinline__ void stage_rc(int b, int& R, int& C) { const int st = b / 1024, sb = b % 1024, swz = sb ^ (((sb >> 9) & 1) << 5); R = (st >> 1) * 16 + swz / 64; C = (st & 1) * 32 + (swz % 64) / 2; }
__host__ __device__ __forceinline__ int perm32(int rho) { const int n = rho >> 4, i = rho & 15; return 8 * (i >> 2) + 4 * n + (i & 3); }

struct Unit { int pm, pn, e; };
struct Gemm { const bf16* A; const bf16* Bt; int M, N, K; size_t bt_estride; int lda; const bf16* A2; int ksw; };

struct StaticOrder {
    int nM, nN, nwg, G, c; const int* pe;
    __device__ void init(int M, int N, int G_, int c_, const int* pe_ = nullptr) { nM = M / BM; nN = N / BM; nwg = nM * nN; G = G_; c = c_; pe = pe_; }
    __device__ bool next(int i, Unit& u) const {
        const long L = (long)i * G + c; if (L >= nwg) return false;
        int wgid = (int)L; { const int q = nwg / NXCD, r = nwg % NXCD, xcd = wgid % NXCD, off = wgid / NXCD; wgid = (xcd < r ? xcd * (q + 1) : r * (q + 1) + (xcd - r) * q) + off; }
        const int nig = WGM * nN, gid = wgid / nig, fm = gid * WGM, gsz = (nM - fm) < WGM ? (nM - fm) : WGM;
        u.pm = fm + ((wgid % nig) % gsz); u.pn = (wgid % nig) / gsz; u.e = pe ? pe[u.pm] : 0; return true;
    }
    __device__ __forceinline__ void a_ready(const Unit&) const {}
    __device__ __forceinline__ void done(const Unit&) const {}
};

template <class Epi, class Sched, bool ALIGN_EPI = true, bool SP2 = true>
__device__ __forceinline__ void gemm_phase(LAS unsigned char* lds, const Gemm g, const Sched& S, const Epi& E, const int wave_s) {
    int tid_l = wave_s * 64 + lane_id(); asm volatile("" : "+v"(tid_l));
    const int tid = tid_l, wid = __builtin_amdgcn_readfirstlane(tid >> 6), lane = tid & 63, wr = wid >> 2, wc = wid & 3, fr = lane & 15, fq = lane >> 4;
    const int K = g.K, nt = K / BK, LDA = g.lda ? g.lda : g.K;
    unsigned voffA[2], voffB[2];
#pragma unroll
    for (int i = 0; i < 2; ++i) { int R, C; stage_rc(tid * 16 + i * 8192, R, C); const int Rb = Epi::PERM ? ((R & ~31) + perm32(R & 31)) : R;
        voffA[i] = (unsigned)(R * LDA + C) * 2u; voffB[i] = (unsigned)(Rb * K + C) * 2u; }
    const size_t kstep = (size_t)(BK * 2);
    const size_t hstep = (size_t)HALF * K * 2, hstepA = (size_t)HALF * LDA * 2;
    const size_t tstep = 2 * hstep, tstepA = 2 * hstepA;
    const unsigned ldsw = (unsigned)wid * 1024u;
    const int aoff = lds_byte(wr * 64 + fr, fq * 8), boff = lds_byte(wc * 32 + fr, fq * 8);
#define PG8_SA(b, h) (((b) * 2 + (h)) * HTB)
#define PG8_SB(b, h) ((4 + (b) * 2 + (h)) * HTB)
#define PG8_STAGE(bufoff, gbase, voff) do { _Pragma("unroll") for (int _i = 0; _i < 2; ++_i) \
        __builtin_amdgcn_global_load_lds((const unsigned*)((const char*)(gbase) + (voff)[_i]), (LAS unsigned*)(lds + (bufoff) + ldsw + _i * 8192), 16, 0, 0); } while (0)
#define PG8_LDA(dst, b, h) do { _Pragma("unroll") for (int m = 0; m < 4; ++m) _Pragma("unroll") for (int k = 0; k < 2; ++k) dst[m][k] = *(const LAS bf16x8*)(lds + PG8_SA(b, h) + aoff + m * 2048 + k * 1024); } while (0)
#define PG8_LDB(dst, b, h) do { _Pragma("unroll") for (int n = 0; n < 2; ++n) _Pragma("unroll") for (int k = 0; k < 2; ++k) dst[n][k] = *(const LAS bf16x8*)(lds + PG8_SB(b, h) + boff + n * 2048 + k * 1024); } while (0)
#define PG8_MMA(ai, bj, At, Bt) do { __builtin_amdgcn_s_setprio(1); _Pragma("unroll") for (int m = 0; m < 4; ++m) _Pragma("unroll") for (int n = 0; n < 2; ++n) _Pragma("unroll") for (int k = 0; k < 2; ++k) \
        acc[ai][bj][m][n] = __builtin_amdgcn_mfma_f32_16x16x32_bf16(Bt[n][k], At[m][k], acc[ai][bj][m][n], 0, 0, 0); __builtin_amdgcn_s_setprio(0); } while (0)
#define PG8_WAIT_V(n) asm volatile("s_waitcnt vmcnt(" #n ")" ::: "memory")
#define PG8_WAIT_L(n) asm volatile("s_waitcnt lgkmcnt(" #n ")" ::: "memory")
#define PG8_BAR __builtin_amdgcn_s_barrier()
#define PG8_SCHED __builtin_amdgcn_sched_barrier(0)
    Unit cur, nxt; int ui = 0;
    if (!S.next(0, cur)) return;
    f32x4 acc[2][2][4][2];
#pragma unroll
    for (int a = 0; a < 2; ++a)
#pragma unroll
        for (int b = 0; b < 2; ++b)
#pragma unroll
            for (int m = 0; m < 4; ++m)
#pragma unroll
                for (int n = 0; n < 2; ++n) acc[a][b][m][n] = (f32x4){0.f, 0.f, 0.f, 0.f};
    bf16x8 At[4][2], B0[2][2], B1[2][2];
    const int ksw = g.ksw ? g.ksw : nt;
    const char* cA = (const char*)g.A + (size_t)cur.pm * tstepA; const char* cB = (const char*)(g.Bt + (size_t)cur.e * g.bt_estride) + (size_t)cur.pn * tstep;
    const char* cA2 = g.ksw ? (const char*)g.A2 + (size_t)cur.pm * tstepA : cA;
    S.a_ready(cur);
    if constexpr (SP2) {
        PG8_STAGE(PG8_SB(0, 0), cB, voffB); PG8_STAGE(PG8_SB(0, 1), cB + hstep, voffB); PG8_STAGE(PG8_SA(0, 0), cA, voffA); PG8_STAGE(PG8_SA(0, 1), cA + hstepA, voffA);
        if (wr == 1) PG8_BAR;
        PG8_WAIT_V(2); PG8_BAR;
        PG8_STAGE(PG8_SB(1, 0), cB + kstep, voffB); PG8_STAGE(PG8_SA(1, 0), cA + kstep, voffA); PG8_STAGE(PG8_SB(1, 1), cB + hstep + kstep, voffB);
        PG8_WAIT_V(6); PG8_BAR;
    } else {
        PG8_STAGE(PG8_SB(0, 0), cB, voffB); PG8_STAGE(PG8_SA(0, 0), cA, voffA); PG8_STAGE(PG8_SB(0, 1), cB + hstep, voffB); PG8_STAGE(PG8_SA(0, 1), cA + hstepA, voffA);
        if (wr == 1) PG8_BAR;
        PG8_WAIT_V(4); PG8_BAR;
        PG8_STAGE(PG8_SB(1, 0), cB + kstep, voffB); PG8_STAGE(PG8_SA(1, 0), cA + kstep, voffA); PG8_STAGE(PG8_SB(1, 1), cB + hstep + kstep, voffB);
        PG8_WAIT_V(6); PG8_BAR;
    }
    for (;;) {
        const bool has_next = S.next(ui + 1, nxt);
        const char* nA = has_next ? (const char*)g.A + (size_t)nxt.pm * tstepA : cA;
        const char* nA2 = (has_next && g.ksw) ? (const char*)g.A2 + (size_t)nxt.pm * tstepA : cA2;
        const char* nB = has_next ? (const char*)(g.Bt + (size_t)nxt.e * g.bt_estride) + (size_t)nxt.pn * tstep : cB;
        for (int t = 0; t < nt; t += 2) {
            const bool last = (t == nt - 2);
            const char* a1 = (t + 1 < ksw) ? cA + (size_t)(t + 1) * kstep : cA2 + (size_t)(t + 1 - ksw) * kstep;
            const char* a2 = last ? nA : ((t + 2 < ksw) ? cA + (size_t)(t + 2) * kstep : cA2 + (size_t)(t + 2 - ksw) * kstep); const char* b2 = last ? nB : cB + (size_t)(t + 2) * kstep;
            const char* a3 = a2 + kstep; const char* b3 = b2 + kstep;
            if (last && has_next) S.a_ready(nxt);
            if constexpr (Epi::HAS_MID) { if (t == ksw) E.mid(acc, cur, wr, wc, fr, fq); }
            if constexpr (SP2) {
            PG8_LDB(B0, 0, 0); PG8_LDB(B1, 0, 1); PG8_SCHED; PG8_LDA(At, 0, 0); PG8_STAGE(PG8_SA(1, 1), a1 + hstepA, voffA);
            PG8_WAIT_V(8); PG8_WAIT_L(0); PG8_BAR; PG8_MMA(0, 0, At, B0); PG8_MMA(0, 1, At, B1); PG8_BAR; PG8_SCHED;
            PG8_LDA(At, 0, 1); PG8_STAGE(PG8_SB(0, 0), b2, voffB); PG8_STAGE(PG8_SB(0, 1), b2 + hstep, voffB); PG8_STAGE(PG8_SA(0, 0), a2, voffA);
            PG8_WAIT_V(8); PG8_WAIT_L(0); PG8_BAR; PG8_MMA(1, 0, At, B0); PG8_MMA(1, 1, At, B1); PG8_BAR; PG8_SCHED;
            PG8_LDB(B0, 1, 0); PG8_LDB(B1, 1, 1); PG8_SCHED; PG8_LDA(At, 1, 0); PG8_STAGE(PG8_SA(0, 1), a2 + hstepA, voffA);
            PG8_WAIT_V(8); PG8_WAIT_L(0); PG8_BAR; PG8_MMA(0, 0, At, B0); PG8_MMA(0, 1, At, B1); PG8_BAR; PG8_SCHED;
            PG8_LDA(At, 1, 1); PG8_STAGE(PG8_SB(1, 0), b3, voffB); PG8_STAGE(PG8_SB(1, 1), b3 + hstep, voffB); PG8_STAGE(PG8_SA(1, 0), a3, voffA);
            PG8_WAIT_V(8); PG8_WAIT_L(0); PG8_BAR; PG8_MMA(1, 0, At, B0); PG8_MMA(1, 1, At, B1); PG8_BAR; PG8_SCHED;
            } else {
            PG8_LDB(B0, 0, 0); PG8_SCHED; PG8_LDA(At, 0, 0); PG8_STAGE(PG8_SA(1, 1), a1 + hstepA, voffA);
            PG8_WAIT_L(8); PG8_BAR; PG8_WAIT_L(0); PG8_MMA(0, 0, At, B0); PG8_BAR; PG8_SCHED;
            PG8_LDB(B1, 0, 1); PG8_STAGE(PG8_SB(0, 0), b2, voffB);
            PG8_BAR; PG8_WAIT_L(0); PG8_MMA(0, 1, At, B1); PG8_BAR;
            PG8_LDA(At, 0, 1); PG8_STAGE(PG8_SA(0, 0), a2, voffA);
            PG8_BAR; PG8_WAIT_L(0); PG8_MMA(1, 0, At, B0); PG8_BAR; PG8_SCHED;
            PG8_STAGE(PG8_SB(0, 1), b2 + hstep, voffB);
            PG8_WAIT_V(6); PG8_BAR; PG8_MMA(1, 1, At, B1); PG8_BAR;
            PG8_LDB(B0, 1, 0); PG8_SCHED; PG8_LDA(At, 1, 0); PG8_STAGE(PG8_SA(0, 1), a2 + hstepA, voffA);
            PG8_WAIT_L(8); PG8_BAR; PG8_WAIT_L(0); PG8_MMA(0, 0, At, B0); PG8_BAR; PG8_SCHED;
            PG8_LDB(B1, 1, 1); PG8_STAGE(PG8_SB(1, 0), b3, voffB);
            PG8_BAR; PG8_WAIT_L(0); PG8_MMA(0, 1, At, B1); PG8_BAR;
            PG8_LDA(At, 1, 1); PG8_STAGE(PG8_SA(1, 0), a3, voffA);
            PG8_BAR; PG8_WAIT_L(0); PG8_MMA(1, 0, At, B0); PG8_BAR; PG8_SCHED;
            PG8_STAGE(PG8_SB(1, 1), b3 + hstep, voffB);
            PG8_WAIT_V(6); PG8_BAR; PG8_MMA(1, 1, At, B1); PG8_BAR;
            }
        }
        if constexpr (ALIGN_EPI) { if (wr == 0) PG8_BAR; }
        E(acc, cur, wr, wc, fr, fq); S.done(cur);
        if (!has_next) break;
#pragma unroll
        for (int a = 0; a < 2; ++a)
#pragma unroll
            for (int b = 0; b < 2; ++b)
#pragma unroll
                for (int m = 0; m < 4; ++m)
#pragma unroll
                    for (int n = 0; n < 2; ++n) acc[a][b][m][n] = (f32x4){0.f, 0.f, 0.f, 0.f};
        cur = nxt; cA = nA; cA2 = nA2; cB = nB; ++ui;
        if constexpr (ALIGN_EPI) { if (wr == 1) PG8_BAR; }
    }
    PG8_WAIT_V(0);
    if constexpr (!ALIGN_EPI) { if (wr == 0) PG8_BAR; }
    PG8_BAR;
#undef PG8_SA
#undef PG8_SB
#undef PG8_STAGE
#undef PG8_LDA
#undef PG8_LDB
#undef PG8_MMA
#undef PG8_WAIT_V
#undef PG8_WAIT_L
#undef PG8_BAR
#undef PG8_SCHED
}
}

#define XB_TMO      128
#define XB_XCNT(j)  (256  + 64 * (j))
#define XB_XSUB(j)  (1280 + 64 * (j))
#define XB_XGEN(j)  (2304 + 64 * (j))
#define XB_TOP      3328
#define XB_TOPGEN   3392
#define XCD_BAR_WORDS 3456
#define XB_SPIN_CAP (1u << 18)
__device__ __forceinline__ unsigned xb_ld(unsigned* p)              { return __hip_atomic_load(p, __ATOMIC_RELAXED, __HIP_MEMORY_SCOPE_AGENT); }
__device__ __forceinline__ unsigned xb_add(unsigned* p, unsigned v) { return __hip_atomic_fetch_add(p, v, __ATOMIC_RELAXED, __HIP_MEMORY_SCOPE_AGENT); }
__device__ __forceinline__ unsigned xb_xcc_id() { return (unsigned)__builtin_amdgcn_s_getreg((3 << 11) | 20) & 0xFu; }
#define XB_SPIN(cond, bar) do { unsigned _sp = 0; while (cond) { __builtin_amdgcn_s_sleep(1); \
    if ((++_sp & 255u) == 0u) { if (xb_ld(&(bar)[XB_TMO])) break; if (_sp > XB_SPIN_CAP) { atomicAdd(&(bar)[XB_TMO], 1u); break; } } } } while (0)
struct XcdBarrier { unsigned* bar; unsigned x; volatile LAS unsigned* st; };
__device__ __forceinline__ XcdBarrier xcd_barrier_post(unsigned* bar, volatile LAS unsigned* st, const bool leader) {
    XcdBarrier b; b.bar = bar; b.x = xb_xcc_id(); b.st = st;
    if (leader) (void)xb_add(&bar[XB_XCNT(b.x)], 1u);
    return b;
}
__device__ __forceinline__ void xcd_barrier_complete(unsigned* bar, unsigned x, unsigned& nloc, unsigned& nx) {
    const unsigned G = gridDim.x * gridDim.y * gridDim.z;
    unsigned sum, cnt, mine, sp = 0u;
    for (;;) {
        sum = 0u; cnt = 0u; mine = 0u;
#pragma unroll
        for (unsigned j = 0; j < 16; ++j) { const unsigned c = xb_ld(&bar[XB_XCNT(j)]); sum += c; cnt += (c > 0u) ? 1u : 0u; mine = (j == x) ? c : mine; }
        if (sum == G) break;
        __builtin_amdgcn_s_sleep(1);
        if ((++sp & 255u) == 0u) { if (xb_ld(&bar[XB_TMO])) break; if (sp > XB_SPIN_CAP) { atomicAdd(&bar[XB_TMO], 1u); break; } }
    }
    nloc = mine > 0u ? mine : 1u; nx = cnt > 0u ? cnt : 1u;
}
__device__ __forceinline__ void xcd_barrier(const XcdBarrier& b, const bool leader) {
    asm volatile("s_waitcnt vmcnt(0)" ::: "memory");
    __syncthreads();
    if (leader) {
        unsigned* bar = b.bar;
        __builtin_amdgcn_s_waitcnt(0);
        unsigned nloc = b.st[0], nx = b.st[1];
        if (nloc == 0u) { xcd_barrier_complete(bar, b.x, nloc, nx); b.st[0] = nloc; b.st[1] = nx; }
        const unsigned old = xb_add(&bar[XB_XSUB(b.x)], 1u);
        const unsigned gen = old / nloc;
        if (old + 1u == (gen + 1u) * nloc) {
            __builtin_amdgcn_fence(__ATOMIC_RELEASE, "agent");
            asm volatile("s_waitcnt vmcnt(0)" ::: "memory");
            const unsigned og = xb_add(&bar[XB_TOP], 1u);
            const unsigned tg = og / nx;
            if (og + 1u == (tg + 1u) * nx) xb_add(&bar[XB_TOPGEN], 1u);
            else XB_SPIN(xb_ld(&bar[XB_TOPGEN]) == tg, bar);
            __builtin_amdgcn_fence(__ATOMIC_ACQUIRE, "agent");
            xb_add(&bar[XB_XGEN(b.x)], 1u);
            asm volatile("s_waitcnt vmcnt(0)" ::: "memory");
        } else {
            XB_SPIN(xb_ld(&bar[XB_XGEN(b.x)]) == gen, bar);
            __builtin_amdgcn_fence(__ATOMIC_ACQUIRE, "agent");
            asm volatile("s_waitcnt vmcnt(0)" ::: "memory");
        }
    }
    __syncthreads();
}

constexpr int NB = 4, SEQ = 8192, DM = 1024, NT = NB * SEQ;
constexpr int NINP = 5632;
constexpr int FF0 = 2752, FF0P = 2816, FFE = 3584, NEXP = 8;
constexpr int NWAVES = 8, NTHR = 512;
constexpr int LDS_BYTES = 155648;
constexpr int MISC_OFF = LDS_BYTES - 64;
constexpr float DN_ALPHA = 1.41421356237309515f;
constexpr int MAXPANELS = 272;
constexpr int MAXCHUNK = 5;

constexpr size_t al256(size_t x) { return (x + 255) & ~(size_t)255; }
constexpr size_t WS_CTL = 0;
constexpr size_t CTL_BYTES = 65536;
constexpr size_t CW_BAR = 0;
constexpr size_t CW_BLKCNT = 16384;
constexpr size_t CW_META = 16384 + 8192;
constexpr size_t CW_PANELE = 16384 + 8192 + 256;
constexpr size_t CW_PE32 = 16384 + 8192 + 2048;
constexpr size_t CW_PROBE = 16384 + 8192 + 4096;
constexpr size_t WS_LBS = WS_CTL + CTL_BYTES;
constexpr size_t WS_KC = WS_LBS + 4096;
constexpr size_t WS_VC = WS_KC + 1048576;
constexpr size_t WS_DEC = WS_VC + 1048576;
constexpr size_t WS_TOPI = WS_DEC + 1048576;
constexpr size_t WS_TOPG = WS_TOPI + (size_t)NT * 4;
constexpr size_t WS_ROWINFO = WS_TOPG + (size_t)NT * 8;
constexpr size_t WS_HID = al256(WS_ROWINFO + (size_t)MAXPANELS * 256 * 4);
constexpr size_t WS_B1 = WS_HID + (size_t)8192 * 128 * 2;
constexpr size_t WS_BIG = al256(WS_B1 + 4096);
constexpr size_t SZ_WIN = (size_t)NINP * DM * 2, SZ_WBR = (size_t)DM * 512 * 2, SZ_WOUT = (size_t)DM * DM * 2;
constexpr size_t WS_WIN0 = WS_BIG, WS_WIN1 = WS_WIN0 + SZ_WIN;
constexpr size_t WS_WBA0 = WS_WIN1 + SZ_WIN, WS_WBA1 = WS_WBA0 + SZ_WBR, WS_WBB0 = WS_WBA1 + SZ_WBR, WS_WBB1 = WS_WBB0 + SZ_WBR;
constexpr size_t WS_WOUT0 = WS_WBB1 + SZ_WBR, WS_WOUT1 = WS_WOUT0 + SZ_WOUT;
constexpr size_t WS_WGU0 = WS_WOUT1 + SZ_WOUT;
constexpr size_t WS_WDN0 = WS_WGU0 + (size_t)NINP * DM * 2;
constexpr size_t WS_W1T = WS_WDN0 + (size_t)DM * FF0P * 2;
constexpr size_t WS_XB = WS_W1T + (size_t)2 * 2 * 256 * 2048 * 2;
constexpr size_t WS_US = WS_XB;
constexpr size_t WS_PROJ = WS_XB + (size_t)NT * DM * 2;
constexpr size_t WS_QHG = WS_PROJ;
constexpr size_t WS_HF = WS_QHG + (size_t)NT * 512 * 2;
constexpr size_t WS_HI = WS_HF + (size_t)NT * 512 * 4;
constexpr size_t WS_HG = WS_HI + (size_t)NT * 512 * 2;
constexpr size_t WS_NQ = WS_HG + (size_t)NT * 512 * 2;
constexpr size_t WS_KV6 = WS_NQ + (size_t)NT * 512 * 2;
constexpr size_t WS_GA = WS_KV6 + (size_t)NT * 768 * 2;
constexpr size_t WS_GB = WS_GA + (size_t)NT * DM * 2;
constexpr size_t WS_NG = WS_GB + (size_t)NT * DM * 2;
constexpr size_t WS_MIX_END = WS_NG + (size_t)NT * 32 * 4;
constexpr size_t WS_H0 = WS_PROJ;
constexpr size_t WS_MGU = WS_BIG;
constexpr size_t WS_MDN = WS_MGU + (size_t)NEXP * 2 * FFE * DM * 2;
constexpr size_t WS_XS = WS_MDN + (size_t)NEXP * DM * FFE * 2;
constexpr size_t WS_HM = WS_XS + (size_t)MAXPANELS * 256 * DM * 2;
constexpr size_t WS_YM = WS_HM + (size_t)64 * 256 * FFE * 2;
constexpr size_t WS_MOE_END = WS_YM + (size_t)NT * 2 * DM * 2;
constexpr size_t WS_END = WS_MOE_END > WS_MIX_END ? WS_MOE_END : WS_MIX_END;

struct Args {
    const float* in[22]; float* out; unsigned char* ws; int ph_lo, ph_hi;
};
typedef const __attribute__((address_space(4))) Args* KArgsP;

struct EpiInProj {
    static constexpr bool PERM = false, HAS_MID = false;
    unsigned char* ws;
    __device__ __forceinline__ void operator()(const f32x4 (&acc)[2][2][4][2], const pg8::Unit& u, int wr, int wc, int fr, int fq) const {
        const int row0 = u.pm * 256 + wr * 64 + fr;
#pragma unroll
        for (int bj = 0; bj < 2; ++bj)
#pragma unroll
            for (int n = 0; n < 2; ++n) {
                const int cb = u.pn * 256 + bj * 128 + wc * 32 + n * 16;
                const int c = cb + 4 * fq;
                int kind = 0, ld = 512, co = 0; size_t base = 0; float sc = 1.f;
                if (cb < 512) { base = WS_QHG; co = c; }
                else if (cb < 1024) { kind = 1; base = WS_HF; co = c - 512; }
                else if (cb < 1536) { base = WS_HI; co = c - 1024; }
                else if (cb < 2048) { base = WS_HG; co = c - 1536; }
                else if (cb < 2560) { base = WS_NQ; co = c - 2048; sc = 0.125f * 1.4426950408889634f; }
                else if (cb < 3328) { kind = 3; base = WS_KV6; const int idx = cb - 2560; co = ((idx >> 7) * 8 + ((idx >> 6) & 1)) * SEQ * 64 + (idx & 63) + 4 * fq; }
                else if (cb < 4352) { base = WS_GA; co = c - 3328; ld = 1024; }
                else if (cb < 5376) { base = WS_GB; co = c - 4352; ld = 1024; }
                else if (cb < 5408) { kind = 1; base = WS_NG; co = c - 5376; ld = 32; }
                else kind = 2;
                if (kind == 2) continue;
#pragma unroll
                for (int ai = 0; ai < 2; ++ai)
#pragma unroll
                    for (int m = 0; m < 4; ++m) {
                        const int row = row0 + ai * 128 + m * 16;
                        const f32x4 v = acc[ai][bj][m][n];
                        if (kind == 0) { u32x2 w; w.x = cvt_pk_bf16(v[0] * sc, v[1] * sc); w.y = cvt_pk_bf16(v[2] * sc, v[3] * sc); *(u32x2*)((bf16*)(ws + base) + (size_t)row * ld + co) = w; }
                        else if (kind == 3) { u32x2 w; w.x = cvt_pk_bf16(v[0], v[1]); w.y = cvt_pk_bf16(v[2], v[3]); *(u32x2*)((bf16*)(ws + base) + (size_t)co + ((size_t)(row >> 13) * 2 * SEQ + (row & (SEQ - 1))) * 64) = w; }
                        else *(f32x4*)((float*)(ws + base) + (size_t)row * ld + co) = v;
                    }
            }
    }
};
struct EpiCmpHid {
    static constexpr bool PERM = false, HAS_MID = false;
    bf16* HID; const float* B1;
    __device__ __forceinline__ void operator()(const f32x4 (&acc)[2][2][4][2], const pg8::Unit& u, int wr, int wc, int fr, int fq) const {
        const int row0 = u.pm * 256 + wr * 64 + fr, col0 = wc * 32 + 4 * fq;
#pragma unroll
        for (int n = 0; n < 2; ++n) { const f32x4 bq = *(const f32x4*)(B1 + u.e * 128 + col0 + n * 16);
#pragma unroll
            for (int ai = 0; ai < 2; ++ai)
#pragma unroll
                for (int m = 0; m < 4; ++m) { const f32x4 v = acc[ai][0][m][n] + bq; float o[4];
#pragma unroll
                    for (int q = 0; q < 4; ++q) { const float x = v[q]; o[q] = 0.5f * x * (1.f + tanhf(0.7978845608028654f * (x + 0.044715f * x * x * x))); }
                    u32x2 w; w.x = cvt_pk_bf16(o[0], o[1]); w.y = cvt_pk_bf16(o[2], o[3]);
                    *(u32x2*)(HID + (size_t)(row0 + ai * 128 + m * 16) * 128 + col0 + n * 16) = w; } }
    }
};
template <bool FIRST> struct EpiGate {
    static constexpr bool PERM = false, HAS_MID = false;
    bf16* Y; const bf16* G;
    __device__ __forceinline__ void operator()(const f32x4 (&acc)[2][2][4][2], const pg8::Unit& u, int wr, int wc, int fr, int fq) const {
        const int row0 = u.pm * 256 + wr * 64 + fr, col0 = u.pn * 256 + wc * 32 + 4 * fq;
#pragma unroll
        for (int ai = 0; ai < 2; ++ai)
#pragma unroll
            for (int m = 0; m < 4; ++m)
#pragma unroll
                for (int bj = 0; bj < 2; ++bj)
#pragma unroll
                    for (int n = 0; n < 2; ++n) {
                        const size_t off = (size_t)(row0 + ai * 128 + m * 16) * DM + col0 + bj * 128 + n * 16;
                        const u32x2 gq = *(const u32x2*)(G + off);
                        const f32x4 v = acc[ai][bj][m][n];
                        float o0 = sigmoidf_(bflo(gq.x)) * v[0], o1 = sigmoidf_(bfhi(gq.x)) * v[1], o2 = sigmoidf_(bflo(gq.y)) * v[2], o3 = sigmoidf_(bfhi(gq.y)) * v[3];
                        if (!FIRST) { const u32x2 yq = *(const u32x2*)(Y + off); o0 += bflo(yq.x); o1 += bfhi(yq.x); o2 += bflo(yq.y); o3 += bfhi(yq.y); }
                        u32x2 w; w.x = cvt_pk_bf16(o0, o1); w.y = cvt_pk_bf16(o2, o3); *(u32x2*)(Y + off) = w;
                    }
    }
};
struct EpiGate2 {
    static constexpr bool PERM = false, HAS_MID = true;
    bf16* Y; const bf16* GA; const bf16* GB;
    static __device__ __forceinline__ float cl(float x) { return fminf(fmaxf(x, -30.f), 30.f); }
    __device__ __forceinline__ void mid(f32x4 (&acc)[2][2][4][2], const pg8::Unit& u, int wr, int wc, int fr, int fq) const {
        int row0 = u.pm * 256 + wr * 64 + fr; const int col0 = u.pn * 256 + wc * 32 + 4 * fq;
        asm volatile("" : "+v"(row0));
#pragma unroll
        for (int ai = 0; ai < 2; ++ai)
#pragma unroll
            for (int m = 0; m < 4; ++m) {
#pragma unroll
                for (int bj = 0; bj < 2; ++bj)
#pragma unroll
                    for (int n = 0; n < 2; ++n) {
                        const size_t off = (size_t)(row0 + ai * 128 + m * 16) * DM + col0 + bj * 128 + n * 16;
                        const u32x2 ga = *(const u32x2*)(GA + off), gb = *(const u32x2*)(GB + off);
                        f32x4 r;
                        r[0] = (1.f + __expf(-cl(bflo(gb.x)))) * __builtin_amdgcn_rcpf(1.f + __expf(-cl(bflo(ga.x))));
                        r[1] = (1.f + __expf(-cl(bfhi(gb.x)))) * __builtin_amdgcn_rcpf(1.f + __expf(-cl(bfhi(ga.x))));
                        r[2] = (1.f + __expf(-cl(bflo(gb.y)))) * __builtin_amdgcn_rcpf(1.f + __expf(-cl(bflo(ga.y))));
                        r[3] = (1.f + __expf(-cl(bfhi(gb.y)))) * __builtin_amdgcn_rcpf(1.f + __expf(-cl(bfhi(ga.y))));
                        acc[ai][bj][m][n] = acc[ai][bj][m][n] * r;
                    }
                asm volatile("" : "+v"(acc[ai][0][m][0]), "+v"(acc[ai][0][m][1]), "+v"(acc[ai][1][m][0]), "+v"(acc[ai][1][m][1]) :: "memory");
            }
    }
    __device__ __forceinline__ void operator()(const f32x4 (&acc)[2][2][4][2], const pg8::Unit& u, int wr, int wc, int fr, int fq) const {
        const int row0 = u.pm * 256 + wr * 64 + fr, col0 = u.pn * 256 + wc * 32 + 4 * fq;
#pragma unroll
        for (int ai = 0; ai < 2; ++ai)
#pragma unroll
            for (int m = 0; m < 4; ++m)
#pragma unroll
                for (int bj = 0; bj < 2; ++bj)
#pragma unroll
                    for (int n = 0; n < 2; ++n) {
                        const size_t off = (size_t)(row0 + ai * 128 + m * 16) * DM + col0 + bj * 128 + n * 16;
                        const u32x2 gb = *(const u32x2*)(GB + off);
                        const f32x4 v = acc[ai][bj][m][n];
                        u32x2 w; w.x = cvt_pk_bf16(v[0] * sigmoidf_(cl(bflo(gb.x))), v[1] * sigmoidf_(cl(bfhi(gb.x)))); w.y = cvt_pk_bf16(v[2] * sigmoidf_(cl(bflo(gb.y))), v[3] * sigmoidf_(cl(bfhi(gb.y))));
                        *(u32x2*)(Y + off) = w;
                    }
    }
};
struct EpiResid {
    static constexpr bool PERM = false, HAS_MID = false;
    const float* XI; float* XO;
    __device__ __forceinline__ void operator()(const f32x4 (&acc)[2][2][4][2], const pg8::Unit& u, int wr, int wc, int fr, int fq) const {
        const int row0 = u.pm * 256 + wr * 64 + fr, col0 = u.pn * 256 + wc * 32 + 4 * fq;
#pragma unroll
        for (int ai = 0; ai < 2; ++ai)
#pragma unroll
            for (int m = 0; m < 4; ++m)
#pragma unroll
                for (int bj = 0; bj < 2; ++bj)
#pragma unroll
                    for (int n = 0; n < 2; ++n) {
                        const size_t off = (size_t)(row0 + ai * 128 + m * 16) * DM + col0 + bj * 128 + n * 16;
                        const f32x4 xi = *(const f32x4*)(XI + off);
                        *(f32x4*)(XO + off) = xi * DN_ALPHA + acc[ai][bj][m][n];
                    }
    }
};
struct EpiSwiglu {
    static constexpr bool PERM = false, HAS_MID = false;
    bf16* H; int ldh;
    __device__ __forceinline__ void operator()(const f32x4 (&acc)[2][2][4][2], const pg8::Unit& u, int wr, int wc, int fr, int fq) const {
        const int row0 = u.pm * 256 + wr * 64 + fr, col0 = u.pn * 128 + wc * 32 + 4 * fq;
#pragma unroll
        for (int ai = 0; ai < 2; ++ai)
#pragma unroll
            for (int m = 0; m < 4; ++m)
#pragma unroll
                for (int n = 0; n < 2; ++n) {
                    const f32x4 gq = acc[ai][0][m][n], uq = acc[ai][1][m][n];
                    u32x2 w; w.x = cvt_pk_bf16(siluf_(gq[0]) * uq[0], siluf_(gq[1]) * uq[1]); w.y = cvt_pk_bf16(siluf_(gq[2]) * uq[2], siluf_(gq[3]) * uq[3]);
                    *(u32x2*)(H + (size_t)(row0 + ai * 128 + m * 16) * ldh + col0 + n * 16) = w;
                }
    }
};
struct EpiScatter {
    static constexpr bool PERM = false, HAS_MID = false;
    bf16* Y; const int* rowinfo;
    __device__ __forceinline__ void operator()(const f32x4 (&acc)[2][2][4][2], const pg8::Unit& u, int wr, int wc, int fr, int fq) const {
        const int row0 = u.pm * 256 + wr * 64 + fr, col0 = u.pn * 256 + wc * 32 + 4 * fq;
#pragma unroll
        for (int ai = 0; ai < 2; ++ai)
#pragma unroll
            for (int m = 0; m < 4; ++m) {
                const int info = rowinfo[row0 + ai * 128 + m * 16];
                if (info < 0) continue;
#pragma unroll
                for (int bj = 0; bj < 2; ++bj)
#pragma unroll
                    for (int n = 0; n < 2; ++n) {
                        const f32x4 v = acc[ai][bj][m][n];
                        u32x2 w; w.x = cvt_pk_bf16(v[0], v[1]); w.y = cvt_pk_bf16(v[2], v[3]);
                        *(u32x2*)(Y + (size_t)info * DM + col0 + bj * 128 + n * 16) = w;
                    }
            }
    }
};

template <int N> struct IConst { static constexpr int value = N; };
__device__ __forceinline__ int rel_bucket(int n) {
    if (n < 16) return n;
    return 16 + (n >= 22) + (n >= 30) + (n >= 40) + (n >= 54) + (n >= 73) + (n >= 99) + (n >= 134) + (n >= 182) + (n >= 246) + (n >= 332) + (n >= 450) + (n >= 609) + (n >= 825) + (n >= 1117) + (n >= 1513);
}
template <class F>
__device__ __forceinline__ void tr_item(F colptr, int ld, int Kvalid, bf16* dst, int dstld, int n0, int k0, LAS float* scr, int lane) {
    const float* cp = colptr(n0 + 4 * (lane & 7));
#pragma unroll
    for (int i = 0; i < 8; ++i) { const int kk = 8 * i + (lane >> 3), k = k0 + kk; f32x4 v = (f32x4){0.f, 0.f, 0.f, 0.f}; if (cp && k < Kvalid) v = *(const f32x4*)(cp + (size_t)k * ld);
        LAS float* s = scr + kk * 33 + 4 * (lane & 7); s[0] = v[0]; s[1] = v[1]; s[2] = v[2]; s[3] = v[3]; }
    WAVE_SYNC();
    const int c = lane & 7;
#pragma unroll
    for (int j = 0; j < 4; ++j) { const int n = (lane >> 3) + 8 * j; const LAS float* s = scr + (8 * c) * 33 + n;
        u32x4 o; o.x = cvt_pk_bf16(s[0 * 33], s[1 * 33]); o.y = cvt_pk_bf16(s[2 * 33], s[3 * 33]); o.z = cvt_pk_bf16(s[4 * 33], s[5 * 33]); o.w = cvt_pk_bf16(s[6 * 33], s[7 * 33]);
        *(u32x4*)(dst + (size_t)(n0 + n) * dstld + k0 + 8 * c) = o; }
    WAVE_SYNC();
}

__global__ void __launch_bounds__(NTHR, 2) mega_fwd(Args args) {
    extern __shared__ __attribute__((aligned(16))) unsigned char lds_raw[];
    LAS unsigned char* lds = (LAS unsigned char*)lds_raw;
    const int G = gridDim.x, bid = blockIdx.x;
    const int nwaves = G * NWAVES;
    KArgsP kap = (KArgsP)__builtin_amdgcn_kernarg_segment_ptr();
    unsigned char* ws0 = kap->ws;
#if ONE_LAUNCH
    constexpr int lo = 0, hi = 64;
#else
    const int lo = kap->ph_lo, hi = kap->ph_hi;
#endif

    volatile LAS unsigned* misc = (volatile LAS unsigned*)(lds + MISC_OFF);
    const int wave_s = __builtin_amdgcn_readfirstlane((int)threadIdx.x >> 6);
    if (wave_s == 0 && lane_id() < 16) misc[lane_id()] = 0u;
    __syncthreads();
    XcdBarrier bar; bar.bar = (unsigned*)(ws0 + WS_CTL + CW_BAR); bar.x = 0; bar.st = misc;
    const bool multi = (hi - lo) > 1;
    if (multi) bar = xcd_barrier_post((unsigned*)(ws0 + WS_CTL + CW_BAR), misc, wave_s == 0 && lane_id() == 0);
#ifndef EN_MASK
#define EN_MASK 0xFFFFFFFFu
#endif
#define EN(b) (((EN_MASK) >> (b)) & 1u)
#define IN(k) (lo <= (k) && (k) < hi)
#ifndef PROBE_GRP
#define PROBE_GRP -1
#endif
#define PROBE_K 4
#ifndef STAGGER_TICKS
#define STAGGER_TICKS 0
#endif
#ifndef SELREP
#define SELREP 1
#endif
#define WINREP 1
#define NSA_SGB 1
#define NSA_DUP_A 0
#define NSA_DUP_B 0
#define NSA_DUP_C 0
#ifndef PROBE_SCALE
#define PROBE_SCALE 1e-6f
#endif
#if PROBE_GRP >= 0
    unsigned long long pr_last = __builtin_amdgcn_s_memrealtime(), pr_acc = 0ull;
#define PMARK(g) do { const unsigned long long _n = __builtin_amdgcn_s_memrealtime(); if ((g) == PROBE_GRP) pr_acc += _n - pr_last; pr_last = _n; } while (0)
#else
    const unsigned long long pr_acc = 0ull; (void)pr_acc;
#define PMARK(g) do { } while (0)
#endif
#define SEAM(k, g) do { if (IN(k) && IN((k) + 1)) { XcdBarrier b_ = bar; asm volatile("" : "+s"(b_.bar)); unsigned bx_ = b_.x; asm volatile("" : "+s"(bx_)); b_.x = bx_; \
        xcd_barrier(b_, wave_s == 0 && lane_id() == 0); } PMARK(g); } while (0)


    if (EN(0) && IN(0)) { PHASE_IDS();
        LAS float* scr = (LAS float*)(lds + wave * 16384);
        constexpr int I_WIN = 16 * (NINP / 32), I_BR = 8 * 32, I_OUT = 16 * 32, I_GU = 16 * (NINP / 32), I_DN = (FF0P / 64) * 32;
        constexpr int I_W1 = 32 * 8;
        constexpr int NITEMS = 2 * (I_WIN + 2 * I_BR + I_OUT) + I_GU + I_DN + 4 * I_W1;
        for (int it = gwave; it < NITEMS; it += nwaves) {
            int r = it;
            if (r < 2 * I_WIN) { const int l = r / I_WIN; r %= I_WIN; const int nb = r % (NINP / 32), kb = r / (NINP / 32);
                const float* W = ap->in[1] + (size_t)l * DM * 5400;
                auto cp = [=](int n) -> const float* { int c; if (n < 3328) c = n; else if (n < 5376) c = n + 24; else if (n < 5400) c = n - 5376 + 3328; else return nullptr; return W + c; };
                tr_item(cp, 5400, DM, (bf16*)(ws + (l ? WS_WIN1 : WS_WIN0)), DM, nb * 32, kb * 64, scr, lane); continue; }
            r -= 2 * I_WIN;
            if (r < 4 * I_BR) { const int which = r / I_BR; r %= I_BR; const int l = which & 1, ab = which >> 1; const int nb = r % 32, kb = r / 32;
                const float* W = ap->in[ab ? 9 : 8] + (size_t)l * 512 * DM;
                auto cp = [=](int n) -> const float* { return W + n; };
                tr_item(cp, DM, 512, (bf16*)(ws + WS_WBA0 + (size_t)l * 2 * SZ_WBR) + ab * 512, DM, nb * 32, kb * 64, scr, lane); continue; }
            r -= 4 * I_BR;
            if (r < 2 * I_OUT) { const int l = r / I_OUT; r %= I_OUT; const int nb = r % 32, kb = r / 32;
                const float* W = ap->in[10] + (size_t)l * DM * DM;
                auto cp = [=](int n) -> const float* { return W + n; };
                tr_item(cp, DM, DM, (bf16*)(ws + (l ? WS_WOUT1 : WS_WOUT0)), DM, nb * 32, kb * 64, scr, lane); continue; }
            r -= 2 * I_OUT;
            if (r < I_GU) { const int nb = r % (NINP / 32), kb = r / (NINP / 32);
                const float* Wg = ap->in[15]; const float* Wu = ap->in[16];
                auto cp = [=](int n) -> const float* { const int pn = n >> 8, hf = (n >> 7) & 1, c = pn * 128 + (n & 127); if (c >= FF0) return nullptr; return (hf ? Wu : Wg) + c; };
                tr_item(cp, FF0, DM, (bf16*)(ws + WS_WGU0), DM, nb * 32, kb * 64, scr, lane); continue; }
            r -= I_GU;
            if (r >= I_DN) { r -= I_DN; const int lk = r / I_W1; r %= I_W1; const int nb = r % 8, kb = r / 8;
                const float* W = ap->in[5] + (size_t)lk * 2048 * 128;
                auto cp = [=](int n) -> const float* { return n < 128 ? W + n : nullptr; };
                tr_item(cp, 128, 2048, (bf16*)(ws + WS_W1T) + (size_t)lk * 256 * 2048, 2048, nb * 32, kb * 64, scr, lane); continue; }
            { const int nb = r % 32, kb = r / 32;
                const float* W = ap->in[17];
                auto cp = [=](int n) -> const float* { return W + n; };
                tr_item(cp, DM, FF0, (bf16*)(ws + WS_WDN0), FF0P, nb * 32, kb * 64, scr, lane); }
        }
        for (int row = gwave; row < NT; row += nwaves) {
            const f32x4* xr = (const f32x4*)(x_in + (size_t)row * DM);
            u32x2* o = (u32x2*)(XB + (size_t)row * DM);
#pragma unroll
            for (int j = 0; j < 4; ++j) { const f32x4 v = xr[64 * j + lane]; u32x2 w; w.x = cvt_pk_bf16(v[0], v[1]); w.y = cvt_pk_bf16(v[2], v[3]); o[64 * j + lane] = w; }
        }
        for (int o = gwave; o < 4 * 128; o += nwaves) { const int lk = o >> 7, j = o & 127; const float* PS = ap->in[4] + (size_t)lk * 2048; const float* W = ap->in[5] + (size_t)lk * 2048 * 128;
            float s = 0.f; for (int k = lane; k < 2048; k += 64) s += PS[k] * W[(size_t)k * 128 + j];
            s = wave_sum(s); if (lane == 0) ((float*)(ws + WS_B1))[o] = s; }
        if (bid == 0 && tid < 32) ((int*)(ws + WS_CTL + CW_PE32))[tid] = tid >> 4;
        if (bid == 0) {
            const float* lg = ap->in[2];
            const float a = lg[tid], b = lg[512 + tid], m = fmaxf(a, b), ea = expf(a - m), eb = expf(b - m), s = ea + eb, p0 = ea / s, p1 = eb / s;
            LBS[tid] = p0 - p0; LBS[512 + tid] = (p0 + p1) - p0;
        }
    }
    SEAM(0, 0);

    for (int l = 0; l < 2; ++l) {
        const int pb = 1 + l * 10;

        if (EN(1) && IN(pb + 0)) { PHASE_IDS();
            if (STAGGER_TICKS > 0 && ((bid >> 3) & 1)) { const unsigned long long t0 = __builtin_amdgcn_s_memrealtime(); while (__builtin_amdgcn_s_memrealtime() - t0 < (unsigned long long)STAGGER_TICKS) __builtin_amdgcn_s_sleep(8); }
            pg8::Gemm g{XB, (const bf16*)(ws + (l ? WS_WIN1 : WS_WIN0)), NT, NINP, DM, 0, 0, nullptr, 0};
            pg8::StaticOrder S; S.init(NT, NINP, G, bid);
            EpiInProj E{ws};
            pg8::gemm_phase<EpiInProj, pg8::StaticOrder>(lds, g, S, E, wave_s);
        }
        SEAM(pb + 0, 1);

        if (EN(2) && IN(pb + 1)) { PHASE_IDS();
            {
                constexpr int RS = 272;
                LAS float* bsf = (LAS float*)lds;
                LAS unsigned char* kd = lds + 32768;
                LAS unsigned char* vt = lds + 32768 + 64 * RS;
                const bf16* HI = (const bf16*)(ws + WS_HI); const float* HF = (const float*)(ws + WS_HF);
                bf16* US = (bf16*)(ws + WS_US); float* DEC = (float*)(ws + WS_DEC);
                const int d = tid & 127, tp = tid >> 7;
                const int d0 = 4 * (tid & 31), tg = tid >> 5;
                f32x4 zr[4]; u32x4 vp0, vp1;
                auto ld_z = [&](int it) { const int h = it & 3, ci = (it >> 2) & 127, b = it >> 9; const size_t tok0 = (size_t)b * SEQ + ci * 64;
#pragma unroll
                    for (int i = 0; i < 4; ++i) zr[i] = *(const f32x4*)(HF + (tok0 + tg + 16 * i) * 512 + h * 128 + d0);
                    const u32x4* src = (const u32x4*)(HI + (tok0 + (tid >> 3)) * 512 + h * 128) + (tid & 7) * 2; vp0 = src[0]; vp1 = src[1]; };
                ld_z(bid);
                LAS float* lbl = (LAS float*)(vt + 64 * RS);
                lbl[tid] = LBS[l * 512 + tid];
                __syncthreads();
                for (int item = bid; item < NB * 128 * 4; item += G) {
                    const int h = item & 3, ci = (item >> 2) & 127, b = item >> 9, bh = b * 4 + h;
                    const size_t tok0 = (size_t)b * SEQ + ci * 64;
                    const f32x4 lb4 = *(const LAS f32x4*)(lbl + h * 128 + d0);
                    f32x4 kk[4];
#pragma unroll
                    for (int i = 0; i < 4; ++i) { const int t = tg + 16 * i; f32x4 lg;
#pragma unroll
                        for (int c = 0; c < 4; ++c) { kk[i][c] = (1.f - lb4[c]) * __builtin_amdgcn_rcpf(1.f + __expf(zr[i][c])); lg[c] = __logf(1.f - kk[i][c]); }
                        *(LAS f32x4*)(bsf + t * 128 + d0) = lg; }
                    { const int t = tid >> 3, c8 = tid & 7; *(LAS u32x4*)(vt + t * RS + c8 * 32) = vp0; *(LAS u32x4*)(vt + t * RS + c8 * 32 + 16) = vp1; }
                    LDS_SYNC();
                    { float run = 0.f;
#pragma unroll
                        for (int i = 0; i < 16; ++i) { run += bsf[(16 * tp + i) * 128 + d]; bsf[(16 * tp + i) * 128 + d] = run; } }
                    LDS_SYNC();
                    float off = 0.f;
                    for (int p = 0; p < tp; ++p) off += bsf[(16 * p + 15) * 128 + d];
                    LDS_SYNC();
#pragma unroll
                    for (int i = 0; i < 16; ++i) bsf[(16 * tp + i) * 128 + d] += off;
                    LDS_SYNC();
                    { const f32x4 bl = *(const LAS f32x4*)(bsf + 63 * 128 + d0);
                        if (tg == 0) { f32x4 e; e[0] = __expf(bl[0]); e[1] = __expf(bl[1]); e[2] = __expf(bl[2]); e[3] = __expf(bl[3]); *(f32x4*)(DEC + ((size_t)bh * 128 + ci) * 128 + d0) = e; }
#pragma unroll
                        for (int i = 0; i < 4; ++i) { const int t = tg + 16 * i; const f32x4 bt = *(const LAS f32x4*)(bsf + t * 128 + d0);
                            u32x2 w; w.x = cvt_pk_bf16(kk[i][0] * __expf(bl[0] - bt[0]), kk[i][1] * __expf(bl[1] - bt[1])); w.y = cvt_pk_bf16(kk[i][2] * __expf(bl[2] - bt[2]), kk[i][3] * __expf(bl[3] - bt[3]));
                            *(LAS u32x2*)(kd + t * RS + d0 * 2) = w; } }
                    LDS_SYNC();
                    ld_z(min(item + G, NB * 128 * 4 - 1));
                    {
                        const int mi = wave >> 1, r31 = lane & 31, hh = lane >> 5, i16 = lane & 15, sub = (lane >> 4) & 1;
                        f32x16 acc[2];
#pragma unroll
                        for (int q = 0; q < 2; ++q)
#pragma unroll
                            for (int r = 0; r < 16; ++r) acc[q][r] = 0.f;
#pragma unroll
                        for (int st = 0; st < 4; ++st) {
                            const LAS unsigned char* ka = kd + (16 * st + 8 * hh + (i16 >> 2)) * RS + (32 * mi + 16 * sub + 4 * (i16 & 3)) * 2;
                            const s16x4 k0 = __builtin_amdgcn_ds_read_tr16_b64_v4i16((LAS s16x4*)ka), k1 = __builtin_amdgcn_ds_read_tr16_b64_v4i16((LAS s16x4*)(ka + 4 * RS));
                            const bf16x8 af = __builtin_shufflevector(k0, k1, 0, 1, 2, 3, 4, 5, 6, 7);
#pragma unroll
                            for (int q = 0; q < 2; ++q) { const int ni = 2 * (wave & 1) + q;
                                const LAS unsigned char* va = vt + (16 * st + 8 * hh + (i16 >> 2)) * RS + (32 * ni + 16 * sub + 4 * (i16 & 3)) * 2;
                                const s16x4 v0 = __builtin_amdgcn_ds_read_tr16_b64_v4i16((LAS s16x4*)va), v1 = __builtin_amdgcn_ds_read_tr16_b64_v4i16((LAS s16x4*)(va + 4 * RS));
                                const bf16x8 bf = __builtin_shufflevector(v0, v1, 0, 1, 2, 3, 4, 5, 6, 7);
                                acc[q] = __builtin_amdgcn_mfma_f32_32x32x16_bf16(af, bf, acc[q], 0, 0, 0); } }
                        bf16* u = US + ((size_t)bh * 128 + ci) * 16384;
#pragma unroll
                        for (int q = 0; q < 2; ++q) { const int dv = 32 * (2 * (wave & 1) + q) + r31;
#pragma unroll
                            for (int rq = 0; rq < 4; ++rq) { u32x2 w; w.x = cvt_pk_bf16(acc[q][4 * rq], acc[q][4 * rq + 1]); w.y = cvt_pk_bf16(acc[q][4 * rq + 2], acc[q][4 * rq + 3]);
                                *(u32x2*)(u + dv * 128 + 32 * mi + 8 * rq + 4 * hh) = w; } }
                    }
                    LDS_SYNC();
                }
            }
            {
                pg8::Gemm g{(const bf16*)(ws + WS_KV6), (const bf16*)(ws + WS_W1T) + (size_t)l * 2 * 256 * 2048, 8192, 256, 2048, (size_t)256 * 2048, 1024, nullptr, 0};
                pg8::StaticOrder S; S.init(8192, 256, G, bid, (const int*)(ws + WS_CTL + CW_PE32));
                EpiCmpHid E{(bf16*)(ws + WS_HID), (const float*)(ws + WS_B1) + l * 256};
                pg8::gemm_phase<EpiCmpHid, pg8::StaticOrder>(lds, g, S, E, wave_s);
            }
        }
        SEAM(pb + 1, 2);

        if (EN(3) && IN(pb + 2)) { PHASE_IDS();
            {
                unsigned* US32 = (unsigned*)(ws + WS_US); const float* DEC = (const float*)(ws + WS_DEC);
                for (int e2 = bid * NTHR + tid; e2 < 16 * 8192; e2 += G * NTHR) {
                    const int bh = e2 >> 13, dv2 = e2 & 8191, d = (2 * dv2) & 127;
                    float s0 = 0.f, s1 = 0.f;
                    unsigned* up = US32 + (size_t)bh * 128 * 8192 + dv2; const float* dp = DEC + (size_t)bh * 128 * 128 + d;
                    unsigned uA[16], uB[16]; f32x2 dA[16], dB[16];
#pragma unroll
                    for (int i = 0; i < 16; ++i) { uA[i] = up[(size_t)i * 8192]; dA[i] = *(const f32x2*)(dp + i * 128); }
#pragma unroll 1
                    for (int c0 = 0; c0 < 128; c0 += 32) {
#pragma unroll
                        for (int i = 0; i < 16; ++i) { uB[i] = up[(size_t)(c0 + 16 + i) * 8192]; dB[i] = *(const f32x2*)(dp + (c0 + 16 + i) * 128); }
#pragma unroll
                        for (int i = 0; i < 16; ++i) { up[(size_t)(c0 + i) * 8192] = cvt_pk_bf16(s0, s1); s0 = dA[i][0] * s0 + bflo(uA[i]); s1 = dA[i][1] * s1 + bfhi(uA[i]); }
                        const int cn = min(c0 + 32, 112);
#pragma unroll
                        for (int i = 0; i < 16; ++i) { uA[i] = up[(size_t)(cn + i) * 8192]; dA[i] = *(const f32x2*)(dp + (cn + i) * 128); }
#pragma unroll
                        for (int i = 0; i < 16; ++i) { up[(size_t)(c0 + 16 + i) * 8192] = cvt_pk_bf16(s0, s1); s0 = dB[i][0] * s0 + bflo(uB[i]); s1 = dB[i][1] * s1 + bfhi(uB[i]); }
                    }
                }
            }
            {
                const bf16* HID = (const bf16*)(ws + WS_HID); bf16* KCb = (bf16*)(ws + WS_KC);
                for (int row = gwave; row < 8192; row += nwaves) { const int kind = row >> 12;
                    const float* W2 = ap->in[6] + ((size_t)l * 2 + kind) * 128 * 64;
                    const unsigned hv = ((const unsigned*)(HID + (size_t)row * 128))[lane];
                    float o = 0.f;
#pragma unroll 8
                    for (int j = 0; j < 64; ++j) { const unsigned hj = (unsigned)__builtin_amdgcn_readlane((int)hv, j); o += bflo(hj) * W2[(2 * j) * 64 + lane] + bfhi(hj) * W2[(2 * j + 1) * 64 + lane]; }
                    KCb[(size_t)row * 64 + lane] = f2bf(o); }
            }
        }
        SEAM(pb + 2, 3);

        if (EN(4) && IN(pb + 3)) {
          if (EN(16)) { PHASE_IDS();
            {
                constexpr int RS = 272;
                LAS float* bsf = (LAS float*)lds;
                LAS unsigned char* qh = lds + 32768;
                LAS unsigned char* q1 = qh + 64 * RS;
                LAS unsigned char* k0 = q1 + 32 * RS;
                LAS unsigned char* k1 = k0 + 32 * RS;
                LAS unsigned char* vt = k1 + 64 * RS;
                LAS float* ssq = (LAS float*)(vt + 64 * RS);
                LAS float* nwl = ssq + 256;
                LAS float* lbl = nwl + 512;
                bf16* QHG = (bf16*)(ws + WS_QHG); const bf16* HI = (const bf16*)(ws + WS_HI); const bf16* HG = (const bf16*)(ws + WS_HG); const float* HF = (const float*)(ws + WS_HF);
                const bf16* US = (const bf16*)(ws + WS_US);
                const float* NW = ap->in[3] + l * 512;
                const int d = tid & 127, tp = tid >> 7;
                const int d0 = 4 * (tid & 31), tg = tid >> 5;
                f32x4 z4[4]; u32x2 qp[4];
                auto ld_zq = [&](int it) { const int h = it & 3, ci = (it >> 2) & 127, b = it >> 9; const size_t tok0 = (size_t)b * SEQ + ci * 64;
#pragma unroll
                    for (int i = 0; i < 4; ++i) { const size_t go = (tok0 + tg + 16 * i) * 512 + h * 128 + d0; z4[i] = *(const f32x4*)(HF + go); qp[i] = *(const u32x2*)(QHG + go); } };
                ld_zq(bid);
                nwl[tid] = NW[tid]; lbl[tid] = LBS[l * 512 + tid];
                __syncthreads();
                int item = bid;
                do {
                    const int h = item & 3, ci = (item >> 2) & 127, b = item >> 9, bh = b * 4 + h;
                    const size_t tok0 = (size_t)b * SEQ + ci * 64;
                    const f32x4 lb4 = *(const LAS f32x4*)(lbl + h * 128 + d0);
                    f32x4 kk[4];
                    {
#pragma unroll
                        for (int i = 0; i < 4; ++i) { const int t = tg + 16 * i; f32x4 lg;
#pragma unroll
                            for (int c = 0; c < 4; ++c) { kk[i][c] = (1.f - lb4[c]) * __builtin_amdgcn_rcpf(1.f + __expf(z4[i][c])); lg[c] = __logf(1.f - kk[i][c]); }
                            *(LAS f32x4*)(bsf + t * 128 + d0) = lg; } }
                    { const int t = tid >> 3, c8 = tid & 7;
                        const u32x4* src = (const u32x4*)(HI + (tok0 + t) * 512 + h * 128) + c8 * 2;
                        const u32x4 a0 = src[0], a1 = src[1]; *(LAS u32x4*)(vt + t * RS + c8 * 32) = a0; *(LAS u32x4*)(vt + t * RS + c8 * 32 + 16) = a1; }
                    bf16x8 sf[8];
                    { const bf16* Sg = US + ((size_t)bh * 128 + ci) * 16384 + (size_t)(32 * (wave & 3) + (lane & 31)) * 128 + 8 * (lane >> 5);
#pragma unroll
                        for (int st = 0; st < 8; ++st) sf[st] = *(const bf16x8*)(Sg + 16 * st); }
                    LDS_SYNC();
                    { float run = 0.f;
#pragma unroll
                        for (int i = 0; i < 16; ++i) { run += bsf[(16 * tp + i) * 128 + d]; bsf[(16 * tp + i) * 128 + d] = run; } }
                    LDS_SYNC();
                    float off = 0.f;
                    for (int p = 0; p < tp; ++p) off += bsf[(16 * p + 15) * 128 + d];
                    LDS_SYNC();
#pragma unroll
                    for (int i = 0; i < 16; ++i) bsf[(16 * tp + i) * 128 + d] += off;
                    LDS_SYNC();
                    { const f32x4 b31 = *(const LAS f32x4*)(bsf + 31 * 128 + d0);
#pragma unroll
                        for (int i = 0; i < 4; ++i) { const int t = tg + 16 * i; const f32x4 bt = *(const LAS f32x4*)(bsf + t * 128 + d0);
                            const float q0 = bflo(qp[i].x), q1v = bfhi(qp[i].x), q2 = bflo(qp[i].y), q3 = bfhi(qp[i].y);
                            u32x2 w;
                            w.x = cvt_pk_bf16(q0 * __expf(bt[0]), q1v * __expf(bt[1])); w.y = cvt_pk_bf16(q2 * __expf(bt[2]), q3 * __expf(bt[3]));
                            *(LAS u32x2*)(qh + t * RS + d0 * 2) = w;
                            w.x = cvt_pk_bf16(kk[i][0] * __expf(fminf(b31[0] - bt[0], 80.f)), kk[i][1] * __expf(fminf(b31[1] - bt[1], 80.f)));
                            w.y = cvt_pk_bf16(kk[i][2] * __expf(fminf(b31[2] - bt[2], 80.f)), kk[i][3] * __expf(fminf(b31[3] - bt[3], 80.f)));
                            *(LAS u32x2*)(k1 + t * RS + d0 * 2) = w;
                            if (i < 2) {
                                w.x = cvt_pk_bf16(kk[i][0] * __expf(fminf(-bt[0], 80.f)), kk[i][1] * __expf(fminf(-bt[1], 80.f)));
                                w.y = cvt_pk_bf16(kk[i][2] * __expf(fminf(-bt[2], 80.f)), kk[i][3] * __expf(fminf(-bt[3], 80.f)));
                                *(LAS u32x2*)(k0 + t * RS + d0 * 2) = w;
                            } else {
                                w.x = cvt_pk_bf16(q0 * __expf(bt[0] - b31[0]), q1v * __expf(bt[1] - b31[1])); w.y = cvt_pk_bf16(q2 * __expf(bt[2] - b31[2]), q3 * __expf(bt[3] - b31[3]));
                                *(LAS u32x2*)(q1 + (t - 32) * RS + d0 * 2) = w; } } }
                    LDS_SYNC();
                    {
                        const int ni = wave & 3, mi = wave >> 2, r31 = lane & 31, hh = lane >> 5, i16 = lane & 15, sub = (lane >> 4) & 1;
                        f32x16 acc;
#pragma unroll
                        for (int r = 0; r < 16; ++r) acc[r] = 0.f;
#pragma unroll
                        for (int st = 0; st < 8; ++st) { const bf16x8 bq = *(const LAS bf16x8*)(qh + (32 * mi + r31) * RS + (16 * st + 8 * hh) * 2);
                            acc = __builtin_amdgcn_mfma_f32_32x32x16_bf16(sf[st], bq, acc, 0, 0, 0); }
#pragma unroll
                        for (int jb = 0; jb < 2; ++jb) { if (jb > mi) continue;
                            f32x16 x;
#pragma unroll
                            for (int r = 0; r < 16; ++r) x[r] = 0.f;
                            const LAS unsigned char* kb = (mi == 0) ? k0 : (k1 + 32 * jb * RS);
                            const LAS unsigned char* qb = (mi == 0) ? qh : q1;
#pragma unroll
                            for (int st = 0; st < 8; ++st) { const bf16x8 ka = *(const LAS bf16x8*)(kb + r31 * RS + (16 * st + 8 * hh) * 2), qq = *(const LAS bf16x8*)(qb + r31 * RS + (16 * st + 8 * hh) * 2);
                                x = __builtin_amdgcn_mfma_f32_32x32x16_bf16(ka, qq, x, 0, 0, 0); }
                            if (jb == mi) {
#pragma unroll
                                for (int r = 0; r < 16; ++r) { const int key = (r & 3) + 8 * (r >> 2) + 4 * hh; if (key > r31) x[r] = 0.f; } }
#pragma unroll
                            for (int s2 = 0; s2 < 2; ++s2) { u32x4 w; w.x = cvt_pk_bf16(x[8 * s2], x[8 * s2 + 1]); w.y = cvt_pk_bf16(x[8 * s2 + 2], x[8 * s2 + 3]); w.z = cvt_pk_bf16(x[8 * s2 + 4], x[8 * s2 + 5]); w.w = cvt_pk_bf16(x[8 * s2 + 6], x[8 * s2 + 7]);
                                const bf16x8 xb = __builtin_bit_cast(bf16x8, w);
                                const LAS unsigned char* va = vt + (32 * jb + 16 * s2 + 4 * hh + (i16 >> 2)) * RS + (32 * ni + 16 * sub + 4 * (i16 & 3)) * 2;
                                const s16x4 v0 = __builtin_amdgcn_ds_read_tr16_b64_v4i16((LAS s16x4*)va), v1 = __builtin_amdgcn_ds_read_tr16_b64_v4i16((LAS s16x4*)(va + 8 * RS));
                                const bf16x8 vf = __builtin_shufflevector(v0, v1, 0, 1, 2, 3, 4, 5, 6, 7);
                                acc = __builtin_amdgcn_mfma_f32_32x32x16_bf16(vf, xb, acc, 0, 0, 0); } }
                        u32x2 gq4[4];
                        { const size_t gg = (tok0 + 32 * mi + r31) * 512 + h * 128 + 32 * ni + 4 * hh;
#pragma unroll
                          for (int rq = 0; rq < 4; ++rq) gq4[rq] = *(const u32x2*)(HG + gg + 8 * rq); }
                        ld_zq(min(item + G, NB * 128 * 4 - 1));
                        float ss = 0.f;
#pragma unroll
                        for (int r = 0; r < 16; ++r) ss += acc[r] * acc[r];
                        ss += __shfl_xor(ss, 32);
                        if (hh == 0) ssq[ni * 64 + 32 * mi + r31] = ss;
                        LDS_SYNC();
                        const int tl = 32 * mi + r31;
                        const float tot = ssq[tl] + ssq[64 + tl] + ssq[128 + tl] + ssq[192 + tl];
                        const float rn = rsqrtf(tot * (1.f / 128.f) + 1e-6f);
                        const size_t go = (tok0 + tl) * 512 + h * 128 + 32 * ni + 4 * hh;
#pragma unroll
                        for (int rq = 0; rq < 4; ++rq) { const u32x2 gq = gq4[rq]; const f32x4 nw = *(const LAS f32x4*)(nwl + h * 128 + 32 * ni + 4 * hh + 8 * rq);
                            u32x2 w; w.x = cvt_pk_bf16(acc[4 * rq] * rn * nw[0] * siluf_(bflo(gq.x)), acc[4 * rq + 1] * rn * nw[1] * siluf_(bfhi(gq.x)));
                            w.y = cvt_pk_bf16(acc[4 * rq + 2] * rn * nw[2] * siluf_(bflo(gq.y)), acc[4 * rq + 3] * rn * nw[3] * siluf_(bfhi(gq.y)));
                            *(u32x2*)(QHG + go + 8 * rq) = w; }
                    }
                    LDS_SYNC();
                    item += G;
                } while (item < NB * 128 * 4);
            }
          }
          PMARK(15);
          if (EN(17)) { PHASE_IDS();
            {
                constexpr int KST = 144, TB = 9216;
                constexpr float LOG2E = 1.4426950408889634f;
                LAS unsigned char* kvb = lds;
                LAS float* lut = (LAS float*)(lds + 4 * TB);
                LAS float* impW = (LAS float*)(lds + 4 * TB + 32768 + wave * 8192);
                LAS unsigned* selm = (LAS unsigned*)(lds + 4 * TB + 32768 + 65536);
                const bf16* NQ = (const bf16*)(ws + WS_NQ); const bf16* KVT = (const bf16*)(ws + WS_KV6); const bf16* KCb = (const bf16*)(ws + WS_KC);
                const float* NG = (const float*)(ws + WS_NG); const float* RB = ap->in[7];
                bf16* OB = (bf16*)(ws + WS_NQ);
                const float NINF = -__builtin_inff();
                const bool lut_once = (G & 7) == 0;
                LAS float* gld = (LAS float*)(lds + 4 * TB + 32768 + 65536 + 1024) + wave * 96;
                if (lut_once) { const int g = bid & 1; __syncthreads();
                    for (int d = tid; d < 2048; d += NTHR) { const int bk = rel_bucket(d); *(LAS f32x4*)(lut + d * 4) = *(const f32x4*)(RB + bk * 8 + g * 4) * LOG2E; } }
                for (int pq = bid; pq < 512; pq += G)
#pragma unroll 1
                for (int odd = 0; odd < 2; ++odd) {
                    const int bg = pq & 7, xx = pq >> 3, tile = odd ? 127 - xx : xx, b = bg >> 1, g = bg & 1, t0 = tile * 64, cur = tile;
                    int lane_u = lane; asm volatile("" : "+v"(lane_u));
                    const int col = lane_u & 15, q4 = lane_u >> 4, head = col & 3, ti = col >> 2;
                    LAS float* ocl = impW + lane_u;
                    const size_t tokw = (size_t)b * SEQ + t0 + 8 * wave;
                    int tq[2]; bf16x8 qf[2][2];
                    auto gatev = [&](int gq, int br) -> float { return gld[(gq * 3 + br) * 16 + col]; };
                    float gl[6];
#pragma unroll
                    for (int gq = 0; gq < 2; ++gq)
#pragma unroll
                        for (int br = 0; br < 3; ++br) gl[gq * 3 + br] = NG[(tokw + 4 * gq + ti) * 32 + (g * 4 + head) * 3 + br];
#pragma unroll
                    for (int gq = 0; gq < 2; ++gq) { tq[gq] = t0 + 8 * wave + 4 * gq + ti; const size_t tok = tokw + 4 * gq + ti;
#pragma unroll
                        for (int s = 0; s < 2; ++s) qf[gq][s] = *(const bf16x8*)(NQ + tok * 512 + (g * 4 + head) * 64 + 32 * s + 8 * q4);
                    }
                    const float bfar = RB[31 * 8 + g * 4 + head] * LOG2E;
                    __syncthreads();
                    if (!lut_once) for (int d = tid; d < 2048; d += NTHR) { const int bk = rel_bucket(d); *(LAS f32x4*)(lut + d * 4) = *(const f32x4*)(RB + bk * 8 + g * 4) * LOG2E; }
                    for (int i = lane; i < 8 * 128; i += 64) impW[i] = 0.f;
                    f32x4 O[2][4], Ls[2];
                    float m[2], l[2], m1[2] = {0.f, 0.f}, linv[2] = {0.f, 0.f}, carry[2] = {0.f, 0.f};
                    const bf16x8 ones8 = {0x3F80, 0x3F80, 0x3F80, 0x3F80, 0x3F80, 0x3F80, 0x3F80, 0x3F80};
                    auto soft = [&](const int mode, const int gq, f32x4 (&st)[4], bf16x8 (&pb)[2], const int pos0, const bool far, const bool full, const float cbias, const bool colsel, const int sblk0) {
                        float tmax = NINF;
                        if (far) {
#pragma unroll
                            for (int kt = 0; kt < 4; ++kt)
#pragma unroll
                                for (int r = 0; r < 4; ++r) tmax = fmaxf(tmax, st[kt][r]);
                            tmax += cbias;
                        } else if (mode >= 2) {
                            const int dbase = tq[gq] - (pos0 + 4 * q4);
                            const LAS float* lb = lut + (dbase - 51) * 4 + head;
                            const float cadd = (mode == 2 && !colsel) ? NINF : 0.f;
                            float bv[4][4];
#pragma unroll
                            for (int kt = 0; kt < 4; ++kt)
#pragma unroll
                                for (int r = 0; r < 4; ++r) bv[kt][r] = lb[(51 - 16 * kt - r) * 4];
                            asm volatile("" : "+v"(bv[0][0]), "+v"(bv[0][1]), "+v"(bv[0][2]), "+v"(bv[0][3]), "+v"(bv[1][0]), "+v"(bv[1][1]), "+v"(bv[1][2]), "+v"(bv[1][3]));
                            asm volatile("" : "+v"(bv[2][0]), "+v"(bv[2][1]), "+v"(bv[2][2]), "+v"(bv[2][3]), "+v"(bv[3][0]), "+v"(bv[3][1]), "+v"(bv[3][2]), "+v"(bv[3][3]));
#pragma unroll
                            for (int kt = 0; kt < 4; ++kt)
#pragma unroll
                                for (int r = 0; r < 4; ++r) { float sv = st[kt][r] + bv[kt][r];
                                    if (mode == 2) sv += cadd;
                                    if (!full) { const int dist = dbase - (16 * kt + r); const bool valid = (mode == 3) ? ((unsigned)dist < 512u) : (dist >= 0); sv = valid ? sv : NINF; }
                                    st[kt][r] = sv; tmax = fmaxf(tmax, sv); }
                        } else {
                            const int dbase = tq[gq] - 16 * (pos0 + 4 * q4) - 31;
                            float bv[4][4];
#pragma unroll
                            for (int kt = 0; kt < 4; ++kt)
#pragma unroll
                                for (int r = 0; r < 4; ++r) { const int dist = dbase - 16 * (16 * kt + r); const unsigned di = (unsigned)dist < 2047u ? (unsigned)dist : 2047u; bv[kt][r] = lut[di * 4 + head]; }
#pragma unroll
                            for (int kt = 0; kt < 4; ++kt)
#pragma unroll
                                for (int r = 0; r < 4; ++r) { float sv = st[kt][r] + bv[kt][r];
                                    if (!full) { const int dist = dbase - 16 * (16 * kt + r); sv = (dist >= 0) ? sv : NINF; }
                                    st[kt][r] = sv; tmax = fmaxf(tmax, sv); }
                        }
                        float muse;
                        if (mode == 1) muse = m1[gq];
                        else {
                            tmax = max_x16(tmax); tmax = max_x32(tmax);
                            const float mnew = fmaxf(m[gq], tmax);
                            if (__any(mnew != m[gq])) {
                                const float mu = (mnew == NINF) ? 0.f : mnew;
                                const float alpha = __builtin_amdgcn_exp2f(m[gq] - mu);
                                m[gq] = mnew; l[gq] *= alpha;
                                if (mode >= 2) { Ls[gq] = Ls[gq] * alpha;
#pragma unroll
                                    for (int mt = 0; mt < 4; ++mt) O[gq][mt] = O[gq][mt] * alpha; }
                            }
                            muse = (m[gq] == NINF) ? 0.f : m[gq];
                        }
                        const float esub = far ? muse - cbias : muse;
                        float ls = 0.f;
#pragma unroll
                        for (int kt = 0; kt < 4; ++kt)
#pragma unroll
                            for (int r = 0; r < 4; ++r) { float p = __builtin_amdgcn_exp2f(st[kt][r] - esub); if (mode == 1) p *= linv[gq]; st[kt][r] = p; if (mode <= 1) ls += p; }
#if NSA_DUP_B
                        if (mode == 2) { float acc2 = 0.f;
#pragma unroll
                            for (int kt = 0; kt < 4; ++kt)
#pragma unroll
                                for (int r = 0; r < 4; ++r) { float x = st[kt][r]; asm volatile("" : "+v"(x)); const float p2 = __builtin_amdgcn_exp2f(x * 0.5f - esub); acc2 = fmaxf(acc2, p2 + x); }
                            asm volatile("" :: "v"(acc2)); }
#endif
                        if (mode <= 1) l[gq] += ls;
                        if (mode == 1) {
                            float a[4], h3[4];
#pragma unroll
                            for (int kt = 0; kt < 4; ++kt) { a[kt] = st[kt][0] + st[kt][1] + st[kt][2] + 0.5f * st[kt][3]; h3[kt] = 0.5f * st[kt][3];
                                a[kt] += dpp_x1(a[kt]); a[kt] += dpp_x2(a[kt]); h3[kt] += dpp_x1(h3[kt]); h3[kt] += dpp_x2(h3[kt]); }
#pragma unroll
                            for (int kt = 0; kt < 4; ++kt) { const float give = (q4 == 3) ? (kt > 0 ? h3[kt - 1] : carry[gq]) : h3[kt];
                                const float prev = __shfl(give, (lane - 16) & 63);
                                if (head == 0) impW[(4 * gq + ti) * 128 + sblk0 + 4 * kt + q4] = a[kt] + prev; }
                            carry[gq] = h3[3];
                        }
                        if (mode != 0) {
#pragma unroll
                            for (int s = 0; s < 2; ++s) { u32x4 w; w.x = cvt_pk_bf16(st[2 * s][0], st[2 * s][1]); w.y = cvt_pk_bf16(st[2 * s][2], st[2 * s][3]);
                                w.z = cvt_pk_bf16(st[2 * s + 1][0], st[2 * s + 1][1]); w.w = cvt_pk_bf16(st[2 * s + 1][2], st[2 * s + 1][3]); pb[s] = __builtin_bit_cast(bf16x8, w); } }
                    };
                    auto tile2 = [&](const int mode, const LAS unsigned char* kbuf, const LAS unsigned char* vbuf, const int pos0, const bool far, const bool full, const bool a0, const bool a1,
                                     const float cb0, const float cb1, const bool cs0, const bool cs1, const int sblk0) {
                        f32x4 st0[4], st1[4]; bf16x8 pb0[2], pb1[2];
#pragma unroll
                        for (int kt = 0; kt < 4; ++kt) {
                            const bf16x8 kf0 = *(const LAS bf16x8*)(kbuf + (16 * kt + col) * KST + 16 * q4), kf1 = *(const LAS bf16x8*)(kbuf + (16 * kt + col) * KST + 64 + 16 * q4);
                            if (a0) { st0[kt] = __builtin_amdgcn_mfma_f32_16x16x32_bf16(kf0, qf[0][0], (f32x4){0.f, 0.f, 0.f, 0.f}, 0, 0, 0); st0[kt] = __builtin_amdgcn_mfma_f32_16x16x32_bf16(kf1, qf[0][1], st0[kt], 0, 0, 0); }
                            if (a1) { st1[kt] = __builtin_amdgcn_mfma_f32_16x16x32_bf16(kf0, qf[1][0], (f32x4){0.f, 0.f, 0.f, 0.f}, 0, 0, 0); st1[kt] = __builtin_amdgcn_mfma_f32_16x16x32_bf16(kf1, qf[1][1], st1[kt], 0, 0, 0); } }
#if NSA_DUP_A
                        if (mode == 2) {
#pragma unroll
                            for (int kt = 0; kt < 4; ++kt) {
                                const bf16x8 kf0 = *(const LAS bf16x8*)(kbuf + (16 * kt + col) * KST + 16 * q4 + 32), kf1 = *(const LAS bf16x8*)(kbuf + (16 * kt + col) * KST + 64 + 16 * q4 - 32);
                                f32x4 d0 = __builtin_amdgcn_mfma_f32_16x16x32_bf16(kf0, qf[0][0], (f32x4){0.f, 0.f, 0.f, 0.f}, 0, 0, 0); d0 = __builtin_amdgcn_mfma_f32_16x16x32_bf16(kf1, qf[0][1], d0, 0, 0, 0);
                                f32x4 d1 = __builtin_amdgcn_mfma_f32_16x16x32_bf16(kf0, qf[1][0], (f32x4){0.f, 0.f, 0.f, 0.f}, 0, 0, 0); d1 = __builtin_amdgcn_mfma_f32_16x16x32_bf16(kf1, qf[1][1], d1, 0, 0, 0);
                                asm volatile("" :: "v"(d0), "v"(d1)); } }
#endif
                        if (a0) soft(mode, 0, st0, pb0, pos0, far, full, cb0, cs0, sblk0);
                        if (a1) soft(mode, 1, st1, pb1, pos0, far, full, cb1, cs1, sblk0);
                        if (mode == 0) return;
#pragma unroll
                        for (int mt = 0; mt < 4; ++mt)
#pragma unroll
                            for (int s = 0; s < 2; ++s) { const LAS unsigned char* a = vbuf + (32 * s + 4 * q4 + (col >> 2)) * KST + (16 * mt + 4 * (col & 3)) * 2;
                                const s16x4 lo = __builtin_amdgcn_ds_read_tr16_b64_v4i16((LAS s16x4*)a), hi = __builtin_amdgcn_ds_read_tr16_b64_v4i16((LAS s16x4*)(a + 16 * KST));
                                const bf16x8 vfs = __builtin_shufflevector(lo, hi, 0, 1, 2, 3, 4, 5, 6, 7);
                                if (a0) O[0][mt] = __builtin_amdgcn_mfma_f32_16x16x32_bf16(vfs, pb0[s], O[0][mt], 0, 0, 0);
                                if (a1) O[1][mt] = __builtin_amdgcn_mfma_f32_16x16x32_bf16(vfs, pb1[s], O[1][mt], 0, 0, 0); }
                        if (mode >= 2) {
#pragma unroll
                            for (int s = 0; s < 2; ++s) { if (a0) Ls[0] = __builtin_amdgcn_mfma_f32_16x16x32_bf16(ones8, pb0[s], Ls[0], 0, 0, 0); if (a1) Ls[1] = __builtin_amdgcn_mfma_f32_16x16x32_bf16(ones8, pb1[s], Ls[1], 0, 0, 0); } }
                    };
                    auto soft_far = [&](const int gq, f32x4 (&st)[4], bf16x8 (&pb)[2], const float mu_old) {
                        float tmax = fmaxf(fmaxf(fmaxf(st[0][0], st[0][1]), fmaxf(st[0][2], st[0][3])), fmaxf(fmaxf(st[1][0], st[1][1]), fmaxf(st[1][2], st[1][3])));
                        tmax = fmaxf(tmax, fmaxf(fmaxf(fmaxf(st[2][0], st[2][1]), fmaxf(st[2][2], st[2][3])), fmaxf(fmaxf(st[3][0], st[3][1]), fmaxf(st[3][2], st[3][3]))));
                        tmax = max_x16(tmax); tmax = max_x32(tmax);
                        if (__any(tmax > 8.f || (m[gq] == NINF && tmax != NINF))) {
                            const float mnew = fmaxf(m[gq], mu_old + tmax), mu = (mnew == NINF) ? 0.f : mnew, alpha = __builtin_amdgcn_exp2f(m[gq] - mu), delta = mu - mu_old;
                            m[gq] = mnew; Ls[gq] = Ls[gq] * alpha;
#pragma unroll
                            for (int mt = 0; mt < 4; ++mt) O[gq][mt] = O[gq][mt] * alpha;
#pragma unroll
                            for (int kt = 0; kt < 4; ++kt)
#pragma unroll
                                for (int r = 0; r < 4; ++r) st[kt][r] -= delta;
                        }
#pragma unroll
                        for (int kt = 0; kt < 4; ++kt)
#pragma unroll
                            for (int r = 0; r < 4; ++r) st[kt][r] = __builtin_amdgcn_exp2f(st[kt][r]);
#pragma unroll
                        for (int s = 0; s < 2; ++s) { u32x4 w; w.x = cvt_pk_bf16(st[2 * s][0], st[2 * s][1]); w.y = cvt_pk_bf16(st[2 * s][2], st[2 * s][3]);
                            w.z = cvt_pk_bf16(st[2 * s + 1][0], st[2 * s + 1][1]); w.w = cvt_pk_bf16(st[2 * s + 1][2], st[2 * s + 1][3]); pb[s] = __builtin_bit_cast(bf16x8, w); }
                    };
                    auto tile_far2 = [&](const LAS unsigned char* kbuf, const LAS unsigned char* vbuf, const float cb0, const float cb1) {
                        f32x4 st0[4], st1[4]; bf16x8 pb0[2], pb1[2];
                        const float mu0 = (m[0] == NINF) ? 0.f : m[0], mu1 = (m[1] == NINF) ? 0.f : m[1];
                        const float c0 = cb0 - mu0, c1 = cb1 - mu1;
                        const f32x4 ci0 = {c0, c0, c0, c0}, ci1 = {c1, c1, c1, c1};
#pragma unroll
                        for (int kt = 0; kt < 4; ++kt) { const bf16x8 kf0 = *(const LAS bf16x8*)(kbuf + (16 * kt + col) * KST + 16 * q4), kf1 = *(const LAS bf16x8*)(kbuf + (16 * kt + col) * KST + 64 + 16 * q4);
                            st0[kt] = __builtin_amdgcn_mfma_f32_16x16x32_bf16(kf0, qf[0][0], ci0, 0, 0, 0); st0[kt] = __builtin_amdgcn_mfma_f32_16x16x32_bf16(kf1, qf[0][1], st0[kt], 0, 0, 0);
                            st1[kt] = __builtin_amdgcn_mfma_f32_16x16x32_bf16(kf0, qf[1][0], ci1, 0, 0, 0); st1[kt] = __builtin_amdgcn_mfma_f32_16x16x32_bf16(kf1, qf[1][1], st1[kt], 0, 0, 0); }
                        soft_far(0, st0, pb0, mu0);
                        soft_far(1, st1, pb1, mu1);
#pragma unroll
                        for (int mt = 0; mt < 4; ++mt)
#pragma unroll
                            for (int s = 0; s < 2; ++s) { const LAS unsigned char* a = vbuf + (32 * s + 4 * q4 + (col >> 2)) * KST + (16 * mt + 4 * (col & 3)) * 2;
                                const s16x4 lo = __builtin_amdgcn_ds_read_tr16_b64_v4i16((LAS s16x4*)a), hi = __builtin_amdgcn_ds_read_tr16_b64_v4i16((LAS s16x4*)(a + 16 * KST));
                                const bf16x8 vfs = __builtin_shufflevector(lo, hi, 0, 1, 2, 3, 4, 5, 6, 7);
                                O[0][mt] = __builtin_amdgcn_mfma_f32_16x16x32_bf16(vfs, pb0[s], O[0][mt], 0, 0, 0);
                                O[1][mt] = __builtin_amdgcn_mfma_f32_16x16x32_bf16(vfs, pb1[s], O[1][mt], 0, 0, 0); }
#pragma unroll
                        for (int s = 0; s < 2; ++s) { Ls[0] = __builtin_amdgcn_mfma_f32_16x16x32_bf16(ones8, pb0[s], Ls[0], 0, 0, 0); Ls[1] = __builtin_amdgcn_mfma_f32_16x16x32_bf16(ones8, pb1[s], Ls[1], 0, 0, 0); }
                    };
                    auto tile_far1 = [&](auto gqc, const LAS unsigned char* kbuf, const LAS unsigned char* vbuf, const float cbx) {
                        constexpr int gq = decltype(gqc)::value;
                        f32x4 st[4]; bf16x8 pb[2];
                        const float mu = (m[gq] == NINF) ? 0.f : m[gq], c = cbx - mu;
                        const f32x4 ci = {c, c, c, c};
#pragma unroll
                        for (int kt = 0; kt < 4; ++kt) { const bf16x8 kf0 = *(const LAS bf16x8*)(kbuf + (16 * kt + col) * KST + 16 * q4), kf1 = *(const LAS bf16x8*)(kbuf + (16 * kt + col) * KST + 64 + 16 * q4);
                            st[kt] = __builtin_amdgcn_mfma_f32_16x16x32_bf16(kf0, qf[gq][0], ci, 0, 0, 0); st[kt] = __builtin_amdgcn_mfma_f32_16x16x32_bf16(kf1, qf[gq][1], st[kt], 0, 0, 0); }
                        soft_far(gq, st, pb, mu);
#pragma unroll
                        for (int mt = 0; mt < 4; ++mt)
#pragma unroll
                            for (int s = 0; s < 2; ++s) { const LAS unsigned char* a = vbuf + (32 * s + 4 * q4 + (col >> 2)) * KST + (16 * mt + 4 * (col & 3)) * 2;
                                const s16x4 lo = __builtin_amdgcn_ds_read_tr16_b64_v4i16((LAS s16x4*)a), hi = __builtin_amdgcn_ds_read_tr16_b64_v4i16((LAS s16x4*)(a + 16 * KST));
                                const bf16x8 vfs = __builtin_shufflevector(lo, hi, 0, 1, 2, 3, 4, 5, 6, 7);
                                O[gq][mt] = __builtin_amdgcn_mfma_f32_16x16x32_bf16(vfs, pb[s], O[gq][mt], 0, 0, 0); }
#pragma unroll
                        for (int s = 0; s < 2; ++s) Ls[gq] = __builtin_amdgcn_mfma_f32_16x16x32_bf16(ones8, pb[s], Ls[gq], 0, 0, 0);
                    };
                    auto lut_c = [&](const int gq, const int pos0, const float sh, f32x4 (&ci)[4]) {
                        const LAS float* lb = lut + (tq[gq] - (pos0 + 4 * q4) - 51) * 4 + head;
#pragma unroll
                        for (int kt = 0; kt < 4; ++kt)
#pragma unroll
                            for (int r = 0; r < 4; ++r) ci[kt][r] = lb[(51 - 16 * kt - r) * 4];
#pragma unroll
                        for (int kt = 0; kt < 4; ++kt)
#pragma unroll
                            for (int r = 0; r < 4; ++r) ci[kt][r] += sh;
                    };
                    auto tile_lut1 = [&](auto gqc, const LAS unsigned char* kbuf, const LAS unsigned char* vbuf, const int pos0, const bool colsel) {
                        constexpr int gq = decltype(gqc)::value;
                        f32x4 st[4]; bf16x8 pb[2];
                        const float mu = (m[gq] == NINF) ? 0.f : m[gq];
                        lut_c(gq, pos0, colsel ? -mu : NINF, st);
#pragma unroll
                        for (int kt = 0; kt < 4; ++kt) { const bf16x8 kf0 = *(const LAS bf16x8*)(kbuf + (16 * kt + col) * KST + 16 * q4), kf1 = *(const LAS bf16x8*)(kbuf + (16 * kt + col) * KST + 64 + 16 * q4);
                            st[kt] = __builtin_amdgcn_mfma_f32_16x16x32_bf16(kf0, qf[gq][0], st[kt], 0, 0, 0); st[kt] = __builtin_amdgcn_mfma_f32_16x16x32_bf16(kf1, qf[gq][1], st[kt], 0, 0, 0); }
                        soft_far(gq, st, pb, mu);
#pragma unroll
                        for (int mt = 0; mt < 4; ++mt)
#pragma unroll
                            for (int s = 0; s < 2; ++s) { const LAS unsigned char* a = vbuf + (32 * s + 4 * q4 + (col >> 2)) * KST + (16 * mt + 4 * (col & 3)) * 2;
                                const s16x4 lo = __builtin_amdgcn_ds_read_tr16_b64_v4i16((LAS s16x4*)a), hi = __builtin_amdgcn_ds_read_tr16_b64_v4i16((LAS s16x4*)(a + 16 * KST));
                                const bf16x8 vfs = __builtin_shufflevector(lo, hi, 0, 1, 2, 3, 4, 5, 6, 7);
                                O[gq][mt] = __builtin_amdgcn_mfma_f32_16x16x32_bf16(vfs, pb[s], O[gq][mt], 0, 0, 0); }
#pragma unroll
                        for (int s = 0; s < 2; ++s) Ls[gq] = __builtin_amdgcn_mfma_f32_16x16x32_bf16(ones8, pb[s], Ls[gq], 0, 0, 0);
                    };
                    auto ld_tile = [&](const bf16* src) -> u32x4 { return *(const u32x4*)(src + tid * 8); };
                    auto st_tile = [&](LAS unsigned char* buf, const u32x4 v) { *(LAS u32x4*)(buf + (tid >> 3) * KST + (tid & 7) * 16) = v; };
                    auto zeroO = [&]() {
#pragma unroll
                        for (int gq = 0; gq < 2; ++gq) { m[gq] = NINF; l[gq] = 0.f; Ls[gq] = (f32x4){0.f, 0.f, 0.f, 0.f};
#pragma unroll
                            for (int mt = 0; mt < 4; ++mt) O[gq][mt] = (f32x4){0.f, 0.f, 0.f, 0.f}; } };
                    const int ntc = (4 * tile + 3 + 63) >> 6;
                    const bf16* kcb = KCb + (size_t)bg * 512 * 64; const bf16* vcb = KCb + (size_t)(8 + bg) * 512 * 64;
                    {
                        zeroO();
                        u32x4 rk = ld_tile(kcb);
                        st_tile(kvb, rk); if (ntc > 1) rk = ld_tile(kcb + 4096);
                        __syncthreads();
#pragma unroll 1
                        for (int i = 0; i < ntc; ++i) { LAS unsigned char* cb = kvb + (i & 1) * 2 * TB;
                            if (i + 1 < ntc) st_tile(kvb + ((i + 1) & 1) * 2 * TB, rk);
                            if (i + 2 < ntc) rk = ld_tile(kcb + (size_t)(i + 2) * 4096);
                            const bool far = (t0 - (16 * (64 * i + 63) + 31)) >= 1513;
                            tile2(0, cb, cb + TB, 64 * i, far, (16 * (64 * i + 63) + 31) <= t0, true, true, bfar, bfar, true, true, 0);
                            __syncthreads(); }
                    }
#pragma unroll
                    for (int gq = 0; gq < 2; ++gq) { float lt = sum_x32(sum_x16(l[gq])); linv[gq] = 1.f / fmaxf(lt, 1e-30f); m1[gq] = (m[gq] == NINF) ? 0.f : m[gq]; }
                    if (q4 == 0) {
#pragma unroll
                        for (int k6 = 0; k6 < 6; ++k6) gld[k6 * 16 + col] = sigmoidf_(gl[k6]); }
                    {
                        zeroO();
                        u32x4 rk = ld_tile(kcb), rv = ld_tile(vcb);
                        st_tile(kvb, rk); st_tile(kvb + TB, rv); if (ntc > 1) { rk = ld_tile(kcb + 4096); rv = ld_tile(vcb + 4096); }
                        __syncthreads();
#pragma unroll 1
                        for (int i = 0; i < ntc; ++i) { LAS unsigned char* cb = kvb + (i & 1) * 2 * TB;
                            if (i + 1 < ntc) { LAS unsigned char* nb = kvb + ((i + 1) & 1) * 2 * TB; st_tile(nb, rk); st_tile(nb + TB, rv); }
                            if (i + 2 < ntc) { rk = ld_tile(kcb + (size_t)(i + 2) * 4096); rv = ld_tile(vcb + (size_t)(i + 2) * 4096); }
                            const bool far = (t0 - (16 * (64 * i + 63) + 31)) >= 1513;
                            tile2(1, cb, cb + TB, 64 * i, far, (16 * (64 * i + 63) + 31) <= t0, true, true, bfar, bfar, true, true, 16 * i);
                            __syncthreads(); }
                    }
                    WAVE_SYNC();
                    {
                        const int tt = lane >> 3, sub = lane & 7;
                        unsigned key[16];
                        const LAS f32x4* ip = (const LAS f32x4*)(impW + tt * 128 + sub * 16);
#pragma unroll
                        for (int q = 0; q < 4; ++q) { const f32x4 v = ip[q];
#pragma unroll
                            for (int e2 = 0; e2 < 4; ++e2) { const int i = 4 * q + e2, s = sub * 16 + i;
                                const bool forced = (s == 0) || (s == cur) || (s == cur - 1);
                                const unsigned k = forced ? 0x7FFFFF80u : ((__float_as_uint(v[e2]) & 0xFFFFFF80u) + 128u);
                                key[i] = (s <= cur) ? (k | (unsigned)(127 - s)) : 0u; } }
                        unsigned w0 = 0u, w1 = 0u, w2 = 0u, w3 = 0u;
#pragma unroll 1
                        for (int k = 0; k < 16; ++k) {
                            unsigned best = key[0];
#pragma unroll
                            for (int i = 1; i < 16; ++i) best = best > key[i] ? best : key[i];
                            { const unsigned o1 = (unsigned)__builtin_amdgcn_mov_dpp((int)best, 0xB1, 0xF, 0xF, true); best = best > o1 ? best : o1;
                              const unsigned o2 = (unsigned)__builtin_amdgcn_mov_dpp((int)best, 0x4E, 0xF, 0xF, true); best = best > o2 ? best : o2;
                              const unsigned o3 = (unsigned)__builtin_amdgcn_mov_dpp((int)best, 0x141, 0xF, 0xF, true); best = best > o3 ? best : o3; }
#pragma unroll
                            for (int i = 0; i < 16; ++i) key[i] = (key[i] == best) ? 0u : key[i];
                            if (best != 0u) { const int idx = 127 - (int)(best & 127u); const unsigned bit = 1u << (idx & 31); const int wd = idx >> 5;
                                w0 |= wd == 0 ? bit : 0u; w1 |= wd == 1 ? bit : 0u; w2 |= wd == 2 ? bit : 0u; w3 |= wd == 3 ? bit : 0u; }
                        }
                        if (sub == 0) { LAS unsigned* sp = selm + (8 * wave + tt) * 4; sp[0] = w0; sp[1] = w1; sp[2] = w2; sp[3] = w3; }
                    }
                    WAVE_SYNC();
#pragma unroll
                    for (int gq = 0; gq < 2; ++gq) { const float g0 = gatev(gq, 0);
#pragma unroll
                        for (int mt = 0; mt < 4; ++mt)
#pragma unroll
                            for (int r = 0; r < 4; ++r) ocl[((gq * 4 + mt) * 4 + r) * 64] = O[gq][mt][r] * g0; }
                    __syncthreads();
                    unsigned long long Ulo, Uhi;
                    { unsigned u[4];
#pragma unroll
                      for (int k = 0; k < 4; ++k) { unsigned x = selm[lane * 4 + k];
#pragma unroll
                        for (int o = 1; o < 64; o <<= 1) x |= __shfl_xor(x, o);
                        u[k] = __builtin_amdgcn_readfirstlane(x); }
                      Ulo = ((unsigned long long)u[1] << 32) | u[0]; Uhi = ((unsigned long long)u[3] << 32) | u[2]; }
                    auto nextj = [&](int j) -> int {
                        if (j < 64) { const unsigned long long x = Ulo >> j; if (x) return j + __builtin_ctzll(x); j = 64; }
                        if (j < 128) { const unsigned long long x = Uhi >> (j - 64); if (x) return j + __builtin_ctzll(x); }
                        return 128; };
                    unsigned long long F0lo, F0hi, F1lo, F1hi;
                    {
                        const int dA = t0 + 8 * wave - (64 * lane + 63), dB = dA - 64 * 64;
                        const bool a0 = lane < cur && rel_bucket(min(dA, 2047)) == rel_bucket(min(dA + 66, 2047)), a1 = lane < cur && rel_bucket(min(dA + 4, 2047)) == rel_bucket(min(dA + 70, 2047));
                        const bool b0 = 64 + lane < cur && rel_bucket(min(dB, 2047)) == rel_bucket(min(dB + 66, 2047)), b1 = 64 + lane < cur && rel_bucket(min(dB + 4, 2047)) == rel_bucket(min(dB + 70, 2047));
                        F0lo = __ballot(a0); F1lo = __ballot(a1); F0hi = __ballot(b0); F1hi = __ballot(b1);
                    }
                    {
                        const bf16* ksb = KVT + (size_t)(2 * 8 + bg) * SEQ * 64; const bf16* vsb = KVT + (size_t)(3 * 8 + bg) * SEQ * 64;
#pragma unroll 1
                        for (int rep = 0; rep < SELREP; ++rep) {
                        zeroO();
                        int j = nextj(0), jn = nextj(j + 1), it = 0;
                        u32x4 rk = ld_tile(ksb + (size_t)j * 4096), rv = ld_tile(vsb + (size_t)j * 4096);
                        st_tile(kvb, rk); st_tile(kvb + TB, rv);
                        if (jn <= cur) { rk = ld_tile(ksb + (size_t)jn * 4096); rv = ld_tile(vsb + (size_t)jn * 4096); }
                        __syncthreads();
#pragma unroll 1
                        while (j <= cur) { LAS unsigned char* cb = kvb + (it & 1) * 2 * TB;
                            const int jnn = jn <= cur ? nextj(jn + 1) : 128;
                            if (jn <= cur) { LAS unsigned char* nb = kvb + ((it + 1) & 1) * 2 * TB; st_tile(nb, rk); st_tile(nb + TB, rv); }
                            if (jnn <= cur) { rk = ld_tile(ksb + (size_t)jnn * 4096); rv = ld_tile(vsb + (size_t)jnn * 4096); }
                            const bool cs0 = (selm[(8 * wave + ti) * 4 + (j >> 5)] >> (j & 31)) & 1u, cs1 = (selm[(8 * wave + 4 + ti) * 4 + (j >> 5)] >> (j & 31)) & 1u;
                            const bool act0 = __ballot(cs0) != 0ull, act1 = __ballot(cs1) != 0ull;
                            const bool far = (t0 - (64 * j + 63)) >= 1513;
                            const bool full = j < cur;
                            const int dlo = t0 + 8 * wave - (64 * j + 63), dl0 = min(dlo, 2047), dl1 = min(dlo + 4, 2047);
                            const bool flat0 = ((j < 64 ? F0lo >> j : F0hi >> (j - 64)) & 1ull) != 0ull, flat1 = ((j < 64 ? F1lo >> j : F1hi >> (j - 64)) & 1ull) != 0ull;
                            const float cb0 = cs0 ? (flat0 ? lut[dl0 * 4 + head] : bfar) : NINF, cb1 = cs1 ? (flat1 ? lut[dl1 * 4 + head] : bfar) : NINF;
                            if (!full) tile2(2, cb, cb + TB, 64 * j, far, full, true, true, cb0, cb1, cs0, cs1, 0);
                            else if (act0 && act1) { if (flat0 && flat1) tile_far2(cb, cb + TB, cb0, cb1); else { tile_lut1(IConst<0>{}, cb, cb + TB, 64 * j, cs0); tile_lut1(IConst<1>{}, cb, cb + TB, 64 * j, cs1); } }
                            else if (act0) { if (flat0) tile_far1(IConst<0>{}, cb, cb + TB, cb0); else tile_lut1(IConst<0>{}, cb, cb + TB, 64 * j, cs0); }
                            else if (act1) { if (flat1) tile_far1(IConst<1>{}, cb, cb + TB, cb1); else tile_lut1(IConst<1>{}, cb, cb + TB, 64 * j, cs1); }
#if NSA_DUP_C
                            __syncthreads();
#endif
                            __syncthreads();
                            j = jn; jn = jnn; ++it;
                        }
                        }
#pragma unroll
                        for (int gq = 0; gq < 2; ++gq) { const float lt = Ls[gq][0]; const float sc = gatev(gq, 1) / fmaxf(lt, 1e-30f);
#pragma unroll
                            for (int mt = 0; mt < 4; ++mt)
#pragma unroll
                                for (int r = 0; r < 4; ++r) ocl[((gq * 4 + mt) * 4 + r) * 64] += O[gq][mt][r] * sc; }
                    }
                    {
                        const bf16* kwb = KVT + (size_t)(4 * 8 + bg) * SEQ * 64; const bf16* vwb = KVT + (size_t)(5 * 8 + bg) * SEQ * 64;
                        const int j0 = cur - 8 < 0 ? 0 : cur - 8, nw = cur - j0 + 1;
#pragma unroll 1
                        for (int wrep = 0; wrep < WINREP; ++wrep) {
                        zeroO();
                        u32x4 rk = ld_tile(kwb + (size_t)j0 * 4096), rv = ld_tile(vwb + (size_t)j0 * 4096);
                        st_tile(kvb, rk); st_tile(kvb + TB, rv);
                        if (nw > 1) { rk = ld_tile(kwb + (size_t)(j0 + 1) * 4096); rv = ld_tile(vwb + (size_t)(j0 + 1) * 4096); }
                        __syncthreads();
#pragma unroll 1
                        for (int i = 0; i < nw; ++i) { LAS unsigned char* cb = kvb + (i & 1) * 2 * TB;
                            if (i + 1 < nw) { LAS unsigned char* nb = kvb + ((i + 1) & 1) * 2 * TB; st_tile(nb, rk); st_tile(nb + TB, rv); }
                            if (i + 2 < nw) { rk = ld_tile(kwb + (size_t)(j0 + i + 2) * 4096); rv = ld_tile(vwb + (size_t)(j0 + i + 2) * 4096); }
                            if ((j0 + i > cur - 8) && (j0 + i < cur)) { tile_lut1(IConst<0>{}, cb, cb + TB, 64 * (j0 + i), true); tile_lut1(IConst<1>{}, cb, cb + TB, 64 * (j0 + i), true); }
                            else tile2(3, cb, cb + TB, 64 * (j0 + i), false, false, true, true, 0.f, 0.f, true, true, 0);
                            __syncthreads(); }
                        }
#pragma unroll
                        for (int gq = 0; gq < 2; ++gq) { const float lt = Ls[gq][0]; const float sc = gatev(gq, 2) / fmaxf(lt, 1e-30f);
#pragma unroll
                            for (int mt = 0; mt < 4; ++mt)
#pragma unroll
                                for (int r = 0; r < 4; ++r) O[gq][mt][r] = ocl[((gq * 4 + mt) * 4 + r) * 64] + O[gq][mt][r] * sc; }
                    }
#pragma unroll
                    for (int gq = 0; gq < 2; ++gq)
#pragma unroll
                        for (int mt = 0; mt < 4; ++mt) { u32x2 w; w.x = cvt_pk_bf16(O[gq][mt][0], O[gq][mt][1]); w.y = cvt_pk_bf16(O[gq][mt][2], O[gq][mt][3]);
                            *(u32x2*)(OB + (tokw + 4 * gq + ti) * 512 + (g * 4 + head) * 64 + 16 * mt + 4 * q4) = w; }
                }
            }
          }
        }
        SEAM(pb + 3, 4);

        if (EN(5) && IN(pb + 4)) { PHASE_IDS();
            pg8::Gemm g{(const bf16*)(ws + WS_QHG), (const bf16*)(ws + WS_WBA0 + (size_t)l * 2 * SZ_WBR), NT, DM, DM, 0, 512, (const bf16*)(ws + WS_NQ), 8};
            pg8::StaticOrder S; S.init(NT, DM, G, bid); EpiGate2 E{(bf16*)(ws + WS_GA), (const bf16*)(ws + WS_GA), (const bf16*)(ws + WS_GB)};
            pg8::gemm_phase<EpiGate2, pg8::StaticOrder>(lds, g, S, E, wave_s);
        }
        SEAM(pb + 4, 5);

        if (EN(6) && IN(pb + 5)) { PHASE_IDS();
            pg8::Gemm g{(const bf16*)(ws + WS_GA), (const bf16*)(ws + (l ? WS_WOUT1 : WS_WOUT0)), NT, DM, DM, 0, 0, nullptr, 0};
            const float* XI = l ? (const float*)X : x_in;
            pg8::StaticOrder S; S.init(NT, DM, G, bid); EpiResid E{XI, X};
            pg8::gemm_phase<EpiResid, pg8::StaticOrder>(lds, g, S, E, wave_s);
        }
        SEAM(pb + 5, 6);

        if (EN(7) && IN(pb + 6)) { PHASE_IDS();
            const float* gam = ap->in[11] + l * DM; const float* bet = ap->in[12] + l * DM;
            LAS int* hist = (LAS int*)(lds + 8 * 16384);
            if (l == 1) { if (tid < 8) hist[tid] = 0; __syncthreads(); }
            const int rpb = (NT + G - 1) / G;
            for (int i = wave; i < rpb; i += NWAVES) {
                const int row = bid * rpb + i; if (row >= NT) break;
                f32x4* xr = (f32x4*)(X + (size_t)row * DM);
                f32x4 v[4]; float s = 0.f;
#pragma unroll
                for (int j = 0; j < 4; ++j) { v[j] = xr[64 * j + lane]; s += (v[j][0] + v[j][1]) + (v[j][2] + v[j][3]); }
                const float mean = wave_sum(s) * (1.f / DM); float s2 = 0.f;
#pragma unroll
                for (int j = 0; j < 4; ++j) { v[j] = v[j] - mean; s2 += (v[j][0] * v[j][0] + v[j][1] * v[j][1]) + (v[j][2] * v[j][2] + v[j][3] * v[j][3]); }
                const float rstd = rsqrtf(wave_sum(s2) * (1.f / DM) + 1e-5f);
#pragma unroll
                for (int j = 0; j < 4; ++j) { const f32x4 gq = ((const f32x4*)gam)[64 * j + lane], bq = ((const f32x4*)bet)[64 * j + lane]; v[j] = v[j] * rstd * gq + bq; xr[64 * j + lane] = v[j]; }
                if (l == 0) { u32x2* o = (u32x2*)(XB + (size_t)row * DM);
#pragma unroll
                    for (int j = 0; j < 4; ++j) { u32x2 w; w.x = cvt_pk_bf16(v[j][0], v[j][1]); w.y = cvt_pk_bf16(v[j][2], v[j][3]); o[64 * j + lane] = w; }
                } else {
                    const float* WR = ap->in[18];
                    float lg[8];
#pragma unroll
                    for (int e = 0; e < 8; ++e) lg[e] = 0.f;
#pragma unroll
                    for (int j = 0; j < 4; ++j)
#pragma unroll
                        for (int q = 0; q < 4; ++q) { const int c = 4 * (64 * j + lane) + q; const f32x4 w0 = *(const f32x4*)(WR + c * 8), w1 = *(const f32x4*)(WR + c * 8 + 4); const float xv = v[j][q];
                            lg[0] += xv * w0[0]; lg[1] += xv * w0[1]; lg[2] += xv * w0[2]; lg[3] += xv * w0[3]; lg[4] += xv * w1[0]; lg[5] += xv * w1[1]; lg[6] += xv * w1[2]; lg[7] += xv * w1[3]; }
#pragma unroll
                    for (int e = 0; e < 8; ++e) lg[e] = wave_sum(lg[e]);
                    int e1 = 0; float v1 = lg[0];
#pragma unroll
                    for (int e = 1; e < 8; ++e) if (lg[e] > v1) { v1 = lg[e]; e1 = e; }
                    int e2 = -1; float v2 = -3e38f;
#pragma unroll
                    for (int e = 0; e < 8; ++e) if (e != e1 && lg[e] > v2) { v2 = lg[e]; e2 = e; }
                    if (lane == 0) { const float g2 = 1.f / (1.f + expf(v1 - v2)), g1 = 1.f - g2;
                        ((int*)(ws + WS_TOPI))[row] = e1 | (e2 << 8); ((float*)(ws + WS_TOPG))[row * 2] = g1; ((float*)(ws + WS_TOPG))[row * 2 + 1] = g2;
                        atomicAdd((int*)&hist[e1], 1); atomicAdd((int*)&hist[e2], 1); }
                }
            }
            if (l == 1) {
                __syncthreads();
                if (tid < 8) ((int*)(ws + WS_CTL + CW_BLKCNT))[bid * 8 + tid] = hist[tid];
                LAS float* scr = (LAS float*)(lds + wave * 16384);
                constexpr int I_GU = 16 * (2 * FFE / 32), I_DN = (FFE / 64) * 32;
                for (int it = gwave; it < NEXP * (I_GU + I_DN); it += nwaves) {
                    const int e = it / (I_GU + I_DN); int r = it % (I_GU + I_DN);
                    if (r < I_GU) { const int nb = r % (2 * FFE / 32), kb = r / (2 * FFE / 32);
                        const float* Wg = ap->in[19] + (size_t)e * DM * FFE; const float* Wu = ap->in[20] + (size_t)e * DM * FFE;
                        auto cp = [=](int n) -> const float* { const int pn = n >> 8, hf = (n >> 7) & 1, c = pn * 128 + (n & 127); return (hf ? Wu : Wg) + c; };
                        tr_item(cp, FFE, DM, (bf16*)(ws + WS_MGU) + (size_t)e * 2 * FFE * DM, DM, nb * 32, kb * 64, scr, lane); }
                    else { r -= I_GU; const int nb = r % 32, kb = r / 32;
                        const float* W = ap->in[21] + (size_t)e * FFE * DM;
                        auto cp = [=](int n) -> const float* { return W + n; };
                        tr_item(cp, DM, FFE, (bf16*)(ws + WS_MDN) + (size_t)e * DM * FFE, FFE, nb * 32, kb * 64, scr, lane); }
                }
            }
        }
        SEAM(pb + 6, 7);

        if (l == 0) {
            if (EN(8) && IN(pb + 7)) { PHASE_IDS();
                pg8::Gemm g{XB, (const bf16*)(ws + WS_WGU0), NT, NINP, DM, 0, 0, nullptr, 0};
                pg8::StaticOrder S; S.init(NT, NINP, G, bid); EpiSwiglu E{(bf16*)(ws + WS_H0), FF0P};
                pg8::gemm_phase<EpiSwiglu, pg8::StaticOrder>(lds, g, S, E, wave_s);
            }
            SEAM(pb + 7, 8);
            if (EN(9) && IN(pb + 8)) { PHASE_IDS();
                pg8::Gemm g{(const bf16*)(ws + WS_H0), (const bf16*)(ws + WS_WDN0), NT, DM, FF0P, 0, 0, nullptr, 0};
                pg8::StaticOrder S; S.init(NT, DM, G, bid); EpiResid E{X, X};
                pg8::gemm_phase<EpiResid, pg8::StaticOrder>(lds, g, S, E, wave_s);
            }
            SEAM(pb + 8, 9);
            if (EN(10) && IN(pb + 9)) { PHASE_IDS();
                const float* gam = ap->in[13]; const float* bet = ap->in[14];
                for (int row = gwave; row < NT; row += nwaves) {
                    f32x4* xr = (f32x4*)(X + (size_t)row * DM);
                    f32x4 v[4]; float s = 0.f;
#pragma unroll
                    for (int j = 0; j < 4; ++j) { v[j] = xr[64 * j + lane]; s += (v[j][0] + v[j][1]) + (v[j][2] + v[j][3]); }
                    const float mean = wave_sum(s) * (1.f / DM); float s2 = 0.f;
#pragma unroll
                    for (int j = 0; j < 4; ++j) { v[j] = v[j] - mean; s2 += (v[j][0] * v[j][0] + v[j][1] * v[j][1]) + (v[j][2] * v[j][2] + v[j][3] * v[j][3]); }
                    const float rstd = rsqrtf(wave_sum(s2) * (1.f / DM) + 1e-5f);
                    u32x2* o = (u32x2*)(XB + (size_t)row * DM);
#pragma unroll
                    for (int j = 0; j < 4; ++j) { const f32x4 gq = ((const f32x4*)gam)[64 * j + lane], bq = ((const f32x4*)bet)[64 * j + lane]; v[j] = v[j] * rstd * gq + bq; xr[64 * j + lane] = v[j];
                        u32x2 w; w.x = cvt_pk_bf16(v[j][0], v[j][1]); w.y = cvt_pk_bf16(v[j][2], v[j][3]); o[64 * j + lane] = w; }
                }
            }
            SEAM(pb + 9, 10);
        } else {
            if (EN(11) && IN(pb + 7)) { PHASE_IDS(); int* META = (int*)(ws + WS_CTL + CW_META); int* PANELE = (int*)(ws + WS_CTL + CW_PANELE); int* ROWINFO = (int*)(ws + WS_ROWINFO); bf16* XS = (bf16*)(ws + WS_XS); (void)META; (void)PANELE; (void)ROWINFO; (void)XS;
                LAS int* sh = (LAS int*)lds;
                const int* BC = (const int*)(ws + WS_CTL + CW_BLKCNT);
                {
                    float tot = 0.f, pre = 0.f;
                    for (int bb = lane; bb < G; bb += 64) { const float c = (float)BC[bb * 8 + wave]; tot += c; pre += (bb < bid) ? c : 0.f; }
                    tot = wave_sum(tot); pre = wave_sum(pre);
                    if (lane == 0) { sh[wave] = (int)tot; sh[8 + wave] = (int)pre; sh[24 + wave] = 0; } }
                __syncthreads();
                if (tid == 0) { int base = 0;
#pragma unroll 1
                    for (int e = 0; e < 8; ++e) { sh[16 + e] = base; base += (sh[e] + 255) & ~255; }
                    sh[32] = base; }
                __syncthreads();
                if (bid == 0) { const int base = sh[32]; if (tid == 0) { META[0] = base / 256; META[1] = (base / 256 + 63) / 64; }
                    if (tid < 8) { META[8 + tid] = sh[16 + tid]; META[16 + tid] = sh[tid]; }
                    for (int p = tid; p < base / 256; p += NTHR) { int e = 0;
#pragma unroll 1
                        for (int q = 1; q < 8; ++q) if (p * 256 >= sh[16 + q]) e = q;
                        PANELE[p] = e; } }
                __syncthreads();
                if (bid < 8) { const int e = bid, r0 = sh[16 + e] + sh[e], r1 = sh[16 + e] + ((sh[e] + 255) & ~255);
                    for (int r = r0 + wave; r < r1; r += NWAVES) { if (lane == 0) ROWINFO[r] = -1;
#pragma unroll
                        for (int j = 0; j < 4; ++j) ((u32x2*)(XS + (size_t)r * DM))[64 * j + lane] = (u32x2){0u, 0u}; } }
                const int rpb = (NT + G - 1) / G;
                for (int i = wave; i < rpb; i += NWAVES) {
                    const int row = bid * rpb + i; if (row >= NT) break;
                    const int ti = ((const int*)(ws + WS_TOPI))[row]; const int e1 = ti & 255, e2 = ti >> 8;
                    int s1 = 0, s2 = 0;
                    if (lane == 0) { s1 = sh[16 + e1] + sh[8 + e1] + atomicAdd((int*)&sh[24 + e1], 1); s2 = sh[16 + e2] + sh[8 + e2] + atomicAdd((int*)&sh[24 + e2], 1); ROWINFO[s1] = row * 2; ROWINFO[s2] = row * 2 + 1; }
                    s1 = __builtin_amdgcn_readfirstlane(s1); s2 = __builtin_amdgcn_readfirstlane(s2);
                    const f32x4* xr = (const f32x4*)(X + (size_t)row * DM);
#pragma unroll
                    for (int j = 0; j < 4; ++j) { const f32x4 v = xr[64 * j + lane]; u32x2 w; w.x = cvt_pk_bf16(v[0], v[1]); w.y = cvt_pk_bf16(v[2], v[3]);
                        ((u32x2*)(XS + (size_t)s1 * DM))[64 * j + lane] = w; ((u32x2*)(XS + (size_t)s2 * DM))[64 * j + lane] = w; }
                }
            }
            SEAM(pb + 7, 11);
            for (int c = 0; c < MAXCHUNK; ++c) {
                if (EN(12) && IN(pb + 8 + 2 * c)) { PHASE_IDS(); int* META = (int*)(ws + WS_CTL + CW_META); int* PANELE = (int*)(ws + WS_CTL + CW_PANELE); int* ROWINFO = (int*)(ws + WS_ROWINFO); bf16* XS = (bf16*)(ws + WS_XS); (void)META; (void)PANELE; (void)ROWINFO; (void)XS;
                    const int P = META[0], nch = META[1];
                    if (c < nch) { const int p0 = (int)((long)c * P / nch), p1 = (int)((long)(c + 1) * P / nch);
                        pg8::Gemm g{XS + (size_t)p0 * 256 * DM, (const bf16*)(ws + WS_MGU), (p1 - p0) * 256, 2 * FFE, DM, (size_t)2 * FFE * DM, 0, nullptr, 0};
                        pg8::StaticOrder S; S.init((p1 - p0) * 256, 2 * FFE, G, bid, PANELE + p0); EpiSwiglu E{(bf16*)(ws + WS_HM), FFE};
                        pg8::gemm_phase<EpiSwiglu, pg8::StaticOrder>(lds, g, S, E, wave_s); }
                }
                SEAM(pb + 8 + 2 * c, 12);
                if (EN(13) && IN(pb + 9 + 2 * c)) { PHASE_IDS(); int* META = (int*)(ws + WS_CTL + CW_META); int* PANELE = (int*)(ws + WS_CTL + CW_PANELE); int* ROWINFO = (int*)(ws + WS_ROWINFO); bf16* XS = (bf16*)(ws + WS_XS); (void)META; (void)PANELE; (void)ROWINFO; (void)XS;
                    const int P = META[0], nch = META[1];
                    if (c < nch) { const int p0 = (int)((long)c * P / nch), p1 = (int)((long)(c + 1) * P / nch);
                        pg8::Gemm g{(const bf16*)(ws + WS_HM), (const bf16*)(ws + WS_MDN), (p1 - p0) * 256, DM, FFE, (size_t)DM * FFE, 0, nullptr, 0};
                        pg8::StaticOrder S; S.init((p1 - p0) * 256, DM, G, bid, PANELE + p0); EpiScatter E{(bf16*)(ws + WS_YM), ROWINFO + p0 * 256};
                        pg8::gemm_phase<EpiScatter, pg8::StaticOrder>(lds, g, S, E, wave_s); }
                }
                if (PROBE_GRP >= 0 && c == MAXCHUNK - 1) { PMARK(13); if (bid == 0 && wave_s == 0 && lane_id() == 0) *(unsigned long long*)(ws0 + WS_CTL + CW_PROBE) = pr_acc; }
                SEAM(pb + 9 + 2 * c, 13);
            }
            if (EN(14) && IN(pb + 8 + 2 * MAXCHUNK)) { PHASE_IDS();
                const float* gam = ap->in[13] + DM; const float* bet = ap->in[14] + DM;
                const bf16* YM = (const bf16*)(ws + WS_YM); const float* TG = (const float*)(ws + WS_TOPG);
                const float pscale = 1.f;
                for (int row = gwave; row < NT; row += nwaves) {
                    f32x4* xr = (f32x4*)(X + (size_t)row * DM);
                    const float g1 = TG[row * 2], g2 = TG[row * 2 + 1];
                    const u32x2* y1 = (const u32x2*)(YM + (size_t)(row * 2) * DM); const u32x2* y2 = (const u32x2*)(YM + (size_t)(row * 2 + 1) * DM);
                    f32x4 v[4]; float s = 0.f;
#pragma unroll
                    for (int j = 0; j < 4; ++j) { const f32x4 xv = xr[64 * j + lane]; const u32x2 a = y1[64 * j + lane], bq = y2[64 * j + lane];
                        v[j][0] = xv[0] * DN_ALPHA + g1 * bflo(a.x) + g2 * bflo(bq.x); v[j][1] = xv[1] * DN_ALPHA + g1 * bfhi(a.x) + g2 * bfhi(bq.x);
                        v[j][2] = xv[2] * DN_ALPHA + g1 * bflo(a.y) + g2 * bflo(bq.y); v[j][3] = xv[3] * DN_ALPHA + g1 * bfhi(a.y) + g2 * bfhi(bq.y);
                        s += (v[j][0] + v[j][1]) + (v[j][2] + v[j][3]); }
                    const float mean = wave_sum(s) * (1.f / DM); float s2 = 0.f;
#pragma unroll
                    for (int j = 0; j < 4; ++j) { v[j] = v[j] - mean; s2 += (v[j][0] * v[j][0] + v[j][1] * v[j][1]) + (v[j][2] * v[j][2] + v[j][3] * v[j][3]); }
                    const float rstd = rsqrtf(wave_sum(s2) * (1.f / DM) + 1e-5f);
#pragma unroll
                    for (int j = 0; j < 4; ++j) { const f32x4 gq = ((const f32x4*)gam)[64 * j + lane], bq = ((const f32x4*)bet)[64 * j + lane]; xr[64 * j + lane] = (v[j] * rstd * gq + bq) * pscale; }
                }
#if PROBE_GRP >= 0
                {
                    const unsigned long long dt = *(const unsigned long long*)(ws + WS_CTL + CW_PROBE) * (unsigned long long)PROBE_K;
                    const unsigned long long t0 = __builtin_amdgcn_s_memrealtime();
                    while (__builtin_amdgcn_s_memrealtime() - t0 < dt) __builtin_amdgcn_s_sleep(8);
                }
#endif
            }
        }
    }
#undef IN
#undef SEAM
}

constexpr int NPHASES = 1 + 10 + 8 + 2 * MAXCHUNK + 1;

extern "C" void kernel_launch(void* const* d_in, const int* in_sizes, int n_in, void* d_out, int out_size, void* d_ws, size_t ws_size, hipStream_t stream) {
    static int grid = 0;
    if (grid == 0) {
        if (n_in != 22 || out_size != NT * DM || ws_size < WS_END) { fprintf(stderr, "kernel_launch: need 22 inputs, %d outputs, >= %zu bytes of workspace; got %d, %d, %zu\n", NT * DM, (size_t)WS_END, n_in, out_size, ws_size); grid = -1; return; }
        int dev = 0, cus = 0, per_cu = 0;
        if (hipGetDevice(&dev) != hipSuccess || hipDeviceGetAttribute(&cus, hipDeviceAttributeMultiprocessorCount, dev) != hipSuccess) { grid = -1; return; }
        if (hipFuncSetAttribute((const void*)mega_fwd, hipFuncAttributeMaxDynamicSharedMemorySize, LDS_BYTES) != hipSuccess) { fprintf(stderr, "kernel_launch: hipFuncSetAttribute failed\n"); grid = -1; return; }
        if (hipOccupancyMaxActiveBlocksPerMultiprocessor(&per_cu, (const void*)mega_fwd, NTHR, LDS_BYTES) != hipSuccess || per_cu < 1) fprintf(stderr, "kernel_launch: occupancy query reports %d\n", per_cu);
        (void)hipGetLastError();
        grid = cus > 256 ? 256 : cus;
    }
    if (grid < 0) return;
    (void)hipMemsetAsync((char*)d_ws + WS_CTL, 0, CTL_BYTES, stream);
    Args a{};
    for (int i = 0; i < 22; ++i) a.in[i] = (const float*)d_in[i];
    a.out = (float*)d_out; a.ws = (unsigned char*)d_ws;
#if ONE_LAUNCH
    a.ph_lo = 0; a.ph_hi = NPHASES;
    hipLaunchKernelGGL(mega_fwd, dim3(grid), dim3(NTHR), LDS_BYTES, stream, a);
#else
    for (int p = 0; p < NPHASES; ++p) { a.ph_lo = p; a.ph_hi = p + 1; hipLaunchKernelGGL(mega_fwd, dim3(grid), dim3(NTHR), LDS_BYTES, stream, a); }
#endif
}
```
